# Optimizing an MI355X kernel written in HIP

```python
import math
import jax, jax.numpy as jnp
from jax import lax
import numpy as np

D_MODEL = 1024
BATCH = 8
SEQ = 2048
DEPTH = 2

GRID_W = 64
NA_HEADS = 8
NA_HEAD_DIM = 64
NA_WIN_ROWS = 8
NA_WIN_COLS = 16
NA_WIDTH = NA_HEADS * NA_HEAD_DIM
DIFF_HEADS = 4
DIFF_QK_DIM = 64
DIFF_V_DIM = 2 * DIFF_QK_DIM
DIFF_QK_WIDTH = DIFF_HEADS * 2 * DIFF_QK_DIM
DIFF_V_WIDTH = DIFF_HEADS * DIFF_V_DIM
Q_BLOCK = 128
T5_BUCKETS = 32
T5_MAX_DIST = 128
D_FF = 4 * D_MODEL
N_GATES = 2
W_IN_COLS = 3 * NA_WIDTH + 2 * DIFF_QK_WIDTH + DIFF_V_WIDTH + N_GATES * D_MODEL
RMS_EPS = 1e-6
NEG_INF = -1e30

kernel_name = "hybrid_na_diffattn_gated_encoder"


def rmsnorm(x, g):
    xf = x.astype(jnp.float32)
    y = xf * lax.rsqrt(jnp.mean(xf * xf, axis=-1, keepdims=True) + RMS_EPS)
    return (y * g.astype(jnp.float32)).astype(x.dtype)


def t5_bucket(rel):
    half = T5_BUCKETS // 2
    max_exact = half // 2
    ret = jnp.where(rel > 0, half, 0)
    n = jnp.abs(rel)
    nf = jnp.maximum(n, 1).astype(jnp.float32)
    large = max_exact + (jnp.log(nf / max_exact) / math.log(T5_MAX_DIST / max_exact)
                         * (half - max_exact)).astype(jnp.int32)
    large = jnp.minimum(large, half - 1)
    return ret + jnp.where(n < max_exact, n, large)


def neighbourhood_attention(q, k, v, rpb):
    B, S, H, dh = q.shape
    rows = S // GRID_W
    wr = min(NA_WIN_ROWS, rows)
    q = q.reshape(B, rows, GRID_W, H, dh)
    k = k.reshape(B, rows, GRID_W, H, dh)
    v = v.reshape(B, rows, GRID_W, H, dh)
    r = jnp.arange(rows)
    r0 = jnp.clip(r - wr // 2, 0, rows - wr)
    row_idx = r0[:, None] + jnp.arange(wr)[None, :]
    kg = k[:, row_idx].reshape(B, rows, wr * GRID_W, H, dh)
    vg = v[:, row_idx].reshape(B, rows, wr * GRID_W, H, dh)
    c = jnp.arange(GRID_W)
    c0 = jnp.clip(c - NA_WIN_COLS // 2, 0, GRID_W - NA_WIN_COLS)
    kc = c[None, :]
    valid = (kc >= c0[:, None]) & (kc < c0[:, None] + NA_WIN_COLS)
    mask = jnp.tile(valid, (1, wr))
    dr = row_idx - r[:, None]
    dc = jnp.clip(kc - c[:, None], -(NA_WIN_COLS - 1), NA_WIN_COLS - 1)
    bias = rpb[:, (dr + NA_WIN_ROWS - 1)[:, :, None, None],
               (dc + NA_WIN_COLS - 1)[None, None, :, :]]
    bias = bias.transpose(0, 1, 3, 2, 4).reshape(H, rows, GRID_W, wr * GRID_W)
    scale = 1.0 / math.sqrt(dh)
    logits = jnp.einsum('brqhd,brkhd->bhrqk', q, kg).astype(jnp.float32) * scale
    logits = logits + bias.astype(jnp.float32)[None]
    logits = jnp.where(mask, logits, NEG_INF)
    p = jax.nn.softmax(logits, axis=-1).astype(v.dtype)
    out = jnp.einsum('bhrqk,brkhd->brqhd', p, vg)
    return out.reshape(B, S, H * dh)


def differential_attention(q1, q2, k1, k2, v, t5_table, lam):
    B, S, H, dk = q1.shape
    nblk = S // Q_BLOCK
    scale = 1.0 / math.sqrt(dk)
    qs = jnp.stack([q1, q2], axis=0).reshape(2, B, nblk, Q_BLOCK, H, dk)
    qs = jnp.moveaxis(qs, 2, 0)
    starts = jnp.arange(nblk, dtype=jnp.int32) * Q_BLOCK
    key_pos = jnp.arange(S, dtype=jnp.int32)

    def block(args):
        qb, start = args
        qpos = start + jnp.arange(Q_BLOCK, dtype=jnp.int32)
        bucket = t5_bucket(key_pos[None, :] - qpos[:, None])
        bias = jnp.transpose(t5_table[bucket], (2, 0, 1)).astype(jnp.float32)
        s1 = jnp.einsum('bqhd,bkhd->bhqk', qb[0], k1).astype(jnp.float32) * scale + bias
        s2 = jnp.einsum('bqhd,bkhd->bhqk', qb[1], k2).astype(jnp.float32) * scale + bias
        p = (jax.nn.softmax(s1, axis=-1) - lam * jax.nn.softmax(s2, axis=-1)).astype(v.dtype)
        return jnp.einsum('bhqk,bkhd->bqhd', p, v)

    out = lax.map(block, (qs, starts))
    return jnp.moveaxis(out, 0, 1).reshape(B, S, H, v.shape[-1])


def setup_inputs(seed: int = 0) -> dict:
    key = jax.random.key(seed)
    ks = jax.random.split(key, 16)
    f32 = jnp.float32

    def nrm(k, shape, s):
        return jax.random.normal(k, shape, f32) * s

    return {
        "x": nrm(ks[0], (BATCH, SEQ, D_MODEL), 1.0),
        "t5_bias": nrm(ks[1], (T5_BUCKETS, DIFF_HEADS), 0.5),
        "final_norm_g": 1.0 + nrm(ks[2], (D_MODEL,), 0.02),
        "norm1_g": 1.0 + nrm(ks[3], (DEPTH, D_MODEL), 0.02),
        "w_in": nrm(ks[4], (DEPTH, D_MODEL, W_IN_COLS), D_MODEL ** -0.5),
        "na_rpb": nrm(ks[5], (DEPTH, NA_HEADS, 2 * NA_WIN_ROWS - 1, 2 * NA_WIN_COLS - 1), 0.2),
        "diff_lambda": nrm(ks[6], (DEPTH, 4, DIFF_QK_DIM), 0.1),
        "diff_subln_g": 1.0 + nrm(ks[7], (DEPTH, DIFF_V_DIM), 0.02),
        "w_na_o": nrm(ks[8], (DEPTH, NA_WIDTH, D_MODEL), NA_WIDTH ** -0.5),
        "w_diff_o": nrm(ks[9], (DEPTH, DIFF_V_WIDTH, D_MODEL), DIFF_V_WIDTH ** -0.5),
        "w_out": nrm(ks[10], (DEPTH, D_MODEL, D_MODEL), D_MODEL ** -0.5),
        "norm2_g": 1.0 + nrm(ks[11], (DEPTH, D_MODEL), 0.02),
        "w_ff1": nrm(ks[12], (DEPTH, D_MODEL, D_FF), D_MODEL ** -0.5),
        "w_ff2": nrm(ks[13], (DEPTH, D_FF, D_MODEL), D_FF ** -0.5),
    }


def reference(x, t5_bias, final_norm_g, norm1_g, w_in, na_rpb, diff_lambda, diff_subln_g,
              w_na_o, w_diff_o, w_out, norm2_g, w_ff1, w_ff2):
    B, S, D = x.shape
    splits = np.cumsum([NA_WIDTH, NA_WIDTH, NA_WIDTH, DIFF_QK_WIDTH, DIFF_QK_WIDTH,
                        DIFF_V_WIDTH, D_MODEL]).tolist()
    for layer in range(DEPTH):
        h = rmsnorm(x, norm1_g[layer])
        proj = jnp.einsum('bsd,de->bse', h, w_in[layer])
        qa, ka, va, qd, kd, vd, ga, gd = jnp.split(proj, splits, axis=-1)

        shp_a = (B, S, NA_HEADS, NA_HEAD_DIM)
        y_na = neighbourhood_attention(qa.reshape(shp_a), ka.reshape(shp_a),
                                       va.reshape(shp_a), na_rpb[layer])

        qd = qd.reshape(B, S, DIFF_HEADS, 2, DIFF_QK_DIM)
        kd = kd.reshape(B, S, DIFF_HEADS, 2, DIFF_QK_DIM)
        vd = vd.reshape(B, S, DIFF_HEADS, DIFF_V_DIM)
        lam_init = 0.8 - 0.6 * math.exp(-0.3 * layer)
        lp = diff_lambda[layer].astype(jnp.float32)
        lam = (jnp.exp(jnp.sum(lp[0] * lp[1])) - jnp.exp(jnp.sum(lp[2] * lp[3]))
               + lam_init)
        od = differential_attention(qd[..., 0, :], qd[..., 1, :], kd[..., 0, :],
                                    kd[..., 1, :], vd, t5_bias, lam)
        od = rmsnorm(od, diff_subln_g[layer]) * (1.0 - lam_init)
        y_diff = od.reshape(B, S, DIFF_V_WIDTH)

        b_na = jnp.einsum('bse,ed->bsd', y_na, w_na_o[layer])
        b_diff = jnp.einsum('bse,ed->bsd', y_diff, w_diff_o[layer])
        merged = jax.nn.sigmoid(ga) * b_na + jax.nn.sigmoid(gd) * b_diff
        x = x + jnp.einsum('bsd,de->bse', merged, w_out[layer])

        h2 = rmsnorm(x, norm2_g[layer])
        u = jnp.square(jax.nn.relu(jnp.einsum('bsd,df->bsf', h2, w_ff1[layer])))
        x = x + jnp.einsum('bsf,fd->bsd', u, w_ff2[layer])
    return rmsnorm(x, final_norm_g)
```

```cpp
#include <hip/hip_runtime.h>
#include <cstdio>
#include <cstdint>

#ifndef DISMASK
#define DISMASK 0
#endif
#define DIS(k) ((DISMASK >> (k)) & 1)
#ifndef MK_PER_PHASE
#define MK_PER_PHASE 1
#endif

#define LAS __attribute__((address_space(3)))
#define GAS __attribute__((address_space(1)))
typedef unsigned short bf16_t;
typedef short bf16x8 __attribute__((ext_vector_type(8)));
typedef short s16x4 __attribute__((ext_vector_type(4)));
typedef float f32x4 __attribute__((ext_vector_type(4)));
typedef float f32x2 __attribute__((ext_vector_type(2)));
typedef float f32x16 __attribute__((ext_vector_type(16)));
typedef unsigned u32x4 __attribute__((ext_vector_type(4)));
typedef unsigned u32x2 __attribute__((ext_vector_type(2)));
typedef __bf16 bf16x2_t __attribute__((ext_vector_type(2)));

constexpr int BATCH = 8, SEQ = 2048, D = 1024, M = BATCH * SEQ, DEPTH = 2, FF = 4096;
constexpr int NQKV = 3072, NGATE = 2048, NIN = 5120;
constexpr float RMS_EPS = 1e-6f;
constexpr float LOG2E = 1.4426950408889634f;
constexpr float C2 = 0.125f * LOG2E;
constexpr int COL_QA = 0, COL_KA = 512, COL_VA = 1024, COL_QD = 1536, COL_KD = 2048, COL_VD = 2560;

__device__ __forceinline__ unsigned cvtpk(float lo, float hi) { f32x2 v = {lo, hi}; bf16x2_t b = __builtin_convertvector(v, bf16x2_t); return __builtin_bit_cast(unsigned, b); }
__device__ __forceinline__ float bf2f(unsigned short u) { return __uint_as_float((unsigned)u << 16); }
__device__ __forceinline__ float bflo(unsigned w) { return __uint_as_float(w << 16); }
__device__ __forceinline__ float bfhi(unsigned w) { return __uint_as_float(w & 0xffff0000u); }

namespace pg8 {
constexpr int BM = 256, BK = 64, HALF = 128, HTB = HALF * BK * 2, STAGE_BYTES = 8 * HTB, NXCD = 8, WGM = 8;
__host__ __device__ __forceinline__ int lds_byte(int r, int c) { const int st = (r >> 4) * 2 + (c >> 5), rr = r & 15, cc = c & 31, ob = rr * 64 + cc * 2; return st * 1024 + (ob ^ (((ob >> 9) & 1) << 5)); }
__host__ __device__ __forceinline__ void stage_rc(int b, int& R, int& C) { const int st = b / 1024, sb = b % 1024, swz = sb ^ (((sb >> 9) & 1) << 5); R = (st >> 1) * 16 + swz / 64; C = (st & 1) * 32 + (swz % 64) / 2; }
__host__ __device__ __forceinline__ int perm32(int rho) { const int n = rho >> 4, i = rho & 15; return 8 * (i >> 2) + 4 * n + (i & 3); }

struct Unit { int pm, pn; };
struct Gemm { const bf16_t* A; const bf16_t* Bt; int M, N, K; };

struct StaticOrder {
    int nM, nN, nwg, G, c;
    __device__ void init(int M_, int N_, int G_, int c_) { nM = M_ / BM; nN = N_ / BM; nwg = nM * nN; G = G_; c = c_; }
    __device__ bool next(int i, Unit& u) const {
        const long L = (long)i * G + c; if (L >= nwg) return false;
        int wgid = (int)L; { const int q = nwg / NXCD, r = nwg % NXCD, xcd = wgid % NXCD, off = wgid / NXCD; wgid = (xcd < r ? xcd * (q + 1) : r * (q + 1) + (xcd - r) * q) + off; }
        const int nig = WGM * nN, gid = wgid / nig, fm = gid * WGM, gsz = (nM - fm) < WGM ? (nM - fm) : WGM;
        u.pm = fm + ((wgid % nig) % gsz); u.pn = (wgid % nig) / gsz; return true;
    }
};

__device__ __forceinline__ float row_rstd(const float* ss, int row) {
    const f32x4* p = (const f32x4*)(ss + (size_t)row * 16);
    const f32x4 a = p[0], b = p[1], c = p[2], d = p[3];
    const float s = ((a[0] + a[1]) + (a[2] + a[3])) + ((b[0] + b[1]) + (b[2] + b[3])) + ((c[0] + c[1]) + (c[2] + c[3])) + ((d[0] + d[1]) + (d[2] + d[3]));
    return 1.0f / sqrtf(s * (1.0f / (float)D) + RMS_EPS);
}

struct EpiProj {
    static constexpr bool PERM = true, HAS_MID = false;
    bf16_t* qkv; bf16_t* gates; const float* ss;
    __device__ __forceinline__ void mid(f32x4 (&acc)[2][2][4][2], const Unit& u, int wr, int wc, int fr, int fq) const {}
    __device__ __forceinline__ void operator()(f32x4 (&acc)[2][2][4][2], const Unit& u, int wr, int wc, int fr, int fq) const {
        const int row0 = u.pm * BM + wr * 64 + fr;
        bf16_t* base; int ldc, colt; float sc = 1.0f;
        if (u.pn < 12) { base = qkv; ldc = NQKV; colt = u.pn * BM; if (u.pn < 2 || u.pn == 6 || u.pn == 7) sc = C2; }
        else { base = gates; ldc = NGATE; colt = (u.pn - 12) * BM; }
        const int col0 = colt + wc * 32 + 8 * fq;
#pragma unroll
        for (int ai = 0; ai < 2; ++ai)
#pragma unroll
            for (int m = 0; m < 4; ++m) { const int row = row0 + ai * HALF + m * 16; const float r = row_rstd(ss, row) * sc; bf16_t* rowp = base + (size_t)row * ldc + col0;
#pragma unroll
                for (int bj = 0; bj < 2; ++bj) { const f32x4 v0 = acc[ai][bj][m][0] * r, v1 = acc[ai][bj][m][1] * r;
                    u32x4 w; w.x = cvtpk(v0[0], v0[1]); w.y = cvtpk(v0[2], v0[3]); w.z = cvtpk(v1[0], v1[1]); w.w = cvtpk(v1[2], v1[3]);
                    *(u32x4*)(rowp + bj * HALF) = w; } }
    }
};
struct EpiFF1 {
    static constexpr bool PERM = true, HAS_MID = false;
    bf16_t* H; const float* ss;
    __device__ __forceinline__ void mid(f32x4 (&acc)[2][2][4][2], const Unit& u, int wr, int wc, int fr, int fq) const {}
    __device__ __forceinline__ void operator()(f32x4 (&acc)[2][2][4][2], const Unit& u, int wr, int wc, int fr, int fq) const {
        const int row0 = u.pm * BM + wr * 64 + fr, col0 = u.pn * BM + wc * 32 + 8 * fq;
#pragma unroll
        for (int ai = 0; ai < 2; ++ai)
#pragma unroll
            for (int m = 0; m < 4; ++m) { const int row = row0 + ai * HALF + m * 16; const float r = row_rstd(ss, row); bf16_t* rowp = H + (size_t)row * FF + col0;
#pragma unroll
                for (int bj = 0; bj < 2; ++bj) { f32x4 v0 = acc[ai][bj][m][0] * r, v1 = acc[ai][bj][m][1] * r;
#pragma unroll
                    for (int e = 0; e < 4; ++e) { const float a = fmaxf(v0[e], 0.f), b = fmaxf(v1[e], 0.f); v0[e] = a * a; v1[e] = b * b; }
                    u32x4 w; w.x = cvtpk(v0[0], v0[1]); w.y = cvtpk(v0[2], v0[3]); w.z = cvtpk(v1[0], v1[1]); w.w = cvtpk(v1[2], v1[3]);
                    *(u32x4*)(rowp + bj * HALF) = w; } }
    }
};
struct EpiMerge {
    static constexpr bool PERM = true, HAS_MID = true;
    bf16_t* O; const bf16_t* gates;
    __device__ __forceinline__ void mid(f32x4 (&acc)[2][2][4][2], const Unit& u, int wr, int wc, int fr, int fq) const {
        const int row0 = u.pm * BM + wr * 64 + fr, col0 = u.pn * BM + wc * 32 + 8 * fq;
        const bf16_t* gp = gates + (size_t)row0 * NGATE + col0;
#pragma unroll
        for (int ai = 0; ai < 2; ++ai)
#pragma unroll
            for (int m = 0; m < 4; ++m) {
                asm volatile("" : "+v"(gp) :: "memory");
#pragma unroll
                for (int bj = 0; bj < 2; ++bj) { const u32x4 ga = *(const GAS u32x4*)(gp + bj * HALF), gd = *(const GAS u32x4*)(gp + 1024 + bj * HALF);
#pragma unroll
                    for (int w = 0; w < 4; ++w) { const float a0 = bflo(ga[w]), a1 = bfhi(ga[w]), d0 = fmaxf(bflo(gd[w]), -80.f), d1 = fmaxf(bfhi(gd[w]), -80.f);
                        const float r0 = (1.f + __expf(-d0)) * __builtin_amdgcn_rcpf(1.f + __expf(-a0)), r1 = (1.f + __expf(-d1)) * __builtin_amdgcn_rcpf(1.f + __expf(-a1));
                        acc[ai][bj][m][w >> 1][(w & 1) * 2] *= r0; acc[ai][bj][m][w >> 1][(w & 1) * 2 + 1] *= r1; } }
                gp += (m == 3 ? (HALF - 48) : 16) * NGATE; }
    }
    __device__ __forceinline__ void operator()(f32x4 (&acc)[2][2][4][2], const Unit& u, int wr, int wc, int fr, int fq) const {
        const int row0 = u.pm * BM + wr * 64 + fr, col0 = u.pn * BM + wc * 32 + 8 * fq;
        const bf16_t* gp = gates + (size_t)row0 * NGATE + 1024 + col0; bf16_t* rowp = O + (size_t)row0 * D + col0;
#pragma unroll
        for (int ai = 0; ai < 2; ++ai)
#pragma unroll
            for (int m = 0; m < 4; ++m) {
                asm volatile("" : "+v"(gp), "+v"(rowp) :: "memory");
#pragma unroll
                for (int bj = 0; bj < 2; ++bj) { const u32x4 gd = *(const GAS u32x4*)(gp + bj * HALF); float o[8];
#pragma unroll
                    for (int w = 0; w < 4; ++w) { const float d0 = fmaxf(bflo(gd[w]), -80.f), d1 = fmaxf(bfhi(gd[w]), -80.f);
                        o[2 * w] = acc[ai][bj][m][w >> 1][(w & 1) * 2] * __builtin_amdgcn_rcpf(1.f + __expf(-d0)); o[2 * w + 1] = acc[ai][bj][m][w >> 1][(w & 1) * 2 + 1] * __builtin_amdgcn_rcpf(1.f + __expf(-d1)); }
                    u32x4 w4; w4.x = cvtpk(o[0], o[1]); w4.y = cvtpk(o[2], o[3]); w4.z = cvtpk(o[4], o[5]); w4.w = cvtpk(o[6], o[7]);
                    *(GAS u32x4*)(rowp + bj * HALF) = w4; }
                gp += (m == 3 ? (HALF - 48) : 16) * NGATE; rowp += (m == 3 ? (HALF - 48) : 16) * D; }
    }
};
struct EpiResid {
    static constexpr bool PERM = true, HAS_MID = false;
    const float* xin; float* xout; bf16_t* xn; const float* g; float* ss;
    __device__ __forceinline__ void mid(f32x4 (&acc)[2][2][4][2], const Unit& u, int wr, int wc, int fr, int fq) const {}
    __device__ __forceinline__ void operator()(f32x4 (&acc)[2][2][4][2], const Unit& u, int wr, int wc, int fr, int fq) const {
        const int row0 = u.pm * BM + wr * 64 + fr, col0 = u.pn * BM + wc * 32 + 8 * fq;
        f32x4 gv[2][2];
#pragma unroll
        for (int bj = 0; bj < 2; ++bj)
#pragma unroll
            for (int n = 0; n < 2; ++n) gv[bj][n] = xn ? *(const f32x4*)(g + col0 + bj * HALF + 4 * n) : (f32x4){0.f, 0.f, 0.f, 0.f};
#pragma unroll
        for (int ai = 0; ai < 2; ++ai)
#pragma unroll
            for (int m = 0; m < 4; ++m) { const int row = row0 + ai * HALF + m * 16; const size_t off = (size_t)row * D + col0; float q = 0.f;
#pragma unroll
                for (int bj = 0; bj < 2; ++bj) { const f32x4 x0 = *(const f32x4*)(xin + off + bj * HALF), x1 = *(const f32x4*)(xin + off + bj * HALF + 4);
                    const f32x4 y0 = x0 + acc[ai][bj][m][0], y1 = x1 + acc[ai][bj][m][1];
                    *(f32x4*)(xout + off + bj * HALF) = y0; *(f32x4*)(xout + off + bj * HALF + 4) = y1;
                    q += (y0[0] * y0[0] + y0[1] * y0[1]) + (y0[2] * y0[2] + y0[3] * y0[3]) + (y1[0] * y1[0] + y1[1] * y1[1]) + (y1[2] * y1[2] + y1[3] * y1[3]);
                    if (xn) { const f32x4 a = y0 * gv[bj][0], b = y1 * gv[bj][1]; u32x4 w; w.x = cvtpk(a[0], a[1]); w.y = cvtpk(a[2], a[3]); w.z = cvtpk(b[0], b[1]); w.w = cvtpk(b[2], b[3]);
                        *(u32x4*)(xn + off + bj * HALF) = w; } }
                q += __shfl_xor(q, 16); q += __shfl_xor(q, 32);
                if (fq == 0) ss[(size_t)row * 16 + u.pn * 4 + wc] = q; }
    }
};

template <class Epi, class Sched, bool ALIGN_EPI, bool SP2>
__device__ __forceinline__ void gemm_phase(LAS unsigned char* lds, const Gemm g, const Sched& S, const Epi& E) {
    int tid_ = threadIdx.x; asm volatile("" : "+v"(tid_));
    const int tid = tid_, wid = __builtin_amdgcn_readfirstlane(tid >> 6), lane = tid & 63, wr = wid >> 2, wc = wid & 3, fr = lane & 15, fq = lane >> 4;
    const int K = g.K, nt = K / BK;
    unsigned voffA[2], voffB[2];
#pragma unroll
    for (int i = 0; i < 2; ++i) { int R, C; stage_rc(tid * 16 + i * 8192, R, C); const int Rb = Epi::PERM ? ((R & ~31) + perm32(R & 31)) : R;
        voffA[i] = (unsigned)(R * K + C) * 2u; voffB[i] = (unsigned)(Rb * K + C) * 2u; }
    const size_t kstep = (size_t)(BK * 2);
    const size_t hstep = (size_t)HALF * K * 2;
    const size_t tstep = 2 * hstep;
    const unsigned ldsw = (unsigned)wid * 1024u;
    const int aoff = lds_byte(wr * 64 + fr, fq * 8), boff = lds_byte(wc * 32 + fr, fq * 8);
#define PG8_SA(b, h) (((b) * 2 + (h)) * HTB)
#define PG8_SB(b, h) ((4 + (b) * 2 + (h)) * HTB)
#define PG8_STAGE(bufoff, gbase, voff) do { _Pragma("unroll") for (int _i = 0; _i < 2; ++_i) \
        __builtin_amdgcn_global_load_lds((const unsigned*)((const char*)(gbase) + (voff)[_i]), (LAS unsigned*)(lds + (bufoff) + ldsw + _i * 8192), 16, 0, 0); } while (0)
#define PG8_LDA(dst, b, h) do { _Pragma("unroll") for (int m = 0; m < 4; ++m) _Pragma("unroll") for (int k = 0; k < 2; ++k) dst[m][k] = *(const LAS bf16x8*)(lds + PG8_SA(b, h) + aoff + m * 2048 + k * 1024); } while (0)
#define PG8_LDB(dst, b, h) do { _Pragma("unroll") for (int n = 0; n < 2; ++n) _Pragma("unroll") for (int k = 0; k < 2; ++k) dst[n][k] = *(const LAS bf16x8*)(lds + PG8_SB(b, h) + boff + n * 2048 + k * 1024); } while (0)
#define PG8_MMA(ai, bj, At, Bt) do { __builtin_amdgcn_s_setprio(1); _Pragma("unroll") for (int m = 0; m < 4; ++m) _Pragma("unroll") for (int n = 0; n < 2; ++n) _Pragma("unroll") for (int k = 0; k < 2; ++k) \
        acc[ai][bj][m][n] = __builtin_amdgcn_mfma_f32_16x16x32_bf16(Bt[n][k], At[m][k], acc[ai][bj][m][n], 0, 0, 0); __builtin_amdgcn_s_setprio(0); } while (0)
#define PG8_WAIT_V(n) asm volatile("s_waitcnt vmcnt(" #n ")" ::: "memory")
#define PG8_WAIT_L(n) asm volatile("s_waitcnt lgkmcnt(" #n ")" ::: "memory")
#define PG8_BAR __builtin_amdgcn_s_barrier()
#define PG8_SCHED __builtin_amdgcn_sched_barrier(0)
    Unit cur, nxt; int ui = 0;
    if (!S.next(0, cur)) return;
    f32x4 acc[2][2][4][2];
#pragma unroll
    for (int a = 0; a < 2; ++a)
#pragma unroll
        for (int b = 0; b < 2; ++b)
#pragma unroll
            for (int m = 0; m < 4; ++m)
#pragma unroll
                for (int n = 0; n < 2; ++n) acc[a][b][m][n] = (f32x4){0.f, 0.f, 0.f, 0.f};
    bf16x8 At[4][2], B0[2][2], B1[2][2];
    const char* cA = (const char*)g.A + (size_t)cur.pm * tstep; const char* cB = (const char*)g.Bt + (size_t)cur.pn * tstep;
    if constexpr (SP2) {
        PG8_STAGE(PG8_SB(0, 0), cB, voffB); PG8_STAGE(PG8_SB(0, 1), cB + hstep, voffB); PG8_STAGE(PG8_SA(0, 0), cA, voffA); PG8_STAGE(PG8_SA(0, 1), cA + hstep, voffA);
        if (wr == 1) PG8_BAR;
        PG8_WAIT_V(2); PG8_BAR;
        PG8_STAGE(PG8_SB(1, 0), cB + kstep, voffB); PG8_STAGE(PG8_SA(1, 0), cA + kstep, voffA); PG8_STAGE(PG8_SB(1, 1), cB + hstep + kstep, voffB);
        PG8_WAIT_V(6); PG8_BAR;
    } else {
        PG8_STAGE(PG8_SB(0, 0), cB, voffB); PG8_STAGE(PG8_SA(0, 0), cA, voffA); PG8_STAGE(PG8_SB(0, 1), cB + hstep, voffB); PG8_STAGE(PG8_SA(0, 1), cA + hstep, voffA);
        if (wr == 1) PG8_BAR;
        PG8_WAIT_V(4); PG8_BAR;
        PG8_STAGE(PG8_SB(1, 0), cB + kstep, voffB); PG8_STAGE(PG8_SA(1, 0), cA + kstep, voffA); PG8_STAGE(PG8_SB(1, 1), cB + hstep + kstep, voffB);
        PG8_WAIT_V(6); PG8_BAR;
    }
    for (;;) {
        const bool has_next = S.next(ui + 1, nxt);
        const char* nA = has_next ? (const char*)g.A + (size_t)nxt.pm * tstep : cA; const char* nB = has_next ? (const char*)g.Bt + (size_t)nxt.pn * tstep : cB;
        for (int t = 0; t < nt; t += 2) {
            if constexpr (Epi::HAS_MID) { if (t == nt / 2) E.mid(acc, cur, wr, wc, fr, fq); }
            const bool last = (t == nt - 2);
            const char* a1 = cA + (size_t)(t + 1) * kstep;
            const char* a2 = last ? nA : cA + (size_t)(t + 2) * kstep; const char* b2 = last ? nB : cB + (size_t)(t + 2) * kstep;
            const char* a3 = a2 + kstep; const char* b3 = b2 + kstep;
            if constexpr (SP2) {
            PG8_LDB(B0, 0, 0); PG8_LDB(B1, 0, 1); PG8_SCHED; PG8_LDA(At, 0, 0); PG8_STAGE(PG8_SA(1, 1), a1 + hstep, voffA);
            PG8_WAIT_V(8); PG8_WAIT_L(0); PG8_BAR; PG8_MMA(0, 0, At, B0); PG8_MMA(0, 1, At, B1); PG8_BAR; PG8_SCHED;
            PG8_LDA(At, 0, 1); PG8_STAGE(PG8_SB(0, 0), b2, voffB); PG8_STAGE(PG8_SB(0, 1), b2 + hstep, voffB); PG8_STAGE(PG8_SA(0, 0), a2, voffA);
            PG8_WAIT_V(8); PG8_WAIT_L(0); PG8_BAR; PG8_MMA(1, 0, At, B0); PG8_MMA(1, 1, At, B1); PG8_BAR; PG8_SCHED;
            PG8_LDB(B0, 1, 0); PG8_LDB(B1, 1, 1); PG8_SCHED; PG8_LDA(At, 1, 0); PG8_STAGE(PG8_SA(0, 1), a2 + hstep, voffA);
            PG8_WAIT_V(8); PG8_WAIT_L(0); PG8_BAR; PG8_MMA(0, 0, At, B0); PG8_MMA(0, 1, At, B1); PG8_BAR; PG8_SCHED;
            PG8_LDA(At, 1, 1); PG8_STAGE(PG8_SB(1, 0), b3, voffB); PG8_STAGE(PG8_SB(1, 1), b3 + hstep, voffB); PG8_STAGE(PG8_SA(1, 0), a3, voffA);
            PG8_WAIT_V(8); PG8_WAIT_L(0); PG8_BAR; PG8_MMA(1, 0, At, B0); PG8_MMA(1, 1, At, B1); PG8_BAR; PG8_SCHED;
            } else {
            PG8_LDB(B0, 0, 0); PG8_SCHED; PG8_LDA(At, 0, 0); PG8_STAGE(PG8_SA(1, 1), a1 + hstep, voffA);
            PG8_WAIT_L(8); PG8_BAR; PG8_WAIT_L(0); PG8_MMA(0, 0, At, B0); PG8_BAR; PG8_SCHED;
            PG8_LDB(B1, 0, 1); PG8_STAGE(PG8_SB(0, 0), b2, voffB);
            PG8_BAR; PG8_WAIT_L(0); PG8_MMA(0, 1, At, B1); PG8_BAR;
            PG8_LDA(At, 0, 1); PG8_STAGE(PG8_SA(0, 0), a2, voffA);
            PG8_BAR; PG8_WAIT_L(0); PG8_MMA(1, 0, At, B0); PG8_BAR; PG8_SCHED;
            PG8_STAGE(PG8_SB(0, 1), b2 + hstep, voffB);
            PG8_WAIT_V(6); PG8_BAR; PG8_MMA(1, 1, At, B1); PG8_BAR;
            PG8_LDB(B0, 1, 0); PG8_SCHED; PG8_LDA(At, 1, 0); PG8_STAGE(PG8_SA(0, 1), a2 + hstep, voffA);
            PG8_WAIT_L(8); PG8_BAR; PG8_WAIT_L(0); PG8_MMA(0, 0, At, B0); PG8_BAR; PG8_SCHED;
            PG8_LDB(B1, 1, 1); PG8_STAGE(PG8_SB(1, 0), b3, voffB);
            PG8_BAR; PG8_WAIT_L(0); PG8_MMA(0, 1, At, B1); PG8_BAR;
            PG8_LDA(At, 1, 1); PG8_STAGE(PG8_SA(1, 0), a3, voffA);
            PG8_BAR; PG8_WAIT_L(0); PG8_MMA(1, 0, At, B0); PG8_BAR; PG8_SCHED;
            PG8_STAGE(PG8_SB(1, 1), b3 + hstep, voffB);
            PG8_WAIT_V(6); PG8_BAR; PG8_MMA(1, 1, At, B1); PG8_BAR;
            }
        }
        if constexpr (ALIGN_EPI) { if (wr == 0) PG8_BAR; }
        E(acc, cur, wr, wc, fr, fq);
        if (!has_next) break;
#pragma unroll
        for (int a = 0; a < 2; ++a)
#pragma unroll
            for (int b = 0; b < 2; ++b)
#pragma unroll
                for (int m = 0; m < 4; ++m)
#pragma unroll
                    for (int n = 0; n < 2; ++n) acc[a][b][m][n] = (f32x4){0.f, 0.f, 0.f, 0.f};
        cur = nxt; cA = nA; cB = nB; ++ui;
        if constexpr (ALIGN_EPI) { if (wr == 1) PG8_BAR; }
    }
    PG8_WAIT_V(0);
    if constexpr (!ALIGN_EPI) { if (wr == 0) PG8_BAR; }
    PG8_BAR;
#undef PG8_SA
#undef PG8_SB
#undef PG8_STAGE
#undef PG8_LDA
#undef PG8_LDB
#undef PG8_MMA
#undef PG8_WAIT_V
#undef PG8_WAIT_L
#undef PG8_BAR
#undef PG8_SCHED
}
}

constexpr size_t MiB = 1u << 20;
constexpr size_t WS_CTL = 0, CTL_ZERO_BYTES = 64 * 1024;
constexpr size_t WS_SS = 1 * MiB;
constexpr size_t WS_W = 2 * MiB, W_LAYER = 30 * MiB;
constexpr size_t WO_IN = 0, WO_M = 10 * MiB, WO_OUT = 12 * MiB, WO_FF1 = 14 * MiB, WO_FF2 = 22 * MiB;
constexpr size_t WS_XNY = 62 * MiB;
constexpr size_t WS_QKV = 94 * MiB;
constexpr size_t WS_GATES = 190 * MiB;
constexpr size_t WS_MERGED = WS_QKV;
constexpr size_t WS_H = WS_QKV;
constexpr size_t WS_END = 254 * MiB;
constexpr int CW_BAR = 1024;

constexpr int RING_OFF = 0, RING_BYTES = 131072;
constexpr int ATT_WSF = 131072;
constexpr int ATT_TBL = ATT_WSF + 4096;
constexpr int LDSCTL_OFF = ATT_TBL + 4096, MISC_OFF = LDSCTL_OFF + 320;
constexpr int LDS_BYTES = 147456;
static_assert(MISC_OFF + 128 <= LDS_BYTES, "LDS map");
constexpr int NWAVES = 8;

#define RLX_AGENT __ATOMIC_RELAXED, __HIP_MEMORY_SCOPE_AGENT
#define LDS_WAIT() asm volatile("s_waitcnt lgkmcnt(0)" ::: "memory")
#define VM_WAIT() asm volatile("s_waitcnt vmcnt(0)" ::: "memory")

#define XB_TMO      128
#define XB_XCNT(j)  (256  + 64 * (j))
#define XB_XSUB(j)  (1280 + 64 * (j))
#define XB_XGEN(j)  (2304 + 64 * (j))
#define XB_TOP      3328
#define XB_TOPGEN   3392
#define XCD_BAR_WORDS 3456
#define XB_SPIN_CAP (1u << 18)
__device__ __forceinline__ unsigned xb_ld(unsigned* p)              { return __hip_atomic_load(p, __ATOMIC_RELAXED, __HIP_MEMORY_SCOPE_AGENT); }
__device__ __forceinline__ unsigned xb_add(unsigned* p, unsigned v) { return __hip_atomic_fetch_add(p, v, __ATOMIC_RELAXED, __HIP_MEMORY_SCOPE_AGENT); }
__device__ __forceinline__ unsigned xb_xcc_id() { return (unsigned)__builtin_amdgcn_s_getreg((3 << 11) | 20) & 0xFu; }
#define XB_SPIN(cond, bar) do { unsigned _sp = 0; while (cond) { __builtin_amdgcn_s_sleep(1); \
    if ((++_sp & 255u) == 0u) { if (xb_ld(&(bar)[XB_TMO])) break; if (_sp > XB_SPIN_CAP) { atomicAdd(&(bar)[XB_TMO], 1u); break; } } } } while (0)
struct XcdBarrier { unsigned* bar; unsigned x; volatile LAS unsigned* st; };
__device__ __forceinline__ XcdBarrier xcd_barrier_post(unsigned* bar, volatile LAS unsigned* st) {
    XcdBarrier b; b.bar = bar; b.x = xb_xcc_id(); b.st = st;
    if (threadIdx.x == 0) (void)xb_add(&bar[XB_XCNT(b.x)], 1u);
    return b;
}
__device__ __forceinline__ void xcd_barrier_complete(unsigned* bar, unsigned x, unsigned& nloc, unsigned& nx) {
    const unsigned G = gridDim.x * gridDim.y * gridDim.z;
    unsigned sum, cnt, mine, sp = 0u;
    for (;;) {
        sum = 0u; cnt = 0u; mine = 0u;
#pragma unroll
        for (unsigned j = 0; j < 16; ++j) { const unsigned c = xb_ld(&bar[XB_XCNT(j)]); sum += c; cnt += (c > 0u) ? 1u : 0u; mine = (j == x) ? c : mine; }
        if (sum == G) break;
        __builtin_amdgcn_s_sleep(1);
        if ((++sp & 255u) == 0u) { if (xb_ld(&bar[XB_TMO])) break; if (sp > XB_SPIN_CAP) { atomicAdd(&bar[XB_TMO], 1u); break; } }
    }
    nloc = mine > 0u ? mine : 1u; nx = cnt > 0u ? cnt : 1u;
}
__device__ __forceinline__ void xcd_barrier(const XcdBarrier& b) {
    asm volatile("s_waitcnt vmcnt(0)" ::: "memory");
    __syncthreads();
    if (threadIdx.x == 0) {
        unsigned* bar = b.bar;
        __builtin_amdgcn_s_waitcnt(0);
        unsigned nloc = b.st[0], nx = b.st[1];
        if (nloc == 0u) { xcd_barrier_complete(bar, b.x, nloc, nx); b.st[0] = nloc; b.st[1] = nx; }
        const unsigned old = xb_add(&bar[XB_XSUB(b.x)], 1u);
        const unsigned gen = old / nloc;
        if (old + 1u == (gen + 1u) * nloc) {
            __builtin_amdgcn_fence(__ATOMIC_RELEASE, "agent");
            asm volatile("s_waitcnt vmcnt(0)" ::: "memory");
            const unsigned og = xb_add(&bar[XB_TOP], 1u);
            const unsigned tg = og / nx;
            if (og + 1u == (tg + 1u) * nx) xb_add(&bar[XB_TOPGEN], 1u);
            else XB_SPIN(xb_ld(&bar[XB_TOPGEN]) == tg, bar);
            __builtin_amdgcn_fence(__ATOMIC_ACQUIRE, "agent");
            xb_add(&bar[XB_XGEN(b.x)], 1u);
            asm volatile("s_waitcnt vmcnt(0)" ::: "memory");
        } else {
            XB_SPIN(xb_ld(&bar[XB_XGEN(b.x)]) == gen, bar);
            __builtin_amdgcn_fence(__ATOMIC_ACQUIRE, "agent");
            asm volatile("s_waitcnt vmcnt(0)" ::: "memory");
        }
    }
    __syncthreads();
}

struct Frame {
    LAS unsigned char* lds;
    int tid, lane, wave, vcu, G;
    const float* in[14]; float* out; unsigned char* ws;
};

__device__ __forceinline__ float wave_sum(float v) {
#pragma unroll
    for (int o = 1; o < 64; o <<= 1) v += __shfl_xor(v, o);
    return v;
}
__device__ __forceinline__ void p0_transpose_item(const float* W, int N, bf16_t* WT, int ldk, int koff, LAS float* scr, int item, int lane) {
    const int nblk = N / 32, kb = item / nblk, nb = item % nblk, k0 = 64 * kb, n0 = 32 * nb;
#pragma unroll 8
    for (int i = 0; i < 32; ++i) { const int kk = 2 * i + (lane >> 5); scr[kk * 33 + (lane & 31)] = W[(size_t)(k0 + kk) * N + n0 + (lane & 31)]; }
    LDS_WAIT(); asm volatile("" ::: "memory");
    const int c = lane & 7;
#pragma unroll
    for (int j = 0; j < 4; ++j) { const int n = (lane >> 3) + 8 * j; const LAS float* s = scr + (8 * c) * 33 + n;
        u32x4 o; o.x = cvtpk(s[0 * 33], s[1 * 33]); o.y = cvtpk(s[2 * 33], s[3 * 33]); o.z = cvtpk(s[4 * 33], s[5 * 33]); o.w = cvtpk(s[6 * 33], s[7 * 33]);
        *(u32x4*)(WT + (size_t)(n0 + n) * ldk + koff + k0 + 8 * c) = o; }
    LDS_WAIT(); asm volatile("" ::: "memory");
}
__device__ __forceinline__ void p0_prologue(Frame& F) {
    LAS float* scr = (LAS float*)(F.lds + RING_OFF + F.wave * 16384);
    const int gw = F.vcu * NWAVES + F.wave, NGW = F.G * NWAVES;
    constexpr int I_IN = (D / 64) * (NIN / 32), I_B = (512 / 64) * (D / 32), I_O = (D / 64) * (D / 32), I_1 = (D / 64) * (FF / 32), I_2 = (FF / 64) * (D / 32);
    constexpr int NL = I_IN + 2 * I_B + I_O + I_1 + I_2, NITEMS = DEPTH * NL;
    for (int it = gw; it < NITEMS; it += NGW) {
        const int L = it / NL; int r = it % NL;
        unsigned char* wb = F.ws + WS_W + (size_t)L * W_LAYER;
        if (r < I_IN) { p0_transpose_item(F.in[4] + (size_t)L * D * NIN, NIN, (bf16_t*)(wb + WO_IN), D, 0, scr, r, F.lane); continue; } r -= I_IN;
        if (r < I_B) { p0_transpose_item(F.in[8] + (size_t)L * 512 * D, D, (bf16_t*)(wb + WO_M), D, 0, scr, r, F.lane); continue; } r -= I_B;
        if (r < I_B) { p0_transpose_item(F.in[9] + (size_t)L * 512 * D, D, (bf16_t*)(wb + WO_M), D, 512, scr, r, F.lane); continue; } r -= I_B;
        if (r < I_O) { p0_transpose_item(F.in[10] + (size_t)L * D * D, D, (bf16_t*)(wb + WO_OUT), D, 0, scr, r, F.lane); continue; } r -= I_O;
        if (r < I_1) { p0_transpose_item(F.in[12] + (size_t)L * D * FF, FF, (bf16_t*)(wb + WO_FF1), D, 0, scr, r, F.lane); continue; } r -= I_1;
        p0_transpose_item(F.in[13] + (size_t)L * FF * D, D, (bf16_t*)(wb + WO_FF2), FF, 0, scr, r, F.lane);
    }
    const float* x = F.in[0]; const float* g = F.in[3]; bf16_t* XN = (bf16_t*)(F.ws + WS_XNY); float* SS = (float*)(F.ws + WS_SS);
    for (int m = gw; m < M; m += NGW) {
        const f32x4* xr = (const f32x4*)(x + (size_t)m * D) + F.lane; const f32x4* gr = (const f32x4*)g + F.lane;
        u32x2* o8 = (u32x2*)(XN + (size_t)m * D) + F.lane; float s = 0.f;
#pragma unroll
        for (int j = 0; j < 4; ++j) { const f32x4 v = xr[64 * j], gg = gr[64 * j]; s += (v[0] * v[0] + v[1] * v[1]) + (v[2] * v[2] + v[3] * v[3]);
            u32x2 w; w.x = cvtpk(v[0] * gg[0], v[1] * gg[1]); w.y = cvtpk(v[2] * gg[2], v[3] * gg[3]); o8[64 * j] = w; }
        s = wave_sum(s);
        if (F.lane < 16) SS[(size_t)m * 16 + F.lane] = (F.lane == 0) ? s : 0.f;
    }
}
__device__ __forceinline__ void final_norm(Frame& F) {
    const int gw = F.vcu * NWAVES + F.wave, NGW = F.G * NWAVES;
    const float* g = F.in[2]; const float* SS = (const float*)(F.ws + WS_SS);
    for (int m = gw; m < M; m += NGW) {
        const float r = pg8::row_rstd(SS, m);
        f32x4* xr = (f32x4*)(F.out + (size_t)m * D) + F.lane; const f32x4* gr = (const f32x4*)g + F.lane;
#pragma unroll
        for (int j = 0; j < 4; ++j) { const f32x4 v = xr[64 * j], gg = gr[64 * j]; xr[64 * j] = v * r * gg; }
    }
}

namespace att {
typedef LAS const char* lcp;
__device__ __forceinline__ int crow(int r, int hi) { return (r & 3) + 8 * (r >> 2) + 4 * hi; }
typedef short v4i16_t __attribute__((ext_vector_type(4)));
__device__ __forceinline__ s16x4 vtr(lcp p) { return __builtin_bit_cast(s16x4, __builtin_amdgcn_ds_read_tr16_b64_v4i16((LAS v4i16_t*)p)); }
#define MFMA32(a, b, c) __builtin_amdgcn_mfma_f32_32x32x16_bf16(a, b, c, 0, 0, 0)
#define ATT_WAIT_BAR() asm volatile("s_waitcnt vmcnt(0) lgkmcnt(0)\n\ts_barrier" ::: "memory")
#define GLDS16(gsrc, ldsdst) __builtin_amdgcn_global_load_lds((const unsigned*)(gsrc), (LAS unsigned*)(ldsdst), 16, 0, 0)

__device__ __forceinline__ void qkt(f32x16& p0, f32x16& p1, lcp kslot, const bf16x8* qr, const f32x16& cinit, int r32, int hi) {
    lcp kb = kslot + hi * 1024 + r32 * 16;
#pragma unroll
    for (int d0 = 0; d0 < 4; ++d0) {
        const bf16x8 b0 = *(const LAS bf16x8*)(kb + d0 * 2048);
        const bf16x8 b1 = *(const LAS bf16x8*)(kb + d0 * 2048 + 512);
        if (d0 == 0) { p0 = MFMA32(b0, qr[0], cinit); p1 = MFMA32(b1, qr[0], cinit); }
        else { p0 = MFMA32(b0, qr[d0], p0); p1 = MFMA32(b1, qr[d0], p1); }
    }
}
__device__ __forceinline__ float rowmax32(const f32x16& p0, const f32x16& p1) {
    float a = fmaxf(p0[0], p1[0]);
#pragma unroll
    for (int r = 1; r < 16; ++r) a = fmaxf(a, fmaxf(p0[r], p1[r]));
    auto rr = __builtin_amdgcn_permlane32_swap(__float_as_uint(a), __float_as_uint(a), false, false);
    return fmaxf(__uint_as_float(rr[0]), __uint_as_float(rr[1]));
}
template <int NB, int THR>
__device__ __forceinline__ void softmax_pv(f32x16& p0, f32x16& p1, f32x16 (&o)[NB], f32x16& negm, float& mhat, float& l, bool first, lcp vb, LAS float* wsf, int r32, int hi) {
    const float rm = rowmax32(p0, p1);
    bool resc = false;
    if (first) {
        mhat += rm;
#pragma unroll
        for (int r = 0; r < 16; ++r) { p0[r] -= rm; p1[r] -= rm; negm[r] = -mhat; }
    } else if (__any(rm > (float)THR)) {
        const float dl = fmaxf(rm, 0.f); mhat += dl;
#pragma unroll
        for (int r = 0; r < 16; ++r) { p0[r] -= dl; p1[r] -= dl; negm[r] = -mhat; }
        const float f = __builtin_amdgcn_exp2f(-dl); l *= f; if (hi == 0) wsf[r32] = f; resc = true;
    }
    float s = 0.f;
#pragma unroll
    for (int r = 0; r < 16; ++r) { p0[r] = __builtin_amdgcn_exp2f(p0[r]); p1[r] = __builtin_amdgcn_exp2f(p1[r]); s += p0[r] + p1[r]; }
    l += s;
    u32x4 pw0, pw1, pw2, pw3;
    pw0 = (u32x4){cvtpk(p0[0], p0[1]), cvtpk(p0[2], p0[3]), cvtpk(p0[4], p0[5]), cvtpk(p0[6], p0[7])};
    pw1 = (u32x4){cvtpk(p0[8], p0[9]), cvtpk(p0[10], p0[11]), cvtpk(p0[12], p0[13]), cvtpk(p0[14], p0[15])};
    pw2 = (u32x4){cvtpk(p1[0], p1[1]), cvtpk(p1[2], p1[3]), cvtpk(p1[4], p1[5]), cvtpk(p1[6], p1[7])};
    pw3 = (u32x4){cvtpk(p1[8], p1[9]), cvtpk(p1[10], p1[11]), cvtpk(p1[12], p1[13]), cvtpk(p1[14], p1[15])};
    if (resc) {
        float fr[16];
#pragma unroll
        for (int r = 0; r < 16; ++r) fr[r] = wsf[crow(r, hi)];
#pragma unroll
        for (int d = 0; d < NB; ++d)
#pragma unroll
            for (int r = 0; r < 16; ++r) o[d][r] *= fr[r];
    }
#pragma unroll
    for (int d0 = 0; d0 < NB; ++d0) {
        s16x4 lo[4], hh[4];
#pragma unroll
        for (int ks = 0; ks < 4; ++ks) { lo[ks] = vtr(vb + d0 * 4096 + ks * 1024); hh[ks] = vtr(vb + d0 * 4096 + ks * 1024 + 512); }
#define ATT_PK(k) (bf16x8){lo[k][0], lo[k][1], lo[k][2], lo[k][3], hh[k][0], hh[k][1], hh[k][2], hh[k][3]}
        o[d0] = MFMA32(__builtin_bit_cast(bf16x8, pw0), ATT_PK(0), o[d0]);
        o[d0] = MFMA32(__builtin_bit_cast(bf16x8, pw1), ATT_PK(1), o[d0]);
        o[d0] = MFMA32(__builtin_bit_cast(bf16x8, pw2), ATT_PK(2), o[d0]);
        o[d0] = MFMA32(__builtin_bit_cast(bf16x8, pw3), ATT_PK(3), o[d0]);
#undef ATT_PK
    }
}
__device__ __forceinline__ void row_inv_l(float l, float (&rli)[16], LAS float* wsf, int r32, int hi) {
    auto rr = __builtin_amdgcn_permlane32_swap(__float_as_uint(l), __float_as_uint(l), false, false);
    const float lt = __uint_as_float(rr[0]) + __uint_as_float(rr[1]);
    if (hi == 0) wsf[32 + r32] = lt;
#pragma unroll
    for (int r = 0; r < 16; ++r) rli[r] = 1.0f / wsf[32 + crow(r, hi)];
}
__device__ __forceinline__ int t5_bucket(int rel) {
    const int n = rel < 0 ? -rel : rel;
    const int large = 8 + (n >= 12) + (n >= 16) + (n >= 23) + (n >= 32) + (n >= 46) + (n >= 64) + (n >= 91);
    return (rel > 0 ? 16 : 0) + (n < 8 ? n : large);
}

template <int THR>
__device__ __forceinline__ void diff_unit(Frame& F, int layer, int bh, int qb) {
    int tid_ = threadIdx.x; asm volatile("" : "+v"(tid_));
    const int tid = tid_, lane = tid & 63, wid = __builtin_amdgcn_readfirstlane(tid >> 6), r32 = lane & 31, hi = lane >> 5;
    const int b = bh >> 2, h = bh & 3, mp = wid >> 2, wq = wid & 3;
    const bf16_t* qkv = (const bf16_t*)(F.ws + WS_QKV);
    bf16_t* Y = (bf16_t*)(F.ws + WS_XNY);
    const size_t tokb = (size_t)b * SEQ;
    LAS unsigned char* lds = F.lds;
    LAS float* wsf = (LAS float*)(lds + ATT_WSF) + wid * 128;
    LAS float* TBL = (LAS float*)(lds + ATT_TBL);
    if (tid < 257) TBL[tid] = F.in[1][t5_bucket(tid - 128) * 4 + h] * LOG2E;
    bf16x8 qr[4];
    { const bf16_t* Qw = qkv + (tokb + qb * 128 + wq * 32 + r32) * NQKV + COL_QD + h * 128 + mp * 64 + hi * 8;
#pragma unroll
      for (int d0 = 0; d0 < 4; ++d0) qr[d0] = *(const bf16x8*)(Qw + d0 * 16); }
    const bf16_t* ksrc = qkv + (tokb + lane) * NQKV + COL_KD + h * 128 + wid * 8;
    const bf16_t* vsrc = qkv + (tokb + 16 * (wid & 3) + (lane >> 2)) * NQKV + COL_VD + h * 128 + (wid >> 2) * 32 + (lane & 3) * 8;
    const int voff = ((lane >> 4) & 1) * 32 + (lane & 3) * 8 + (4 * hi + ((lane & 15) >> 2)) * 64;
#define DIFF_DMA(t, buf) do { const size_t go_ = (size_t)(t) * 64 * NQKV; LAS unsigned char* rb_ = lds + (buf) * 32768 + wid * 1024; \
        GLDS16(ksrc + go_, rb_); GLDS16(ksrc + go_ + 64, rb_ + 8192); GLDS16(vsrc + go_, rb_ + 16384); GLDS16(vsrc + go_ + 64, rb_ + 24576); } while (0)
    f32x16 o[4]; o[0] = f32x16{}; o[1] = f32x16{}; o[2] = f32x16{}; o[3] = f32x16{};
    f32x16 negm = f32x16{}; float mhat = 0.f, l = 0.f;
    const int qw0 = qb * 128 + wq * 32;
    DIFF_DMA(0, 0);
    ATT_WAIT_BAR();
    const float tL = TBL[0], tR = TBL[256];
    constexpr int NT = SEQ / 64;
    for (int t = 0; t < NT; ++t) {
        const int buf = t & 1;
        if (t + 1 < NT) DIFF_DMA(t + 1, buf ^ 1);
        lcp kslot = (lcp)(lds + buf * 32768 + mp * 8192);
        lcp vb = (lcp)(lds + buf * 32768 + 16384 + voff);
        f32x16 p0, p1;
        qkt(p0, p1, kslot, qr, negm, r32, hi);
        const int dk = t * 64 - qw0;
        if (dk >= 122) {
#pragma unroll
            for (int r = 0; r < 16; ++r) { p0[r] += tR; p1[r] += tR; }
        } else if (dk <= -154) {
#pragma unroll
            for (int r = 0; r < 16; ++r) { p0[r] += tL; p1[r] += tL; }
        } else {
            const int base = dk - r32 + 128;
#pragma unroll
            for (int r = 0; r < 16; ++r) {
                int i0 = base + crow(r, hi), i1 = i0 + 32;
                i0 = i0 < 0 ? 0 : (i0 > 256 ? 256 : i0); i1 = i1 < 0 ? 0 : (i1 > 256 ? 256 : i1);
                p0[r] += TBL[i0]; p1[r] += TBL[i1];
            }
        }
        softmax_pv<4, THR>(p0, p1, o, negm, mhat, l, t == 0, vb, wsf, r32, hi);
        ATT_WAIT_BAR();
    }
#undef DIFF_DMA
    float rli[16]; row_inv_l(l, rli, wsf, r32, hi);
#pragma unroll
    for (int d = 0; d < 4; ++d)
#pragma unroll
        for (int r = 0; r < 16; ++r) o[d][r] *= rli[r];
    LAS float* xch = (LAS float*)(lds + 65536) + wq * 4096;
    if (mp == 1) {
#pragma unroll
        for (int d = 0; d < 4; ++d)
#pragma unroll
            for (int r = 0; r < 16; ++r) xch[(d * 16 + r) * 64 + lane] = o[d][r];
    }
    ATT_WAIT_BAR();
    if (mp == 0) {
        const float* lp = F.in[6] + layer * 256;
        const float s1 = wave_sum(lp[lane] * lp[64 + lane]), s2 = wave_sum(lp[128 + lane] * lp[192 + lane]);
        const float lam_init = 0.8f - 0.6f * expf(-0.3f * (float)layer);
        const float lam = expf(s1) - expf(s2) + lam_init;
        float ssq[16];
#pragma unroll
        for (int r = 0; r < 16; ++r) ssq[r] = 0.f;
#pragma unroll
        for (int d = 0; d < 4; ++d)
#pragma unroll
            for (int r = 0; r < 16; ++r) { const float v = o[d][r] - lam * xch[(d * 16 + r) * 64 + lane]; o[d][r] = v; ssq[r] += v * v; }
#pragma unroll
        for (int r = 0; r < 16; ++r) {
            float v = ssq[r];
            v += __shfl_xor(v, 1); v += __shfl_xor(v, 2); v += __shfl_xor(v, 4); v += __shfl_xor(v, 8); v += __shfl_xor(v, 16);
            ssq[r] = (1.0f - lam_init) / sqrtf(v * (1.0f / 128.0f) + RMS_EPS);
        }
        const float* sg = F.in[7] + layer * 128;
        bf16_t* yb = Y + (tokb + qb * 128 + wq * 32) * D + 512 + h * 128 + r32;
#pragma unroll
        for (int d = 0; d < 4; ++d) { const float gg = sg[d * 32 + r32];
#pragma unroll
            for (int r = 0; r < 16; ++r) { const float v = o[d][r] * ssq[r] * gg; yb[(size_t)crow(r, hi) * D + d * 32] = (bf16_t)(cvtpk(v, v) & 0xffffu); } }
    }
    ATT_WAIT_BAR();
}

template <int THR>
__device__ __forceinline__ void na_unit(Frame& F, int layer, int idx) {
    int tid_ = threadIdx.x; asm volatile("" : "+v"(tid_));
    const int tid = tid_, lane = tid & 63, wid = __builtin_amdgcn_readfirstlane(tid >> 6), r32 = lane & 31, hi = lane >> 5;
    const int b = idx >> 6, h = (idx >> 3) & 7, g = idx & 7;
    const int row = 4 * g + (wid >> 1), half = wid & 1, c = 32 * half + r32;
    const bf16_t* qkv = (const bf16_t*)(F.ws + WS_QKV);
    bf16_t* Y = (bf16_t*)(F.ws + WS_XNY);
    const size_t tokb = (size_t)b * SEQ;
    LAS unsigned char* lds = F.lds;
    LAS float* wsf = (LAS float*)(lds + ATT_WSF) + wid * 128;
    LAS float* RPB = (LAS float*)(lds + ATT_TBL);
    if (tid < 480) { const int dr = tid >> 5, i = tid & 31; RPB[tid] = (i < 31) ? F.in[5][((size_t)(layer * 8 + h) * 15 + dr) * 31 + i] * LOG2E : 0.f; }
    bf16x8 qr[4];
    { const bf16_t* Qw = qkv + (tokb + row * 64 + c) * NQKV + COL_QA + h * 64 + hi * 8;
#pragma unroll
      for (int d0 = 0; d0 < 4; ++d0) qr[d0] = *(const bf16x8*)(Qw + d0 * 16); }
    const int lo = (4 * g - 4) < 0 ? 0 : ((4 * g - 4) > 24 ? 24 : (4 * g - 4));
    const int hr = ((4 * g - 1) < 0 ? 0 : ((4 * g - 1) > 24 ? 24 : (4 * g - 1))) + 7;
    const int ntile = hr - lo + 1;
    const int r0 = (row - 4) < 0 ? 0 : ((row - 4) > 24 ? 24 : (row - 4));
    const int c0 = (c - 8) < 0 ? 0 : ((c - 8) > 48 ? 48 : (c - 8));
    const bf16_t* ksrc = qkv + (tokb + lane) * NQKV + COL_KA + h * 64 + wid * 8;
    const bf16_t* vsrc = qkv + (tokb + 16 * (wid & 3) + (lane >> 2)) * NQKV + COL_VA + h * 64 + (wid >> 2) * 32 + (lane & 3) * 8;
    const int voff = ((lane >> 4) & 1) * 32 + (lane & 3) * 8 + (4 * hi + ((lane & 15) >> 2)) * 64;
#define NA_DMA(kr, buf) do { const size_t go_ = (size_t)(kr) * 64 * NQKV; LAS unsigned char* rb_ = lds + (buf) * 32768 + wid * 1024; \
        GLDS16(ksrc + go_, rb_); GLDS16(vsrc + go_, rb_ + 16384); } while (0)
    f32x16 o[2]; o[0] = f32x16{}; o[1] = f32x16{};
    f32x16 negm = f32x16{}; float mhat = 0.f, l = 0.f;
    NA_DMA(lo, 0);
    ATT_WAIT_BAR();
    for (int tt = 0; tt < ntile; ++tt) {
        const int buf = tt & 1, kr = lo + tt;
        if (tt + 1 < ntile) NA_DMA(kr + 1, buf ^ 1);
        if (kr >= r0 && kr < r0 + 8) {
            lcp kslot = (lcp)(lds + buf * 32768);
            lcp vb = (lcp)(lds + buf * 32768 + 16384 + voff);
            f32x16 p0, p1;
            qkt(p0, p1, kslot, qr, negm, r32, hi);
            const LAS float* rp = RPB + (kr - row + 7) * 32;
#pragma unroll
            for (int r = 0; r < 16; ++r) {
                const int k0c = crow(r, hi), k1c = k0c + 32;
                int i0 = k0c - c + 15, i1 = k1c - c + 15;
                const bool v0 = (k0c >= c0) && (k0c < c0 + 16), v1 = (k1c >= c0) && (k1c < c0 + 16);
                i0 = i0 < 0 ? 0 : (i0 > 30 ? 30 : i0); i1 = i1 < 0 ? 0 : (i1 > 30 ? 30 : i1);
                const float b0 = rp[i0], b1 = rp[i1];
                p0[r] = v0 ? p0[r] + b0 : -INFINITY; p1[r] = v1 ? p1[r] + b1 : -INFINITY;
            }
            softmax_pv<2, THR>(p0, p1, o, negm, mhat, l, kr == r0, vb, wsf, r32, hi);
        }
        ATT_WAIT_BAR();
    }
#undef NA_DMA
    float rli[16]; row_inv_l(l, rli, wsf, r32, hi);
    bf16_t* yb = Y + (tokb + row * 64 + 32 * half) * D + h * 64 + r32;
#pragma unroll
    for (int d = 0; d < 2; ++d)
#pragma unroll
        for (int r = 0; r < 16; ++r) { const float v = o[d][r] * rli[r]; yb[(size_t)crow(r, hi) * D + d * 32] = (bf16_t)(cvtpk(v, v) & 0xffffu); }
    ATT_WAIT_BAR();
}
}

constexpr int NPHASE = 2 + 6 * DEPTH;
struct Args { const float* in[14]; float* out; unsigned char* ws; int ph_lo, ph_hi; };
__global__ void __launch_bounds__(NWAVES * 64, 2) enc_fwd(Args args) {
    extern __shared__ __attribute__((aligned(16))) unsigned char lds[];
    Frame F;
    F.lds = (LAS unsigned char*)lds;
    F.tid = threadIdx.x; F.lane = F.tid & 63; F.wave = __builtin_amdgcn_readfirstlane(F.tid >> 6);
    F.G = gridDim.x; { const int bx = blockIdx.x; F.vcu = (F.G % 8 == 0) ? (bx % 8) * (F.G / 8) + bx / 8 : bx; }
#pragma unroll
    for (int i = 0; i < 14; ++i) F.in[i] = args.in[i];
    F.out = args.out; F.ws = args.ws;
    unsigned char* ws = args.ws;
    volatile LAS unsigned* MISC = (volatile LAS unsigned*)(F.lds + MISC_OFF);
    for (int u = F.tid; u < (LDS_BYTES - LDSCTL_OFF) / 4; u += NWAVES * 64) ((LAS unsigned*)(F.lds + LDSCTL_OFF))[u] = 0u;
    __syncthreads();
    XcdBarrier bar; bar.bar = (unsigned*)(ws + WS_CTL) + CW_BAR; bar.x = 0; bar.st = nullptr;
#if !MK_PER_PHASE
    bar = xcd_barrier_post((unsigned*)(ws + WS_CTL) + CW_BAR, MISC + 8);
#endif
    const int lo = args.ph_lo, hi = args.ph_hi;
#define IN(k) (lo <= (k) && (k) < hi)
#if MK_PER_PHASE
#define SEAM(k) do { } while (0)
#else
#define SEAM(k) do { if (IN(k) && IN((k) + 1)) xcd_barrier(bar); } while (0)
#endif
    bf16_t* XNY = (bf16_t*)(ws + WS_XNY); bf16_t* QKV = (bf16_t*)(ws + WS_QKV); bf16_t* GATES = (bf16_t*)(ws + WS_GATES);
    bf16_t* MERGED = (bf16_t*)(ws + WS_MERGED); bf16_t* HB = (bf16_t*)(ws + WS_H); float* SS = (float*)(ws + WS_SS);

    if (IN(0)) { p0_prologue(F); } SEAM(0);
#pragma unroll 1
    for (int L = 0; L < DEPTH; ++L) {
        const int pb = 1 + 6 * L;
        unsigned char* wb = ws + WS_W + (size_t)L * W_LAYER;
        const float* xin = (L == 0) ? F.in[0] : F.out;
        if (IN(pb + 0) && !DIS(0)) {
            pg8::Gemm g{XNY, (const bf16_t*)(wb + WO_IN), M, NIN, D}; pg8::StaticOrder S; S.init(M, NIN, F.G, (int)blockIdx.x);
            pg8::EpiProj E{QKV, GATES, SS};
            pg8::gemm_phase<pg8::EpiProj, pg8::StaticOrder, true, true>(F.lds + RING_OFF, g, S, E);
        } SEAM(pb + 0);
        if (IN(pb + 1) && !DIS(1)) {
#ifndef NO_DIFF
#pragma unroll 1
            for (int i = 0; i < 512; ++i) { const int u = 2 * F.vcu + (i & 1) + (i >> 1) * 2 * F.G; if (u >= 512) break; att::diff_unit<8>(F, L, u >> 4, u & 15); }
#endif
#ifndef NO_NA
#pragma unroll 1
            for (int i = 0; i < 512; ++i) { const int u = 2 * F.vcu + (i & 1) + (i >> 1) * 2 * F.G; if (u >= 512) break; att::na_unit<8>(F, L, u); }
#endif
        } SEAM(pb + 1);
        if (IN(pb + 2) && !DIS(2)) {
            pg8::Gemm g{XNY, (const bf16_t*)(wb + WO_M), M, D, D}; pg8::StaticOrder S; S.init(M, D, F.G, (int)blockIdx.x);
            pg8::EpiMerge E{MERGED, GATES};
            pg8::gemm_phase<pg8::EpiMerge, pg8::StaticOrder, false, true>(F.lds + RING_OFF, g, S, E);
        } SEAM(pb + 2);
        if (IN(pb + 3) && !DIS(3)) {
            pg8::Gemm g{MERGED, (const bf16_t*)(wb + WO_OUT), M, D, D}; pg8::StaticOrder S; S.init(M, D, F.G, (int)blockIdx.x);
            pg8::EpiResid E{xin, F.out, XNY, F.in[11] + L * D, SS};
            pg8::gemm_phase<pg8::EpiResid, pg8::StaticOrder, false, true>(F.lds + RING_OFF, g, S, E);
        } SEAM(pb + 3);
        if (IN(pb + 4) && !DIS(4)) {
            pg8::Gemm g{XNY, (const bf16_t*)(wb + WO_FF1), M, FF, D}; pg8::StaticOrder S; S.init(M, FF, F.G, (int)blockIdx.x);
            pg8::EpiFF1 E{HB, SS};
            pg8::gemm_phase<pg8::EpiFF1, pg8::StaticOrder, true, true>(F.lds + RING_OFF, g, S, E);
        } SEAM(pb + 4);
        if (IN(pb + 5) && !DIS(5)) {
            pg8::Gemm g{HB, (const bf16_t*)(wb + WO_FF2), M, D, FF}; pg8::StaticOrder S; S.init(M, D, F.G, (int)blockIdx.x);
            pg8::EpiResid E{F.out, F.out, (L + 1 < DEPTH) ? XNY : (bf16_t*)nullptr, F.in[3] + (L + 1 < DEPTH ? (L + 1) * D : 0), SS};
            pg8::gemm_phase<pg8::EpiResid, pg8::StaticOrder, false, true>(F.lds + RING_OFF, g, S, E);
        } SEAM(pb + 5);
    }
    if (IN(NPHASE - 1)) final_norm(F);
#undef IN
#undef SEAM
}

extern "C" void kernel_launch(void* const* d_in, const int* in_sizes, int n_in, void* d_out, int out_size, void* d_ws, size_t ws_size, hipStream_t stream) {
    static int grid = 0;
    if (grid == 0) {
        if (n_in != 14 || in_sizes[0] != M * D || out_size != M * D || ws_size < WS_END) { fprintf(stderr, "kernel_launch: unexpected shapes (n_in %d, in0 %d, out %d, ws %zu); nothing launched\n", n_in, n_in > 0 ? in_sizes[0] : -1, out_size, ws_size); grid = -1; return; }
        int dev = 0, cus = 0;
        if (hipGetDevice(&dev) != hipSuccess || hipDeviceGetAttribute(&cus, hipDeviceAttributeMultiprocessorCount, dev) != hipSuccess) { grid = -1; return; }
        if (hipFuncSetAttribute((const void*)enc_fwd, hipFuncAttributeMaxDynamicSharedMemorySize, LDS_BYTES) != hipSuccess) { fprintf(stderr, "kernel_launch: hipFuncSetAttribute failed\n"); grid = -1; return; }
        int per_cu = 0;
        if (hipOccupancyMaxActiveBlocksPerMultiprocessor(&per_cu, (const void*)enc_fwd, NWAVES * 64, LDS_BYTES) != hipSuccess || per_cu < 1) fprintf(stderr, "kernel_launch: occupancy query reports %d per CU\n", per_cu);
        (void)hipGetLastError();
        grid = cus;
    }
    if (grid < 0) return;
    Args a{};
    for (int i = 0; i < 14; ++i) a.in[i] = (const float*)d_in[i];
    a.out = (float*)d_out; a.ws = (unsigned char*)d_ws;
#if MK_PER_PHASE
    for (int p = 0; p < NPHASE; ++p) { a.ph_lo = p; a.ph_hi = p + 1; hipLaunchKernelGGL(enc_fwd, dim3(grid), dim3(NWAVES * 64), LDS_BYTES, stream, a); }
#else
    if (hipMemsetAsync((char*)d_ws + WS_CTL, 0, CTL_ZERO_BYTES, stream) != hipSuccess) { fprintf(stderr, "kernel_launch: memset failed\n"); return; }
    a.ph_lo = 0; a.ph_hi = NPHASE;
    hipLaunchKernelGGL(enc_fwd, dim3(grid), dim3(NWAVES * 64), LDS_BYTES, stream, a);
#endif
}
```

```cpp
#include <hip/hip_runtime.h>
#include <cstdio>
#include <cstdint>

#ifndef DISMASK
#define DISMASK 0
#endif
#define DIS(k) ((DISMASK >> (k)) & 1)
#ifndef MK_PER_PHASE
#define MK_PER_PHASE 0
#endif

#define LAS __attribute__((address_space(3)))
#define GAS __attribute__((address_space(1)))
typedef unsigned short bf16_t;
typedef short bf16x8 __attribute__((ext_vector_type(8)));
typedef short s16x4 __attribute__((ext_vector_type(4)));
typedef float f32x4 __attribute__((ext_vector_type(4)));
typedef float f32x2 __attribute__((ext_vector_type(2)));
typedef float f32x16 __attribute__((ext_vector_type(16)));
typedef unsigned u32x4 __attribute__((ext_vector_type(4)));
typedef unsigned u32x2 __attribute__((ext_vector_type(2)));
typedef __bf16 bf16x2_t __attribute__((ext_vector_type(2)));

constexpr int BATCH = 8, SEQ = 2048, D = 1024, M = BATCH * SEQ, DEPTH = 2, FF = 4096;
constexpr int NQKV = 3072, NGATE = 2048, NIN = 5120;
constexpr float RMS_EPS = 1e-6f;
constexpr float LOG2E = 1.4426950408889634f;
constexpr float C2 = 0.125f * LOG2E;
constexpr int COL_QA = 0, COL_KA = 512, COL_VA = 1024, COL_QD = 1536, COL_KD = 2048, COL_VD = 2560;

__device__ __forceinline__ unsigned cvtpk(float lo, float hi) { f32x2 v = {lo, hi}; bf16x2_t b = __builtin_convertvector(v, bf16x2_t); return __builtin_bit_cast(unsigned, b); }
__device__ __forceinline__ float bf2f(unsigned short u) { return __uint_as_float((unsigned)u << 16); }
__device__ __forceinline__ float bflo(unsigned w) { return __uint_as_float(w << 16); }
__device__ __forceinline__ float bfhi(unsigned w) { return __uint_as_float(w & 0xffff0000u); }

namespace pg8 {
constexpr int BM = 256, BK = 64, HALF = 128, HTB = HALF * BK * 2, STAGE_BYTES = 8 * HTB, NXCD = 8, WGM = 8;
__host__ __device__ __forceinline__ int lds_byte(int r, int c) { const int st = (r >> 4) * 2 + (c >> 5), rr = r & 15, cc = c & 31, ob = rr * 64 + cc * 2; return st * 1024 + (ob ^ (((ob >> 9) & 1) << 5)); }
__host__ __device__ __forceinline__ void stage_rc(int b, int& R, int& C) { const int st = b / 1024, sb = b % 1024, swz = sb ^ (((sb >> 9) & 1) << 5); R = (st >> 1) * 16 + swz / 64; C = (st & 1) * 32 + (swz % 64) / 2; }
__host__ __device__ __forceinline__ int perm32(int rho) { const int n = rho >> 4, i = rho & 15; return 8 * (i >> 2) + 4 * n + (i & 3); }

struct Unit { int pm, pn; };
struct Gemm { const bf16_t* A; const bf16_t* Bt; int M, N, K; };

struct StaticOrder {
    int nM, nN, nwg, G, c;
    __device__ void init(int M_, int N_, int G_, int c_) { nM = M_ / BM; nN = N_ / BM; nwg = nM * nN; G = G_; c = c_; }
    __device__ bool next(int i, Unit& u) const {
        const long L = (long)i * G + c; if (L >= nwg) return false;
        int wgid = (int)L; { const int q = nwg / NXCD, r = nwg % NXCD, xcd = wgid % NXCD, off = wgid / NXCD; wgid = (xcd < r ? xcd * (q + 1) : r * (q + 1) + (xcd - r) * q) + off; }
        const int nig = WGM * nN, gid = wgid / nig, fm = gid * WGM, gsz = (nM - fm) < WGM ? (nM - fm) : WGM;
        u.pm = fm + ((wgid % nig) % gsz); u.pn = (wgid % nig) / gsz; return true;
    }
};

__device__ __forceinline__ float row_rstd(const float* ss, int row) {
    const f32x4* p = (const f32x4*)(ss + (size_t)row * 16);
    const f32x4 a = p[0], b = p[1], c = p[2], d = p[3];
    const float s = ((a[0] + a[1]) + (a[2] + a[3])) + ((b[0] + b[1]) + (b[2] + b[3])) + ((c[0] + c[1]) + (c[2] + c[3])) + ((d[0] + d[1]) + (d[2] + d[3]));
    return 1.0f / sqrtf(s * (1.0f / (float)D) + RMS_EPS);
}

struct EpiProj {
    static constexpr bool PERM = true, HAS_MID = false;
    bf16_t* qkv; bf16_t* gates; const float* ss;
    __device__ __forceinline__ void mid(f32x4 (&acc)[2][2][4][2], const Unit& u, int wr, int wc, int fr, int fq) const {}
    __device__ __forceinline__ void operator()(f32x4 (&acc)[2][2][4][2], const Unit& u, int wr, int wc, int fr, int fq) const {
        const int row0 = u.pm * BM + wr * 64 + fr;
        bf16_t* base; int ldc, colt; float sc = 1.0f;
        if (u.pn < 12) { base = qkv; ldc = NQKV; colt = u.pn * BM; if (u.pn < 2 || u.pn == 6 || u.pn == 7) sc = C2; }
        else { base = gates; ldc = NGATE; colt = (u.pn - 12) * BM; }
        const int col0 = colt + wc * 32 + 8 * fq;
#pragma unroll
        for (int ai = 0; ai < 2; ++ai)
#pragma unroll
            for (int m = 0; m < 4; ++m) { const int row = row0 + ai * HALF + m * 16; const float r = row_rstd(ss, row) * sc; bf16_t* rowp = base + (size_t)row * ldc + col0;
#pragma unroll
                for (int bj = 0; bj < 2; ++bj) { const f32x4 v0 = acc[ai][bj][m][0] * r, v1 = acc[ai][bj][m][1] * r;
                    u32x4 w; w.x = cvtpk(v0[0], v0[1]); w.y = cvtpk(v0[2], v0[3]); w.z = cvtpk(v1[0], v1[1]); w.w = cvtpk(v1[2], v1[3]);
                    *(u32x4*)(rowp + bj * HALF) = w; } }
    }
};
struct EpiFF1 {
    static constexpr bool PERM = true, HAS_MID = false;
    bf16_t* H; const float* ss;
    __device__ __forceinline__ void mid(f32x4 (&acc)[2][2][4][2], const Unit& u, int wr, int wc, int fr, int fq) const {}
    __device__ __forceinline__ void operator()(f32x4 (&acc)[2][2][4][2], const Unit& u, int wr, int wc, int fr, int fq) const {
        const int row0 = u.pm * BM + wr * 64 + fr, col0 = u.pn * BM + wc * 32 + 8 * fq;
#pragma unroll
        for (int ai = 0; ai < 2; ++ai)
#pragma unroll
            for (int m = 0; m < 4; ++m) { const int row = row0 + ai * HALF + m * 16; const float r = row_rstd(ss, row); bf16_t* rowp = H + (size_t)row * FF + col0;
#pragma unroll
                for (int bj = 0; bj < 2; ++bj) { f32x4 v0 = acc[ai][bj][m][0] * r, v1 = acc[ai][bj][m][1] * r;
#pragma unroll
                    for (int e = 0; e < 4; ++e) { const float a = fmaxf(v0[e], 0.f), b = fmaxf(v1[e], 0.f); v0[e] = a * a; v1[e] = b * b; }
                    u32x4 w; w.x = cvtpk(v0[0], v0[1]); w.y = cvtpk(v0[2], v0[3]); w.z = cvtpk(v1[0], v1[1]); w.w = cvtpk(v1[2], v1[3]);
                    *(u32x4*)(rowp + bj * HALF) = w; } }
    }
};
struct EpiMerge {
    static constexpr bool PERM = true, HAS_MID = true;
    bf16_t* O; const bf16_t* gates;
    __device__ __forceinline__ void mid(f32x4 (&acc)[2][2][4][2], const Unit& u, int wr, int wc, int fr, int fq) const {
        const int row0 = u.pm * BM + wr * 64 + fr, col0 = u.pn * BM + wc * 32 + 8 * fq;
        const bf16_t* gp = gates + (size_t)row0 * NGATE + col0;
#pragma unroll
        for (int ai = 0; ai < 2; ++ai)
#pragma unroll
            for (int m = 0; m < 4; ++m) {
                asm volatile("" : "+v"(gp) :: "memory");
#pragma unroll
                for (int bj = 0; bj < 2; ++bj) { const u32x4 ga = *(const GAS u32x4*)(gp + bj * HALF), gd = *(const GAS u32x4*)(gp + 1024 + bj * HALF);
#pragma unroll
                    for (int w = 0; w < 4; ++w) { const float a0 = bflo(ga[w]), a1 = bfhi(ga[w]), d0 = fmaxf(bflo(gd[w]), -80.f), d1 = fmaxf(bfhi(gd[w]), -80.f);
                        const float r0 = (1.f + __expf(-d0)) * __builtin_amdgcn_rcpf(1.f + __expf(-a0)), r1 = (1.f + __expf(-d1)) * __builtin_amdgcn_rcpf(1.f + __expf(-a1));
                        acc[ai][bj][m][w >> 1][(w & 1) * 2] *= r0; acc[ai][bj][m][w >> 1][(w & 1) * 2 + 1] *= r1; } }
                gp += (m == 3 ? (HALF - 48) : 16) * NGATE; }
    }
    __device__ __forceinline__ void operator()(f32x4 (&acc)[2][2][4][2], const Unit& u, int wr, int wc, int fr, int fq) const {
        const int row0 = u.pm * BM + wr * 64 + fr, col0 = u.pn * BM + wc * 32 + 8 * fq;
        const bf16_t* gp = gates + (size_t)row0 * NGATE + 1024 + col0; bf16_t* rowp = O + (size_t)row0 * D + col0;
#pragma unroll
        for (int ai = 0; ai < 2; ++ai)
#pragma unroll
            for (int m = 0; m < 4; ++m) {
                asm volatile("" : "+v"(gp), "+v"(rowp) :: "memory");
#pragma unroll
                for (int bj = 0; bj < 2; ++bj) { const u32x4 gd = *(const GAS u32x4*)(gp + bj * HALF); float o[8];
#pragma unroll
                    for (int w = 0; w < 4; ++w) { const float d0 = fmaxf(bflo(gd[w]), -80.f), d1 = fmaxf(bfhi(gd[w]), -80.f);
                        o[2 * w] = acc[ai][bj][m][w >> 1][(w & 1) * 2] * __builtin_amdgcn_rcpf(1.f + __expf(-d0)); o[2 * w + 1] = acc[ai][bj][m][w >> 1][(w & 1) * 2 + 1] * __builtin_amdgcn_rcpf(1.f + __expf(-d1)); }
                    u32x4 w4; w4.x = cvtpk(o[0], o[1]); w4.y = cvtpk(o[2], o[3]); w4.z = cvtpk(o[4], o[5]); w4.w = cvtpk(o[6], o[7]);
                    *(GAS u32x4*)(rowp + bj * HALF) = w4; }
                gp += (m == 3 ? (HALF - 48) : 16) * NGATE; rowp += (m == 3 ? (HALF - 48) : 16) * D; }
    }
};
struct EpiResid {
    static constexpr bool PERM = true, HAS_MID = false;
    const float* xin; float* xout; bf16_t* xn; const float* g; float* ss;
    __device__ __forceinline__ void mid(f32x4 (&acc)[2][2][4][2], const Unit& u, int wr, int wc, int fr, int fq) const {}
    __device__ __forceinline__ void operator()(f32x4 (&acc)[2][2][4][2], const Unit& u, int wr, int wc, int fr, int fq) const {
        const int row0 = u.pm * BM + wr * 64 + fr, col0 = u.pn * BM + wc * 32 + 8 * fq;
        f32x4 gv[2][2];
#pragma unroll
        for (int bj = 0; bj < 2; ++bj)
#pragma unroll
            for (int n = 0; n < 2; ++n) gv[bj][n] = xn ? *(const f32x4*)(g + col0 + bj * HALF + 4 * n) : (f32x4){0.f, 0.f, 0.f, 0.f};
#pragma unroll
        for (int ai = 0; ai < 2; ++ai)
#pragma unroll
            for (int m = 0; m < 4; ++m) { const int row = row0 + ai * HALF + m * 16; const size_t off = (size_t)row * D + col0; float q = 0.f;
#pragma unroll
                for (int bj = 0; bj < 2; ++bj) { const f32x4 x0 = *(const f32x4*)(xin + off + bj * HALF), x1 = *(const f32x4*)(xin + off + bj * HALF + 4);
                    const f32x4 y0 = x0 + acc[ai][bj][m][0], y1 = x1 + acc[ai][bj][m][1];
                    *(f32x4*)(xout + off + bj * HALF) = y0; *(f32x4*)(xout + off + bj * HALF + 4) = y1;
                    q += (y0[0] * y0[0] + y0[1] * y0[1]) + (y0[2] * y0[2] + y0[3] * y0[3]) + (y1[0] * y1[0] + y1[1] * y1[1]) + (y1[2] * y1[2] + y1[3] * y1[3]);
                    if (xn) { const f32x4 a = y0 * gv[bj][0], b = y1 * gv[bj][1]; u32x4 w; w.x = cvtpk(a[0], a[1]); w.y = cvtpk(a[2], a[3]); w.z = cvtpk(b[0], b[1]); w.w = cvtpk(b[2], b[3]);
                        *(u32x4*)(xn + off + bj * HALF) = w; } }
                q += __shfl_xor(q, 16); q += __shfl_xor(q, 32);
                if (fq == 0) ss[(size_t)row * 16 + u.pn * 4 + wc] = q; }
    }
};

template <class Epi, class Sched, bool ALIGN_EPI, bool SP2>
__device__ __forceinline__ void gemm_phase(LAS unsigned char* lds, const Gemm g, const Sched& S, const Epi& E) {
    int tid_ = threadIdx.x; asm volatile("" : "+v"(tid_));
    const int tid = tid_, wid = __builtin_amdgcn_readfirstlane(tid >> 6), lane = tid & 63, wr = wid >> 2, wc = wid & 3, fr = lane & 15, fq = lane >> 4;
    const int K = g.K, nt = K / BK;
    unsigned voffA[2], voffB[2];
#pragma unroll
    for (int i = 0; i < 2; ++i) { int R, C; stage_rc(tid * 16 + i * 8192, R, C); const int Rb = Epi::PERM ? ((R & ~31) + perm32(R & 31)) : R;
        voffA[i] = (unsigned)(R * K + C) * 2u; voffB[i] = (unsigned)(Rb * K + C) * 2u; }
    const size_t kstep = (size_t)(BK * 2);
    const size_t hstep = (size_t)HALF * K * 2;
    const size_t tstep = 2 * hstep;
    const unsigned ldsw = (unsigned)wid * 1024u;
    const int aoff = lds_byte(wr * 64 + fr, fq * 8), boff = lds_byte(wc * 32 + fr, fq * 8);
#define PG8_SA(b, h) (((b) * 2 + (h)) * HTB)
#define PG8_SB(b, h) ((4 + (b) * 2 + (h)) * HTB)
#define PG8_STAGE(bufoff, gbase, voff) do { _Pragma("unroll") for (int _i = 0; _i < 2; ++_i) \
        __builtin_amdgcn_global_load_lds((const unsigned*)((const char*)(gbase) + (voff)[_i]), (LAS unsigned*)(lds + (bufoff) + ldsw + _i * 8192), 16, 0, 0); } while (0)
#define PG8_LDA(dst, b, h) do { _Pragma("unroll") for (int m = 0; m < 4; ++m) _Pragma("unroll") for (int k = 0; k < 2; ++k) dst[m][k] = *(const LAS bf16x8*)(lds + PG8_SA(b, h) + aoff + m * 2048 + k * 1024); } while (0)
#define PG8_LDB(dst, b, h) do { _Pragma("unroll") for (int n = 0; n < 2; ++n) _Pragma("unroll") for (int k = 0; k < 2; ++k) dst[n][k] = *(const LAS bf16x8*)(lds + PG8_SB(b, h) + boff + n * 2048 + k * 1024); } while (0)
#define PG8_MMA(ai, bj, At, Bt) do { __builtin_amdgcn_s_setprio(1); _Pragma("unroll") for (int m = 0; m < 4; ++m) _Pragma("unroll") for (int n = 0; n < 2; ++n) _Pragma("unroll") for (int k = 0; k < 2; ++k) \
        acc[ai][bj][m][n] = __builtin_amdgcn_mfma_f32_16x16x32_bf16(Bt[n][k], At[m][k], acc[ai][bj][m][n], 0, 0, 0); __builtin_amdgcn_s_setprio(0); } while (0)
#define PG8_WAIT_V(n) asm volatile("s_waitcnt vmcnt(" #n ")" ::: "memory")
#define PG8_WAIT_L(n) asm volatile("s_waitcnt lgkmcnt(" #n ")" ::: "memory")
#define PG8_BAR __builtin_amdgcn_s_barrier()
#define PG8_SCHED __builtin_amdgcn_sched_barrier(0)
    Unit cur, nxt; int ui = 0;
    if (!S.next(0, cur)) return;
    f32x4 acc[2][2][4][2];
#pragma unroll
    for (int a = 0; a < 2; ++a)
#pragma unroll
        for (int b = 0; b < 2; ++b)
#pragma unroll
            for (int m = 0; m < 4; ++m)
#pragma unroll
                for (int n = 0; n < 2; ++n) acc[a][b][m][n] = (f32x4){0.f, 0.f, 0.f, 0.f};
    bf16x8 At[4][2], B0[2][2], B1[2][2];
    const char* cA = (const char*)g.A + (size_t)cur.pm * tstep; const char* cB = (const char*)g.Bt + (size_t)cur.pn * tstep;
    if constexpr (SP2) {
        PG8_STAGE(PG8_SB(0, 0), cB, voffB); PG8_STAGE(PG8_SB(0, 1), cB + hstep, voffB); PG8_STAGE(PG8_SA(0, 0), cA, voffA); PG8_STAGE(PG8_SA(0, 1), cA + hstep, voffA);
        if (wr == 1) PG8_BAR;
        PG8_WAIT_V(2); PG8_BAR;
        PG8_STAGE(PG8_SB(1, 0), cB + kstep, voffB); PG8_STAGE(PG8_SA(1, 0), cA + kstep, voffA); PG8_STAGE(PG8_SB(1, 1), cB + hstep + kstep, voffB);
        PG8_WAIT_V(6); PG8_BAR;
    } else {
        PG8_STAGE(PG8_SB(0, 0), cB, voffB); PG8_STAGE(PG8_SA(0, 0), cA, voffA); PG8_STAGE(PG8_SB(0, 1), cB + hstep, voffB); PG8_STAGE(PG8_SA(0, 1), cA + hstep, voffA);
        if (wr == 1) PG8_BAR;
        PG8_WAIT_V(4); PG8_BAR;
        PG8_STAGE(PG8_SB(1, 0), cB + kstep, voffB); PG8_STAGE(PG8_SA(1, 0), cA + kstep, voffA); PG8_STAGE(PG8_SB(1, 1), cB + hstep + kstep, voffB);
        PG8_WAIT_V(6); PG8_BAR;
    }
    for (;;) {
        const bool has_next = S.next(ui + 1, nxt);
        const char* nA = has_next ? (const char*)g.A + (size_t)nxt.pm * tstep : cA; const char* nB = has_next ? (const char*)g.Bt + (size_t)nxt.pn * tstep : cB;
        for (int t = 0; t < nt; t += 2) {
            if constexpr (Epi::HAS_MID) { if (t == nt / 2) E.mid(acc, cur, wr, wc, fr, fq); }
            const bool last = (t == nt - 2);
            const char* a1 = cA + (size_t)(t + 1) * kstep;
            const char* a2 = last ? nA : cA + (size_t)(t + 2) * kstep; const char* b2 = last ? nB : cB + (size_t)(t + 2) * kstep;
            const char* a3 = a2 + kstep; const char* b3 = b2 + kstep;
            if constexpr (SP2) {
            PG8_LDB(B0, 0, 0); PG8_LDB(B1, 0, 1); PG8_SCHED; PG8_LDA(At, 0, 0); PG8_STAGE(PG8_SA(1, 1), a1 + hstep, voffA);
            PG8_WAIT_V(8); PG8_WAIT_L(0); PG8_BAR; PG8_MMA(0, 0, At, B0); PG8_MMA(0, 1, At, B1); PG8_BAR; PG8_SCHED;
            PG8_LDA(At, 0, 1); PG8_STAGE(PG8_SB(0, 0), b2, voffB); PG8_STAGE(PG8_SB(0, 1), b2 + hstep, voffB); PG8_STAGE(PG8_SA(0, 0), a2, voffA);
            PG8_WAIT_V(8); PG8_WAIT_L(0); PG8_BAR; PG8_MMA(1, 0, At, B0); PG8_MMA(1, 1, At, B1); PG8_BAR; PG8_SCHED;
            PG8_LDB(B0, 1, 0); PG8_LDB(B1, 1, 1); PG8_SCHED; PG8_LDA(At, 1, 0); PG8_STAGE(PG8_SA(0, 1), a2 + hstep, voffA);
            PG8_WAIT_V(8); PG8_WAIT_L(0); PG8_BAR; PG8_MMA(0, 0, At, B0); PG8_MMA(0, 1, At, B1); PG8_BAR; PG8_SCHED;
            PG8_LDA(At, 1, 1); PG8_STAGE(PG8_SB(1, 0), b3, voffB); PG8_STAGE(PG8_SB(1, 1), b3 + hstep, voffB); PG8_STAGE(PG8_SA(1, 0), a3, voffA);
            PG8_WAIT_V(8); PG8_WAIT_L(0); PG8_BAR; PG8_MMA(1, 0, At, B0); PG8_MMA(1, 1, At, B1); PG8_BAR; PG8_SCHED;
            } else {
            PG8_LDB(B0, 0, 0); PG8_SCHED; PG8_LDA(At, 0, 0); PG8_STAGE(PG8_SA(1, 1), a1 + hstep, voffA);
            PG8_WAIT_L(8); PG8_BAR; PG8_WAIT_L(0); PG8_MMA(0, 0, At, B0); PG8_BAR; PG8_SCHED;
            PG8_LDB(B1, 0, 1); PG8_STAGE(PG8_SB(0, 0), b2, voffB);
            PG8_BAR; PG8_WAIT_L(0); PG8_MMA(0, 1, At, B1); PG8_BAR;
            PG8_LDA(At, 0, 1); PG8_STAGE(PG8_SA(0, 0), a2, voffA);
            PG8_BAR; PG8_WAIT_L(0); PG8_MMA(1, 0, At, B0); PG8_BAR; PG8_SCHED;
            PG8_STAGE(PG8_SB(0, 1), b2 + hstep, voffB);
            PG8_WAIT_V(6); PG8_BAR; PG8_MMA(1, 1, At, B1); PG8_BAR;
            PG8_LDB(B0, 1, 0); PG8_SCHED; PG8_LDA(At, 1, 0); PG8_STAGE(PG8_SA(0, 1), a2 + hstep, voffA);
            PG8_WAIT_L(8); PG8_BAR; PG8_WAIT_L(0); PG8_MMA(0, 0, At, B0); PG8_BAR; PG8_SCHED;
            PG8_LDB(B1, 1, 1); PG8_STAGE(PG8_SB(1, 0), b3, voffB);
            PG8_BAR; PG8_WAIT_L(0); PG8_MMA(0, 1, At, B1); PG8_BAR;
            PG8_LDA(At, 1, 1); PG8_STAGE(PG8_SA(1, 0), a3, voffA);
            PG8_BAR; PG8_WAIT_L(0); PG8_MMA(1, 0, At, B0); PG8_BAR; PG8_SCHED;
            PG8_STAGE(PG8_SB(1, 1), b3 + hstep, voffB);
            PG8_WAIT_V(6); PG8_BAR; PG8_MMA(1, 1, At, B1); PG8_BAR;
            }
        }
        if constexpr (ALIGN_EPI) { if (wr == 0) PG8_BAR; }
        E(acc, cur, wr, wc, fr, fq);
        if (!has_next) break;
#pragma unroll
        for (int a = 0; a < 2; ++a)
#pragma unroll
            for (int b = 0; b < 2; ++b)
#pragma unroll
                for (int m = 0; m < 4; ++m)
#pragma unroll
                    for (int n = 0; n < 2; ++n) acc[a][b][m][n] = (f32x4){0.f, 0.f, 0.f, 0.f};
        cur = nxt; cA = nA; cB = nB; ++ui;
        if constexpr (ALIGN_EPI) { if (wr == 1) PG8_BAR; }
    }
    PG8_WAIT_V(0);
    if constexpr (!ALIGN_EPI) { if (wr == 0) PG8_BAR; }
    PG8_BAR;
#undef PG8_SA
#undef PG8_SB
#undef PG8_STAGE
#undef PG8_LDA
#undef PG8_LDB
#undef PG8_MMA
#undef PG8_WAIT_V
#undef PG8_WAIT_L
#undef PG8_BAR
#undef PG8_SCHED
}
}

constexpr size_t MiB = 1u << 20;
constexpr size_t WS_CTL = 0, CTL_ZERO_BYTES = 64 * 1024;
constexpr size_t WS_SS = 1 * MiB;
constexpr size_t WS_W = 2 * MiB, W_LAYER = 30 * MiB;
constexpr size_t WO_IN = 0, WO_M = 10 * MiB, WO_OUT = 12 * MiB, WO_FF1 = 14 * MiB, WO_FF2 = 22 * MiB;
constexpr size_t WS_XNY = 62 * MiB;
constexpr size_t WS_QKV = 94 * MiB;
constexpr size_t WS_GATES = 190 * MiB;
constexpr size_t WS_MERGED = WS_QKV;
constexpr size_t WS_H = WS_QKV;
constexpr size_t WS_END = 254 * MiB;
constexpr int CW_BAR = 1024;

constexpr int RING_OFF = 0, RING_BYTES = 131072;
constexpr int ATT_WSF = 131072;
constexpr int ATT_TBL = ATT_WSF + 4096;
constexpr int LDSCTL_OFF = ATT_TBL + 4096, MISC_OFF = LDSCTL_OFF + 320;
constexpr int LDS_BYTES = 147456;
static_assert(MISC_OFF + 128 <= LDS_BYTES, "LDS map");
constexpr int NWAVES = 8;

#define RLX_AGENT __ATOMIC_RELAXED, __HIP_MEMORY_SCOPE_AGENT
#define LDS_WAIT() asm volatile("s_waitcnt lgkmcnt(0)" ::: "memory")
#define VM_WAIT() asm volatile("s_waitcnt vmcnt(0)" ::: "memory")

#define XB_TMO      128
#define XB_XCNT(j)  (256  + 64 * (j))
#define XB_XSUB(j)  (1280 + 64 * (j))
#define XB_XGEN(j)  (2304 + 64 * (j))
#define XB_TOP      3328
#define XB_TOPGEN   3392
#define XCD_BAR_WORDS 3456
#define XB_SPIN_CAP (1u << 18)
__device__ __forceinline__ unsigned xb_ld(unsigned* p)              { return __hip_atomic_load(p, __ATOMIC_RELAXED, __HIP_MEMORY_SCOPE_AGENT); }
__device__ __forceinline__ unsigned xb_add(unsigned* p, unsigned v) { return __hip_atomic_fetch_add(p, v, __ATOMIC_RELAXED, __HIP_MEMORY_SCOPE_AGENT); }
__device__ __forceinline__ unsigned xb_xcc_id() { return (unsigned)__builtin_amdgcn_s_getreg((3 << 11) | 20) & 0xFu; }
#define XB_SPIN(cond, bar) do { unsigned _sp = 0; while (cond) { __builtin_amdgcn_s_sleep(1); \
    if ((++_sp & 255u) == 0u) { if (xb_ld(&(bar)[XB_TMO])) break; if (_sp > XB_SPIN_CAP) { atomicAdd(&(bar)[XB_TMO], 1u); break; } } } } while (0)
struct XcdBarrier { unsigned* bar; unsigned x; volatile LAS unsigned* st; };
__device__ __forceinline__ XcdBarrier xcd_barrier_post(unsigned* bar, volatile LAS unsigned* st) {
    XcdBarrier b; b.bar = bar; b.x = xb_xcc_id(); b.st = st;
    if (threadIdx.x == 0) (void)xb_add(&bar[XB_XCNT(b.x)], 1u);
    return b;
}
__device__ __forceinline__ void xcd_barrier_complete(unsigned* bar, unsigned x, unsigned& nloc, unsigned& nx) {
    const unsigned G = gridDim.x * gridDim.y * gridDim.z;
    unsigned sum, cnt, mine, sp = 0u;
    for (;;) {
        sum = 0u; cnt = 0u; mine = 0u;
#pragma unroll
        for (unsigned j = 0; j < 16; ++j) { const unsigned c = xb_ld(&bar[XB_XCNT(j)]); sum += c; cnt += (c > 0u) ? 1u : 0u; mine = (j == x) ? c : mine; }
        if (sum == G) break;
        __builtin_amdgcn_s_sleep(1);
        if ((++sp & 255u) == 0u) { if (xb_ld(&bar[XB_TMO])) break; if (sp > XB_SPIN_CAP) { atomicAdd(&bar[XB_TMO], 1u); break; } }
    }
    nloc = mine > 0u ? mine : 1u; nx = cnt > 0u ? cnt : 1u;
}
__device__ __forceinline__ void xcd_barrier(const XcdBarrier& b) {
    asm volatile("s_waitcnt vmcnt(0)" ::: "memory");
    __syncthreads();
    if (threadIdx.x == 0) {
        unsigned* bar = b.bar;
        __builtin_amdgcn_s_waitcnt(0);
        unsigned nloc = b.st[0], nx = b.st[1];
        if (nloc == 0u) { xcd_barrier_complete(bar, b.x, nloc, nx); b.st[0] = nloc; b.st[1] = nx; }
        const unsigned old = xb_add(&bar[XB_XSUB(b.x)], 1u);
        const unsigned gen = old / nloc;
        if (old + 1u == (gen + 1u) * nloc) {
            __builtin_amdgcn_fence(__ATOMIC_RELEASE, "agent");
            asm volatile("s_waitcnt vmcnt(0)" ::: "memory");
            const unsigned og = xb_add(&bar[XB_TOP], 1u);
            const unsigned tg = og / nx;
            if (og + 1u == (tg + 1u) * nx) xb_add(&bar[XB_TOPGEN], 1u);
            else XB_SPIN(xb_ld(&bar[XB_TOPGEN]) == tg, bar);
            __builtin_amdgcn_fence(__ATOMIC_ACQUIRE, "agent");
            xb_add(&bar[XB_XGEN(b.x)], 1u);
            asm volatile("s_waitcnt vmcnt(0)" ::: "memory");
        } else {
            XB_SPIN(xb_ld(&bar[XB_XGEN(b.x)]) == gen, bar);
            __builtin_amdgcn_fence(__ATOMIC_ACQUIRE, "agent");
            asm volatile("s_waitcnt vmcnt(0)" ::: "memory");
        }
    }
    __syncthreads();
}

struct Frame {
    LAS unsigned char* lds;
    int vcu, G;
    float* out; unsigned char* ws;
};
#define PHASE_IDS() int tid_ = threadIdx.x; asm volatile("" : "+v"(tid_)); const int tid = tid_, lane = tid & 63, wave = __builtin_amdgcn_readfirstlane(tid >> 6); (void)tid; (void)lane; (void)wave
__device__ __forceinline__ const float* arg_in(int k) { asm volatile("" : "+s"(k)); return ((const float* const __attribute__((address_space(4)))*)__builtin_amdgcn_kernarg_segment_ptr())[k]; }

__device__ __forceinline__ float wave_sum(float v) {
#pragma unroll
    for (int o = 1; o < 64; o <<= 1) v += __shfl_xor(v, o);
    return v;
}
__device__ __forceinline__ void p0_transpose_item(const float* W, int N, bf16_t* WT, int ldk, int koff, LAS float* scr, int item, int lane) {
    const int nblk = N / 32, kb = item / nblk, nb = item % nblk, k0 = 64 * kb, n0 = 32 * nb;
#pragma unroll 8
    for (int i = 0; i < 32; ++i) { const int kk = 2 * i + (lane >> 5); scr[kk * 33 + (lane & 31)] = W[(size_t)(k0 + kk) * N + n0 + (lane & 31)]; }
    LDS_WAIT(); asm volatile("" ::: "memory");
    const int c = lane & 7;
#pragma unroll
    for (int j = 0; j < 4; ++j) { const int n = (lane >> 3) + 8 * j; const LAS float* s = scr + (8 * c) * 33 + n;
        u32x4 o; o.x = cvtpk(s[0 * 33], s[1 * 33]); o.y = cvtpk(s[2 * 33], s[3 * 33]); o.z = cvtpk(s[4 * 33], s[5 * 33]); o.w = cvtpk(s[6 * 33], s[7 * 33]);
        *(u32x4*)(WT + (size_t)(n0 + n) * ldk + koff + k0 + 8 * c) = o; }
    LDS_WAIT(); asm volatile("" ::: "memory");
}
__device__ __forceinline__ void p0_prologue(Frame& F) {
    PHASE_IDS();
    LAS float* scr = (LAS float*)(F.lds + RING_OFF + wave * 16384);
    const int gw = F.vcu * NWAVES + wave, NGW = F.G * NWAVES;
    constexpr int I_IN = (D / 64) * (NIN / 32), I_B = (512 / 64) * (D / 32), I_O = (D / 64) * (D / 32), I_1 = (D / 64) * (FF / 32), I_2 = (FF / 64) * (D / 32);
    constexpr int NL = I_IN + 2 * I_B + I_O + I_1 + I_2, NITEMS = DEPTH * NL;
    for (int it = gw; it < NITEMS; it += NGW) {
        const int L = it / NL; int r = it % NL;
        unsigned char* wb = F.ws + WS_W + (size_t)L * W_LAYER;
        if (r < I_IN) { p0_transpose_item(arg_in(4) + (size_t)L * D * NIN, NIN, (bf16_t*)(wb + WO_IN), D, 0, scr, r, lane); continue; } r -= I_IN;
        if (r < I_B) { p0_transpose_item(arg_in(8) + (size_t)L * 512 * D, D, (bf16_t*)(wb + WO_M), D, 0, scr, r, lane); continue; } r -= I_B;
        if (r < I_B) { p0_transpose_item(arg_in(9) + (size_t)L * 512 * D, D, (bf16_t*)(wb + WO_M), D, 512, scr, r, lane); continue; } r -= I_B;
        if (r < I_O) { p0_transpose_item(arg_in(10) + (size_t)L * D * D, D, (bf16_t*)(wb + WO_OUT), D, 0, scr, r, lane); continue; } r -= I_O;
        if (r < I_1) { p0_transpose_item(arg_in(12) + (size_t)L * D * FF, FF, (bf16_t*)(wb + WO_FF1), D, 0, scr, r, lane); continue; } r -= I_1;
        p0_transpose_item(arg_in(13) + (size_t)L * FF * D, D, (bf16_t*)(wb + WO_FF2), FF, 0, scr, r, lane);
    }
    const float* x = arg_in(0); const float* g = arg_in(3); bf16_t* XN = (bf16_t*)(F.ws + WS_XNY); float* SS = (float*)(F.ws + WS_SS);
    for (int m = gw; m < M; m += NGW) {
        const f32x4* xr = (const f32x4*)(x + (size_t)m * D) + lane; const f32x4* gr = (const f32x4*)g + lane;
        u32x2* o8 = (u32x2*)(XN + (size_t)m * D) + lane; float s = 0.f;
#pragma unroll
        for (int j = 0; j < 4; ++j) { const f32x4 v = xr[64 * j], gg = gr[64 * j]; s += (v[0] * v[0] + v[1] * v[1]) + (v[2] * v[2] + v[3] * v[3]);
            u32x2 w; w.x = cvtpk(v[0] * gg[0], v[1] * gg[1]); w.y = cvtpk(v[2] * gg[2], v[3] * gg[3]); o8[64 * j] = w; }
        s = wave_sum(s);
        if (lane < 16) SS[(size_t)m * 16 + lane] = (lane == 0) ? s : 0.f;
    }
}
__device__ __forceinline__ void final_norm(Frame& F) {
    PHASE_IDS();
    const int gw = F.vcu * NWAVES + wave, NGW = F.G * NWAVES;
    const float* g = arg_in(2); const float* SS = (const float*)(F.ws + WS_SS);
    for (int m = gw; m < M; m += NGW) {
        const float r = pg8::row_rstd(SS, m);
        f32x4* xr = (f32x4*)(F.out + (size_t)m * D) + lane; const f32x4* gr = (const f32x4*)g + lane;
#pragma unroll
        for (int j = 0; j < 4; ++j) { const f32x4 v = xr[64 * j], gg = gr[64 * j]; xr[64 * j] = v * r * gg; }
    }
}

namespace att {
typedef LAS const char* lcp;
__device__ __forceinline__ int crow(int r, int hi) { return (r & 3) + 8 * (r >> 2) + 4 * hi; }
typedef short v4i16_t __attribute__((ext_vector_type(4)));
__device__ __forceinline__ s16x4 vtr(lcp p) { return __builtin_bit_cast(s16x4, __builtin_amdgcn_ds_read_tr16_b64_v4i16((LAS v4i16_t*)p)); }
#define MFMA32(a, b, c) __builtin_amdgcn_mfma_f32_32x32x16_bf16(a, b, c, 0, 0, 0)
#define ATT_WAIT_BAR() asm volatile("s_waitcnt vmcnt(0) lgkmcnt(0)\n\ts_barrier" ::: "memory")
#define GLDS16(gsrc, ldsdst) __builtin_amdgcn_global_load_lds((const unsigned*)(gsrc), (LAS unsigned*)(ldsdst), 16, 0, 0)

__device__ __forceinline__ void qkt(f32x16& p0, f32x16& p1, lcp kslot, const bf16x8* qr, int r32, int hi) {
    lcp kb = kslot + hi * 1024 + r32 * 16;
    p0 = f32x16{}; p1 = f32x16{};
#pragma unroll
    for (int d0 = 0; d0 < 4; ++d0) {
        const bf16x8 b0 = *(const LAS bf16x8*)(kb + d0 * 2048);
        const bf16x8 b1 = *(const LAS bf16x8*)(kb + d0 * 2048 + 512);
        p0 = MFMA32(b0, qr[d0], p0); p1 = MFMA32(b1, qr[d0], p1);
    }
}
__device__ __forceinline__ float rowmax32(const f32x16& p0, const f32x16& p1) {
    float a = fmaxf(p0[0], p1[0]);
#pragma unroll
    for (int r = 1; r < 16; ++r) a = fmaxf(a, fmaxf(p0[r], p1[r]));
    auto rr = __builtin_amdgcn_permlane32_swap(__float_as_uint(a), __float_as_uint(a), false, false);
    return fmaxf(__uint_as_float(rr[0]), __uint_as_float(rr[1]));
}
template <int NB, int THR>
__device__ __forceinline__ void softmax_pv(f32x16& p0, f32x16& p1, f32x16 (&o)[NB], float& mhat, float& l, bool first, lcp vb, LAS float* wsf, int r32, int hi) {
    const float rm = rowmax32(p0, p1);
    bool resc = false;
    if (first) {
        mhat += rm;
#pragma unroll
        for (int r = 0; r < 16; ++r) { p0[r] -= rm; p1[r] -= rm; }
    } else if (__any(rm > (float)THR)) {
        const float dl = fmaxf(rm, 0.f); mhat += dl;
#pragma unroll
        for (int r = 0; r < 16; ++r) { p0[r] -= dl; p1[r] -= dl; }
        const float f = __builtin_amdgcn_exp2f(-dl); l *= f; if (hi == 0) wsf[r32] = f; resc = true;
    }
    float s = 0.f;
#pragma unroll
    for (int r = 0; r < 16; ++r) { p0[r] = __builtin_amdgcn_exp2f(p0[r]); p1[r] = __builtin_amdgcn_exp2f(p1[r]); s += p0[r] + p1[r]; }
    l += s;
    u32x4 pw0, pw1, pw2, pw3;
    pw0 = (u32x4){cvtpk(p0[0], p0[1]), cvtpk(p0[2], p0[3]), cvtpk(p0[4], p0[5]), cvtpk(p0[6], p0[7])};
    pw1 = (u32x4){cvtpk(p0[8], p0[9]), cvtpk(p0[10], p0[11]), cvtpk(p0[12], p0[13]), cvtpk(p0[14], p0[15])};
    pw2 = (u32x4){cvtpk(p1[0], p1[1]), cvtpk(p1[2], p1[3]), cvtpk(p1[4], p1[5]), cvtpk(p1[6], p1[7])};
    pw3 = (u32x4){cvtpk(p1[8], p1[9]), cvtpk(p1[10], p1[11]), cvtpk(p1[12], p1[13]), cvtpk(p1[14], p1[15])};
    if (resc) {
        float fr[16];
#pragma unroll
        for (int r = 0; r < 16; ++r) fr[r] = wsf[crow(r, hi)];
#pragma unroll
        for (int d = 0; d < NB; ++d)
#pragma unroll
            for (int r = 0; r < 16; ++r) o[d][r] *= fr[r];
    }
#pragma unroll
    for (int d0 = 0; d0 < NB; ++d0) {
        s16x4 lo[4], hh[4];
#pragma unroll
        for (int ks = 0; ks < 4; ++ks) { lo[ks] = vtr(vb + d0 * 4096 + ks * 1024); hh[ks] = vtr(vb + d0 * 4096 + ks * 1024 + 512); }
#define ATT_PK(k) (bf16x8){lo[k][0], lo[k][1], lo[k][2], lo[k][3], hh[k][0], hh[k][1], hh[k][2], hh[k][3]}
        o[d0] = MFMA32(__builtin_bit_cast(bf16x8, pw0), ATT_PK(0), o[d0]);
        o[d0] = MFMA32(__builtin_bit_cast(bf16x8, pw1), ATT_PK(1), o[d0]);
        o[d0] = MFMA32(__builtin_bit_cast(bf16x8, pw2), ATT_PK(2), o[d0]);
        o[d0] = MFMA32(__builtin_bit_cast(bf16x8, pw3), ATT_PK(3), o[d0]);
#undef ATT_PK
    }
}
__device__ __forceinline__ void row_inv_l(float l, float (&rli)[16], LAS float* wsf, int r32, int hi) {
    auto rr = __builtin_amdgcn_permlane32_swap(__float_as_uint(l), __float_as_uint(l), false, false);
    const float lt = __uint_as_float(rr[0]) + __uint_as_float(rr[1]);
    if (hi == 0) wsf[32 + r32] = lt;
#pragma unroll
    for (int r = 0; r < 16; ++r) rli[r] = 1.0f / wsf[32 + crow(r, hi)];
}
__device__ __forceinline__ int t5_bucket(int rel) {
    const int n = rel < 0 ? -rel : rel;
    const int large = 8 + (n >= 12) + (n >= 16) + (n >= 23) + (n >= 32) + (n >= 46) + (n >= 64) + (n >= 91);
    return (rel > 0 ? 16 : 0) + (n < 8 ? n : large);
}

template <int THR>
__device__ __forceinline__ void diff_unit(Frame& F, int layer, int bh, int qb) {
    int tid_ = threadIdx.x; asm volatile("" : "+v"(tid_));
    const int tid = tid_, lane = tid & 63, wid = __builtin_amdgcn_readfirstlane(tid >> 6), r32 = lane & 31, hi = lane >> 5;
    const int b = bh >> 2, h = bh & 3, mp = wid >> 2, wq = wid & 3;
    const bf16_t* qkv = (const bf16_t*)(F.ws + WS_QKV);
    bf16_t* Y = (bf16_t*)(F.ws + WS_XNY);
    const size_t tokb = (size_t)b * SEQ;
    LAS unsigned char* lds = F.lds;
    LAS float* wsf = (LAS float*)(lds + ATT_WSF) + wid * 128;
    LAS float* TBL = (LAS float*)(lds + ATT_TBL);
    if (tid < 257) TBL[tid] = arg_in(1)[t5_bucket(tid - 128) * 4 + h] * LOG2E;
    bf16x8 qr[4];
    { const bf16_t* Qw = qkv + (tokb + qb * 128 + wq * 32 + r32) * NQKV + COL_QD + h * 128 + mp * 64 + hi * 8;
#pragma unroll
      for (int d0 = 0; d0 < 4; ++d0) qr[d0] = *(const bf16x8*)(Qw + d0 * 16); }
    const bf16_t* ksrc = qkv + (tokb + lane) * NQKV + COL_KD + h * 128 + wid * 8;
    const bf16_t* vsrc = qkv + (tokb + 16 * (wid & 3) + (lane >> 2)) * NQKV + COL_VD + h * 128 + (wid >> 2) * 32 + (lane & 3) * 8;
    const int voff = ((lane >> 4) & 1) * 32 + (lane & 3) * 8 + (4 * hi + ((lane & 15) >> 2)) * 64;
#define DIFF_DMA(t, buf) do { const size_t go_ = (size_t)(t) * 64 * NQKV; LAS unsigned char* rb_ = lds + (buf) * 32768 + wid * 1024; \
        GLDS16(ksrc + go_, rb_); GLDS16(ksrc + go_ + 64, rb_ + 8192); GLDS16(vsrc + go_, rb_ + 16384); GLDS16(vsrc + go_ + 64, rb_ + 24576); } while (0)
    f32x16 o[4]; o[0] = f32x16{}; o[1] = f32x16{}; o[2] = f32x16{}; o[3] = f32x16{};
    float mhat = 0.f, l = 0.f;
    const int qw0 = qb * 128 + wq * 32;
    DIFF_DMA(0, 0);
    ATT_WAIT_BAR();
    const float tL = TBL[0], tR = TBL[256];
    constexpr int NT = SEQ / 64;
    for (int t = 0; t < NT; ++t) {
        const int buf = t & 1;
        if (t + 1 < NT) DIFF_DMA(t + 1, buf ^ 1);
        lcp kslot = (lcp)(lds + buf * 32768 + mp * 8192);
        lcp vb = (lcp)(lds + buf * 32768 + 16384 + voff);
        f32x16 p0, p1;
        qkt(p0, p1, kslot, qr, r32, hi);
        const int dk = t * 64 - qw0;
        if (dk >= 122) {
            const float cb = tR - mhat;
#pragma unroll
            for (int r = 0; r < 16; ++r) { p0[r] += cb; p1[r] += cb; }
        } else if (dk <= -154) {
            const float cb = tL - mhat;
#pragma unroll
            for (int r = 0; r < 16; ++r) { p0[r] += cb; p1[r] += cb; }
        } else {
            const int base = dk - r32 + 128;
#pragma unroll
            for (int r = 0; r < 16; ++r) {
                int i0 = base + crow(r, hi), i1 = i0 + 32;
                i0 = i0 < 0 ? 0 : (i0 > 256 ? 256 : i0); i1 = i1 < 0 ? 0 : (i1 > 256 ? 256 : i1);
                p0[r] += TBL[i0] - mhat; p1[r] += TBL[i1] - mhat;
            }
        }
        softmax_pv<4, THR>(p0, p1, o, mhat, l, t == 0, vb, wsf, r32, hi);
        ATT_WAIT_BAR();
    }
#undef DIFF_DMA
    float rli[16]; row_inv_l(l, rli, wsf, r32, hi);
#pragma unroll
    for (int d = 0; d < 4; ++d)
#pragma unroll
        for (int r = 0; r < 16; ++r) o[d][r] *= rli[r];
    LAS float* xch = (LAS float*)(lds + 65536) + wq * 4096;
    if (mp == 1) {
#pragma unroll
        for (int d = 0; d < 4; ++d)
#pragma unroll
            for (int r = 0; r < 16; ++r) xch[(d * 16 + r) * 64 + lane] = o[d][r];
    }
    ATT_WAIT_BAR();
    if (mp == 0) {
        const float* lp = arg_in(6) + layer * 256;
        const float s1 = wave_sum(lp[lane] * lp[64 + lane]), s2 = wave_sum(lp[128 + lane] * lp[192 + lane]);
        const float lam_init = 0.8f - 0.6f * expf(-0.3f * (float)layer);
        const float lam = expf(s1) - expf(s2) + lam_init;
        float ssq[16];
#pragma unroll
        for (int r = 0; r < 16; ++r) ssq[r] = 0.f;
#pragma unroll
        for (int d = 0; d < 4; ++d)
#pragma unroll
            for (int r = 0; r < 16; ++r) { const float v = o[d][r] - lam * xch[(d * 16 + r) * 64 + lane]; o[d][r] = v; ssq[r] += v * v; }
#pragma unroll
        for (int r = 0; r < 16; ++r) {
            float v = ssq[r];
            v += __shfl_xor(v, 1); v += __shfl_xor(v, 2); v += __shfl_xor(v, 4); v += __shfl_xor(v, 8); v += __shfl_xor(v, 16);
            ssq[r] = (1.0f - lam_init) / sqrtf(v * (1.0f / 128.0f) + RMS_EPS);
        }
        const float* sg = arg_in(7) + layer * 128;
        bf16_t* yb = Y + (tokb + qb * 128 + wq * 32) * D + 512 + h * 128 + r32;
#pragma unroll
        for (int d = 0; d < 4; ++d) { const float gg = sg[d * 32 + r32];
#pragma unroll
            for (int r = 0; r < 16; ++r) { const float v = o[d][r] * ssq[r] * gg; yb[(size_t)crow(r, hi) * D + d * 32] = (bf16_t)(cvtpk(v, v) & 0xffffu); } }
    }
    ATT_WAIT_BAR();
}

template <int THR>
__device__ __forceinline__ void na_unit(Frame& F, int layer, int idx) {
    int tid_ = threadIdx.x; asm volatile("" : "+v"(tid_));
    const int tid = tid_, lane = tid & 63, wid = __builtin_amdgcn_readfirstlane(tid >> 6), r32 = lane & 31, hi = lane >> 5;
    const int b = idx >> 6, h = (idx >> 3) & 7, g = idx & 7;
    const int row = 4 * g + (wid >> 1), half = wid & 1, c = 32 * half + r32;
    const bf16_t* qkv = (const bf16_t*)(F.ws + WS_QKV);
    bf16_t* Y = (bf16_t*)(F.ws + WS_XNY);
    const size_t tokb = (size_t)b * SEQ;
    LAS unsigned char* lds = F.lds;
    LAS float* wsf = (LAS float*)(lds + ATT_WSF) + wid * 128;
    LAS float* RPB = (LAS float*)(lds + ATT_TBL);
    if (tid < 480) { const int dr = tid >> 5, i = tid & 31; RPB[tid] = (i < 31) ? arg_in(5)[((size_t)(layer * 8 + h) * 15 + dr) * 31 + i] * LOG2E : 0.f; }
    bf16x8 qr[4];
    { const bf16_t* Qw = qkv + (tokb + row * 64 + c) * NQKV + COL_QA + h * 64 + hi * 8;
#pragma unroll
      for (int d0 = 0; d0 < 4; ++d0) qr[d0] = *(const bf16x8*)(Qw + d0 * 16); }
    const int lo = (4 * g - 4) < 0 ? 0 : ((4 * g - 4) > 24 ? 24 : (4 * g - 4));
    const int hr = ((4 * g - 1) < 0 ? 0 : ((4 * g - 1) > 24 ? 24 : (4 * g - 1))) + 7;
    const int ntile = hr - lo + 1;
    const int r0 = (row - 4) < 0 ? 0 : ((row - 4) > 24 ? 24 : (row - 4));
    const int c0 = (c - 8) < 0 ? 0 : ((c - 8) > 48 ? 48 : (c - 8));
    const bf16_t* ksrc = qkv + (tokb + lane) * NQKV + COL_KA + h * 64 + wid * 8;
    const bf16_t* vsrc = qkv + (tokb + 16 * (wid & 3) + (lane >> 2)) * NQKV + COL_VA + h * 64 + (wid >> 2) * 32 + (lane & 3) * 8;
    const int voff = ((lane >> 4) & 1) * 32 + (lane & 3) * 8 + (4 * hi + ((lane & 15) >> 2)) * 64;
#define NA_DMA(kr, buf) do { const size_t go_ = (size_t)(kr) * 64 * NQKV; LAS unsigned char* rb_ = lds + (buf) * 32768 + wid * 1024; \
        GLDS16(ksrc + go_, rb_); GLDS16(vsrc + go_, rb_ + 16384); } while (0)
    f32x16 o[2]; o[0] = f32x16{}; o[1] = f32x16{};
    float mhat = 0.f, l = 0.f;
    NA_DMA(lo, 0);
    ATT_WAIT_BAR();
    for (int tt = 0; tt < ntile; ++tt) {
        const int buf = tt & 1, kr = lo + tt;
        if (tt + 1 < ntile) NA_DMA(kr + 1, buf ^ 1);
        if (kr >= r0 && kr < r0 + 8) {
            lcp kslot = (lcp)(lds + buf * 32768);
            lcp vb = (lcp)(lds + buf * 32768 + 16384 + voff);
            f32x16 p0, p1;
            qkt(p0, p1, kslot, qr, r32, hi);
            const LAS float* rp = RPB + (kr - row + 7) * 32;
#pragma unroll
            for (int r = 0; r < 16; ++r) {
                const int k0c = crow(r, hi), k1c = k0c + 32;
                int i0 = k0c - c + 15, i1 = k1c - c + 15;
                const bool v0 = (k0c >= c0) && (k0c < c0 + 16), v1 = (k1c >= c0) && (k1c < c0 + 16);
                i0 = i0 < 0 ? 0 : (i0 > 30 ? 30 : i0); i1 = i1 < 0 ? 0 : (i1 > 30 ? 30 : i1);
                const float b0 = rp[i0] - mhat, b1 = rp[i1] - mhat;
                p0[r] = v0 ? p0[r] + b0 : -INFINITY; p1[r] = v1 ? p1[r] + b1 : -INFINITY;
            }
            softmax_pv<2, THR>(p0, p1, o, mhat, l, kr == r0, vb, wsf, r32, hi);
        }
        ATT_WAIT_BAR();
    }
#undef NA_DMA
    float rli[16]; row_inv_l(l, rli, wsf, r32, hi);
    bf16_t* yb = Y + (tokb + row * 64 + 32 * half) * D + h * 64 + r32;
#pragma unroll
    for (int d = 0; d < 2; ++d)
#pragma unroll
        for (int r = 0; r < 16; ++r) { const float v = o[d][r] * rli[r]; yb[(size_t)crow(r, hi) * D + d * 32] = (bf16_t)(cvtpk(v, v) & 0xffffu); }
    ATT_WAIT_BAR();
}
}

constexpr int NPHASE = 2 + 6 * DEPTH;
struct Args { const float* in[14]; float* out; unsigned char* ws; int ph_lo, ph_hi; };
__global__ void __launch_bounds__(NWAVES * 64, 2) enc_fwd(Args args) {
    extern __shared__ __attribute__((aligned(16))) unsigned char lds[];
    Frame F;
    F.lds = (LAS unsigned char*)lds;
    F.G = gridDim.x; { const int bx = blockIdx.x; F.vcu = (F.G % 8 == 0) ? (bx % 8) * (F.G / 8) + bx / 8 : bx; }
    F.out = args.out; F.ws = args.ws;
    unsigned char* ws = args.ws;
    volatile LAS unsigned* MISC = (volatile LAS unsigned*)(F.lds + MISC_OFF);
    for (int u = threadIdx.x; u < (LDS_BYTES - LDSCTL_OFF) / 4; u += NWAVES * 64) ((LAS unsigned*)(F.lds + LDSCTL_OFF))[u] = 0u;
    __syncthreads();
    XcdBarrier bar; bar.bar = (unsigned*)(ws + WS_CTL) + CW_BAR; bar.x = 0; bar.st = nullptr;
#if !MK_PER_PHASE
    bar = xcd_barrier_post((unsigned*)(ws + WS_CTL) + CW_BAR, MISC + 8);
#endif
    const int lo = args.ph_lo, hi = args.ph_hi;
#define IN(k) (lo <= (k) && (k) < hi)
#if MK_PER_PHASE
#define SEAM(k) do { } while (0)
#else
#define SEAM(k) do { if (IN(k) && IN((k) + 1)) xcd_barrier(bar); } while (0)
#endif
    bf16_t* XNY = (bf16_t*)(ws + WS_XNY); bf16_t* QKV = (bf16_t*)(ws + WS_QKV); bf16_t* GATES = (bf16_t*)(ws + WS_GATES);
    bf16_t* MERGED = (bf16_t*)(ws + WS_MERGED); bf16_t* HB = (bf16_t*)(ws + WS_H); float* SS = (float*)(ws + WS_SS);

    if (IN(0)) { p0_prologue(F); } SEAM(0);
#pragma unroll 1
    for (int L = 0; L < DEPTH; ++L) {
        const int pb = 1 + 6 * L;
        unsigned char* wb = ws + WS_W + (size_t)L * W_LAYER;
        if (IN(pb + 0) && !DIS(0)) {
            pg8::Gemm g{XNY, (const bf16_t*)(wb + WO_IN), M, NIN, D}; pg8::StaticOrder S; S.init(M, NIN, F.G, (int)blockIdx.x);
            pg8::EpiProj E{QKV, GATES, SS};
            pg8::gemm_phase<pg8::EpiProj, pg8::StaticOrder, true, true>(F.lds + RING_OFF, g, S, E);
        } SEAM(pb + 0);
        if (IN(pb + 1) && !DIS(1)) {
#ifndef NO_DIFF
#pragma unroll 1
            for (int i = 0; i < 512; ++i) { const int u = 2 * F.vcu + (i & 1) + (i >> 1) * 2 * F.G; if (u >= 512) break; att::diff_unit<8>(F, L, u >> 4, u & 15); }
#endif
#ifndef NO_NA
#pragma unroll 1
            for (int i = 0; i < 512; ++i) { const int u = 2 * F.vcu + (i & 1) + (i >> 1) * 2 * F.G; if (u >= 512) break; att::na_unit<8>(F, L, u); }
#endif
        } SEAM(pb + 1);
        if (IN(pb + 2) && !DIS(2)) {
            pg8::Gemm g{XNY, (const bf16_t*)(wb + WO_M), M, D, D}; pg8::StaticOrder S; S.init(M, D, F.G, (int)blockIdx.x);
            pg8::EpiMerge E{MERGED, GATES};
            pg8::gemm_phase<pg8::EpiMerge, pg8::StaticOrder, false, true>(F.lds + RING_OFF, g, S, E);
        } SEAM(pb + 2);
        if (IN(pb + 3) && !DIS(3)) {
            pg8::Gemm g{MERGED, (const bf16_t*)(wb + WO_OUT), M, D, D}; pg8::StaticOrder S; S.init(M, D, F.G, (int)blockIdx.x);
            const float* xin = (L == 0) ? arg_in(0) : F.out;
            pg8::EpiResid E{xin, F.out, XNY, arg_in(11) + L * D, SS};
            pg8::gemm_phase<pg8::EpiResid, pg8::StaticOrder, false, true>(F.lds + RING_OFF, g, S, E);
        } SEAM(pb + 3);
        if (IN(pb + 4) && !DIS(4)) {
            pg8::Gemm g{XNY, (const bf16_t*)(wb + WO_FF1), M, FF, D}; pg8::StaticOrder S; S.init(M, FF, F.G, (int)blockIdx.x);
            pg8::EpiFF1 E{HB, SS};
            pg8::gemm_phase<pg8::EpiFF1, pg8::StaticOrder, true, true>(F.lds + RING_OFF, g, S, E);
        } SEAM(pb + 4);
        if (IN(pb + 5) && !DIS(5)) {
            pg8::Gemm g{HB, (const bf16_t*)(wb + WO_FF2), M, D, FF}; pg8::StaticOrder S; S.init(M, D, F.G, (int)blockIdx.x);
            pg8::EpiResid E{F.out, F.out, (L + 1 < DEPTH) ? XNY : (bf16_t*)nullptr, arg_in(3) + (L + 1 < DEPTH ? (L + 1) * D : 0), SS};
            pg8::gemm_phase<pg8::EpiResid, pg8::StaticOrder, false, true>(F.lds + RING_OFF, g, S, E);
        } SEAM(pb + 5);
    }
    if (IN(NPHASE - 1)) final_norm(F);
#undef IN
#undef SEAM
}

extern "C" void kernel_launch(void* const* d_in, const int* in_sizes, int n_in, void* d_out, int out_size, void* d_ws, size_t ws_size, hipStream_t stream) {
    static int grid = 0;
    if (grid == 0) {
        if (n_in != 14 || in_sizes[0] != M * D || out_size != M * D || ws_size < WS_END) { fprintf(stderr, "kernel_launch: unexpected shapes (n_in %d, in0 %d, out %d, ws %zu); nothing launched\n", n_in, n_in > 0 ? in_sizes[0] : -1, out_size, ws_size); grid = -1; return; }
        int dev = 0, cus = 0;
        if (hipGetDevice(&dev) != hipSuccess || hipDeviceGetAttribute(&cus, hipDeviceAttributeMultiprocessorCount, dev) != hipSuccess) { grid = -1; return; }
        if (hipFuncSetAttribute((const void*)enc_fwd, hipFuncAttributeMaxDynamicSharedMemorySize, LDS_BYTES) != hipSuccess) { fprintf(stderr, "kernel_launch: hipFuncSetAttribute failed\n"); grid = -1; return; }
        int per_cu = 0;
        if (hipOccupancyMaxActiveBlocksPerMultiprocessor(&per_cu, (const void*)enc_fwd, NWAVES * 64, LDS_BYTES) != hipSuccess || per_cu < 1) fprintf(stderr, "kernel_launch: occupancy query reports %d per CU\n", per_cu);
        (void)hipGetLastError();
        grid = cus;
    }
    if (grid < 0) return;
    Args a{};
    for (int i = 0; i < 14; ++i) a.in[i] = (const float*)d_in[i];
    a.out = (float*)d_out; a.ws = (unsigned char*)d_ws;
#if MK_PER_PHASE
    for (int p = 0; p < NPHASE; ++p) { a.ph_lo = p; a.ph_hi = p + 1; hipLaunchKernelGGL(enc_fwd, dim3(grid), dim3(NWAVES * 64), LDS_BYTES, stream, a); }
#else
    if (hipMemsetAsync((char*)d_ws + WS_CTL, 0, CTL_ZERO_BYTES, stream) != hipSuccess) { fprintf(stderr, "kernel_launch: memset failed\n"); return; }
    a.ph_lo = 0; a.ph_hi = NPHASE;
    hipLaunchKernelGGL(enc_fwd, dim3(grid), dim3(NWAVES * 64), LDS_BYTES, stream, a);
#endif
}
```

```cpp
#include <hip/hip_runtime.h>
#include <cstdio>
#include <cstdint>

#define LAS __attribute__((address_space(3)))
#define GAS __attribute__((address_space(1)))
typedef unsigned short bf16_t;
typedef short bf16x8 __attribute__((ext_vector_type(8)));
typedef short s16x4 __attribute__((ext_vector_type(4)));
typedef float f32x4 __attribute__((ext_vector_type(4)));
typedef float f32x2 __attribute__((ext_vector_type(2)));
typedef float f32x16 __attribute__((ext_vector_type(16)));
typedef unsigned u32x4 __attribute__((ext_vector_type(4)));
typedef unsigned u32x2 __attribute__((ext_vector_type(2)));
typedef __bf16 bf16x2_t __attribute__((ext_vector_type(2)));

constexpr int BATCH = 8, SEQ = 2048, D = 1024, M = BATCH * SEQ, DEPTH = 2, FF = 4096;
constexpr int NQKV = 3072, NGATE = 2048, NIN = 5120;
constexpr int MB = SEQ;
constexpr float RMS_EPS = 1e-6f;
constexpr float LOG2E = 1.4426950408889634f;
constexpr float C2 = 0.125f * LOG2E;
constexpr int COL_QA = 0, COL_KA = 512, COL_VA = 1024, COL_QD = 1536, COL_KD = 2048, COL_VD = 2560;

__device__ __forceinline__ unsigned cvtpk(float lo, float hi) { f32x2 v = {lo, hi}; bf16x2_t b = __builtin_convertvector(v, bf16x2_t); return __builtin_bit_cast(unsigned, b); }
__device__ __forceinline__ float bf2f(unsigned short u) { return __uint_as_float((unsigned)u << 16); }
__device__ __forceinline__ float bflo(unsigned w) { return __uint_as_float(w << 16); }
__device__ __forceinline__ float bfhi(unsigned w) { return __uint_as_float(w & 0xffff0000u); }

__device__ __forceinline__ unsigned lane_id_now() { unsigned l; asm volatile("v_mbcnt_lo_u32_b32 %0, -1, 0\n\tv_mbcnt_hi_u32_b32 %0, -1, %0" : "=v"(l)); return l; }
__device__ __forceinline__ void store16_wt(void* p, u32x4 v) { asm volatile("global_store_dwordx4 %0, %1, off sc1\n\ts_nop 1" :: "v"(p), "v"(v) : "memory"); }
namespace pg8 {
constexpr int BM = 256, BK = 64, HALF = 128, HTB = HALF * BK * 2, STAGE_BYTES = 8 * HTB, NXCD = 8, WGM = 8;
__host__ __device__ __forceinline__ int lds_byte(int r, int c) { const int st = (r >> 4) * 2 + (c >> 5), rr = r & 15, cc = c & 31, ob = rr * 64 + cc * 2; return st * 1024 + (ob ^ (((ob >> 9) & 1) << 5)); }
__host__ __device__ __forceinline__ void stage_rc(int b, int& R, int& C) { const int st = b / 1024, sb = b % 1024, swz = sb ^ (((sb >> 9) & 1) << 5); R = (st >> 1) * 16 + swz / 64; C = (st & 1) * 32 + (swz % 64) / 2; }
__host__ __device__ __forceinline__ int perm32(int rho) { const int n = rho >> 4, i = rho & 15; return 8 * (i >> 2) + 4 * n + (i & 3); }

struct Unit { int pm, pn; };
struct Gemm { const bf16_t* A; const bf16_t* Bt; int M, N, K; };

struct BatchOrder {
    int nN, nloc, rank;
    __device__ bool next(int i, Unit& u) const { const int L = i * nloc + rank; if (L >= 8 * nN) return false; u.pm = L & 7; u.pn = L >> 3; return true; }
};

__device__ __forceinline__ float row_rstd(const float* ss, int row) {
    const f32x4 a = *(const f32x4*)(ss + (size_t)row * 4);
    const float s = (a[0] + a[1]) + (a[2] + a[3]);
    return 1.0f / sqrtf(s * (1.0f / (float)D) + RMS_EPS);
}

struct EpiProj {
    static constexpr bool HAS_POST = false;
    static constexpr bool PERM = true, HAS_MID = false;
    bf16_t* qkv; bf16_t* gates; const float* ss;
    __device__ __forceinline__ void mid(f32x4 (&acc)[2][2][4][2], const Unit& u, int wr, int wc, int fr, int fq) const {}
    __device__ __forceinline__ void operator()(f32x4 (&acc)[2][2][4][2], const Unit& u, int wr, int wc, int fr, int fq) const {
        const int row0 = u.pm * BM + wr * 64 + fr;
        float rs[2][4];
#pragma unroll
        for (int ai = 0; ai < 2; ++ai)
#pragma unroll
            for (int m = 0; m < 4; ++m) rs[ai][m] = row_rstd(ss, row0 + ai * HALF + m * 16);
        if (u.pn < 12) {
            const float sc = (u.pn < 2 || u.pn == 6 || u.pn == 7) ? C2 : 1.0f;
            const int col0 = u.pn * BM + wc * 32 + 8 * fq;
#pragma unroll
            for (int ai = 0; ai < 2; ++ai)
#pragma unroll
                for (int m = 0; m < 4; ++m) { const int row = row0 + ai * HALF + m * 16; const float r = rs[ai][m] * sc; bf16_t* rowp = qkv + (size_t)row * NQKV + col0;
#pragma unroll
                    for (int bj = 0; bj < 2; ++bj) { const f32x4 v0 = acc[ai][bj][m][0] * r, v1 = acc[ai][bj][m][1] * r;
                        u32x4 w; w.x = cvtpk(v0[0], v0[1]); w.y = cvtpk(v0[2], v0[3]); w.z = cvtpk(v1[0], v1[1]); w.w = cvtpk(v1[2], v1[3]);
                        store16_wt(rowp + bj * HALF, w); } }
        } else {
            const int col0 = (u.pn - 12) * HALF + wc * 32 + 8 * fq;
#pragma unroll
            for (int ai = 0; ai < 2; ++ai)
#pragma unroll
                for (int m = 0; m < 4; ++m) { const int row = row0 + ai * HALF + m * 16; const float r = rs[ai][m]; float rho[8], sg[8];
#pragma unroll
                    for (int n = 0; n < 2; ++n)
#pragma unroll
                        for (int e = 0; e < 4; ++e) { const float ga = acc[ai][0][m][n][e] * r, gd = fmaxf(acc[ai][1][m][n][e] * r, -80.f);
                            const float ed = 1.f + __expf(-gd), ea = 1.f + __expf(-ga); rho[4 * n + e] = ed * __builtin_amdgcn_rcpf(ea); sg[4 * n + e] = __builtin_amdgcn_rcpf(ed); }
                    u32x4 w; w.x = cvtpk(rho[0], rho[1]); w.y = cvtpk(rho[2], rho[3]); w.z = cvtpk(rho[4], rho[5]); w.w = cvtpk(rho[6], rho[7]);
                    store16_wt(gates + (size_t)row * D + col0, w);
                    w.x = cvtpk(sg[0], sg[1]); w.y = cvtpk(sg[2], sg[3]); w.z = cvtpk(sg[4], sg[5]); w.w = cvtpk(sg[6], sg[7]);
                    store16_wt(gates + (size_t)MB * D + (size_t)row * D + col0, w); }
        }
    }
};
struct EpiFF1 {
    static constexpr bool HAS_POST = false;
    static constexpr bool PERM = true, HAS_MID = false;
    bf16_t* H; const float* ss;
    __device__ __forceinline__ void mid(f32x4 (&acc)[2][2][4][2], const Unit& u, int wr, int wc, int fr, int fq) const {}
    __device__ __forceinline__ void operator()(f32x4 (&acc)[2][2][4][2], const Unit& u, int wr, int wc, int fr, int fq) const {
        const int row0 = u.pm * BM + wr * 64 + fr, col0 = u.pn * BM + wc * 32 + 8 * fq;
        float rs[2][4];
#pragma unroll
        for (int ai = 0; ai < 2; ++ai)
#pragma unroll
            for (int m = 0; m < 4; ++m) rs[ai][m] = row_rstd(ss, row0 + ai * HALF + m * 16);
#pragma unroll
        for (int ai = 0; ai < 2; ++ai)
#pragma unroll
            for (int m = 0; m < 4; ++m) { const int row = row0 + ai * HALF + m * 16; const float r = rs[ai][m]; bf16_t* rowp = H + (size_t)row * FF + col0;
#pragma unroll
                for (int bj = 0; bj < 2; ++bj) { f32x4 v0 = acc[ai][bj][m][0] * r, v1 = acc[ai][bj][m][1] * r;
#pragma unroll
                    for (int e = 0; e < 4; ++e) { const float a = fmaxf(v0[e], 0.f), b = fmaxf(v1[e], 0.f); v0[e] = a * a; v1[e] = b * b; }
                    u32x4 w; w.x = cvtpk(v0[0], v0[1]); w.y = cvtpk(v0[2], v0[3]); w.z = cvtpk(v1[0], v1[1]); w.w = cvtpk(v1[2], v1[3]);
                    store16_wt(rowp + bj * HALF, w); } }
    }
};
struct EpiMerge {
    static constexpr bool HAS_POST = false;
    static constexpr bool PERM = true, HAS_MID = true;
    bf16_t* O; const bf16_t* gates;
    __device__ __forceinline__ void mid(f32x4 (&acc)[2][2][4][2], const Unit& u, int wr, int wc, int fr, int fq) const {
        const int row0 = u.pm * BM + wr * 64 + fr, col0 = u.pn * BM + wc * 32 + 8 * fq;
        const bf16_t* gp = gates + (size_t)row0 * D + col0;
#pragma unroll
        for (int ai = 0; ai < 2; ++ai)
#pragma unroll
            for (int mp = 0; mp < 2; ++mp) {
                asm volatile("" : "+v"(gp) :: "memory");
                u32x4 g[2][2];
#pragma unroll
                for (int q = 0; q < 2; ++q)
#pragma unroll
                    for (int bj = 0; bj < 2; ++bj) g[q][bj] = *(const GAS u32x4*)(gp + q * 16 * D + bj * HALF);
#pragma unroll
                for (int q = 0; q < 2; ++q)
#pragma unroll
                    for (int bj = 0; bj < 2; ++bj)
#pragma unroll
                        for (int w = 0; w < 4; ++w) { acc[ai][bj][2 * mp + q][w >> 1][(w & 1) * 2] *= bflo(g[q][bj][w]); acc[ai][bj][2 * mp + q][w >> 1][(w & 1) * 2 + 1] *= bfhi(g[q][bj][w]); }
                gp += (mp == 1 ? (HALF - 32) : 32) * D; }
    }
    __device__ __forceinline__ void operator()(f32x4 (&acc)[2][2][4][2], const Unit& u, int wr, int wc, int fr, int fq) const {
        const int row0 = u.pm * BM + wr * 64 + fr, col0 = u.pn * BM + wc * 32 + 8 * fq;
        const bf16_t* gp = gates + (size_t)MB * D + (size_t)row0 * D + col0; bf16_t* rowp = O + (size_t)row0 * D + col0;
#pragma unroll
        for (int ai = 0; ai < 2; ++ai)
#pragma unroll
            for (int mp = 0; mp < 2; ++mp) {
                asm volatile("" : "+v"(gp), "+v"(rowp) :: "memory");
                u32x4 g[2][2];
#pragma unroll
                for (int q = 0; q < 2; ++q)
#pragma unroll
                    for (int bj = 0; bj < 2; ++bj) g[q][bj] = *(const GAS u32x4*)(gp + q * 16 * D + bj * HALF);
#pragma unroll
                for (int q = 0; q < 2; ++q)
#pragma unroll
                    for (int bj = 0; bj < 2; ++bj) { float o[8];
#pragma unroll
                        for (int w = 0; w < 4; ++w) { o[2 * w] = acc[ai][bj][2 * mp + q][w >> 1][(w & 1) * 2] * bflo(g[q][bj][w]); o[2 * w + 1] = acc[ai][bj][2 * mp + q][w >> 1][(w & 1) * 2 + 1] * bfhi(g[q][bj][w]); }
                        u32x4 w4; w4.x = cvtpk(o[0], o[1]); w4.y = cvtpk(o[2], o[3]); w4.z = cvtpk(o[4], o[5]); w4.w = cvtpk(o[6], o[7]);
                        store16_wt((void*)(rowp + q * 16 * D + bj * HALF), w4); }
                gp += (mp == 1 ? (HALF - 32) : 32) * D; rowp += (mp == 1 ? (HALF - 32) : 32) * D; }
    }
};
struct EpiResid {
    static constexpr bool HAS_POST = true;
    static constexpr bool PERM = true, HAS_MID = false;
    bf16_t* xb; float* ss; float qs[2][4];
    __device__ __forceinline__ void mid(f32x4 (&acc)[2][2][4][2], const Unit& u, int wr, int wc, int fr, int fq) const {}
    __device__ __forceinline__ void operator()(f32x4 (&acc)[2][2][4][2], const Unit& u, int wr, int wc, int fr, int fq) {
        const int row0 = u.pm * BM + wr * 64 + fr, col0 = u.pn * BM + wc * 32 + 8 * fq;
#pragma unroll
        for (int ai = 0; ai < 2; ++ai)
#pragma unroll
            for (int m = 0; m < 4; ++m) { const int row = row0 + ai * HALF + m * 16; bf16_t* rowp = xb + (size_t)row * D + col0; float q = 0.f;
#pragma unroll
                for (int bj = 0; bj < 2; ++bj) { const u32x4 xv = *(const u32x4*)(rowp + bj * HALF);
                    const f32x4 y0 = (f32x4){bflo(xv.x), bfhi(xv.x), bflo(xv.y), bfhi(xv.y)} + acc[ai][bj][m][0], y1 = (f32x4){bflo(xv.z), bfhi(xv.z), bflo(xv.w), bfhi(xv.w)} + acc[ai][bj][m][1];
                    q += (y0[0] * y0[0] + y0[1] * y0[1]) + (y0[2] * y0[2] + y0[3] * y0[3]) + (y1[0] * y1[0] + y1[1] * y1[1]) + (y1[2] * y1[2] + y1[3] * y1[3]);
                    u32x4 w; w.x = cvtpk(y0[0], y0[1]); w.y = cvtpk(y0[2], y0[3]); w.z = cvtpk(y1[0], y1[1]); w.w = cvtpk(y1[2], y1[3]);
                    *(u32x4*)(rowp + bj * HALF) = w; }
                q += __shfl_xor(q, 16); q += __shfl_xor(q, 32);
                qs[ai][m] = q; }
    }
    __device__ __forceinline__ void post(LAS unsigned char* lds, f32x4 (&acc)[2][2][4][2], const Unit& u, int wr, int wc, int fr, int fq, int tid) {
        LAS float* P = (LAS float*)lds;
        if (fq == 0) {
#pragma unroll
            for (int ai = 0; ai < 2; ++ai)
#pragma unroll
                for (int m = 0; m < 4; ++m) P[(ai * HALF + wr * 64 + m * 16 + fr) * 4 + wc] = qs[ai][m];
        }
        asm volatile("s_waitcnt lgkmcnt(0)" ::: "memory"); __builtin_amdgcn_s_barrier(); asm volatile("" ::: "memory");
        if (tid < 256) { const f32x4 v = *(const LAS f32x4*)(P + tid * 4); ss[(size_t)(u.pm * BM + tid) * 4 + u.pn] = (v[0] + v[1]) + (v[2] + v[3]); }
    }
};

struct EpiFinal {
    static constexpr bool HAS_POST = true;
    static constexpr bool PERM = true, HAS_MID = false;
    const bf16_t* xb; float* ss; const float* g; float* out; unsigned* cnt; float qs[2][4];
    __device__ __forceinline__ void mid(f32x4 (&acc)[2][2][4][2], const Unit& u, int wr, int wc, int fr, int fq) const {}
    __device__ __forceinline__ void operator()(f32x4 (&acc)[2][2][4][2], const Unit& u, int wr, int wc, int fr, int fq) {
        const int row0 = u.pm * BM + wr * 64 + fr, col0 = u.pn * BM + wc * 32 + 8 * fq;
#pragma unroll
        for (int ai = 0; ai < 2; ++ai)
#pragma unroll
            for (int m = 0; m < 4; ++m) { const int row = row0 + ai * HALF + m * 16; const bf16_t* rowp = xb + (size_t)row * D + col0; float q = 0.f;
#pragma unroll
                for (int bj = 0; bj < 2; ++bj) { const u32x4 xv = *(const u32x4*)(rowp + bj * HALF);
                    const f32x4 y0 = (f32x4){bflo(xv.x), bfhi(xv.x), bflo(xv.y), bfhi(xv.y)} + acc[ai][bj][m][0], y1 = (f32x4){bflo(xv.z), bfhi(xv.z), bflo(xv.w), bfhi(xv.w)} + acc[ai][bj][m][1];
                    q += (y0[0] * y0[0] + y0[1] * y0[1]) + (y0[2] * y0[2] + y0[3] * y0[3]) + (y1[0] * y1[0] + y1[1] * y1[1]) + (y1[2] * y1[2] + y1[3] * y1[3]);
                    acc[ai][bj][m][0] = y0; acc[ai][bj][m][1] = y1; }
                q += __shfl_xor(q, 16); q += __shfl_xor(q, 32);
                qs[ai][m] = q; }
    }
    __device__ __forceinline__ void post(LAS unsigned char* lds, f32x4 (&acc)[2][2][4][2], const Unit& u, int wr, int wc, int fr, int fq, int tid) {
        LAS float* P = (LAS float*)lds;
        LAS float* S = (LAS float*)(lds + 4096);
        LAS unsigned* flag = (LAS unsigned*)(lds + 4096 + 1024);
        if (fq == 0) {
#pragma unroll
            for (int ai = 0; ai < 2; ++ai)
#pragma unroll
                for (int m = 0; m < 4; ++m) P[(ai * HALF + wr * 64 + m * 16 + fr) * 4 + wc] = qs[ai][m];
        }
        asm volatile("s_waitcnt lgkmcnt(0)" ::: "memory"); __builtin_amdgcn_s_barrier(); asm volatile("" ::: "memory");
        unsigned* pc = cnt + 64 * u.pm;
        if (tid < 256) {
            const f32x4 v = *(const LAS f32x4*)(P + tid * 4);
            __hip_atomic_store(ss + (size_t)(u.pm * BM + tid) * 4 + u.pn, (v[0] + v[1]) + (v[2] + v[3]), __ATOMIC_RELAXED, __HIP_MEMORY_SCOPE_AGENT);
            asm volatile("s_waitcnt vmcnt(0)" ::: "memory");
            if ((tid & 63) == 0) __hip_atomic_fetch_add(pc, 1u, __ATOMIC_RELAXED, __HIP_MEMORY_SCOPE_AGENT);
        }
        if (tid < 64) {
            unsigned sp = 0;
            while ((unsigned)__builtin_amdgcn_readfirstlane(__hip_atomic_load(pc, __ATOMIC_RELAXED, __HIP_MEMORY_SCOPE_AGENT)) < 16u) { __builtin_amdgcn_s_sleep(2); if (++sp > (1u << 20)) break; }
            __builtin_amdgcn_fence(__ATOMIC_ACQUIRE, "agent");
            asm volatile("s_waitcnt vmcnt(0)" ::: "memory");
            if (tid == 0) flag[0] = 1u;
        }
        asm volatile("s_waitcnt lgkmcnt(0)" ::: "memory"); __builtin_amdgcn_s_barrier(); asm volatile("" ::: "memory");
        if (tid < 256) {
            const float* sp4 = ss + (size_t)(u.pm * BM + tid) * 4; float t = 0.f;
#pragma unroll
            for (int j = 0; j < 4; ++j) t += __hip_atomic_load(sp4 + j, __ATOMIC_RELAXED, __HIP_MEMORY_SCOPE_AGENT);
            S[tid] = 1.0f / sqrtf(t * (1.0f / (float)D) + RMS_EPS);
        }
        asm volatile("s_waitcnt vmcnt(0) lgkmcnt(0)" ::: "memory"); __builtin_amdgcn_s_barrier(); asm volatile("" ::: "memory");
        const int row0 = u.pm * BM + wr * 64 + fr, col0 = u.pn * BM + wc * 32 + 8 * fq;
        f32x4 gv[2][2];
#pragma unroll
        for (int bj = 0; bj < 2; ++bj)
#pragma unroll
            for (int n = 0; n < 2; ++n) gv[bj][n] = *(const f32x4*)(g + col0 + bj * HALF + 4 * n);
#pragma unroll
        for (int ai = 0; ai < 2; ++ai)
#pragma unroll
            for (int m = 0; m < 4; ++m) { const int rl = ai * HALF + wr * 64 + m * 16 + fr; const float r = S[rl]; float* rowp = out + (size_t)(u.pm * BM + rl) * D + col0;
#pragma unroll
                for (int bj = 0; bj < 2; ++bj) { *(f32x4*)(rowp + bj * HALF) = acc[ai][bj][m][0] * r * gv[bj][0]; *(f32x4*)(rowp + bj * HALF + 4) = acc[ai][bj][m][1] * r * gv[bj][1]; } }
    }
};

template <class Epi, class Sched, bool ALIGN_EPI, bool SP2>
__device__ __forceinline__ void gemm_phase(LAS unsigned char* lds, const Gemm g, const Sched& S, Epi& E, int wave_) {
    const int tid_ = wave_ * 64 + (int)lane_id_now();
    const int tid = tid_, wid = __builtin_amdgcn_readfirstlane(tid >> 6), lane = tid & 63, wr = wid >> 2, wc = wid & 3, fr = lane & 15, fq = lane >> 4;
    const int K = g.K, nt = K / BK;
    unsigned voffA[2], voffB[2];
#pragma unroll
    for (int i = 0; i < 2; ++i) { int R, C; stage_rc(tid * 16 + i * 8192, R, C); const int Rb = Epi::PERM ? ((R & ~31) + perm32(R & 31)) : R;
        voffA[i] = (unsigned)(R * K + C) * 2u; voffB[i] = (unsigned)(Rb * K + C) * 2u; }
    const size_t kstep = (size_t)(BK * 2);
    const size_t hstep = (size_t)HALF * K * 2;
    const size_t tstep = 2 * hstep;
    const unsigned ldsw = (unsigned)wid * 1024u;
    const int aoff = lds_byte(wr * 64 + fr, fq * 8), boff = lds_byte(wc * 32 + fr, fq * 8);
#define PG8_SA(b, h) (((b) * 2 + (h)) * HTB)
#define PG8_SB(b, h) ((4 + (b) * 2 + (h)) * HTB)
#define PG8_STAGE(bufoff, gbase, voff) do { _Pragma("unroll") for (int _i = 0; _i < 2; ++_i) \
        __builtin_amdgcn_global_load_lds((const unsigned*)((const char*)(gbase) + (voff)[_i]), (LAS unsigned*)(lds + (bufoff) + ldsw + _i * 8192), 16, 0, 0); } while (0)
#define PG8_LDA(dst, b, h) do { _Pragma("unroll") for (int m = 0; m < 4; ++m) _Pragma("unroll") for (int k = 0; k < 2; ++k) dst[m][k] = *(const LAS bf16x8*)(lds + PG8_SA(b, h) + aoff + m * 2048 + k * 1024); } while (0)
#define PG8_LDB(dst, b, h) do { _Pragma("unroll") for (int n = 0; n < 2; ++n) _Pragma("unroll") for (int k = 0; k < 2; ++k) dst[n][k] = *(const LAS bf16x8*)(lds + PG8_SB(b, h) + boff + n * 2048 + k * 1024); } while (0)
#define PG8_MMA(ai, bj, At, Bt) do { __builtin_amdgcn_s_setprio(1); _Pragma("unroll") for (int m = 0; m < 4; ++m) _Pragma("unroll") for (int n = 0; n < 2; ++n) _Pragma("unroll") for (int k = 0; k < 2; ++k) \
        acc[ai][bj][m][n] = __builtin_amdgcn_mfma_f32_16x16x32_bf16(Bt[n][k], At[m][k], acc[ai][bj][m][n], 0, 0, 0); __builtin_amdgcn_s_setprio(0); } while (0)
#define PG8_WAIT_V(n) asm volatile("s_waitcnt vmcnt(" #n ")" ::: "memory")
#define PG8_WAIT_L(n) asm volatile("s_waitcnt lgkmcnt(" #n ")" ::: "memory")
#define PG8_BAR __builtin_amdgcn_s_barrier()
#define PG8_SCHED __builtin_amdgcn_sched_barrier(0)
    Unit cur, nxt; int ui = 0;
    if (!S.next(0, cur)) return;
    f32x4 acc[2][2][4][2];
#pragma unroll
    for (int a = 0; a < 2; ++a)
#pragma unroll
        for (int b = 0; b < 2; ++b)
#pragma unroll
            for (int m = 0; m < 4; ++m)
#pragma unroll
                for (int n = 0; n < 2; ++n) acc[a][b][m][n] = (f32x4){0.f, 0.f, 0.f, 0.f};
    bf16x8 At[4][2], B0[2][2], B1[2][2];
    const char* cA = (const char*)g.A + (size_t)cur.pm * tstep; const char* cB = (const char*)g.Bt + (size_t)cur.pn * tstep;
    if constexpr (SP2) {
        PG8_STAGE(PG8_SB(0, 0), cB, voffB); PG8_STAGE(PG8_SB(0, 1), cB + hstep, voffB); PG8_STAGE(PG8_SA(0, 0), cA, voffA); PG8_STAGE(PG8_SA(0, 1), cA + hstep, voffA);
        if (wr == 1) PG8_BAR;
        PG8_WAIT_V(2); PG8_BAR;
        PG8_STAGE(PG8_SB(1, 0), cB + kstep, voffB); PG8_STAGE(PG8_SA(1, 0), cA + kstep, voffA); PG8_STAGE(PG8_SB(1, 1), cB + hstep + kstep, voffB);
        PG8_WAIT_V(6); PG8_BAR;
    } else {
        PG8_STAGE(PG8_SB(0, 0), cB, voffB); PG8_STAGE(PG8_SA(0, 0), cA, voffA); PG8_STAGE(PG8_SB(0, 1), cB + hstep, voffB); PG8_STAGE(PG8_SA(0, 1), cA + hstep, voffA);
        if (wr == 1) PG8_BAR;
        PG8_WAIT_V(4); PG8_BAR;
        PG8_STAGE(PG8_SB(1, 0), cB + kstep, voffB); PG8_STAGE(PG8_SA(1, 0), cA + kstep, voffA); PG8_STAGE(PG8_SB(1, 1), cB + hstep + kstep, voffB);
        PG8_WAIT_V(6); PG8_BAR;
    }
    for (;;) {
        const bool has_next = S.next(ui + 1, nxt);
        const char* nA = has_next ? (const char*)g.A + (size_t)nxt.pm * tstep : cA; const char* nB = has_next ? (const char*)g.Bt + (size_t)nxt.pn * tstep : cB;
        for (int t = 0; t < nt; t += 2) {
            if constexpr (Epi::HAS_MID) { if (t == nt / 2) E.mid(acc, cur, wr, wc, fr, fq); }
            const bool last = (t == nt - 2);
            const char* a1 = cA + (size_t)(t + 1) * kstep;
            const char* a2 = last ? nA : cA + (size_t)(t + 2) * kstep; const char* b2 = last ? nB : cB + (size_t)(t + 2) * kstep;
            const char* a3 = a2 + kstep; const char* b3 = b2 + kstep;
            if constexpr (SP2) {
            PG8_LDB(B0, 0, 0); PG8_LDB(B1, 0, 1); PG8_SCHED; PG8_LDA(At, 0, 0); PG8_STAGE(PG8_SA(1, 1), a1 + hstep, voffA);
            PG8_WAIT_V(8); PG8_WAIT_L(0); PG8_BAR; PG8_MMA(0, 0, At, B0); PG8_MMA(0, 1, At, B1); PG8_BAR; PG8_SCHED;
            PG8_LDA(At, 0, 1); PG8_STAGE(PG8_SB(0, 0), b2, voffB); PG8_STAGE(PG8_SB(0, 1), b2 + hstep, voffB); PG8_STAGE(PG8_SA(0, 0), a2, voffA);
            PG8_WAIT_V(8); PG8_WAIT_L(0); PG8_BAR; PG8_MMA(1, 0, At, B0); PG8_MMA(1, 1, At, B1); PG8_BAR; PG8_SCHED;
            PG8_LDB(B0, 1, 0); PG8_LDB(B1, 1, 1); PG8_SCHED; PG8_LDA(At, 1, 0); PG8_STAGE(PG8_SA(0, 1), a2 + hstep, voffA);
            PG8_WAIT_V(8); PG8_WAIT_L(0); PG8_BAR; PG8_MMA(0, 0, At, B0); PG8_MMA(0, 1, At, B1); PG8_BAR; PG8_SCHED;
            PG8_LDA(At, 1, 1); PG8_STAGE(PG8_SB(1, 0), b3, voffB); PG8_STAGE(PG8_SB(1, 1), b3 + hstep, voffB); PG8_STAGE(PG8_SA(1, 0), a3, voffA);
            PG8_WAIT_V(8); PG8_WAIT_L(0); PG8_BAR; PG8_MMA(1, 0, At, B0); PG8_MMA(1, 1, At, B1); PG8_BAR; PG8_SCHED;
            } else {
            PG8_LDB(B0, 0, 0); PG8_SCHED; PG8_LDA(At, 0, 0); PG8_STAGE(PG8_SA(1, 1), a1 + hstep, voffA);
            PG8_WAIT_L(8); PG8_BAR; PG8_WAIT_L(0); PG8_MMA(0, 0, At, B0); PG8_BAR; PG8_SCHED;
            PG8_LDB(B1, 0, 1); PG8_STAGE(PG8_SB(0, 0), b2, voffB);
            PG8_BAR; PG8_WAIT_L(0); PG8_MMA(0, 1, At, B1); PG8_BAR;
            PG8_LDA(At, 0, 1); PG8_STAGE(PG8_SA(0, 0), a2, voffA);
            PG8_BAR; PG8_WAIT_L(0); PG8_MMA(1, 0, At, B0); PG8_BAR; PG8_SCHED;
            PG8_STAGE(PG8_SB(0, 1), b2 + hstep, voffB);
            PG8_WAIT_V(6); PG8_BAR; PG8_MMA(1, 1, At, B1); PG8_BAR;
            PG8_LDB(B0, 1, 0); PG8_SCHED; PG8_LDA(At, 1, 0); PG8_STAGE(PG8_SA(0, 1), a2 + hstep, voffA);
            PG8_WAIT_L(8); PG8_BAR; PG8_WAIT_L(0); PG8_MMA(0, 0, At, B0); PG8_BAR; PG8_SCHED;
            PG8_LDB(B1, 1, 1); PG8_STAGE(PG8_SB(1, 0), b3, voffB);
            PG8_BAR; PG8_WAIT_L(0); PG8_MMA(0, 1, At, B1); PG8_BAR;
            PG8_LDA(At, 1, 1); PG8_STAGE(PG8_SA(1, 0), a3, voffA);
            PG8_BAR; PG8_WAIT_L(0); PG8_MMA(1, 0, At, B0); PG8_BAR; PG8_SCHED;
            PG8_STAGE(PG8_SB(1, 1), b3 + hstep, voffB);
            PG8_WAIT_V(6); PG8_BAR; PG8_MMA(1, 1, At, B1); PG8_BAR;
            }
        }
        if constexpr (ALIGN_EPI) { if (wr == 0) PG8_BAR; }
        E(acc, cur, wr, wc, fr, fq);
        if (!has_next) break;
#pragma unroll
        for (int a = 0; a < 2; ++a)
#pragma unroll
            for (int b = 0; b < 2; ++b)
#pragma unroll
                for (int m = 0; m < 4; ++m)
#pragma unroll
                    for (int n = 0; n < 2; ++n) acc[a][b][m][n] = (f32x4){0.f, 0.f, 0.f, 0.f};
        cur = nxt; cA = nA; cB = nB; ++ui;
        if constexpr (ALIGN_EPI) { if (wr == 1) PG8_BAR; }
    }
    PG8_WAIT_V(0);
    if constexpr (!ALIGN_EPI) { if (wr == 0) PG8_BAR; }
    PG8_BAR;
    if constexpr (Epi::HAS_POST) E.post(lds, acc, cur, wr, wc, fr, fq, tid);
#undef PG8_SA
#undef PG8_SB
#undef PG8_STAGE
#undef PG8_LDA
#undef PG8_LDB
#undef PG8_MMA
#undef PG8_WAIT_V
#undef PG8_WAIT_L
#undef PG8_BAR
#undef PG8_SCHED
}
}

constexpr size_t MiB = 1u << 20;
constexpr size_t WS_CTL = 0, CTL_ZERO_BYTES = 64 * 1024;
constexpr size_t WS_SS = 1 * MiB;
constexpr size_t WS_W = 2 * MiB, W_LAYER = 30 * MiB;
constexpr size_t WO_IN = 0, WO_M = 10 * MiB, WO_OUT = 12 * MiB, WO_FF1 = 14 * MiB, WO_FF2 = 22 * MiB;
constexpr size_t WS_XNY = 62 * MiB;
constexpr size_t WS_QKV = 94 * MiB;
constexpr size_t BREG = 20 * MiB, BREG_GATES = 12 * MiB;
constexpr size_t WS_GATES = 190 * MiB;
constexpr size_t WS_MERGED = WS_QKV;
constexpr size_t WS_H = WS_QKV;
constexpr size_t WS_END = 254 * MiB;
constexpr int CW_BAR = 1024;
constexpr int CW_PANEL = 8192;

constexpr int RING_OFF = 0, RING_BYTES = 131072;
constexpr int ATT_WSF = 131072;
constexpr int ATT_TBL = ATT_WSF + 4096;
constexpr int LDSCTL_OFF = ATT_TBL + 4096, MISC_OFF = LDSCTL_OFF + 320;
constexpr int LDS_BYTES = 147456;
static_assert(MISC_OFF + 128 <= LDS_BYTES, "LDS map");
constexpr int NWAVES = 8;

#define RLX_AGENT __ATOMIC_RELAXED, __HIP_MEMORY_SCOPE_AGENT
#define LDS_WAIT() asm volatile("s_waitcnt lgkmcnt(0)" ::: "memory")
#define VM_WAIT() asm volatile("s_waitcnt vmcnt(0)" ::: "memory")

#define XB_TMO      128
#define XB_XCNT(j)  (256  + 64 * (j))
#define XB_XSUB(j)  (1280 + 64 * (j))
#define XB_XGEN(j)  (2304 + 64 * (j))
#define XB_TOP      3328
#define XB_TOPGEN   3392
#define XCD_BAR_WORDS 3456
#define XB_SPIN_CAP (1u << 18)
__device__ __forceinline__ unsigned xb_ld(unsigned* p)              { return __hip_atomic_load(p, __ATOMIC_RELAXED, __HIP_MEMORY_SCOPE_AGENT); }
__device__ __forceinline__ unsigned xb_add(unsigned* p, unsigned v) { return __hip_atomic_fetch_add(p, v, __ATOMIC_RELAXED, __HIP_MEMORY_SCOPE_AGENT); }
__device__ __forceinline__ unsigned xb_xcc_id() { return (unsigned)__builtin_amdgcn_s_getreg((3 << 11) | 20) & 0xFu; }
#define XB_SPIN(cond, bar) do { unsigned _sp = 0; while (cond) { __builtin_amdgcn_s_sleep(1); \
    if ((++_sp & 255u) == 0u) { if (xb_ld(&(bar)[XB_TMO])) break; if (_sp > XB_SPIN_CAP) { atomicAdd(&(bar)[XB_TMO], 1u); break; } } } } while (0)
struct XcdBarrier { unsigned* bar; unsigned x; volatile LAS unsigned* st; int wave; };
__device__ __forceinline__ bool xb_leader(int wave) { return wave == 0 && lane_id_now() == 0u; }
__device__ __forceinline__ XcdBarrier xcd_barrier_post(unsigned* bar, volatile LAS unsigned* st, int wave) {
    XcdBarrier b; b.bar = bar; b.x = xb_xcc_id(); b.st = st; b.wave = wave;
    if (xb_leader(wave)) st[2] = xb_add(&bar[XB_XCNT(b.x)], 1u);
    return b;
}
__device__ __forceinline__ void xcd_barrier_complete(unsigned* bar, unsigned x, unsigned& nloc, unsigned& nx, unsigned& xi) {
    const unsigned G = gridDim.x * gridDim.y * gridDim.z;
    unsigned sum, cnt, mine, below, sp = 0u;
    for (;;) {
        sum = 0u; cnt = 0u; mine = 0u; below = 0u;
#pragma unroll
        for (unsigned j = 0; j < 16; ++j) { const unsigned c = xb_ld(&bar[XB_XCNT(j)]); sum += c; cnt += (c > 0u) ? 1u : 0u; mine = (j == x) ? c : mine; below += (c > 0u && j < x) ? 1u : 0u; }
        if (sum == G) break;
        __builtin_amdgcn_s_sleep(1);
        if ((++sp & 255u) == 0u) { if (xb_ld(&bar[XB_TMO])) break; if (sp > XB_SPIN_CAP) { atomicAdd(&bar[XB_TMO], 1u); break; } }
    }
    nloc = mine > 0u ? mine : 1u; nx = cnt > 0u ? cnt : 1u; xi = below;
}
__device__ __forceinline__ void xcd_barrier(const XcdBarrier& b) {
    asm volatile("s_waitcnt vmcnt(0)" ::: "memory");
    __syncthreads();
    if (xb_leader(b.wave)) {
        unsigned* bar = b.bar;
        __builtin_amdgcn_s_waitcnt(0);
        unsigned nloc = b.st[0], nx = b.st[1];
        if (nloc == 0u) { unsigned xi; xcd_barrier_complete(bar, b.x, nloc, nx, xi); b.st[0] = nloc; b.st[1] = nx; b.st[3] = xi; }
        const unsigned old = xb_add(&bar[XB_XSUB(b.x)], 1u);
        const unsigned gen = old / nloc;
        if (old + 1u == (gen + 1u) * nloc) {
            __builtin_amdgcn_fence(__ATOMIC_RELEASE, "agent");
            asm volatile("s_waitcnt vmcnt(0)" ::: "memory");
            const unsigned og = xb_add(&bar[XB_TOP], 1u);
            const unsigned tg = og / nx;
            if (og + 1u == (tg + 1u) * nx) xb_add(&bar[XB_TOPGEN], 1u);
            else XB_SPIN(xb_ld(&bar[XB_TOPGEN]) == tg, bar);
            __builtin_amdgcn_fence(__ATOMIC_ACQUIRE, "agent");
            xb_add(&bar[XB_XGEN(b.x)], 1u);
            asm volatile("s_waitcnt vmcnt(0)" ::: "memory");
        } else {
            XB_SPIN(xb_ld(&bar[XB_XGEN(b.x)]) == gen, bar);
            __builtin_amdgcn_fence(__ATOMIC_ACQUIRE, "agent");
            asm volatile("s_waitcnt vmcnt(0)" ::: "memory");
        }
    }
    __syncthreads();
}

#define XL_SUB(j) (3584 + 64 * (j))
#define XL_GEN(j) (4608 + 64 * (j))
__device__ __forceinline__ void xcc_local_barrier(unsigned* bar, unsigned x, unsigned nloc, int wave, unsigned& gen) {
    asm volatile("s_waitcnt vmcnt(0)" ::: "memory");
    __syncthreads();
    if (xb_leader(wave)) {
        __builtin_amdgcn_s_waitcnt(0);
        const unsigned old = xb_add(&bar[XL_SUB(x)], 1u);
        if (old + 1u == (gen + 1u) * nloc) xb_add(&bar[XL_GEN(x)], 1u);
        else XB_SPIN(xb_ld(&bar[XL_GEN(x)]) == gen, bar);
        __builtin_amdgcn_fence(__ATOMIC_ACQUIRE, "agent");
        asm volatile("s_waitcnt vmcnt(0)" ::: "memory");
    }
    ++gen;
    __syncthreads();
}

struct Frame {
    LAS unsigned char* lds;
    int vcu, G, wave;
    float* out; unsigned char* ws;
};
__device__ __forceinline__ int phase_tid(int wave) { return wave * 64 + (int)lane_id_now(); }
#define PHASE_IDS() const int tid_ = phase_tid(F.wave); const int tid = tid_, lane = tid & 63, wave = __builtin_amdgcn_readfirstlane(tid >> 6); (void)tid; (void)lane; (void)wave
__device__ __forceinline__ const float* arg_in(int k) { asm volatile("" : "+s"(k)); return ((const float* const __attribute__((address_space(4)))*)__builtin_amdgcn_kernarg_segment_ptr())[k]; }

__device__ __forceinline__ float wave_sum(float v) {
#pragma unroll
    for (int o = 1; o < 64; o <<= 1) v += __shfl_xor(v, o);
    return v;
}
__device__ __forceinline__ void p0_transpose_item(const float* W, int N, bf16_t* WT, int ldk, int koff, LAS float* scr, int item, int lane, const float* gk = nullptr, bool gate_remap = false) {
    const int nblk = N / 32, kb = item / nblk, nb = item % nblk, k0 = 64 * kb, n0 = 32 * nb;
    int nd = n0;
    if (gate_remap && n0 >= NQKV) { const int gcol = n0 - NQKV, isd = gcol >= D, c = isd ? gcol - D : gcol; nd = NQKV + (c >> 7) * 256 + isd * 128 + (c & 127); }
    const float* src = W + (size_t)(k0 + (lane >> 3)) * N + n0 + (lane & 7) * 4;
    f32x4 v[8];
#pragma unroll
    for (int i = 0; i < 8; ++i) v[i] = *(const f32x4*)(src + (size_t)(8 * i) * N);
    if (gk) {
#pragma unroll
        for (int i = 0; i < 8; ++i) v[i] = v[i] * gk[k0 + 8 * i + (lane >> 3)]; }
#pragma unroll
    for (int i = 0; i < 8; ++i) { LAS float* d = scr + (8 * i + (lane >> 3)) * 33 + (lane & 7) * 4; d[0] = v[i][0]; d[1] = v[i][1]; d[2] = v[i][2]; d[3] = v[i][3]; }
    LDS_WAIT(); asm volatile("" ::: "memory");
    const int c = lane & 7;
#pragma unroll
    for (int j = 0; j < 4; ++j) { const int n = (lane >> 3) + 8 * j; const LAS float* s = scr + (8 * c) * 33 + n;
        u32x4 o; o.x = cvtpk(s[0 * 33], s[1 * 33]); o.y = cvtpk(s[2 * 33], s[3 * 33]); o.z = cvtpk(s[4 * 33], s[5 * 33]); o.w = cvtpk(s[6 * 33], s[7 * 33]);
        *(u32x4*)(WT + (size_t)(nd + n) * ldk + koff + k0 + 8 * c) = o; }
    LDS_WAIT(); asm volatile("" ::: "memory");
}
__device__ __forceinline__ void p0_prologue(Frame& F) {
    PHASE_IDS();
    LAS float* scr = (LAS float*)(F.lds + RING_OFF + wave * 16384);
    const int gw = F.vcu * NWAVES + wave, NGW = F.G * NWAVES;
    constexpr int I_IN = (D / 64) * (NIN / 32), I_B = (512 / 64) * (D / 32), I_O = (D / 64) * (D / 32), I_1 = (D / 64) * (FF / 32), I_2 = (FF / 64) * (D / 32);
    constexpr int NL = I_IN + 2 * I_B + I_O + I_1 + I_2, NITEMS = DEPTH * NL;
    for (int it = gw; it < NITEMS; it += NGW) {
        const int L = it / NL; int r = it % NL;
        unsigned char* wb = F.ws + WS_W + (size_t)L * W_LAYER;
        if (r < I_IN) { p0_transpose_item(arg_in(4) + (size_t)L * D * NIN, NIN, (bf16_t*)(wb + WO_IN), D, 0, scr, r, lane, arg_in(3) + L * D, true); continue; } r -= I_IN;
        if (r < I_B) { p0_transpose_item(arg_in(8) + (size_t)L * 512 * D, D, (bf16_t*)(wb + WO_M), D, 0, scr, r, lane); continue; } r -= I_B;
        if (r < I_B) { p0_transpose_item(arg_in(9) + (size_t)L * 512 * D, D, (bf16_t*)(wb + WO_M), D, 512, scr, r, lane); continue; } r -= I_B;
        if (r < I_O) { p0_transpose_item(arg_in(10) + (size_t)L * D * D, D, (bf16_t*)(wb + WO_OUT), D, 0, scr, r, lane); continue; } r -= I_O;
        if (r < I_1) { p0_transpose_item(arg_in(12) + (size_t)L * D * FF, FF, (bf16_t*)(wb + WO_FF1), D, 0, scr, r, lane, arg_in(11) + L * D); continue; } r -= I_1;
        p0_transpose_item(arg_in(13) + (size_t)L * FF * D, D, (bf16_t*)(wb + WO_FF2), FF, 0, scr, r, lane);
    }
    const float* x = arg_in(0); bf16_t* XN = (bf16_t*)(F.ws + WS_XNY); float* SS = (float*)(F.ws + WS_SS);
    for (int m0 = 2 * gw; m0 < M; m0 += 2 * NGW) {
        f32x4 v[2][4];
#pragma unroll
        for (int q = 0; q < 2; ++q)
#pragma unroll
            for (int j = 0; j < 4; ++j) v[q][j] = ((const f32x4*)(x + (size_t)(m0 + q) * D) + lane)[64 * j];
#pragma unroll
        for (int q = 0; q < 2; ++q) { const int m = m0 + q; u32x2* o8 = (u32x2*)(XN + (size_t)m * D) + lane; float s = 0.f;
#pragma unroll
            for (int j = 0; j < 4; ++j) { const f32x4 vv = v[q][j]; s += (vv[0] * vv[0] + vv[1] * vv[1]) + (vv[2] * vv[2] + vv[3] * vv[3]);
                u32x2 w; w.x = cvtpk(vv[0], vv[1]); w.y = cvtpk(vv[2], vv[3]); o8[64 * j] = w; }
            s = wave_sum(s);
            if (lane < 4) SS[(size_t)m * 4 + lane] = (lane == 0) ? s : 0.f; }
    }
}
namespace att {
typedef LAS const char* lcp;
__device__ __forceinline__ int crow(int r, int hi) { return (r & 3) + 8 * (r >> 2) + 4 * hi; }
typedef short v4i16_t __attribute__((ext_vector_type(4)));
__device__ __forceinline__ s16x4 vtr(lcp p) { return __builtin_bit_cast(s16x4, __builtin_amdgcn_ds_read_tr16_b64_v4i16((LAS v4i16_t*)p)); }
#define MFMA32(a, b, c) __builtin_amdgcn_mfma_f32_32x32x16_bf16(a, b, c, 0, 0, 0)
#define ATT_WAIT_BAR(N) asm volatile("s_waitcnt vmcnt(" #N ") lgkmcnt(0)\n\ts_barrier" ::: "memory")
__device__ __forceinline__ void glds16(const void* gsrc, unsigned lds_dst) { unsigned keep;
    asm volatile("s_mov_b32 %0, m0\n\ts_mov_b32 m0, %2\n\ts_nop 0\n\tglobal_load_lds_dwordx4 %1, off\n\ts_mov_b32 m0, %0" : "=&s"(keep) : "v"(gsrc), "s"(lds_dst) : "memory"); }
#define GLDS16(gsrc, ldsdst) glds16((const void*)(gsrc), (unsigned)__builtin_amdgcn_readfirstlane((int)(unsigned)(uintptr_t)(ldsdst)))
__device__ __forceinline__ void glds16s(unsigned voff, const void* sbase, unsigned lds_dst) { unsigned keep;
    asm volatile("s_mov_b32 %0, m0\n\ts_mov_b32 m0, %2\n\ts_nop 2\n\tglobal_load_lds_dwordx4 %1, %3\n\ts_mov_b32 m0, %0" : "=&s"(keep) : "v"(voff), "s"(lds_dst), "s"(sbase) : "memory"); }
#define GLDS16S(voff, sbase, ldsdst) glds16s((voff), (const void*)(sbase), (unsigned)__builtin_amdgcn_readfirstlane((int)(unsigned)(uintptr_t)(ldsdst)))
#define ATT_BAR_IF(cond, N) do { if (cond) ATT_WAIT_BAR(N); } while (0)
#define MX3(a, b, c) __builtin_fmaxf(__builtin_fmaxf((a), (b)), (c))

__device__ __forceinline__ void kload(bf16x8 (&kf)[8], lcp kslot, const int (&koff)[4]) {
#pragma unroll
    for (int d0 = 0; d0 < 4; ++d0) { kf[2 * d0] = *(const LAS bf16x8*)(kslot + koff[d0]); kf[2 * d0 + 1] = *(const LAS bf16x8*)(kslot + koff[d0] + 4096); }
}
__device__ __forceinline__ void qk_mfma(f32x16& p0, f32x16& p1, const bf16x8 (&kf)[8], const bf16x8* qr, const f32x16& cinit) {
    p0 = MFMA32(kf[0], qr[0], cinit); p1 = MFMA32(kf[1], qr[0], cinit);
#pragma unroll
    for (int d0 = 1; d0 < 4; ++d0) { p0 = MFMA32(kf[2 * d0], qr[d0], p0); p1 = MFMA32(kf[2 * d0 + 1], qr[d0], p1); }
}
__device__ __forceinline__ float rowmax32(const f32x16& p0, const f32x16& p1) {
    float a = MX3(p0[0], p0[1], p1[0]), b = MX3(p0[2], p0[3], p1[1]); a = MX3(a, p1[2], p1[3]);
#pragma unroll
    for (int r = 4; r < 16; r += 4) { a = MX3(a, p0[r], p0[r + 1]); b = MX3(b, p0[r + 2], p0[r + 3]); a = MX3(a, p1[r], p1[r + 1]); b = MX3(b, p1[r + 2], p1[r + 3]); }
    a = __builtin_fmaxf(a, b);
    auto rr = __builtin_amdgcn_permlane32_swap(__float_as_uint(a), __float_as_uint(a), false, false);
    return __builtin_fmaxf(__uint_as_float(rr[0]), __uint_as_float(rr[1]));
}
template <int NB, int THR>
__device__ __forceinline__ bool softmax_part(f32x16& p0, f32x16& p1, f32x16 (&o)[NB], float& mhat, float& l, bool first, LAS float* wsf, int r32, int hi, u32x4 (&pw)[4]) {
    const float rm = rowmax32(p0, p1);
    bool resc = false, moved = false;
    if (first) {
        mhat += rm; moved = true;
#pragma unroll
        for (int r = 0; r < 16; ++r) { p0[r] -= rm; p1[r] -= rm; }
    } else if (__any(rm > (float)THR)) {
        const float dl = fmaxf(rm, 0.f); mhat += dl; moved = true; resc = true;
#pragma unroll
        for (int r = 0; r < 16; ++r) { p0[r] -= dl; p1[r] -= dl; }
        const float f = __builtin_amdgcn_exp2f(-dl); l *= f; if (hi == 0) wsf[r32] = f;
    }
    float s = 0.f;
#pragma unroll
    for (int r = 0; r < 16; ++r) { p0[r] = __builtin_amdgcn_exp2f(p0[r]); p1[r] = __builtin_amdgcn_exp2f(p1[r]); s += p0[r] + p1[r]; }
    l += s;
    pw[0] = (u32x4){cvtpk(p0[0], p0[1]), cvtpk(p0[2], p0[3]), cvtpk(p0[4], p0[5]), cvtpk(p0[6], p0[7])};
    pw[1] = (u32x4){cvtpk(p0[8], p0[9]), cvtpk(p0[10], p0[11]), cvtpk(p0[12], p0[13]), cvtpk(p0[14], p0[15])};
    pw[2] = (u32x4){cvtpk(p1[0], p1[1]), cvtpk(p1[2], p1[3]), cvtpk(p1[4], p1[5]), cvtpk(p1[6], p1[7])};
    pw[3] = (u32x4){cvtpk(p1[8], p1[9]), cvtpk(p1[10], p1[11]), cvtpk(p1[12], p1[13]), cvtpk(p1[14], p1[15])};
    if (resc) {
        float fr[16];
#pragma unroll
        for (int r = 0; r < 16; ++r) fr[r] = wsf[crow(r, hi)];
#pragma unroll
        for (int d = 0; d < NB; ++d)
#pragma unroll
            for (int r = 0; r < 16; ++r) o[d][r] *= fr[r];
    }
    return moved;
}
__device__ __forceinline__ void vload0(s16x4 (&lo)[4], s16x4 (&hh)[4], lcp vb) {
#pragma unroll
    for (int ks = 0; ks < 4; ++ks) { lo[ks] = vtr(vb + ks * 1024); hh[ks] = vtr(vb + ks * 1024 + 512); }
}
template <int NB>
__device__ __forceinline__ void pv_part(f32x16 (&o)[NB], lcp vb, const u32x4 (&pw)[4], const s16x4 (&lo0)[4], const s16x4 (&hh0)[4]) {
    s16x4 lo[2][4], hh[2][4];
#pragma unroll
    for (int ks = 0; ks < 4; ++ks) { lo[0][ks] = lo0[ks]; hh[0][ks] = hh0[ks]; }
#pragma unroll
    for (int d0 = 0; d0 < NB; ++d0) {
        if (d0 + 1 < NB) {
#pragma unroll
            for (int ks = 0; ks < 4; ++ks) { lo[(d0 + 1) & 1][ks] = vtr(vb + (d0 + 1) * 4096 + ks * 1024); hh[(d0 + 1) & 1][ks] = vtr(vb + (d0 + 1) * 4096 + ks * 1024 + 512); }
        }
        __builtin_amdgcn_sched_barrier(0);
#define ATT_PK(k) (bf16x8){lo[d0 & 1][k][0], lo[d0 & 1][k][1], lo[d0 & 1][k][2], lo[d0 & 1][k][3], hh[d0 & 1][k][0], hh[d0 & 1][k][1], hh[d0 & 1][k][2], hh[d0 & 1][k][3]}
        o[d0] = MFMA32(__builtin_bit_cast(bf16x8, pw[0]), ATT_PK(0), o[d0]);
        o[d0] = MFMA32(__builtin_bit_cast(bf16x8, pw[1]), ATT_PK(1), o[d0]);
        o[d0] = MFMA32(__builtin_bit_cast(bf16x8, pw[2]), ATT_PK(2), o[d0]);
        o[d0] = MFMA32(__builtin_bit_cast(bf16x8, pw[3]), ATT_PK(3), o[d0]);
#undef ATT_PK
        __builtin_amdgcn_sched_barrier(0);
    }
}
__device__ __forceinline__ void row_inv_l(float l, float (&rli)[16], LAS float* wsf, int r32, int hi) {
    auto rr = __builtin_amdgcn_permlane32_swap(__float_as_uint(l), __float_as_uint(l), false, false);
    const float lt = __uint_as_float(rr[0]) + __uint_as_float(rr[1]);
    if (hi == 0) wsf[32 + r32] = lt;
#pragma unroll
    for (int r = 0; r < 16; ++r) rli[r] = __builtin_amdgcn_rcpf(wsf[32 + crow(r, hi)]);
}
__device__ __forceinline__ int t5_bucket(int rel) {
    const int n = rel < 0 ? -rel : rel;
    const int large = 8 + (n >= 12) + (n >= 16) + (n >= 23) + (n >= 32) + (n >= 46) + (n >= 64) + (n >= 91);
    return (rel > 0 ? 16 : 0) + (n < 8 ? n : large);
}


template <int THR>
__device__ __forceinline__ void diff_unit(Frame& F, int layer, const bf16_t* qkv, bf16_t* Y, int h, int qb) {
    const int tid = phase_tid(F.wave), wid = F.wave;
    const int mp = wid >> 2, wq = wid & 3;
    const size_t tokb = 0;
    LAS unsigned char* lds = F.lds;
    LAS float* wsf = (LAS float*)(lds + ATT_WSF) + wid * 128;
    LAS float* TBL = (LAS float*)(lds + ATT_TBL);
    constexpr int NT = SEQ / 64;
    f32x16 o[4]; float l = 0.f;
    {
    const int lane = tid & 63, r32 = lane & 31, hi = lane >> 5;
    const bf16_t* kbase = qkv + tokb * NQKV + COL_KD + h * 128; const bf16_t* vbase_g = qkv + tokb * NQKV + COL_VD + h * 128;
#define DIFF_KVO(L_) ((unsigned)((8 * wid + ((L_) >> 3)) * NQKV + (((L_) & 7) ^ ((L_) >> 3)) * 8) * 2u)
#define DIFF_VVO(L_) ((unsigned)((16 * (wid & 3) + ((L_) >> 2)) * NQKV + (wid >> 2) * 32 + ((L_) & 3) * 8) * 2u)
#define DIFF_DMA_K(t) do { const int tt_ = (t) < NT ? (t) : NT - 1; const size_t go_ = (size_t)tt_ * 64 * NQKV; LAS unsigned char* rb_ = lds + ((t) & 3) * 16384 + wid * 1024; \
        int ld_ = lane; asm volatile("" : "+v"(ld_)); const unsigned kvo_ = DIFF_KVO(ld_); GLDS16S(kvo_, kbase + go_, rb_); GLDS16S(kvo_, kbase + go_ + 64, rb_ + 8192); } while (0)
#define DIFF_DMA_V(t) do { const int tt_ = (t) < NT ? (t) : NT - 1; const size_t go_ = (size_t)tt_ * 64 * NQKV; LAS unsigned char* rb_ = lds + 65536 + ((t) & 3) * 16384 + wid * 1024; \
        int ld_ = lane; asm volatile("" : "+v"(ld_)); const unsigned vvo_ = DIFF_VVO(ld_); GLDS16S(vvo_, vbase_g + go_, rb_); GLDS16S(vvo_, vbase_g + go_ + 64, rb_ + 8192); } while (0)
    DIFF_DMA_K(0); DIFF_DMA_K(1); DIFF_DMA_V(0); DIFF_DMA_K(2); DIFF_DMA_V(1);
    if (tid < 257) TBL[tid] = arg_in(1)[t5_bucket(tid - 128) * 4 + h] * LOG2E;
    bf16x8 qr[4];
    { const bf16_t* Qw = qkv + (tokb + qb * 128 + wq * 32 + r32) * NQKV + COL_QD + h * 128 + mp * 64 + hi * 8;
#pragma unroll
      for (int d0 = 0; d0 < 4; ++d0) qr[d0] = *(const bf16x8*)(Qw + d0 * 16); }
    asm volatile("" : "+v"(qr[0]), "+v"(qr[1]), "+v"(qr[2]), "+v"(qr[3]));
    const int voff = ((lane >> 4) & 1) * 32 + (lane & 3) * 8 + (4 * hi + ((lane & 15) >> 2)) * 64;
    o[0] = f32x16{}; o[1] = f32x16{}; o[2] = f32x16{}; o[3] = f32x16{};
    float mhat = 0.f;
    const int qw0 = qb * 128 + wq * 32;
    ATT_WAIT_BAR(8);
    const float tL = __uint_as_float((unsigned)__builtin_amdgcn_readfirstlane((int)__float_as_uint(TBL[0]))), tR = __uint_as_float((unsigned)__builtin_amdgcn_readfirstlane((int)__float_as_uint(TBL[256])));
    bf16x8 kf[8]; f32x16 p0, p1, cinit; u32x4 pwA[4], pwB[4]; s16x4 vlo[2][4], vhh[2][4]; bool moved = false; int zc_id;
    { const int dk0 = 0 - qw0; zc_id = (dk0 >= 122) ? 1 : 2; const float c0 = (zc_id == 1 ? tR : tL);
#pragma unroll
      for (int r = 0; r < 16; ++r) cinit[r] = c0; }
#define SBAR() __builtin_amdgcn_sched_barrier(0)
#define PIN(x) asm volatile("" : "+v"(x))
#define DIFF_SCORES(t, FIRST) do { \
        { int rk_ = r32; asm volatile("" : "+v"(rk_)); int koff[4];                       \
          _Pragma("unroll") for (int d0 = 0; d0 < 4; ++d0) koff[d0] = rk_ * 128 + (((2 * d0 + hi) ^ (rk_ & 7)) << 4); \
          kload(kf, (lcp)(lds + ((t) & 3) * 16384 + mp * 8192), koff); } \
        SBAR();                                                                     \
        qk_mfma(p0, p1, kf, qr, cinit); \
        SBAR(); \
        DIFF_DMA_K((t) + 3); DIFF_DMA_V((t) + 2); \
        const int dk_ = (t) * 64 - qw0; const int zone_ = (dk_ >= 122) ? 1 : ((dk_ <= -154) ? 2 : 0); \
        if (zone_ == 0) { int rq_ = r32; asm volatile("" : "+v"(rq_)); const int base_ = dk_ - rq_ + 128; const float zc_ = (zc_id == 1) ? tR : tL; \
            _Pragma("unroll") for (int r = 0; r < 16; ++r) { int i0 = base_ + crow(r, hi), i1 = i0 + 32; \
                i0 = i0 < 0 ? 0 : (i0 > 256 ? 256 : i0); i1 = i1 < 0 ? 0 : (i1 > 256 ? 256 : i1); \
                p0[r] += TBL[i0] - zc_; p1[r] += TBL[i1] - zc_; if ((r & 3) == 3) SBAR(); } } \
        const float rm_ = rowmax32(p0, p1); \
        bool shift_ = FIRST; float dl_ = rm_; moved = false; \
        if (!(FIRST)) { moved = __any(rm_ > (float)THR); shift_ = moved; dl_ = fmaxf(rm_, 0.f); } \
        if (shift_) { mhat += dl_; \
            _Pragma("unroll") for (int r = 0; r < 16; ++r) { float a_ = p0[r], b_ = p1[r]; asm volatile("v_sub_f32_e32 %0, %0, %2\n\tv_sub_f32_e32 %1, %1, %2" : "+v"(a_), "+v"(b_) : "v"(dl_)); p0[r] = a_; p1[r] = b_; } \
            if (!(FIRST)) { const float f_ = __builtin_amdgcn_exp2f(-dl_); l *= f_; if (hi == 0) wsf[r32] = f_; } } \
        { const int dn_ = dk_ + 64; const int zn_ = (dn_ >= 122) ? 1 : ((dn_ <= -154) ? 2 : 0); \
          if (shift_ || (zn_ != 0 && zn_ != zc_id)) { if (zn_ != 0) zc_id = zn_; const float cb_ = ((zc_id == 1) ? tR : tL) - mhat; \
              _Pragma("unroll") for (int r = 0; r < 16; ++r) cinit[r] = cb_; } } \
        SBAR(); } while (0)
#define DIFF_EXP2(g, PWN, SACC) do { \
        float x0_ = ((g) < 8 ? p0[2 * ((g) & 7)] : p1[2 * ((g) & 7)]), x1_ = ((g) < 8 ? p0[2 * ((g) & 7) + 1] : p1[2 * ((g) & 7) + 1]); \
        x0_ = __builtin_amdgcn_exp2f(x0_); x1_ = __builtin_amdgcn_exp2f(x1_); SACC += x0_; SACC += x1_; PWN[(g) >> 2][(g) & 3] = cvtpk(x0_, x1_); } while (0)
#define VFRAG(B, i) (bf16x8){vlo[B][i][0], vlo[B][i][1], vlo[B][i][2], vlo[B][i][3], vhh[B][i][0], vhh[B][i][1], vhh[B][i][2], vhh[B][i][3]}
#define DIFF_GAP(g, PWC, PWN, VB) do { \
        o[(g) >> 2] = MFMA32(__builtin_bit_cast(bf16x8, PWC[(g) & 3]), VFRAG(((g) >> 2) & 1, (g) & 3), o[(g) >> 2]); \
        if ((g) < 12) { vlo[(((g) >> 2) + 1) & 1][(g) & 3] = vtr(VB + (((g) >> 2) + 1) * 4096 + ((g) & 3) * 1024); vhh[(((g) >> 2) + 1) & 1][(g) & 3] = vtr(VB + (((g) >> 2) + 1) * 4096 + ((g) & 3) * 1024 + 512); } \
        DIFF_EXP2(g, PWN, sacc_); PIN(sacc_); PIN(PWN[(g) >> 2]); SBAR(); } while (0)
#define DIFF_STEP(t, PWC, PWN) do { \
        lcp vb_ = (lcp)(lds + 65536 + (((t) - 1) & 3) * 16384 + voff); \
        _Pragma("unroll") for (int i = 0; i < 4; ++i) { vlo[0][i] = vtr(vb_ + i * 1024); vhh[0][i] = vtr(vb_ + i * 1024 + 512); } \
        DIFF_SCORES(t, false); \
        float sacc_ = 0.f; \
        DIFF_GAP(0, PWC, PWN, vb_); DIFF_GAP(1, PWC, PWN, vb_); DIFF_GAP(2, PWC, PWN, vb_); DIFF_GAP(3, PWC, PWN, vb_); \
        DIFF_GAP(4, PWC, PWN, vb_); DIFF_GAP(5, PWC, PWN, vb_); DIFF_GAP(6, PWC, PWN, vb_); DIFF_GAP(7, PWC, PWN, vb_); \
        DIFF_GAP(8, PWC, PWN, vb_); DIFF_GAP(9, PWC, PWN, vb_); DIFF_GAP(10, PWC, PWN, vb_); DIFF_GAP(11, PWC, PWN, vb_); \
        DIFF_GAP(12, PWC, PWN, vb_); DIFF_GAP(13, PWC, PWN, vb_); DIFF_GAP(14, PWC, PWN, vb_); DIFF_GAP(15, PWC, PWN, vb_); \
        l += sacc_; \
        ATT_WAIT_BAR(8); \
        if (moved) { float fr_[16]; \
            _Pragma("unroll") for (int r = 0; r < 16; ++r) fr_[r] = wsf[crow(r, hi)]; \
            _Pragma("unroll") for (int d = 0; d < 4; ++d) _Pragma("unroll") for (int r = 0; r < 16; ++r) o[d][r] *= fr_[r]; \
} \
    } while (0)
    if (wid >= 4) __builtin_amdgcn_s_setprio(1);
    DIFF_SCORES(0, true);
    { float sacc_ = 0.f;
#pragma unroll
      for (int g = 0; g < 16; ++g) DIFF_EXP2(g, pwA, sacc_);
      l += sacc_; }
    ATT_WAIT_BAR(8);
#pragma unroll 1
    for (int t = 1; t + 1 < NT; t += 2) { DIFF_STEP(t, pwA, pwB); DIFF_STEP(t + 1, pwB, pwA); }
    DIFF_STEP(NT - 1, pwA, pwB);
    { lcp vb_ = (lcp)(lds + 65536 + ((NT - 1) & 3) * 16384 + voff); s16x4 l0[4], h0[4]; vload0(l0, h0, vb_); pv_part<4>(o, vb_, pwB, l0, h0); }
    __builtin_amdgcn_s_setprio(0);
    ATT_WAIT_BAR(0);
#undef DIFF_DMA_K
#undef DIFF_DMA_V
#undef DIFF_KVO
#undef DIFF_VVO
#undef DIFF_SCORES
#undef DIFF_EXP2
#undef DIFF_GAP
#undef DIFF_STEP
#undef VFRAG
#undef SBAR
#undef PIN
    }
    const int tid2_ = phase_tid(F.wave);
    const int lane = tid2_ & 63, r32 = lane & 31, hi = lane >> 5;
    const float* lp = arg_in(6) + layer * 256;
    const float lpa = lp[lane] * lp[64 + lane], lpb = lp[128 + lane] * lp[192 + lane];
    const float* sg = arg_in(7) + layer * 128;
    float sgv[4];
#pragma unroll
    for (int d = 0; d < 4; ++d) sgv[d] = sg[d * 32 + r32];
    float rli[16]; row_inv_l(l, rli, wsf, r32, hi);
#pragma unroll
    for (int d = 0; d < 4; ++d)
#pragma unroll
        for (int r = 0; r < 16; ++r) o[d][r] *= rli[r];
    LAS float* xch = (LAS float*)(lds) + wq * 4096;
    if (mp == 1) {
#pragma unroll
        for (int d = 0; d < 4; ++d)
#pragma unroll
            for (int r4 = 0; r4 < 4; ++r4) *(LAS f32x4*)(xch + ((d * 4 + r4) * 64 + lane) * 4) = (f32x4){o[d][4 * r4], o[d][4 * r4 + 1], o[d][4 * r4 + 2], o[d][4 * r4 + 3]};
    }
    ATT_WAIT_BAR(0);
    if (mp == 0) {
        const float s1 = wave_sum(lpa), s2 = wave_sum(lpb);
        unsigned lbits_ = (layer == 0) ? 0x3E4CCCCDu : 0x3EB60549u; asm volatile("" : "+s"(lbits_));
        const float lam_init = __uint_as_float(lbits_);
        const float lam = expf(s1) - expf(s2) + lam_init;
        float ssq[16];
#pragma unroll
        for (int r = 0; r < 16; ++r) ssq[r] = 0.f;
#pragma unroll
        for (int d = 0; d < 4; ++d)
#pragma unroll
            for (int r4 = 0; r4 < 4; ++r4) { const f32x4 x2 = *(const LAS f32x4*)(xch + ((d * 4 + r4) * 64 + lane) * 4);
#pragma unroll
                for (int e = 0; e < 4; ++e) { const int r = 4 * r4 + e; const float v = o[d][r] - lam * x2[e]; o[d][r] = v; ssq[r] += v * v; } }
#pragma unroll
        for (int r = 0; r < 16; ++r) {
            float v = ssq[r];
            v += __shfl_xor(v, 1); v += __shfl_xor(v, 2); v += __shfl_xor(v, 4); v += __shfl_xor(v, 8); v += __shfl_xor(v, 16);
            ssq[r] = (1.0f - lam_init) * __builtin_amdgcn_rsqf(v * (1.0f / 128.0f) + RMS_EPS);
        }
        LAS bf16_t* stg = (LAS bf16_t*)(lds + 65536) + wq * 4096;
#pragma unroll
        for (int d = 0; d < 4; ++d) { const float gg = sgv[d];
#pragma unroll
            for (int r = 0; r < 16; ++r) { const float v = o[d][r] * ssq[r] * gg; stg[crow(r, hi) * 128 + d * 32 + r32] = (bf16_t)(cvtpk(v, v) & 0xffffu); } }
        bf16_t* yb = Y + (tokb + qb * 128 + wq * 32 + (lane >> 4)) * D + 512 + h * 128 + (lane & 15) * 8;
#pragma unroll
        for (int i = 0; i < 8; ++i) { const u32x4 v = *(const LAS u32x4*)(stg + (i * 4 + (lane >> 4)) * 128 + (lane & 15) * 8); store16_wt(yb + (size_t)i * 4 * D, v); }
    }
    ATT_WAIT_BAR(0);
}

template <int HALF> __device__ __forceinline__ void na_vload(s16x4 (&lo)[2][3], s16x4 (&hh)[2][3], lcp vb);
template <int HALF>
__device__ __forceinline__ void na_cinit(f32x16& cF, float mhat, int vbase) {
    constexpr int FO = HALF ? 32 : 0;
#pragma unroll
    for (int r = 0; r < 16; ++r) { const int e = (r & 3) + 8 * (r >> 2) + FO; cF[r] = ((unsigned)(vbase + e) < 16u) ? -mhat : -INFINITY; }
}
template <int HALF, int THR>
__device__ __forceinline__ void na_scores(f32x16& p0, f32x16& p1, const bf16x8 (&kf)[8], const bf16x8* qr, f32x16& cF, f32x16 (&o)[2], float& mhat, float& l, bool first,
                                           const LAS float* rp, int vbase, LAS float* wsf, int r32, int hi, u32x4 (&pw)[4], lcp vb, s16x4 (&vlo)[2][3], s16x4 (&vhh)[2][3]) {
    { const f32x16 z = f32x16{};
      if (HALF) { p0 = MFMA32(kf[0], qr[0], z); p1 = MFMA32(kf[1], qr[0], cF); } else { p0 = MFMA32(kf[0], qr[0], cF); p1 = MFMA32(kf[1], qr[0], z); } }
#pragma unroll
    for (int d0 = 1; d0 < 4; ++d0) { p0 = MFMA32(kf[2 * d0], qr[d0], p0); p1 = MFMA32(kf[2 * d0 + 1], qr[d0], p1); }
    na_vload<HALF>(vlo, vhh, vb);
    __builtin_amdgcn_sched_barrier(0);
    f32x16& FB = HALF ? p1 : p0; f32x16& PB = HALF ? p0 : p1;
    constexpr int PR = HALF ? 12 : 0, FO = HALF ? 32 : 0, PO = HALF ? 0 : 32;
#pragma unroll
    for (int r = 0; r < 16; ++r) { const int e = (r & 3) + 8 * (r >> 2) + FO; FB[r] += rp[e]; }
#pragma unroll
    for (int r = PR; r < PR + 4; ++r) { const int e = (r & 3) + 8 * (r >> 2) + PO; PB[r] = ((unsigned)(vbase + e) < 16u) ? PB[r] + (rp[e] - mhat) : -INFINITY; }
    float a = MX3(FB[0], FB[1], FB[2]), c = MX3(FB[3], FB[4], FB[5]);
    a = MX3(a, FB[6], FB[7]); c = MX3(c, FB[8], FB[9]); a = MX3(a, FB[10], FB[11]); c = MX3(c, FB[12], FB[13]); a = MX3(a, FB[14], FB[15]); c = MX3(c, PB[PR], PB[PR + 1]); a = MX3(a, PB[PR + 2], PB[PR + 3]);
    a = __builtin_fmaxf(a, c);
    { auto rr = __builtin_amdgcn_permlane32_swap(__float_as_uint(a), __float_as_uint(a), false, false); a = __builtin_fmaxf(__uint_as_float(rr[0]), __uint_as_float(rr[1])); }
    const float rm = a; bool resc = false, shift = first; float dl = rm;
    if (!first) { shift = __any(rm > (float)THR); resc = shift; dl = fmaxf(rm, 0.f); }
    if (shift) { mhat += dl;
#pragma unroll
        for (int r = 0; r < 16; ++r) FB[r] -= dl;
#pragma unroll
        for (int r = PR; r < PR + 4; ++r) PB[r] -= dl;
        na_cinit<HALF>(cF, mhat, vbase);
        if (resc) { const float f = __builtin_amdgcn_exp2f(-dl); l *= f; if (hi == 0) wsf[r32] = f; } }
    float s = 0.f;
#pragma unroll
    for (int r = 0; r < 16; ++r) { FB[r] = __builtin_amdgcn_exp2f(FB[r]); s += FB[r]; }
#pragma unroll
    for (int r = PR; r < PR + 4; ++r) { PB[r] = __builtin_amdgcn_exp2f(PB[r]); s += PB[r]; }
    l += s;
    const u32x4 f0 = (u32x4){cvtpk(FB[0], FB[1]), cvtpk(FB[2], FB[3]), cvtpk(FB[4], FB[5]), cvtpk(FB[6], FB[7])};
    const u32x4 f1 = (u32x4){cvtpk(FB[8], FB[9]), cvtpk(FB[10], FB[11]), cvtpk(FB[12], FB[13]), cvtpk(FB[14], FB[15])};
    if (HALF == 0) { pw[0] = f0; pw[1] = f1; pw[2] = (u32x4){cvtpk(PB[0], PB[1]), cvtpk(PB[2], PB[3]), 0u, 0u}; }
    else { pw[2] = f0; pw[3] = f1; pw[1] = (u32x4){0u, 0u, cvtpk(PB[12], PB[13]), cvtpk(PB[14], PB[15])}; }
    if (resc) {
        float fr[16];
#pragma unroll
        for (int r = 0; r < 16; ++r) fr[r] = wsf[crow(r, hi)];
#pragma unroll
        for (int d = 0; d < 2; ++d)
#pragma unroll
            for (int r = 0; r < 16; ++r) o[d][r] *= fr[r];
    }
}
template <int HALF>
__device__ __forceinline__ void na_vload(s16x4 (&lo)[2][3], s16x4 (&hh)[2][3], lcp vb) {
    constexpr int K0 = HALF ? 1 : 0;
#pragma unroll
    for (int d0 = 0; d0 < 2; ++d0)
#pragma unroll
        for (int k = 0; k < 3; ++k) { lo[d0][k] = vtr(vb + d0 * 4096 + (K0 + k) * 1024); hh[d0][k] = vtr(vb + d0 * 4096 + (K0 + k) * 1024 + 512); }
}
template <int HALF>
__device__ __forceinline__ void na_pv(f32x16 (&o)[2], const u32x4 (&pw)[4], const s16x4 (&lo)[2][3], const s16x4 (&hh)[2][3]) {
    constexpr int K0 = HALF ? 1 : 0;
#pragma unroll
    for (int d0 = 0; d0 < 2; ++d0)
#pragma unroll
        for (int k = 0; k < 3; ++k)
            o[d0] = MFMA32(__builtin_bit_cast(bf16x8, pw[K0 + k]), ((bf16x8){lo[d0][k][0], lo[d0][k][1], lo[d0][k][2], lo[d0][k][3], hh[d0][k][0], hh[d0][k][1], hh[d0][k][2], hh[d0][k][3]}), o[d0]);
}
template <int THR>
__device__ __forceinline__ void na_unit(Frame& F, int layer, const bf16_t* qkv, bf16_t* Y, int idx) {
    const int tid = phase_tid(F.wave), lane = tid & 63, wid = F.wave, r32 = lane & 31, hi = lane >> 5;
    const int hp = (idx >> 4) & 3, rp2 = idx & 15, grp = wid >> 2;
    const int h = 2 * hp + (wid >> 2), row = 2 * rp2 + ((wid >> 1) & 1), half = wid & 1, c = 32 * half + r32;
    const size_t tokb = 0;
    LAS unsigned char* lds = F.lds;
    LAS float* wsf = (LAS float*)(lds + ATT_WSF) + wid * 128;
    LAS float* RPB = (LAS float*)(lds + ATT_TBL);
    const int rA = 2 * rp2, rB = 2 * rp2 + 1;
    const int lo = (rA - 4) < 0 ? 0 : ((rA - 4) > 24 ? 24 : (rA - 4));
    const int hr = ((rB - 4) < 0 ? 0 : ((rB - 4) > 24 ? 24 : (rB - 4))) + 7;
    const int ntile = hr - lo + 1;
    const int r0 = (row - 4) < 0 ? 0 : ((row - 4) > 24 ? 24 : (row - 4));
    const bf16_t* kbase = qkv + tokb * NQKV + COL_KA + (2 * hp) * 64; const bf16_t* vbase_g = qkv + tokb * NQKV + COL_VA + (2 * hp) * 64;
    const unsigned kvo = (unsigned)((8 * wid + (lane >> 3)) * NQKV + ((lane & 7) ^ (lane >> 3)) * 8) * 2u;
    const unsigned vvo = (unsigned)((16 * (wid & 3) + (lane >> 2)) * NQKV + (wid >> 2) * 32 + (lane & 3) * 8) * 2u;
#define NA_DMA(tt) do { const int t2_ = (tt) < ntile ? (tt) : ntile - 1; const size_t go_ = (size_t)(lo + t2_) * 64 * NQKV; LAS unsigned char* rb_ = lds + ((tt) & 3) * 32768 + wid * 1024; \
        GLDS16S(kvo, kbase + go_, rb_); GLDS16S(kvo, kbase + go_ + 64, rb_ + 8192); GLDS16S(vvo, vbase_g + go_, rb_ + 16384); GLDS16S(vvo, vbase_g + go_ + 64, rb_ + 24576); } while (0)
    NA_DMA(0); NA_DMA(1); NA_DMA(2);
    if (tid < 480) { const int dr = tid >> 5, i = tid & 31;
        RPB[tid] = (i < 31) ? arg_in(5)[((size_t)(layer * 8 + 2 * hp) * 15 + dr) * 31 + i] * LOG2E : 0.f;
        RPB[480 + tid] = (i < 31) ? arg_in(5)[((size_t)(layer * 8 + 2 * hp + 1) * 15 + dr) * 31 + i] * LOG2E : 0.f; }
    bf16x8 qr[4];
    { const bf16_t* Qw = qkv + (tokb + row * 64 + c) * NQKV + COL_QA + h * 64 + hi * 8;
#pragma unroll
      for (int d0 = 0; d0 < 4; ++d0) qr[d0] = *(const bf16x8*)(Qw + d0 * 16); }
    asm volatile("" : "+v"(qr[0]), "+v"(qr[1]), "+v"(qr[2]), "+v"(qr[3]));
    const int voff = ((lane >> 4) & 1) * 32 + (lane & 3) * 8 + (4 * hi + ((lane & 15) >> 2)) * 64 + grp * 8192;
    int koff[4];
#pragma unroll
    for (int d0 = 0; d0 < 4; ++d0) koff[d0] = r32 * 128 + (((2 * d0 + hi) ^ (r32 & 7)) << 4) + grp * 8192;
    f32x16 o[2]; o[0] = f32x16{}; o[1] = f32x16{};
    float mhat = 0.f, l = 0.f;
    u32x4 pw[4];
    ATT_WAIT_BAR(8);
    bf16x8 kf[8];
    kload(kf, (lcp)(lds), koff);
    const int c0 = (c - 8) < 0 ? 0 : ((c - 8) > 48 ? 48 : (c - 8));
    const int vbase = 4 * hi - c0;
    const int rpoff = grp * 480 + (4 * hi - c + 15);
    f32x16 cF;
    if (half == 0) na_cinit<0>(cF, 0.f, vbase); else na_cinit<1>(cF, 0.f, vbase);
#pragma unroll 1
    for (int t = 0; t < ntile; ++t) {
        const int kr = lo + t; const bool act = (kr >= r0 && kr < r0 + 8);
        lcp vb = (lcp)(lds + (t & 3) * 32768 + 16384 + voff);
        s16x4 vlo[2][3], vhh[2][3];
        if (act) {
            f32x16 p0, p1;
            int ro = rpoff; asm volatile("" : "+v"(ro));
            const LAS float* rp = RPB + (kr - row + 7) * 32 + ro;
            if (half == 0) na_scores<0, THR>(p0, p1, kf, qr, cF, o, mhat, l, kr == r0, rp, vbase, wsf, r32, hi, pw, vb, vlo, vhh);
            else           na_scores<1, THR>(p0, p1, kf, qr, cF, o, mhat, l, kr == r0, rp, vbase, wsf, r32, hi, pw, vb, vlo, vhh);
        }
        if (grp == 1) { ATT_WAIT_BAR(4); NA_DMA(t + 3); if (t + 1 < ntile) kload(kf, (lcp)(lds + ((t + 1) & 3) * 32768), koff); }
        __builtin_amdgcn_sched_barrier(0);
        if (act) { if (half == 0) na_pv<0>(o, pw, vlo, vhh); else na_pv<1>(o, pw, vlo, vhh); }
        if (grp == 0) { ATT_WAIT_BAR(4); NA_DMA(t + 3); if (t + 1 < ntile) kload(kf, (lcp)(lds + ((t + 1) & 3) * 32768), koff); }
    }
    ATT_WAIT_BAR(0);
#undef NA_DMA
    float rli[16]; row_inv_l(l, rli, wsf, r32, hi);
    LAS bf16_t* stg = (LAS bf16_t*)(lds + 65536) + wid * 2048;
#pragma unroll
    for (int d = 0; d < 2; ++d)
#pragma unroll
        for (int r = 0; r < 16; ++r) { const float v = o[d][r] * rli[r]; stg[crow(r, hi) * 64 + d * 32 + r32] = (bf16_t)(cvtpk(v, v) & 0xffffu); }
    bf16_t* yb = Y + (tokb + row * 64 + 32 * half + (lane >> 3)) * D + h * 64 + (lane & 7) * 8;
#pragma unroll
    for (int i = 0; i < 4; ++i) { const u32x4 v = *(const LAS u32x4*)(stg + (i * 8 + (lane >> 3)) * 64 + (lane & 7) * 8); store16_wt(yb + (size_t)i * 8 * D, v); }
    ATT_WAIT_BAR(0);
}
}

struct Args { const float* in[14]; float* out; unsigned char* ws; };
__global__ void __launch_bounds__(NWAVES * 64, 2) enc_fwd(Args args) {
    extern __shared__ __attribute__((aligned(16))) unsigned char lds[];
    Frame F;
    F.lds = (LAS unsigned char*)lds;
    F.wave = __builtin_amdgcn_readfirstlane((int)threadIdx.x >> 6); F.G = gridDim.x; { const int bx = blockIdx.x; F.vcu = (F.G % 8 == 0) ? (bx % 8) * (F.G / 8) + bx / 8 : bx; }
    F.out = args.out; F.ws = args.ws;
    unsigned char* ws = args.ws;
    volatile LAS unsigned* MISC = (volatile LAS unsigned*)(F.lds + MISC_OFF);
    for (int u = threadIdx.x; u < (LDS_BYTES - LDSCTL_OFF) / 4; u += NWAVES * 64) ((LAS unsigned*)(F.lds + LDSCTL_OFF))[u] = 0u;
    __syncthreads();
    XcdBarrier bar; bar.bar = (unsigned*)(ws + WS_CTL) + CW_BAR; bar.x = 0; bar.st = nullptr; bar.wave = F.wave;
    bar = xcd_barrier_post((unsigned*)(ws + WS_CTL) + CW_BAR, MISC + 8, F.wave);
    p0_prologue(F);
    xcd_barrier(bar);
    const unsigned xcc = bar.x;
    const int nloc = __builtin_amdgcn_readfirstlane((int)MISC[8]), nx = __builtin_amdgcn_readfirstlane((int)MISC[9]);
    const int rank = __builtin_amdgcn_readfirstlane((int)MISC[10]), xi = __builtin_amdgcn_readfirstlane((int)MISC[11]);
    unsigned* lbar = (unsigned*)(ws + WS_CTL) + CW_BAR;
    unsigned lgen = 0;
#define LSEAM() xcc_local_barrier(lbar, xcc, (unsigned)nloc, F.wave, lgen)
#pragma unroll 1
    for (int bb = xi; bb < BATCH; bb += nx) {
        unsigned char* breg = ws + WS_QKV + (size_t)bb * BREG;
        bf16_t* QKVb = (bf16_t*)breg; bf16_t* GATESb = (bf16_t*)(breg + BREG_GATES); bf16_t* MERGEDb = (bf16_t*)breg; bf16_t* HBb = (bf16_t*)breg;
        bf16_t* XBb = (bf16_t*)(ws + WS_XNY) + (size_t)bb * MB * D; float* SSb = (float*)(ws + WS_SS) + (size_t)bb * MB * 4;
        bf16_t* Yb = (bf16_t*)((unsigned char*)F.out + (size_t)bb * MB * D * 4);
        float* OUTb = F.out + (size_t)bb * MB * D;
#pragma unroll 1
        for (int L = 0; L < DEPTH; ++L) {
            unsigned char* wb = ws + WS_W + (size_t)L * W_LAYER;
            {
                pg8::Gemm g{XBb, (const bf16_t*)(wb + WO_IN), MB, NIN, D}; pg8::BatchOrder S{NIN / 256, nloc, rank};
                pg8::EpiProj E{QKVb, GATESb, SSb};
                pg8::gemm_phase<pg8::EpiProj, pg8::BatchOrder, true, true>(F.lds + RING_OFF, g, S, E, F.wave);
            }
            LSEAM();
            {
#pragma unroll 1
                for (int u = 2 * rank; u < 64; u += 2 * nloc) { att::diff_unit<8>(F, L, QKVb, Yb, u >> 4, u & 15); att::diff_unit<8>(F, L, QKVb, Yb, (u + 1) >> 4, (u + 1) & 15); }
#pragma unroll 1
                for (int u = 2 * rank; u < 64; u += 2 * nloc) { att::na_unit<8>(F, L, QKVb, Yb, u); att::na_unit<8>(F, L, QKVb, Yb, u + 1); }
            }
            LSEAM();
            {
                pg8::Gemm g{Yb, (const bf16_t*)(wb + WO_M), MB, D, D}; pg8::BatchOrder S{D / 256, nloc, rank};
                pg8::EpiMerge E{MERGEDb, GATESb};
                pg8::gemm_phase<pg8::EpiMerge, pg8::BatchOrder, true, true>(F.lds + RING_OFF, g, S, E, F.wave);
            }
            LSEAM();
            {
                pg8::Gemm g{MERGEDb, (const bf16_t*)(wb + WO_OUT), MB, D, D}; pg8::BatchOrder S{D / 256, nloc, rank};
                pg8::EpiResid E{XBb, SSb, {}};
                pg8::gemm_phase<pg8::EpiResid, pg8::BatchOrder, true, true>(F.lds + RING_OFF, g, S, E, F.wave);
            }
            LSEAM();
            {
                pg8::Gemm g{XBb, (const bf16_t*)(wb + WO_FF1), MB, FF, D}; pg8::BatchOrder S{FF / 256, nloc, rank};
                pg8::EpiFF1 E{HBb, SSb};
                pg8::gemm_phase<pg8::EpiFF1, pg8::BatchOrder, true, true>(F.lds + RING_OFF, g, S, E, F.wave);
            }
            LSEAM();
            {
                pg8::Gemm g{HBb, (const bf16_t*)(wb + WO_FF2), MB, D, FF}; pg8::BatchOrder S{D / 256, nloc, rank};
                if (L + 1 < DEPTH) { pg8::EpiResid E{XBb, SSb, {}};
                    pg8::gemm_phase<pg8::EpiResid, pg8::BatchOrder, true, true>(F.lds + RING_OFF, g, S, E, F.wave); }
                else { pg8::EpiFinal E{XBb, SSb, arg_in(2), OUTb, (unsigned*)(ws + WS_CTL) + CW_PANEL + bb * 8 * 64, {}};
                    pg8::gemm_phase<pg8::EpiFinal, pg8::BatchOrder, true, true>(F.lds + RING_OFF, g, S, E, F.wave); }
            }
            if (L + 1 < DEPTH) LSEAM();
        }
        if (bb + nx < BATCH) LSEAM();
    }
#undef LSEAM
}

extern "C" void kernel_launch(void* const* d_in, const int* in_sizes, int n_in, void* d_out, int out_size, void* d_ws, size_t ws_size, hipStream_t stream) {
    static int grid = 0;
    if (grid == 0) {
        if (n_in != 14 || in_sizes[0] != M * D || out_size != M * D || ws_size < WS_END) { fprintf(stderr, "kernel_launch: unexpected shapes (n_in %d, in0 %d, out %d, ws %zu); nothing launched\n", n_in, n_in > 0 ? in_sizes[0] : -1, out_size, ws_size); grid = -1; return; }
        int dev = 0, cus = 0;
        if (hipGetDevice(&dev) != hipSuccess || hipDeviceGetAttribute(&cus, hipDeviceAttributeMultiprocessorCount, dev) != hipSuccess) { grid = -1; return; }
        if (hipFuncSetAttribute((const void*)enc_fwd, hipFuncAttributeMaxDynamicSharedMemorySize, LDS_BYTES) != hipSuccess) { fprintf(stderr, "kernel_launch: hipFuncSetAttribute failed\n"); grid = -1; return; }
        int per_cu = 0;
        if (hipOccupancyMaxActiveBlocksPerMultiprocessor(&per_cu, (const void*)enc_fwd, NWAVES * 64, LDS_BYTES) != hipSuccess || per_cu < 1) fprintf(stderr, "kernel_launch: occupancy query reports %d per CU\n", per_cu);
        (void)hipGetLastError();
        grid = cus;
    }
    if (grid < 0) return;
    Args a{};
    for (int i = 0; i < 14; ++i) a.in[i] = (const float*)d_in[i];
    a.out = (float*)d_out; a.ws = (unsigned char*)d_ws;
    if (hipMemsetAsync((char*)d_ws + WS_CTL, 0, CTL_ZERO_BYTES, stream) != hipSuccess) { fprintf(stderr, "kernel_launch: memset failed\n"); return; }
    hipLaunchKernelGGL(enc_fwd, dim3(grid), dim3(NWAVES * 64), LDS_BYTES, stream, a);
}
```

```cpp
#include <hip/hip_runtime.h>
#include <cstdio>
#include <cstdint>

#define LAS __attribute__((address_space(3)))
#define GAS __attribute__((address_space(1)))
typedef unsigned short bf16_t;
typedef short bf16x8 __attribute__((ext_vector_type(8)));
typedef short s16x4 __attribute__((ext_vector_type(4)));
typedef float f32x4 __attribute__((ext_vector_type(4)));
typedef float f32x2 __attribute__((ext_vector_type(2)));
typedef float f32x16 __attribute__((ext_vector_type(16)));
typedef unsigned u32x4 __attribute__((ext_vector_type(4)));
typedef unsigned u32x2 __attribute__((ext_vector_type(2)));
typedef __bf16 bf16x2_t __attribute__((ext_vector_type(2)));

constexpr int BATCH = 8, SEQ = 2048, D = 1024, M = BATCH * SEQ, DEPTH = 2, FF = 4096;
constexpr int NQKV = 3072, NGATE = 2048, NIN = 5120;
constexpr int MB = SEQ;
constexpr float RMS_EPS = 1e-6f;
constexpr float LOG2E = 1.4426950408889634f;
constexpr float C2 = 0.125f * LOG2E;
constexpr int COL_QA = 0, COL_KA = 512, COL_VA = 1024, COL_QD = 1536, COL_KD = 2048, COL_VD = 2560;

__device__ __forceinline__ unsigned cvtpk(float lo, float hi) { f32x2 v = {lo, hi}; bf16x2_t b = __builtin_convertvector(v, bf16x2_t); return __builtin_bit_cast(unsigned, b); }
__device__ __forceinline__ float bf2f(unsigned short u) { return __uint_as_float((unsigned)u << 16); }
__device__ __forceinline__ float bflo(unsigned w) { return __uint_as_float(w << 16); }
__device__ __forceinline__ float bfhi(unsigned w) { return __uint_as_float(w & 0xffff0000u); }

__device__ __forceinline__ unsigned lane_id_now() { unsigned l; asm volatile("v_mbcnt_lo_u32_b32 %0, -1, 0\n\tv_mbcnt_hi_u32_b32 %0, -1, %0" : "=v"(l)); return l; }
__device__ __forceinline__ void store16_wt(void* p, u32x4 v) { asm volatile("global_store_dwordx4 %0, %1, off sc1\n\ts_nop 1" :: "v"(p), "v"(v) : "memory"); }
namespace pg8 {
constexpr int BM = 256, BK = 64, HALF = 128, HTB = HALF * BK * 2, STAGE_BYTES = 8 * HTB, NXCD = 8, WGM = 8;
__host__ __device__ __forceinline__ int lds_byte(int r, int c) { const int st = (r >> 4) * 2 + (c >> 5), rr = r & 15, cc = c & 31, ob = rr * 64 + cc * 2; return st * 1024 + (ob ^ (((ob >> 9) & 1) << 5)); }
__host__ __device__ __forceinline__ void stage_rc(int b, int& R, int& C) { const int st = b / 1024, sb = b % 1024, swz = sb ^ (((sb >> 9) & 1) << 5); R = (st >> 1) * 16 + swz / 64; C = (st & 1) * 32 + (swz % 64) / 2; }
__host__ __device__ __forceinline__ int perm32(int rho) { const int n = rho >> 4, i = rho & 15; return 8 * (i >> 2) + 4 * n + (i & 3); }

struct Unit { int pm, pn; };
struct Gemm { const bf16_t* A; const bf16_t* Bt; int M, N, K; };

struct BatchOrder {
    int nN, nloc, rank;
    __device__ bool next(int i, Unit& u) const { const int L = i * nloc + rank; if (L >= 8 * nN) return false; u.pm = L & 7; u.pn = L >> 3; return true; }
};

__device__ __forceinline__ float row_rstd(const float* ss, int row) {
    const f32x4 a = *(const f32x4*)(ss + (size_t)row * 4);
    const float s = (a[0] + a[1]) + (a[2] + a[3]);
    return 1.0f / sqrtf(s * (1.0f / (float)D) + RMS_EPS);
}

struct EpiProj {
    static constexpr bool HAS_POST = false;
    static constexpr bool PERM = true, HAS_MID = false;
    bf16_t* qkv; bf16_t* gates; const float* ss;
    __device__ __forceinline__ void mid(f32x4 (&acc)[2][2][4][2], const Unit& u, int wr, int wc, int fr, int fq) const {}
    __device__ __forceinline__ void operator()(f32x4 (&acc)[2][2][4][2], const Unit& u, int wr, int wc, int fr, int fq) const {
        const int row0 = u.pm * BM + wr * 64 + fr;
        float rs[2][4];
#pragma unroll
        for (int ai = 0; ai < 2; ++ai)
#pragma unroll
            for (int m = 0; m < 4; ++m) rs[ai][m] = row_rstd(ss, row0 + ai * HALF + m * 16);
        if (u.pn < 12) {
            const float sc = (u.pn < 2 || u.pn == 6 || u.pn == 7) ? C2 : 1.0f;
            const int col0 = u.pn * BM + wc * 32 + 8 * fq;
#pragma unroll
            for (int ai = 0; ai < 2; ++ai)
#pragma unroll
                for (int m = 0; m < 4; ++m) { const int row = row0 + ai * HALF + m * 16; const float r = rs[ai][m] * sc; bf16_t* rowp = qkv + (size_t)row * NQKV + col0;
#pragma unroll
                    for (int bj = 0; bj < 2; ++bj) { const f32x4 v0 = acc[ai][bj][m][0] * r, v1 = acc[ai][bj][m][1] * r;
                        u32x4 w; w.x = cvtpk(v0[0], v0[1]); w.y = cvtpk(v0[2], v0[3]); w.z = cvtpk(v1[0], v1[1]); w.w = cvtpk(v1[2], v1[3]);
                        store16_wt(rowp + bj * HALF, w); } }
        } else {
            const int col0 = (u.pn - 12) * HALF + wc * 32 + 8 * fq;
#pragma unroll
            for (int ai = 0; ai < 2; ++ai)
#pragma unroll
                for (int m = 0; m < 4; ++m) { const int row = row0 + ai * HALF + m * 16; const float r = rs[ai][m]; float rho[8], sg[8];
#pragma unroll
                    for (int n = 0; n < 2; ++n)
#pragma unroll
                        for (int e = 0; e < 4; ++e) { const float ga = acc[ai][0][m][n][e] * r, gd = fmaxf(acc[ai][1][m][n][e] * r, -80.f);
                            const float ed = 1.f + __expf(-gd), ea = 1.f + __expf(-ga); rho[4 * n + e] = ed * __builtin_amdgcn_rcpf(ea); sg[4 * n + e] = __builtin_amdgcn_rcpf(ed); }
                    u32x4 w; w.x = cvtpk(rho[0], rho[1]); w.y = cvtpk(rho[2], rho[3]); w.z = cvtpk(rho[4], rho[5]); w.w = cvtpk(rho[6], rho[7]);
                    store16_wt(gates + (size_t)row * D + col0, w);
                    w.x = cvtpk(sg[0], sg[1]); w.y = cvtpk(sg[2], sg[3]); w.z = cvtpk(sg[4], sg[5]); w.w = cvtpk(sg[6], sg[7]);
                    store16_wt(gates + (size_t)MB * D + (size_t)row * D + col0, w); }
        }
    }
};
struct EpiFF1 {
    static constexpr bool HAS_POST = false;
    static constexpr bool PERM = true, HAS_MID = false;
    bf16_t* H; const float* ss;
    __device__ __forceinline__ void mid(f32x4 (&acc)[2][2][4][2], const Unit& u, int wr, int wc, int fr, int fq) const {}
    __device__ __forceinline__ void operator()(f32x4 (&acc)[2][2][4][2], const Unit& u, int wr, int wc, int fr, int fq) const {
        const int row0 = u.pm * BM + wr * 64 + fr, col0 = u.pn * BM + wc * 32 + 8 * fq;
        float rs[2][4];
#pragma unroll
        for (int ai = 0; ai < 2; ++ai)
#pragma unroll
            for (int m = 0; m < 4; ++m) rs[ai][m] = row_rstd(ss, row0 + ai * HALF + m * 16);
#pragma unroll
        for (int ai = 0; ai < 2; ++ai)
#pragma unroll
            for (int m = 0; m < 4; ++m) { const int row = row0 + ai * HALF + m * 16; const float r = rs[ai][m]; bf16_t* rowp = H + (size_t)row * FF + col0;
#pragma unroll
                for (int bj = 0; bj < 2; ++bj) { f32x4 v0 = acc[ai][bj][m][0] * r, v1 = acc[ai][bj][m][1] * r;
#pragma unroll
                    for (int e = 0; e < 4; ++e) { const float a = fmaxf(v0[e], 0.f), b = fmaxf(v1[e], 0.f); v0[e] = a * a; v1[e] = b * b; }
                    u32x4 w; w.x = cvtpk(v0[0], v0[1]); w.y = cvtpk(v0[2], v0[3]); w.z = cvtpk(v1[0], v1[1]); w.w = cvtpk(v1[2], v1[3]);
                    store16_wt(rowp + bj * HALF, w); } }
    }
};
struct EpiMerge {
    static constexpr bool HAS_POST = false;
    static constexpr bool PERM = true, HAS_MID = true;
    bf16_t* O; const bf16_t* gates;
    __device__ __forceinline__ void mid(f32x4 (&acc)[2][2][4][2], const Unit& u, int wr, int wc, int fr, int fq) const {
        const int row0 = u.pm * BM + wr * 64 + fr, col0 = u.pn * BM + wc * 32 + 8 * fq;
        const bf16_t* gp = gates + (size_t)row0 * D + col0;
#pragma unroll
        for (int ai = 0; ai < 2; ++ai) {
            asm volatile("" : "+v"(gp) :: "memory");
            u32x4 g[4][2];
#pragma unroll
            for (int q = 0; q < 4; ++q)
#pragma unroll
                for (int bj = 0; bj < 2; ++bj) g[q][bj] = *(const GAS u32x4*)(gp + q * 16 * D + bj * HALF);
#pragma unroll
            for (int q = 0; q < 4; ++q)
#pragma unroll
                for (int bj = 0; bj < 2; ++bj)
#pragma unroll
                    for (int w = 0; w < 4; ++w) { acc[ai][bj][q][w >> 1][(w & 1) * 2] *= bflo(g[q][bj][w]); acc[ai][bj][q][w >> 1][(w & 1) * 2 + 1] *= bfhi(g[q][bj][w]); }
            gp += HALF * D; }
    }
    __device__ __forceinline__ void operator()(f32x4 (&acc)[2][2][4][2], const Unit& u, int wr, int wc, int fr, int fq) const {
        const int row0 = u.pm * BM + wr * 64 + fr, col0 = u.pn * BM + wc * 32 + 8 * fq;
        const bf16_t* gp = gates + (size_t)MB * D + (size_t)row0 * D + col0; bf16_t* rowp = O + (size_t)row0 * D + col0;
#pragma unroll
        for (int ai = 0; ai < 2; ++ai) {
            asm volatile("" : "+v"(gp), "+v"(rowp) :: "memory");
            u32x4 g[4][2];
#pragma unroll
            for (int q = 0; q < 4; ++q)
#pragma unroll
                for (int bj = 0; bj < 2; ++bj) g[q][bj] = *(const GAS u32x4*)(gp + q * 16 * D + bj * HALF);
#pragma unroll
            for (int q = 0; q < 4; ++q)
#pragma unroll
                for (int bj = 0; bj < 2; ++bj) { float o[8];
#pragma unroll
                    for (int w = 0; w < 4; ++w) { o[2 * w] = acc[ai][bj][q][w >> 1][(w & 1) * 2] * bflo(g[q][bj][w]); o[2 * w + 1] = acc[ai][bj][q][w >> 1][(w & 1) * 2 + 1] * bfhi(g[q][bj][w]); }
                    u32x4 w4; w4.x = cvtpk(o[0], o[1]); w4.y = cvtpk(o[2], o[3]); w4.z = cvtpk(o[4], o[5]); w4.w = cvtpk(o[6], o[7]);
                    store16_wt((void*)(rowp + q * 16 * D + bj * HALF), w4); }
            gp += HALF * D; rowp += HALF * D; }
    }
};
struct EpiResid {
    static constexpr bool HAS_POST = true;
    static constexpr bool PERM = true, HAS_MID = false;
    bf16_t* xb; float* ss; float qs[2][4];
    __device__ __forceinline__ void mid(f32x4 (&acc)[2][2][4][2], const Unit& u, int wr, int wc, int fr, int fq) const {}
    __device__ __forceinline__ void operator()(f32x4 (&acc)[2][2][4][2], const Unit& u, int wr, int wc, int fr, int fq) {
        const int row0 = u.pm * BM + wr * 64 + fr, col0 = u.pn * BM + wc * 32 + 8 * fq;
#pragma unroll
        for (int ai = 0; ai < 2; ++ai)
#pragma unroll
            for (int m = 0; m < 4; ++m) { const int row = row0 + ai * HALF + m * 16; bf16_t* rowp = xb + (size_t)row * D + col0; float q = 0.f;
#pragma unroll
                for (int bj = 0; bj < 2; ++bj) { const u32x4 xv = *(const u32x4*)(rowp + bj * HALF);
                    const f32x4 y0 = (f32x4){bflo(xv.x), bfhi(xv.x), bflo(xv.y), bfhi(xv.y)} + acc[ai][bj][m][0], y1 = (f32x4){bflo(xv.z), bfhi(xv.z), bflo(xv.w), bfhi(xv.w)} + acc[ai][bj][m][1];
                    q += (y0[0] * y0[0] + y0[1] * y0[1]) + (y0[2] * y0[2] + y0[3] * y0[3]) + (y1[0] * y1[0] + y1[1] * y1[1]) + (y1[2] * y1[2] + y1[3] * y1[3]);
                    u32x4 w; w.x = cvtpk(y0[0], y0[1]); w.y = cvtpk(y0[2], y0[3]); w.z = cvtpk(y1[0], y1[1]); w.w = cvtpk(y1[2], y1[3]);
                    *(u32x4*)(rowp + bj * HALF) = w; }
                q += __shfl_xor(q, 16); q += __shfl_xor(q, 32);
                qs[ai][m] = q; }
    }
    __device__ __forceinline__ void post(LAS unsigned char* lds, f32x4 (&acc)[2][2][4][2], const Unit& u, int wr, int wc, int fr, int fq, int tid) {
        LAS float* P = (LAS float*)lds;
        if (fq == 0) {
#pragma unroll
            for (int ai = 0; ai < 2; ++ai)
#pragma unroll
                for (int m = 0; m < 4; ++m) P[(ai * HALF + wr * 64 + m * 16 + fr) * 4 + wc] = qs[ai][m];
        }
        asm volatile("s_waitcnt lgkmcnt(0)" ::: "memory"); __builtin_amdgcn_s_barrier(); asm volatile("" ::: "memory");
        if (tid < 256) { const f32x4 v = *(const LAS f32x4*)(P + tid * 4); ss[(size_t)(u.pm * BM + tid) * 4 + u.pn] = (v[0] + v[1]) + (v[2] + v[3]); }
    }
};

struct EpiFinal {
    static constexpr bool HAS_POST = true;
    static constexpr bool PERM = true, HAS_MID = false;
    const bf16_t* xb; float* ss; const float* g; float* out; unsigned* cnt; float qs[2][4];
    __device__ __forceinline__ void mid(f32x4 (&acc)[2][2][4][2], const Unit& u, int wr, int wc, int fr, int fq) const {}
    __device__ __forceinline__ void operator()(f32x4 (&acc)[2][2][4][2], const Unit& u, int wr, int wc, int fr, int fq) {
        const int row0 = u.pm * BM + wr * 64 + fr, col0 = u.pn * BM + wc * 32 + 8 * fq;
#pragma unroll
        for (int ai = 0; ai < 2; ++ai)
#pragma unroll
            for (int m = 0; m < 4; ++m) { const int row = row0 + ai * HALF + m * 16; const bf16_t* rowp = xb + (size_t)row * D + col0; float q = 0.f;
#pragma unroll
                for (int bj = 0; bj < 2; ++bj) { const u32x4 xv = *(const u32x4*)(rowp + bj * HALF);
                    const f32x4 y0 = (f32x4){bflo(xv.x), bfhi(xv.x), bflo(xv.y), bfhi(xv.y)} + acc[ai][bj][m][0], y1 = (f32x4){bflo(xv.z), bfhi(xv.z), bflo(xv.w), bfhi(xv.w)} + acc[ai][bj][m][1];
                    q += (y0[0] * y0[0] + y0[1] * y0[1]) + (y0[2] * y0[2] + y0[3] * y0[3]) + (y1[0] * y1[0] + y1[1] * y1[1]) + (y1[2] * y1[2] + y1[3] * y1[3]);
                    acc[ai][bj][m][0] = y0; acc[ai][bj][m][1] = y1; }
                q += __shfl_xor(q, 16); q += __shfl_xor(q, 32);
                qs[ai][m] = q; }
    }
    __device__ __forceinline__ void post(LAS unsigned char* lds, f32x4 (&acc)[2][2][4][2], const Unit& u, int wr, int wc, int fr, int fq, int tid) {
        LAS float* P = (LAS float*)lds;
        LAS float* S = (LAS float*)(lds + 4096);
        LAS unsigned* flag = (LAS unsigned*)(lds + 4096 + 1024);
        if (fq == 0) {
#pragma unroll
            for (int ai = 0; ai < 2; ++ai)
#pragma unroll
                for (int m = 0; m < 4; ++m) P[(ai * HALF + wr * 64 + m * 16 + fr) * 4 + wc] = qs[ai][m];
        }
        asm volatile("s_waitcnt lgkmcnt(0)" ::: "memory"); __builtin_amdgcn_s_barrier(); asm volatile("" ::: "memory");
        unsigned* pc = cnt + 64 * u.pm;
        if (tid < 256) {
            const f32x4 v = *(const LAS f32x4*)(P + tid * 4);
            __hip_atomic_store(ss + (size_t)(u.pm * BM + tid) * 4 + u.pn, (v[0] + v[1]) + (v[2] + v[3]), __ATOMIC_RELAXED, __HIP_MEMORY_SCOPE_AGENT);
            asm volatile("s_waitcnt vmcnt(0)" ::: "memory");
            if ((tid & 63) == 0) __hip_atomic_fetch_add(pc, 1u, __ATOMIC_RELAXED, __HIP_MEMORY_SCOPE_AGENT);
        }
        if (tid < 64) {
            unsigned sp = 0;
            while ((unsigned)__builtin_amdgcn_readfirstlane(__hip_atomic_load(pc, __ATOMIC_RELAXED, __HIP_MEMORY_SCOPE_AGENT)) < 16u) { __builtin_amdgcn_s_sleep(2); if (++sp > (1u << 20)) break; }
            __builtin_amdgcn_fence(__ATOMIC_ACQUIRE, "agent");
            asm volatile("s_waitcnt vmcnt(0)" ::: "memory");
            if (tid == 0) flag[0] = 1u;
        }
        asm volatile("s_waitcnt lgkmcnt(0)" ::: "memory"); __builtin_amdgcn_s_barrier(); asm volatile("" ::: "memory");
        if (tid < 256) {
            const float* sp4 = ss + (size_t)(u.pm * BM + tid) * 4; float t = 0.f;
#pragma unroll
            for (int j = 0; j < 4; ++j) t += __hip_atomic_load(sp4 + j, __ATOMIC_RELAXED, __HIP_MEMORY_SCOPE_AGENT);
            S[tid] = 1.0f / sqrtf(t * (1.0f / (float)D) + RMS_EPS);
        }
        asm volatile("s_waitcnt vmcnt(0) lgkmcnt(0)" ::: "memory"); __builtin_amdgcn_s_barrier(); asm volatile("" ::: "memory");
        const int row0 = u.pm * BM + wr * 64 + fr, col0 = u.pn * BM + wc * 32 + 8 * fq;
        f32x4 gv[2][2];
#pragma unroll
        for (int bj = 0; bj < 2; ++bj)
#pragma unroll
            for (int n = 0; n < 2; ++n) gv[bj][n] = *(const f32x4*)(g + col0 + bj * HALF + 4 * n);
#pragma unroll
        for (int ai = 0; ai < 2; ++ai)
#pragma unroll
            for (int m = 0; m < 4; ++m) { const int rl = ai * HALF + wr * 64 + m * 16 + fr; const float r = S[rl]; float* rowp = out + (size_t)(u.pm * BM + rl) * D + col0;
#pragma unroll
                for (int bj = 0; bj < 2; ++bj) { *(f32x4*)(rowp + bj * HALF) = acc[ai][bj][m][0] * r * gv[bj][0]; *(f32x4*)(rowp + bj * HALF + 4) = acc[ai][bj][m][1] * r * gv[bj][1]; } }
    }
};

template <class Epi, class Sched, bool ALIGN_EPI, bool SP2>
__device__ __forceinline__ void gemm_phase(LAS unsigned char* lds, const Gemm g, const Sched& S, Epi& E, int wave_) {
    const int tid_ = wave_ * 64 + (int)lane_id_now();
    const int tid = tid_, wid = __builtin_amdgcn_readfirstlane(tid >> 6), lane = tid & 63, wr = wid >> 2, wc = wid & 3, fr = lane & 15, fq = lane >> 4;
    const int K = g.K, nt = K / BK;
    unsigned voffA[2], voffB[2];
#pragma unroll
    for (int i = 0; i < 2; ++i) { int R, C; stage_rc(tid * 16 + i * 8192, R, C); const int Rb = Epi::PERM ? ((R & ~31) + perm32(R & 31)) : R;
        voffA[i] = (unsigned)(R * K + C) * 2u; voffB[i] = (unsigned)(Rb * K + C) * 2u; }
    const size_t kstep = (size_t)(BK * 2);
    const size_t hstep = (size_t)HALF * K * 2;
    const size_t tstep = 2 * hstep;
    const unsigned ldsw = (unsigned)wid * 1024u;
    const int aoff = lds_byte(wr * 64 + fr, fq * 8), boff = lds_byte(wc * 32 + fr, fq * 8);
#define PG8_SA(b, h) (((b) * 2 + (h)) * HTB)
#define PG8_SB(b, h) ((4 + (b) * 2 + (h)) * HTB)
#define PG8_STAGE(bufoff, gbase, voff) do { _Pragma("unroll") for (int _i = 0; _i < 2; ++_i) \
        __builtin_amdgcn_global_load_lds((const unsigned*)((const char*)(gbase) + (voff)[_i]), (LAS unsigned*)(lds + (bufoff) + ldsw + _i * 8192), 16, 0, 0); } while (0)
#define PG8_LDA(dst, b, h) do { _Pragma("unroll") for (int m = 0; m < 4; ++m) _Pragma("unroll") for (int k = 0; k < 2; ++k) dst[m][k] = *(const LAS bf16x8*)(lds + PG8_SA(b, h) + aoff + m * 2048 + k * 1024); } while (0)
#define PG8_LDB(dst, b, h) do { _Pragma("unroll") for (int n = 0; n < 2; ++n) _Pragma("unroll") for (int k = 0; k < 2; ++k) dst[n][k] = *(const LAS bf16x8*)(lds + PG8_SB(b, h) + boff + n * 2048 + k * 1024); } while (0)
#define PG8_MMA(ai, bj, At, Bt) do { __builtin_amdgcn_s_setprio(1); _Pragma("unroll") for (int m = 0; m < 4; ++m) _Pragma("unroll") for (int n = 0; n < 2; ++n) _Pragma("unroll") for (int k = 0; k < 2; ++k) \
        acc[ai][bj][m][n] = __builtin_amdgcn_mfma_f32_16x16x32_bf16(Bt[n][k], At[m][k], acc[ai][bj][m][n], 0, 0, 0); __builtin_amdgcn_s_setprio(0); } while (0)
#define PG8_WAIT_V(n) asm volatile("s_waitcnt vmcnt(" #n ")" ::: "memory")
#define PG8_WAIT_L(n) asm volatile("s_waitcnt lgkmcnt(" #n ")" ::: "memory")
#define PG8_BAR __builtin_amdgcn_s_barrier()
#define PG8_SCHED __builtin_amdgcn_sched_barrier(0)
    Unit cur, nxt; int ui = 0;
    if (!S.next(0, cur)) return;
    f32x4 acc[2][2][4][2];
#pragma unroll
    for (int a = 0; a < 2; ++a)
#pragma unroll
        for (int b = 0; b < 2; ++b)
#pragma unroll
            for (int m = 0; m < 4; ++m)
#pragma unroll
                for (int n = 0; n < 2; ++n) acc[a][b][m][n] = (f32x4){0.f, 0.f, 0.f, 0.f};
    bf16x8 At[4][2], B0[2][2], B1[2][2];
    const char* cA = (const char*)g.A + (size_t)cur.pm * tstep; const char* cB = (const char*)g.Bt + (size_t)cur.pn * tstep;
    if constexpr (SP2) {
        PG8_STAGE(PG8_SB(0, 0), cB, voffB); PG8_STAGE(PG8_SB(0, 1), cB + hstep, voffB); PG8_STAGE(PG8_SA(0, 0), cA, voffA); PG8_STAGE(PG8_SA(0, 1), cA + hstep, voffA);
        if (wr == 1) PG8_BAR;
        PG8_WAIT_V(2); PG8_BAR;
        PG8_STAGE(PG8_SB(1, 0), cB + kstep, voffB); PG8_STAGE(PG8_SA(1, 0), cA + kstep, voffA); PG8_STAGE(PG8_SB(1, 1), cB + hstep + kstep, voffB);
        PG8_WAIT_V(6); PG8_BAR;
    } else {
        PG8_STAGE(PG8_SB(0, 0), cB, voffB); PG8_STAGE(PG8_SA(0, 0), cA, voffA); PG8_STAGE(PG8_SB(0, 1), cB + hstep, voffB); PG8_STAGE(PG8_SA(0, 1), cA + hstep, voffA);
        if (wr == 1) PG8_BAR;
        PG8_WAIT_V(4); PG8_BAR;
        PG8_STAGE(PG8_SB(1, 0), cB + kstep, voffB); PG8_STAGE(PG8_SA(1, 0), cA + kstep, voffA); PG8_STAGE(PG8_SB(1, 1), cB + hstep + kstep, voffB);
        PG8_WAIT_V(6); PG8_BAR;
    }
    for (;;) {
        const bool has_next = S.next(ui + 1, nxt);
        const char* nA = has_next ? (const char*)g.A + (size_t)nxt.pm * tstep : cA; const char* nB = has_next ? (const char*)g.Bt + (size_t)nxt.pn * tstep : cB;
        for (int t = 0; t < nt; t += 2) {
            if constexpr (Epi::HAS_MID) { if (t == nt / 2) E.mid(acc, cur, wr, wc, fr, fq); }
            const bool last = (t == nt - 2);
            const char* a1 = cA + (size_t)(t + 1) * kstep;
            const char* a2 = last ? nA : cA + (size_t)(t + 2) * kstep; const char* b2 = last ? nB : cB + (size_t)(t + 2) * kstep;
            const char* a3 = a2 + kstep; const char* b3 = b2 + kstep;
            if constexpr (SP2) {
            PG8_LDB(B0, 0, 0); PG8_LDB(B1, 0, 1); PG8_SCHED; PG8_LDA(At, 0, 0); PG8_STAGE(PG8_SA(1, 1), a1 + hstep, voffA);
            PG8_WAIT_V(8); PG8_WAIT_L(0); PG8_BAR; PG8_MMA(0, 0, At, B0); PG8_MMA(0, 1, At, B1); PG8_BAR; PG8_SCHED;
            PG8_LDA(At, 0, 1); PG8_STAGE(PG8_SB(0, 0), b2, voffB); PG8_STAGE(PG8_SB(0, 1), b2 + hstep, voffB); PG8_STAGE(PG8_SA(0, 0), a2, voffA);
            PG8_WAIT_V(8); PG8_WAIT_L(0); PG8_BAR; PG8_MMA(1, 0, At, B0); PG8_MMA(1, 1, At, B1); PG8_BAR; PG8_SCHED;
            PG8_LDB(B0, 1, 0); PG8_LDB(B1, 1, 1); PG8_SCHED; PG8_LDA(At, 1, 0); PG8_STAGE(PG8_SA(0, 1), a2 + hstep, voffA);
            PG8_WAIT_V(8); PG8_WAIT_L(0); PG8_BAR; PG8_MMA(0, 0, At, B0); PG8_MMA(0, 1, At, B1); PG8_BAR; PG8_SCHED;
            PG8_LDA(At, 1, 1); PG8_STAGE(PG8_SB(1, 0), b3, voffB); PG8_STAGE(PG8_SB(1, 1), b3 + hstep, voffB); PG8_STAGE(PG8_SA(1, 0), a3, voffA);
            PG8_WAIT_V(8); PG8_WAIT_L(0); PG8_BAR; PG8_MMA(1, 0, At, B0); PG8_MMA(1, 1, At, B1); PG8_BAR; PG8_SCHED;
            } else {
            PG8_LDB(B0, 0, 0); PG8_SCHED; PG8_LDA(At, 0, 0); PG8_STAGE(PG8_SA(1, 1), a1 + hstep, voffA);
            PG8_WAIT_L(8); PG8_BAR; PG8_WAIT_L(0); PG8_MMA(0, 0, At, B0); PG8_BAR; PG8_SCHED;
            PG8_LDB(B1, 0, 1); PG8_STAGE(PG8_SB(0, 0), b2, voffB);
            PG8_BAR; PG8_WAIT_L(0); PG8_MMA(0, 1, At, B1); PG8_BAR;
            PG8_LDA(At, 0, 1); PG8_STAGE(PG8_SA(0, 0), a2, voffA);
            PG8_BAR; PG8_WAIT_L(0); PG8_MMA(1, 0, At, B0); PG8_BAR; PG8_SCHED;
            PG8_STAGE(PG8_SB(0, 1), b2 + hstep, voffB);
            PG8_WAIT_V(6); PG8_BAR; PG8_MMA(1, 1, At, B1); PG8_BAR;
            PG8_LDB(B0, 1, 0); PG8_SCHED; PG8_LDA(At, 1, 0); PG8_STAGE(PG8_SA(0, 1), a2 + hstep, voffA);
            PG8_WAIT_L(8); PG8_BAR; PG8_WAIT_L(0); PG8_MMA(0, 0, At, B0); PG8_BAR; PG8_SCHED;
            PG8_LDB(B1, 1, 1); PG8_STAGE(PG8_SB(1, 0), b3, voffB);
            PG8_BAR; PG8_WAIT_L(0); PG8_MMA(0, 1, At, B1); PG8_BAR;
            PG8_LDA(At, 1, 1); PG8_STAGE(PG8_SA(1, 0), a3, voffA);
            PG8_BAR; PG8_WAIT_L(0); PG8_MMA(1, 0, At, B0); PG8_BAR; PG8_SCHED;
            PG8_STAGE(PG8_SB(1, 1), b3 + hstep, voffB);
            PG8_WAIT_V(6); PG8_BAR; PG8_MMA(1, 1, At, B1); PG8_BAR;
            }
        }
        if constexpr (ALIGN_EPI) { if (wr == 0) PG8_BAR; }
        E(acc, cur, wr, wc, fr, fq);
        if (!has_next) break;
#pragma unroll
        for (int a = 0; a < 2; ++a)
#pragma unroll
            for (int b = 0; b < 2; ++b)
#pragma unroll
                for (int m = 0; m < 4; ++m)
#pragma unroll
                    for (int n = 0; n < 2; ++n) acc[a][b][m][n] = (f32x4){0.f, 0.f, 0.f, 0.f};
        cur = nxt; cA = nA; cB = nB; ++ui;
        if constexpr (ALIGN_EPI) { if (wr == 1) PG8_BAR; }
    }
    PG8_WAIT_V(0);
    if constexpr (!ALIGN_EPI) { if (wr == 0) PG8_BAR; }
    PG8_BAR;
    if constexpr (Epi::HAS_POST) E.post(lds, acc, cur, wr, wc, fr, fq, tid);
#undef PG8_SA
#undef PG8_SB
#undef PG8_STAGE
#undef PG8_LDA
#undef PG8_LDB
#undef PG8_MMA
#undef PG8_WAIT_V
#undef PG8_WAIT_L
#undef PG8_BAR
#undef PG8_SCHED
}
}

constexpr size_t MiB = 1u << 20;
constexpr size_t WS_CTL = 0, CTL_ZERO_BYTES = 64 * 1024;
constexpr size_t WS_SS = 1 * MiB;
constexpr size_t WS_W = 2 * MiB, W_LAYER = 30 * MiB;
constexpr size_t WO_IN = 0, WO_M = 10 * MiB, WO_OUT = 12 * MiB, WO_FF1 = 14 * MiB, WO_FF2 = 22 * MiB;
constexpr size_t WS_XNY = 62 * MiB;
constexpr size_t WS_QKV = 94 * MiB;
constexpr size_t BREG = 20 * MiB, BREG_GATES = 12 * MiB;
constexpr size_t WS_GATES = 190 * MiB;
constexpr size_t WS_MERGED = WS_QKV;
constexpr size_t WS_H = WS_QKV;
constexpr size_t WS_END = 254 * MiB;
constexpr int CW_BAR = 1024;
constexpr int CW_PANEL = 8192;

constexpr int RING_OFF = 0, RING_BYTES = 131072;
constexpr int ATT_WSF = 131072;
constexpr int ATT_TBL = ATT_WSF + 4096;
constexpr int LDSCTL_OFF = ATT_TBL + 4096, MISC_OFF = LDSCTL_OFF + 320;
constexpr int LDS_BYTES = 147456;
static_assert(MISC_OFF + 128 <= LDS_BYTES, "LDS map");
constexpr int NWAVES = 8;

#define RLX_AGENT __ATOMIC_RELAXED, __HIP_MEMORY_SCOPE_AGENT
#define LDS_WAIT() asm volatile("s_waitcnt lgkmcnt(0)" ::: "memory")
#define VM_WAIT() asm volatile("s_waitcnt vmcnt(0)" ::: "memory")

#define XB_TMO      128
#define XB_XCNT(j)  (256  + 64 * (j))
#define XB_XSUB(j)  (1280 + 64 * (j))
#define XB_XGEN(j)  (2304 + 64 * (j))
#define XB_TOP      3328
#define XB_TOPGEN   3392
#define XCD_BAR_WORDS 3456
#define XB_SPIN_CAP (1u << 18)
__device__ __forceinline__ unsigned xb_ld(unsigned* p)              { return __hip_atomic_load(p, __ATOMIC_RELAXED, __HIP_MEMORY_SCOPE_AGENT); }
__device__ __forceinline__ unsigned xb_add(unsigned* p, unsigned v) { return __hip_atomic_fetch_add(p, v, __ATOMIC_RELAXED, __HIP_MEMORY_SCOPE_AGENT); }
__device__ __forceinline__ unsigned xb_xcc_id() { return (unsigned)__builtin_amdgcn_s_getreg((3 << 11) | 20) & 0xFu; }
#define XB_SPIN(cond, bar) do { unsigned _sp = 0; while (cond) { __builtin_amdgcn_s_sleep(1); \
    if ((++_sp & 255u) == 0u) { if (xb_ld(&(bar)[XB_TMO])) break; if (_sp > XB_SPIN_CAP) { atomicAdd(&(bar)[XB_TMO], 1u); break; } } } } while (0)
struct XcdBarrier { unsigned* bar; unsigned x; volatile LAS unsigned* st; int wave; };
__device__ __forceinline__ bool xb_leader(int wave) { return wave == 0 && lane_id_now() == 0u; }
__device__ __forceinline__ XcdBarrier xcd_barrier_post(unsigned* bar, volatile LAS unsigned* st, int wave) {
    XcdBarrier b; b.bar = bar; b.x = xb_xcc_id(); b.st = st; b.wave = wave;
    if (xb_leader(wave)) st[2] = xb_add(&bar[XB_XCNT(b.x)], 1u);
    return b;
}
__device__ __forceinline__ void xcd_barrier_complete(unsigned* bar, unsigned x, unsigned& nloc, unsigned& nx, unsigned& xi) {
    const unsigned G = gridDim.x * gridDim.y * gridDim.z;
    unsigned sum, cnt, mine, below, sp = 0u;
    for (;;) {
        sum = 0u; cnt = 0u; mine = 0u; below = 0u;
#pragma unroll
        for (unsigned j = 0; j < 16; ++j) { const unsigned c = xb_ld(&bar[XB_XCNT(j)]); sum += c; cnt += (c > 0u) ? 1u : 0u; mine = (j == x) ? c : mine; below += (c > 0u && j < x) ? 1u : 0u; }
        if (sum == G) break;
        __builtin_amdgcn_s_sleep(1);
        if ((++sp & 255u) == 0u) { if (xb_ld(&bar[XB_TMO])) break; if (sp > XB_SPIN_CAP) { atomicAdd(&bar[XB_TMO], 1u); break; } }
    }
    nloc = mine > 0u ? mine : 1u; nx = cnt > 0u ? cnt : 1u; xi = below;
}
__device__ __forceinline__ void xcd_barrier(const XcdBarrier& b) {
    asm volatile("s_waitcnt vmcnt(0)" ::: "memory");
    __syncthreads();
    if (xb_leader(b.wave)) {
        unsigned* bar = b.bar;
        __builtin_amdgcn_s_waitcnt(0);
        unsigned nloc = b.st[0], nx = b.st[1];
        if (nloc == 0u) { unsigned xi; xcd_barrier_complete(bar, b.x, nloc, nx, xi); b.st[0] = nloc; b.st[1] = nx; b.st[3] = xi; }
        const unsigned old = xb_add(&bar[XB_XSUB(b.x)], 1u);
        const unsigned gen = old / nloc;
        if (old + 1u == (gen + 1u) * nloc) {
            __builtin_amdgcn_fence(__ATOMIC_RELEASE, "agent");
            asm volatile("s_waitcnt vmcnt(0)" ::: "memory");
            const unsigned og = xb_add(&bar[XB_TOP], 1u);
            const unsigned tg = og / nx;
            if (og + 1u == (tg + 1u) * nx) xb_add(&bar[XB_TOPGEN], 1u);
            else XB_SPIN(xb_ld(&bar[XB_TOPGEN]) == tg, bar);
            __builtin_amdgcn_fence(__ATOMIC_ACQUIRE, "agent");
            xb_add(&bar[XB_XGEN(b.x)], 1u);
            asm volatile("s_waitcnt vmcnt(0)" ::: "memory");
        } else {
            XB_SPIN(xb_ld(&bar[XB_XGEN(b.x)]) == gen, bar);
            __builtin_amdgcn_fence(__ATOMIC_ACQUIRE, "agent");
            asm volatile("s_waitcnt vmcnt(0)" ::: "memory");
        }
    }
    __syncthreads();
}

#define XL_SUB(j) (3584 + 64 * (j))
#define XL_GEN(j) (4608 + 64 * (j))
__device__ __forceinline__ void xcc_local_barrier(unsigned* bar, unsigned x, unsigned nloc, int wave, unsigned& gen) {
    asm volatile("s_waitcnt vmcnt(0)" ::: "memory");
    __syncthreads();
    if (xb_leader(wave)) {
        __builtin_amdgcn_s_waitcnt(0);
        const unsigned old = xb_add(&bar[XL_SUB(x)], 1u);
        if (old + 1u == (gen + 1u) * nloc) xb_add(&bar[XL_GEN(x)], 1u);
        else XB_SPIN(xb_ld(&bar[XL_GEN(x)]) == gen, bar);
        __builtin_amdgcn_fence(__ATOMIC_ACQUIRE, "agent");
        asm volatile("s_waitcnt vmcnt(0)" ::: "memory");
    }
    ++gen;
    __syncthreads();
}

struct Frame {
    LAS unsigned char* lds;
    int vcu, G, wave;
    float* out; unsigned char* ws;
};
__device__ __forceinline__ int phase_tid(int wave) { return wave * 64 + (int)lane_id_now(); }
#define PHASE_IDS() const int tid_ = phase_tid(F.wave); const int tid = tid_, lane = tid & 63, wave = __builtin_amdgcn_readfirstlane(tid >> 6); (void)tid; (void)lane; (void)wave
__device__ __forceinline__ const float* arg_in(int k) { asm volatile("" : "+s"(k)); return ((const float* const __attribute__((address_space(4)))*)__builtin_amdgcn_kernarg_segment_ptr())[k]; }

__device__ __forceinline__ float wave_sum(float v) {
#pragma unroll
    for (int o = 1; o < 64; o <<= 1) v += __shfl_xor(v, o);
    return v;
}
__device__ __forceinline__ void p0_transpose_item(const float* W, int N, bf16_t* WT, int ldk, int koff, LAS float* scr, int item, int lane, const float* gk = nullptr, bool gate_remap = false) {
    const int nblk = N / 32, kb = item / nblk, nb = item % nblk, k0 = 64 * kb, n0 = 32 * nb;
    int nd = n0;
    if (gate_remap && n0 >= NQKV) { const int gcol = n0 - NQKV, isd = gcol >= D, c = isd ? gcol - D : gcol; nd = NQKV + (c >> 7) * 256 + isd * 128 + (c & 127); }
    const float* src = W + (size_t)(k0 + (lane >> 3)) * N + n0 + (lane & 7) * 4;
    f32x4 v[8];
#pragma unroll
    for (int i = 0; i < 8; ++i) v[i] = *(const f32x4*)(src + (size_t)(8 * i) * N);
    if (gk) {
#pragma unroll
        for (int i = 0; i < 8; ++i) v[i] = v[i] * gk[k0 + 8 * i + (lane >> 3)]; }
#pragma unroll
    for (int i = 0; i < 8; ++i) { LAS float* d = scr + (8 * i + (lane >> 3)) * 33 + (lane & 7) * 4; d[0] = v[i][0]; d[1] = v[i][1]; d[2] = v[i][2]; d[3] = v[i][3]; }
    LDS_WAIT(); asm volatile("" ::: "memory");
    const int c = lane & 7;
#pragma unroll
    for (int j = 0; j < 4; ++j) { const int n = (lane >> 3) + 8 * j; const LAS float* s = scr + (8 * c) * 33 + n;
        u32x4 o; o.x = cvtpk(s[0 * 33], s[1 * 33]); o.y = cvtpk(s[2 * 33], s[3 * 33]); o.z = cvtpk(s[4 * 33], s[5 * 33]); o.w = cvtpk(s[6 * 33], s[7 * 33]);
        *(u32x4*)(WT + (size_t)(nd + n) * ldk + koff + k0 + 8 * c) = o; }
    LDS_WAIT(); asm volatile("" ::: "memory");
}
__device__ __forceinline__ void p0_prologue(Frame& F) {
    PHASE_IDS();
    LAS float* scr = (LAS float*)(F.lds + RING_OFF + wave * 16384);
    const int gw = F.vcu * NWAVES + wave, NGW = F.G * NWAVES;
    constexpr int I_IN = (D / 64) * (NIN / 32), I_B = (512 / 64) * (D / 32), I_O = (D / 64) * (D / 32), I_1 = (D / 64) * (FF / 32), I_2 = (FF / 64) * (D / 32);
    constexpr int NL = I_IN + 2 * I_B + I_O + I_1 + I_2, NITEMS = DEPTH * NL;
    for (int it = gw; it < NITEMS; it += NGW) {
        const int L = it / NL; int r = it % NL;
        unsigned char* wb = F.ws + WS_W + (size_t)L * W_LAYER;
        if (r < I_IN) { p0_transpose_item(arg_in(4) + (size_t)L * D * NIN, NIN, (bf16_t*)(wb + WO_IN), D, 0, scr, r, lane, arg_in(3) + L * D, true); continue; } r -= I_IN;
        if (r < I_B) { p0_transpose_item(arg_in(8) + (size_t)L * 512 * D, D, (bf16_t*)(wb + WO_M), D, 0, scr, r, lane); continue; } r -= I_B;
        if (r < I_B) { p0_transpose_item(arg_in(9) + (size_t)L * 512 * D, D, (bf16_t*)(wb + WO_M), D, 512, scr, r, lane); continue; } r -= I_B;
        if (r < I_O) { p0_transpose_item(arg_in(10) + (size_t)L * D * D, D, (bf16_t*)(wb + WO_OUT), D, 0, scr, r, lane); continue; } r -= I_O;
        if (r < I_1) { p0_transpose_item(arg_in(12) + (size_t)L * D * FF, FF, (bf16_t*)(wb + WO_FF1), D, 0, scr, r, lane, arg_in(11) + L * D); continue; } r -= I_1;
        p0_transpose_item(arg_in(13) + (size_t)L * FF * D, D, (bf16_t*)(wb + WO_FF2), FF, 0, scr, r, lane);
    }
    const float* x = arg_in(0); bf16_t* XN = (bf16_t*)(F.ws + WS_XNY); float* SS = (float*)(F.ws + WS_SS);
    for (int m0 = 2 * gw; m0 < M; m0 += 2 * NGW) {
        f32x4 v[2][4];
#pragma unroll
        for (int q = 0; q < 2; ++q)
#pragma unroll
            for (int j = 0; j < 4; ++j) v[q][j] = ((const f32x4*)(x + (size_t)(m0 + q) * D) + lane)[64 * j];
#pragma unroll
        for (int q = 0; q < 2; ++q) { const int m = m0 + q; u32x2* o8 = (u32x2*)(XN + (size_t)m * D) + lane; float s = 0.f;
#pragma unroll
            for (int j = 0; j < 4; ++j) { const f32x4 vv = v[q][j]; s += (vv[0] * vv[0] + vv[1] * vv[1]) + (vv[2] * vv[2] + vv[3] * vv[3]);
                u32x2 w; w.x = cvtpk(vv[0], vv[1]); w.y = cvtpk(vv[2], vv[3]); o8[64 * j] = w; }
            s = wave_sum(s);
            if (lane < 4) SS[(size_t)m * 4 + lane] = (lane == 0) ? s : 0.f; }
    }
}
namespace att {
typedef LAS const char* lcp;
__device__ __forceinline__ int crow(int r, int hi) { return (r & 3) + 8 * (r >> 2) + 4 * hi; }
typedef short v4i16_t __attribute__((ext_vector_type(4)));
__device__ __forceinline__ s16x4 vtr(lcp p) { return __builtin_bit_cast(s16x4, __builtin_amdgcn_ds_read_tr16_b64_v4i16((LAS v4i16_t*)p)); }
#define MFMA32(a, b, c) __builtin_amdgcn_mfma_f32_32x32x16_bf16(a, b, c, 0, 0, 0)
#define ATT_WAIT_BAR(N) asm volatile("s_waitcnt vmcnt(" #N ") lgkmcnt(0)\n\ts_barrier" ::: "memory")
__device__ __forceinline__ void glds16(const void* gsrc, unsigned lds_dst) { unsigned keep;
    asm volatile("s_mov_b32 %0, m0\n\ts_mov_b32 m0, %2\n\ts_nop 0\n\tglobal_load_lds_dwordx4 %1, off\n\ts_mov_b32 m0, %0" : "=&s"(keep) : "v"(gsrc), "s"(lds_dst) : "memory"); }
#define GLDS16(gsrc, ldsdst) glds16((const void*)(gsrc), (unsigned)__builtin_amdgcn_readfirstlane((int)(unsigned)(uintptr_t)(ldsdst)))
__device__ __forceinline__ void glds16s(unsigned voff, const void* sbase, unsigned lds_dst) { unsigned keep;
    asm volatile("s_mov_b32 %0, m0\n\ts_mov_b32 m0, %2\n\ts_nop 2\n\tglobal_load_lds_dwordx4 %1, %3\n\ts_mov_b32 m0, %0" : "=&s"(keep) : "v"(voff), "s"(lds_dst), "s"(sbase) : "memory"); }
#define GLDS16S(voff, sbase, ldsdst) glds16s((voff), (const void*)(sbase), (unsigned)__builtin_amdgcn_readfirstlane((int)(unsigned)(uintptr_t)(ldsdst)))
#define ATT_BAR_IF(cond, N) do { if (cond) ATT_WAIT_BAR(N); } while (0)
#define MX3(a, b, c) __builtin_fmaxf(__builtin_fmaxf((a), (b)), (c))

__device__ __forceinline__ void kload(bf16x8 (&kf)[8], lcp kslot, const int (&koff)[4]) {
#pragma unroll
    for (int d0 = 0; d0 < 4; ++d0) { kf[2 * d0] = *(const LAS bf16x8*)(kslot + koff[d0]); kf[2 * d0 + 1] = *(const LAS bf16x8*)(kslot + koff[d0] + 4096); }
}
__device__ __forceinline__ void qk_mfma(f32x16& p0, f32x16& p1, const bf16x8 (&kf)[8], const bf16x8* qr, const f32x16& cinit) {
    p0 = MFMA32(kf[0], qr[0], cinit); p1 = MFMA32(kf[1], qr[0], cinit);
#pragma unroll
    for (int d0 = 1; d0 < 4; ++d0) { p0 = MFMA32(kf[2 * d0], qr[d0], p0); p1 = MFMA32(kf[2 * d0 + 1], qr[d0], p1); }
}
__device__ __forceinline__ float rowmax32(const f32x16& p0, const f32x16& p1) {
    float a = MX3(p0[0], p0[1], p1[0]), b = MX3(p0[2], p0[3], p1[1]); a = MX3(a, p1[2], p1[3]);
#pragma unroll
    for (int r = 4; r < 16; r += 4) { a = MX3(a, p0[r], p0[r + 1]); b = MX3(b, p0[r + 2], p0[r + 3]); a = MX3(a, p1[r], p1[r + 1]); b = MX3(b, p1[r + 2], p1[r + 3]); }
    a = __builtin_fmaxf(a, b);
    auto rr = __builtin_amdgcn_permlane32_swap(__float_as_uint(a), __float_as_uint(a), false, false);
    return __builtin_fmaxf(__uint_as_float(rr[0]), __uint_as_float(rr[1]));
}
template <int NB, int THR>
__device__ __forceinline__ bool softmax_part(f32x16& p0, f32x16& p1, f32x16 (&o)[NB], float& mhat, float& l, bool first, LAS float* wsf, int r32, int hi, u32x4 (&pw)[4]) {
    const float rm = rowmax32(p0, p1);
    bool resc = false, moved = false;
    if (first) {
        mhat += rm; moved = true;
#pragma unroll
        for (int r = 0; r < 16; ++r) { p0[r] -= rm; p1[r] -= rm; }
    } else if (__any(rm > (float)THR)) {
        const float dl = fmaxf(rm, 0.f); mhat += dl; moved = true; resc = true;
#pragma unroll
        for (int r = 0; r < 16; ++r) { p0[r] -= dl; p1[r] -= dl; }
        const float f = __builtin_amdgcn_exp2f(-dl); l *= f; if (hi == 0) wsf[r32] = f;
    }
    float s = 0.f;
#pragma unroll
    for (int r = 0; r < 16; ++r) { p0[r] = __builtin_amdgcn_exp2f(p0[r]); p1[r] = __builtin_amdgcn_exp2f(p1[r]); s += p0[r] + p1[r]; }
    l += s;
    pw[0] = (u32x4){cvtpk(p0[0], p0[1]), cvtpk(p0[2], p0[3]), cvtpk(p0[4], p0[5]), cvtpk(p0[6], p0[7])};
    pw[1] = (u32x4){cvtpk(p0[8], p0[9]), cvtpk(p0[10], p0[11]), cvtpk(p0[12], p0[13]), cvtpk(p0[14], p0[15])};
    pw[2] = (u32x4){cvtpk(p1[0], p1[1]), cvtpk(p1[2], p1[3]), cvtpk(p1[4], p1[5]), cvtpk(p1[6], p1[7])};
    pw[3] = (u32x4){cvtpk(p1[8], p1[9]), cvtpk(p1[10], p1[11]), cvtpk(p1[12], p1[13]), cvtpk(p1[14], p1[15])};
    if (resc) {
        float fr[16];
#pragma unroll
        for (int r = 0; r < 16; ++r) fr[r] = wsf[crow(r, hi)];
#pragma unroll
        for (int d = 0; d < NB; ++d)
#pragma unroll
            for (int r = 0; r < 16; ++r) o[d][r] *= fr[r];
    }
    return moved;
}
__device__ __forceinline__ void vload0(s16x4 (&lo)[4], s16x4 (&hh)[4], lcp vb) {
#pragma unroll
    for (int ks = 0; ks < 4; ++ks) { lo[ks] = vtr(vb + ks * 1024); hh[ks] = vtr(vb + ks * 1024 + 512); }
}
template <int NB>
__device__ __forceinline__ void pv_part(f32x16 (&o)[NB], lcp vb, const u32x4 (&pw)[4], const s16x4 (&lo0)[4], const s16x4 (&hh0)[4]) {
    s16x4 lo[2][4], hh[2][4];
#pragma unroll
    for (int ks = 0; ks < 4; ++ks) { lo[0][ks] = lo0[ks]; hh[0][ks] = hh0[ks]; }
#pragma unroll
    for (int d0 = 0; d0 < NB; ++d0) {
        if (d0 + 1 < NB) {
#pragma unroll
            for (int ks = 0; ks < 4; ++ks) { lo[(d0 + 1) & 1][ks] = vtr(vb + (d0 + 1) * 4096 + ks * 1024); hh[(d0 + 1) & 1][ks] = vtr(vb + (d0 + 1) * 4096 + ks * 1024 + 512); }
        }
        __builtin_amdgcn_sched_barrier(0);
#define ATT_PK(k) (bf16x8){lo[d0 & 1][k][0], lo[d0 & 1][k][1], lo[d0 & 1][k][2], lo[d0 & 1][k][3], hh[d0 & 1][k][0], hh[d0 & 1][k][1], hh[d0 & 1][k][2], hh[d0 & 1][k][3]}
        o[d0] = MFMA32(__builtin_bit_cast(bf16x8, pw[0]), ATT_PK(0), o[d0]);
        o[d0] = MFMA32(__builtin_bit_cast(bf16x8, pw[1]), ATT_PK(1), o[d0]);
        o[d0] = MFMA32(__builtin_bit_cast(bf16x8, pw[2]), ATT_PK(2), o[d0]);
        o[d0] = MFMA32(__builtin_bit_cast(bf16x8, pw[3]), ATT_PK(3), o[d0]);
#undef ATT_PK
        __builtin_amdgcn_sched_barrier(0);
    }
}
__device__ __forceinline__ void row_inv_l(float l, float (&rli)[16], LAS float* wsf, int r32, int hi) {
    auto rr = __builtin_amdgcn_permlane32_swap(__float_as_uint(l), __float_as_uint(l), false, false);
    const float lt = __uint_as_float(rr[0]) + __uint_as_float(rr[1]);
    if (hi == 0) wsf[32 + r32] = lt;
#pragma unroll
    for (int r = 0; r < 16; ++r) rli[r] = __builtin_amdgcn_rcpf(wsf[32 + crow(r, hi)]);
}
__device__ __forceinline__ int t5_bucket(int rel) {
    const int n = rel < 0 ? -rel : rel;
    const int large = 8 + (n >= 12) + (n >= 16) + (n >= 23) + (n >= 32) + (n >= 46) + (n >= 64) + (n >= 91);
    return (rel > 0 ? 16 : 0) + (n < 8 ? n : large);
}


template <int THR>
__device__ __forceinline__ void diff_unit(Frame& F, int layer, const bf16_t* qkv, bf16_t* Y, int h, int qb) {
    const int tid = phase_tid(F.wave), wid = F.wave;
    const int mp = wid >> 2, wq = wid & 3;
    const size_t tokb = 0;
    LAS unsigned char* lds = F.lds;
    LAS float* wsf = (LAS float*)(lds + ATT_WSF) + wid * 128;
    LAS float* TBL = (LAS float*)(lds + ATT_TBL);
    constexpr int NT = SEQ / 64;
    f32x16 o[4]; float l = 0.f;
    {
    const int lane = tid & 63, r32 = lane & 31, hi = lane >> 5;
    const bf16_t* kbase = qkv + tokb * NQKV + COL_KD + h * 128; const bf16_t* vbase_g = qkv + tokb * NQKV + COL_VD + h * 128;
#define DIFF_KVO(L_) ((unsigned)((8 * wid + ((L_) >> 3)) * NQKV + (((L_) & 7) ^ ((L_) >> 3)) * 8) * 2u)
#define DIFF_VVO(L_) ((unsigned)((16 * (wid & 3) + ((L_) >> 2)) * NQKV + (wid >> 2) * 32 + ((L_) & 3) * 8) * 2u)
#define DIFF_DMA_K(t) do { const int tt_ = (t) < NT ? (t) : NT - 1; const size_t go_ = (size_t)tt_ * 64 * NQKV; LAS unsigned char* rb_ = lds + ((t) & 3) * 16384 + wid * 1024; \
        int ld_ = lane; asm volatile("" : "+v"(ld_)); const unsigned kvo_ = DIFF_KVO(ld_); GLDS16S(kvo_, kbase + go_, rb_); GLDS16S(kvo_, kbase + go_ + 64, rb_ + 8192); } while (0)
#define DIFF_DMA_V(t) do { const int tt_ = (t) < NT ? (t) : NT - 1; const size_t go_ = (size_t)tt_ * 64 * NQKV; LAS unsigned char* rb_ = lds + 65536 + ((t) & 3) * 16384 + wid * 1024; \
        int ld_ = lane; asm volatile("" : "+v"(ld_)); const unsigned vvo_ = DIFF_VVO(ld_); GLDS16S(vvo_, vbase_g + go_, rb_); GLDS16S(vvo_, vbase_g + go_ + 64, rb_ + 8192); } while (0)
    DIFF_DMA_K(0); DIFF_DMA_K(1); DIFF_DMA_V(0); DIFF_DMA_K(2); DIFF_DMA_V(1);
    if (tid < 257) TBL[tid] = arg_in(1)[t5_bucket(tid - 128) * 4 + h] * LOG2E;
    bf16x8 qr[4];
    { const bf16_t* Qw = qkv + (tokb + qb * 128 + wq * 32 + r32) * NQKV + COL_QD + h * 128 + mp * 64 + hi * 8;
#pragma unroll
      for (int d0 = 0; d0 < 4; ++d0) qr[d0] = *(const bf16x8*)(Qw + d0 * 16); }
    asm volatile("" : "+v"(qr[0]), "+v"(qr[1]), "+v"(qr[2]), "+v"(qr[3]));
    const int voff = ((lane >> 4) & 1) * 32 + (lane & 3) * 8 + (4 * hi + ((lane & 15) >> 2)) * 64;
    o[0] = f32x16{}; o[1] = f32x16{}; o[2] = f32x16{}; o[3] = f32x16{};
    float mhat = 0.f;
    const int qw0 = qb * 128 + wq * 32;
    ATT_WAIT_BAR(8);
    const float tL = __uint_as_float((unsigned)__builtin_amdgcn_readfirstlane((int)__float_as_uint(TBL[0]))), tR = __uint_as_float((unsigned)__builtin_amdgcn_readfirstlane((int)__float_as_uint(TBL[256])));
    bf16x8 kf[8]; f32x16 p0, p1, cinit; u32x4 pwA[4], pwB[4]; s16x4 vlo[2][4], vhh[2][4]; bool moved = false; int zc_id;
    { const int dk0 = 0 - qw0; zc_id = (dk0 >= 122) ? 1 : 2; const float c0 = (zc_id == 1 ? tR : tL);
#pragma unroll
      for (int r = 0; r < 16; ++r) cinit[r] = c0; }
#define SBAR() __builtin_amdgcn_sched_barrier(0)
#define PIN(x) asm volatile("" : "+v"(x))
#define DIFF_SCORES(t, FIRST) do { \
        { int rk_ = r32; asm volatile("" : "+v"(rk_)); int koff[4];                       \
          _Pragma("unroll") for (int d0 = 0; d0 < 4; ++d0) koff[d0] = rk_ * 128 + (((2 * d0 + hi) ^ (rk_ & 7)) << 4); \
          kload(kf, (lcp)(lds + ((t) & 3) * 16384 + mp * 8192), koff); } \
        SBAR();                                                                     \
        qk_mfma(p0, p1, kf, qr, cinit); \
        SBAR(); \
        DIFF_DMA_K((t) + 3); DIFF_DMA_V((t) + 2); \
        const int dk_ = (t) * 64 - qw0; const int zone_ = (dk_ >= 122) ? 1 : ((dk_ <= -154) ? 2 : 0); \
        if (zone_ == 0) { int rq_ = r32; asm volatile("" : "+v"(rq_)); const int base_ = dk_ - rq_ + 128; const float zc_ = (zc_id == 1) ? tR : tL; \
            _Pragma("unroll") for (int r = 0; r < 16; ++r) { int i0 = base_ + crow(r, hi), i1 = i0 + 32; \
                i0 = i0 < 0 ? 0 : (i0 > 256 ? 256 : i0); i1 = i1 < 0 ? 0 : (i1 > 256 ? 256 : i1); \
                p0[r] += TBL[i0] - zc_; p1[r] += TBL[i1] - zc_; if ((r & 3) == 3) SBAR(); } } \
        const float rm_ = rowmax32(p0, p1); \
        bool shift_ = FIRST; float dl_ = rm_; moved = false; \
        if (!(FIRST)) { moved = __any(rm_ > (float)THR); shift_ = moved; dl_ = fmaxf(rm_, 0.f); } \
        if (shift_) { mhat += dl_; \
            _Pragma("unroll") for (int r = 0; r < 16; ++r) { float a_ = p0[r], b_ = p1[r]; asm volatile("v_sub_f32_e32 %0, %0, %2\n\tv_sub_f32_e32 %1, %1, %2" : "+v"(a_), "+v"(b_) : "v"(dl_)); p0[r] = a_; p1[r] = b_; } \
            if (!(FIRST)) { const float f_ = __builtin_amdgcn_exp2f(-dl_); l *= f_; if (hi == 0) wsf[r32] = f_; } } \
        { const int dn_ = dk_ + 64; const int zn_ = (dn_ >= 122) ? 1 : ((dn_ <= -154) ? 2 : 0); \
          if (shift_ || (zn_ != 0 && zn_ != zc_id)) { if (zn_ != 0) zc_id = zn_; const float cb_ = ((zc_id == 1) ? tR : tL) - mhat; \
              _Pragma("unroll") for (int r = 0; r < 16; ++r) cinit[r] = cb_; } } \
        SBAR(); } while (0)
#define DIFF_EXP2(g, PWN, SACC) do { \
        float x0_ = ((g) < 8 ? p0[2 * ((g) & 7)] : p1[2 * ((g) & 7)]), x1_ = ((g) < 8 ? p0[2 * ((g) & 7) + 1] : p1[2 * ((g) & 7) + 1]); \
        x0_ = __builtin_amdgcn_exp2f(x0_); x1_ = __builtin_amdgcn_exp2f(x1_); SACC += x0_; SACC += x1_; PWN[(g) >> 2][(g) & 3] = cvtpk(x0_, x1_); } while (0)
#define VFRAG(B, i) (bf16x8){vlo[B][i][0], vlo[B][i][1], vlo[B][i][2], vlo[B][i][3], vhh[B][i][0], vhh[B][i][1], vhh[B][i][2], vhh[B][i][3]}
#define DIFF_GAP(g, PWC, PWN, VB) do { \
        o[(g) >> 2] = MFMA32(__builtin_bit_cast(bf16x8, PWC[(g) & 3]), VFRAG(((g) >> 2) & 1, (g) & 3), o[(g) >> 2]); \
        if ((g) < 12) { vlo[(((g) >> 2) + 1) & 1][(g) & 3] = vtr(VB + (((g) >> 2) + 1) * 4096 + ((g) & 3) * 1024); vhh[(((g) >> 2) + 1) & 1][(g) & 3] = vtr(VB + (((g) >> 2) + 1) * 4096 + ((g) & 3) * 1024 + 512); } \
        DIFF_EXP2(g, PWN, sacc_); PIN(sacc_); PIN(PWN[(g) >> 2]); SBAR(); } while (0)
#define DIFF_STEP(t, PWC, PWN) do { \
        lcp vb_ = (lcp)(lds + 65536 + (((t) - 1) & 3) * 16384 + voff); \
        _Pragma("unroll") for (int i = 0; i < 4; ++i) { vlo[0][i] = vtr(vb_ + i * 1024); vhh[0][i] = vtr(vb_ + i * 1024 + 512); } \
        DIFF_SCORES(t, false); \
        float sacc_ = 0.f; \
        DIFF_GAP(0, PWC, PWN, vb_); DIFF_GAP(1, PWC, PWN, vb_); DIFF_GAP(2, PWC, PWN, vb_); DIFF_GAP(3, PWC, PWN, vb_); \
        DIFF_GAP(4, PWC, PWN, vb_); DIFF_GAP(5, PWC, PWN, vb_); DIFF_GAP(6, PWC, PWN, vb_); DIFF_GAP(7, PWC, PWN, vb_); \
        DIFF_GAP(8, PWC, PWN, vb_); DIFF_GAP(9, PWC, PWN, vb_); DIFF_GAP(10, PWC, PWN, vb_); DIFF_GAP(11, PWC, PWN, vb_); \
        DIFF_GAP(12, PWC, PWN, vb_); DIFF_GAP(13, PWC, PWN, vb_); DIFF_GAP(14, PWC, PWN, vb_); DIFF_GAP(15, PWC, PWN, vb_); \
        l += sacc_; \
        ATT_WAIT_BAR(8); \
        if (moved) { float fr_[16]; \
            _Pragma("unroll") for (int r = 0; r < 16; ++r) fr_[r] = wsf[crow(r, hi)]; \
            _Pragma("unroll") for (int d = 0; d < 4; ++d) _Pragma("unroll") for (int r = 0; r < 16; ++r) o[d][r] *= fr_[r]; \
} \
    } while (0)
    if (wid >= 4) __builtin_amdgcn_s_setprio(1);
    DIFF_SCORES(0, true);
    { float sacc_ = 0.f;
#pragma unroll
      for (int g = 0; g < 16; ++g) DIFF_EXP2(g, pwA, sacc_);
      l += sacc_; }
    ATT_WAIT_BAR(8);
#pragma unroll 1
    for (int t = 1; t + 1 < NT; t += 2) { DIFF_STEP(t, pwA, pwB); DIFF_STEP(t + 1, pwB, pwA); }
    DIFF_STEP(NT - 1, pwA, pwB);
    { lcp vb_ = (lcp)(lds + 65536 + ((NT - 1) & 3) * 16384 + voff); s16x4 l0[4], h0[4]; vload0(l0, h0, vb_); pv_part<4>(o, vb_, pwB, l0, h0); }
    __builtin_amdgcn_s_setprio(0);
    ATT_WAIT_BAR(0);
#undef DIFF_DMA_K
#undef DIFF_DMA_V
#undef DIFF_KVO
#undef DIFF_VVO
#undef DIFF_SCORES
#undef DIFF_EXP2
#undef DIFF_GAP
#undef DIFF_STEP
#undef VFRAG
#undef SBAR
#undef PIN
    }
    const int tid2_ = phase_tid(F.wave);
    const int lane = tid2_ & 63, r32 = lane & 31, hi = lane >> 5;
    const float* lp = arg_in(6) + layer * 256;
    const float lpa = lp[lane] * lp[64 + lane], lpb = lp[128 + lane] * lp[192 + lane];
    const float* sg = arg_in(7) + layer * 128;
    float sgv[4];
#pragma unroll
    for (int d = 0; d < 4; ++d) sgv[d] = sg[d * 32 + r32];
    float rli[16]; row_inv_l(l, rli, wsf, r32, hi);
#pragma unroll
    for (int d = 0; d < 4; ++d)
#pragma unroll
        for (int r = 0; r < 16; ++r) o[d][r] *= rli[r];
    LAS float* xch = (LAS float*)(lds) + wq * 4096;
    if (mp == 1) {
#pragma unroll
        for (int d = 0; d < 4; ++d)
#pragma unroll
            for (int r4 = 0; r4 < 4; ++r4) *(LAS f32x4*)(xch + ((d * 4 + r4) * 64 + lane) * 4) = (f32x4){o[d][4 * r4], o[d][4 * r4 + 1], o[d][4 * r4 + 2], o[d][4 * r4 + 3]};
    }
    ATT_WAIT_BAR(0);
    if (mp == 0) {
        const float s1 = wave_sum(lpa), s2 = wave_sum(lpb);
        unsigned lbits_ = (layer == 0) ? 0x3E4CCCCDu : 0x3EB60549u; asm volatile("" : "+s"(lbits_));
        const float lam_init = __uint_as_float(lbits_);
        const float lam = expf(s1) - expf(s2) + lam_init;
        float ssq[16];
#pragma unroll
        for (int r = 0; r < 16; ++r) ssq[r] = 0.f;
#pragma unroll
        for (int d = 0; d < 4; ++d)
#pragma unroll
            for (int r4 = 0; r4 < 4; ++r4) { const f32x4 x2 = *(const LAS f32x4*)(xch + ((d * 4 + r4) * 64 + lane) * 4);
#pragma unroll
                for (int e = 0; e < 4; ++e) { const int r = 4 * r4 + e; const float v = o[d][r] - lam * x2[e]; o[d][r] = v; ssq[r] += v * v; } }
#pragma unroll
        for (int r = 0; r < 16; ++r) {
            float v = ssq[r];
            v += __shfl_xor(v, 1); v += __shfl_xor(v, 2); v += __shfl_xor(v, 4); v += __shfl_xor(v, 8); v += __shfl_xor(v, 16);
            ssq[r] = (1.0f - lam_init) * __builtin_amdgcn_rsqf(v * (1.0f / 128.0f) + RMS_EPS);
        }
        LAS bf16_t* stg = (LAS bf16_t*)(lds + 65536) + wq * 4096;
#pragma unroll
        for (int d = 0; d < 4; ++d) { const float gg = sgv[d];
#pragma unroll
            for (int r = 0; r < 16; ++r) { const float v = o[d][r] * ssq[r] * gg; stg[crow(r, hi) * 128 + d * 32 + r32] = (bf16_t)(cvtpk(v, v) & 0xffffu); } }
        bf16_t* yb = Y + (tokb + qb * 128 + wq * 32 + (lane >> 4)) * D + 512 + h * 128 + (lane & 15) * 8;
#pragma unroll
        for (int i = 0; i < 8; ++i) { const u32x4 v = *(const LAS u32x4*)(stg + (i * 4 + (lane >> 4)) * 128 + (lane & 15) * 8); store16_wt(yb + (size_t)i * 4 * D, v); }
    }
    ATT_WAIT_BAR(0);
}

template <int HALF> __device__ __forceinline__ void na_vload(s16x4 (&lo)[2][3], s16x4 (&hh)[2][3], lcp vb);
template <int HALF>
__device__ __forceinline__ void na_cinit(f32x16& cF, float mhat, int vbase) {
    constexpr int FO = HALF ? 32 : 0;
#pragma unroll
    for (int r = 0; r < 16; ++r) { const int e = (r & 3) + 8 * (r >> 2) + FO; cF[r] = ((unsigned)(vbase + e) < 16u) ? -mhat : -INFINITY; }
}
template <int HALF, int THR>
__device__ __forceinline__ void na_scores(f32x16& p0, f32x16& p1, const bf16x8 (&kf)[8], const bf16x8* qr, f32x16& cF, f32x16 (&o)[2], float& mhat, float& l, bool first,
                                           const LAS float* rp, int vbase, LAS float* wsf, int r32, int hi, u32x4 (&pw)[4], lcp vb, s16x4 (&vlo)[2][3], s16x4 (&vhh)[2][3]) {
    { const f32x16 z = f32x16{};
      if (HALF) { p0 = MFMA32(kf[0], qr[0], z); p1 = MFMA32(kf[1], qr[0], cF); } else { p0 = MFMA32(kf[0], qr[0], cF); p1 = MFMA32(kf[1], qr[0], z); } }
#pragma unroll
    for (int d0 = 1; d0 < 4; ++d0) { p0 = MFMA32(kf[2 * d0], qr[d0], p0); p1 = MFMA32(kf[2 * d0 + 1], qr[d0], p1); }
    na_vload<HALF>(vlo, vhh, vb);
    __builtin_amdgcn_sched_barrier(0);
    f32x16& FB = HALF ? p1 : p0; f32x16& PB = HALF ? p0 : p1;
    constexpr int PR = HALF ? 12 : 0, FO = HALF ? 32 : 0, PO = HALF ? 0 : 32;
#pragma unroll
    for (int r = 0; r < 16; ++r) { const int e = (r & 3) + 8 * (r >> 2) + FO; FB[r] += rp[e]; }
#pragma unroll
    for (int r = PR; r < PR + 4; ++r) { const int e = (r & 3) + 8 * (r >> 2) + PO; PB[r] = ((unsigned)(vbase + e) < 16u) ? PB[r] + (rp[e] - mhat) : -INFINITY; }
    float a = MX3(FB[0], FB[1], FB[2]), c = MX3(FB[3], FB[4], FB[5]);
    a = MX3(a, FB[6], FB[7]); c = MX3(c, FB[8], FB[9]); a = MX3(a, FB[10], FB[11]); c = MX3(c, FB[12], FB[13]); a = MX3(a, FB[14], FB[15]); c = MX3(c, PB[PR], PB[PR + 1]); a = MX3(a, PB[PR + 2], PB[PR + 3]);
    a = __builtin_fmaxf(a, c);
    { auto rr = __builtin_amdgcn_permlane32_swap(__float_as_uint(a), __float_as_uint(a), false, false); a = __builtin_fmaxf(__uint_as_float(rr[0]), __uint_as_float(rr[1])); }
    const float rm = a; bool resc = false, shift = first; float dl = rm;
    if (!first) { shift = __any(rm > (float)THR); resc = shift; dl = fmaxf(rm, 0.f); }
    if (shift) { mhat += dl;
#pragma unroll
        for (int r = 0; r < 16; ++r) FB[r] -= dl;
#pragma unroll
        for (int r = PR; r < PR + 4; ++r) PB[r] -= dl;
        na_cinit<HALF>(cF, mhat, vbase);
        if (resc) { const float f = __builtin_amdgcn_exp2f(-dl); l *= f; if (hi == 0) wsf[r32] = f; } }
    float s = 0.f;
#pragma unroll
    for (int r = 0; r < 16; ++r) { FB[r] = __builtin_amdgcn_exp2f(FB[r]); s += FB[r]; }
#pragma unroll
    for (int r = PR; r < PR + 4; ++r) { PB[r] = __builtin_amdgcn_exp2f(PB[r]); s += PB[r]; }
    l += s;
    const u32x4 f0 = (u32x4){cvtpk(FB[0], FB[1]), cvtpk(FB[2], FB[3]), cvtpk(FB[4], FB[5]), cvtpk(FB[6], FB[7])};
    const u32x4 f1 = (u32x4){cvtpk(FB[8], FB[9]), cvtpk(FB[10], FB[11]), cvtpk(FB[12], FB[13]), cvtpk(FB[14], FB[15])};
    if (HALF == 0) { pw[0] = f0; pw[1] = f1; pw[2] = (u32x4){cvtpk(PB[0], PB[1]), cvtpk(PB[2], PB[3]), 0u, 0u}; }
    else { pw[2] = f0; pw[3] = f1; pw[1] = (u32x4){0u, 0u, cvtpk(PB[12], PB[13]), cvtpk(PB[14], PB[15])}; }
    if (resc) {
        float fr[16];
#pragma unroll
        for (int r = 0; r < 16; ++r) fr[r] = wsf[crow(r, hi)];
#pragma unroll
        for (int d = 0; d < 2; ++d)
#pragma unroll
            for (int r = 0; r < 16; ++r) o[d][r] *= fr[r];
    }
}
template <int HALF>
__device__ __forceinline__ void na_vload(s16x4 (&lo)[2][3], s16x4 (&hh)[2][3], lcp vb) {
    constexpr int K0 = HALF ? 1 : 0;
#pragma unroll
    for (int d0 = 0; d0 < 2; ++d0)
#pragma unroll
        for (int k = 0; k < 3; ++k) { lo[d0][k] = vtr(vb + d0 * 4096 + (K0 + k) * 1024); hh[d0][k] = vtr(vb + d0 * 4096 + (K0 + k) * 1024 + 512); }
}
template <int HALF>
__device__ __forceinline__ void na_pv(f32x16 (&o)[2], const u32x4 (&pw)[4], const s16x4 (&lo)[2][3], const s16x4 (&hh)[2][3]) {
    constexpr int K0 = HALF ? 1 : 0;
#pragma unroll
    for (int d0 = 0; d0 < 2; ++d0)
#pragma unroll
        for (int k = 0; k < 3; ++k)
            o[d0] = MFMA32(__builtin_bit_cast(bf16x8, pw[K0 + k]), ((bf16x8){lo[d0][k][0], lo[d0][k][1], lo[d0][k][2], lo[d0][k][3], hh[d0][k][0], hh[d0][k][1], hh[d0][k][2], hh[d0][k][3]}), o[d0]);
}
template <int THR>
__device__ __forceinline__ void na_unit(Frame& F, int layer, const bf16_t* qkv, bf16_t* Y, int idx) {
    const int tid = phase_tid(F.wave), lane = tid & 63, wid = F.wave, r32 = lane & 31, hi = lane >> 5;
    const int hp = (idx >> 4) & 3, rp2 = idx & 15, grp = wid >> 2;
    const int h = 2 * hp + (wid >> 2), row = 2 * rp2 + ((wid >> 1) & 1), half = wid & 1, c = 32 * half + r32;
    const size_t tokb = 0;
    LAS unsigned char* lds = F.lds;
    LAS float* wsf = (LAS float*)(lds + ATT_WSF) + wid * 128;
    LAS float* RPB = (LAS float*)(lds + ATT_TBL);
    const int rA = 2 * rp2, rB = 2 * rp2 + 1;
    const int lo = (rA - 4) < 0 ? 0 : ((rA - 4) > 24 ? 24 : (rA - 4));
    const int hr = ((rB - 4) < 0 ? 0 : ((rB - 4) > 24 ? 24 : (rB - 4))) + 7;
    const int ntile = hr - lo + 1;
    const int r0 = (row - 4) < 0 ? 0 : ((row - 4) > 24 ? 24 : (row - 4));
    const bf16_t* kbase = qkv + tokb * NQKV + COL_KA + (2 * hp) * 64; const bf16_t* vbase_g = qkv + tokb * NQKV + COL_VA + (2 * hp) * 64;
    const unsigned kvo = (unsigned)((8 * wid + (lane >> 3)) * NQKV + ((lane & 7) ^ (lane >> 3)) * 8) * 2u;
    const unsigned vvo = (unsigned)((16 * (wid & 3) + (lane >> 2)) * NQKV + (wid >> 2) * 32 + (lane & 3) * 8) * 2u;
#define NA_DMA(tt) do { const int t2_ = (tt) < ntile ? (tt) : ntile - 1; const size_t go_ = (size_t)(lo + t2_) * 64 * NQKV; LAS unsigned char* rb_ = lds + ((tt) & 3) * 32768 + wid * 1024; \
        GLDS16S(kvo, kbase + go_, rb_); GLDS16S(kvo, kbase + go_ + 64, rb_ + 8192); GLDS16S(vvo, vbase_g + go_, rb_ + 16384); GLDS16S(vvo, vbase_g + go_ + 64, rb_ + 24576); } while (0)
    NA_DMA(0); NA_DMA(1); NA_DMA(2);
    if (tid < 480) { const int dr = tid >> 5, i = tid & 31;
        RPB[tid] = (i < 31) ? arg_in(5)[((size_t)(layer * 8 + 2 * hp) * 15 + dr) * 31 + i] * LOG2E : 0.f;
        RPB[480 + tid] = (i < 31) ? arg_in(5)[((size_t)(layer * 8 + 2 * hp + 1) * 15 + dr) * 31 + i] * LOG2E : 0.f; }
    bf16x8 qr[4];
    { const bf16_t* Qw = qkv + (tokb + row * 64 + c) * NQKV + COL_QA + h * 64 + hi * 8;
#pragma unroll
      for (int d0 = 0; d0 < 4; ++d0) qr[d0] = *(const bf16x8*)(Qw + d0 * 16); }
    asm volatile("" : "+v"(qr[0]), "+v"(qr[1]), "+v"(qr[2]), "+v"(qr[3]));
    const int voff = ((lane >> 4) & 1) * 32 + (lane & 3) * 8 + (4 * hi + ((lane & 15) >> 2)) * 64 + grp * 8192;
    int koff[4];
#pragma unroll
    for (int d0 = 0; d0 < 4; ++d0) koff[d0] = r32 * 128 + (((2 * d0 + hi) ^ (r32 & 7)) << 4) + grp * 8192;
    f32x16 o[2]; o[0] = f32x16{}; o[1] = f32x16{};
    float mhat = 0.f, l = 0.f;
    u32x4 pw[4];
    ATT_WAIT_BAR(8);
    bf16x8 kf[8];
    kload(kf, (lcp)(lds), koff);
    const int c0 = (c - 8) < 0 ? 0 : ((c - 8) > 48 ? 48 : (c - 8));
    const int vbase = 4 * hi - c0;
    const int rpoff = grp * 480 + (4 * hi - c + 15);
    f32x16 cF;
    if (half == 0) na_cinit<0>(cF, 0.f, vbase); else na_cinit<1>(cF, 0.f, vbase);
#pragma unroll 1
    for (int t = 0; t < ntile; ++t) {
        const int kr = lo + t; const bool act = (kr >= r0 && kr < r0 + 8);
        lcp vb = (lcp)(lds + (t & 3) * 32768 + 16384 + voff);
        s16x4 vlo[2][3], vhh[2][3];
        if (act) {
            f32x16 p0, p1;
            int ro = rpoff; asm volatile("" : "+v"(ro));
            const LAS float* rp = RPB + (kr - row + 7) * 32 + ro;
            if (half == 0) na_scores<0, THR>(p0, p1, kf, qr, cF, o, mhat, l, kr == r0, rp, vbase, wsf, r32, hi, pw, vb, vlo, vhh);
            else           na_scores<1, THR>(p0, p1, kf, qr, cF, o, mhat, l, kr == r0, rp, vbase, wsf, r32, hi, pw, vb, vlo, vhh);
        }
        if (grp == 1) { ATT_WAIT_BAR(4); NA_DMA(t + 3); if (t + 1 < ntile) kload(kf, (lcp)(lds + ((t + 1) & 3) * 32768), koff); }
        __builtin_amdgcn_sched_barrier(0);
        if (act) { if (half == 0) na_pv<0>(o, pw, vlo, vhh); else na_pv<1>(o, pw, vlo, vhh); }
        if (grp == 0) { ATT_WAIT_BAR(4); NA_DMA(t + 3); if (t + 1 < ntile) kload(kf, (lcp)(lds + ((t + 1) & 3) * 32768), koff); }
    }
    ATT_WAIT_BAR(0);
#undef NA_DMA
    float rli[16]; row_inv_l(l, rli, wsf, r32, hi);
    LAS bf16_t* stg = (LAS bf16_t*)(lds + 65536) + wid * 2048;
#pragma unroll
    for (int d = 0; d < 2; ++d)
#pragma unroll
        for (int r = 0; r < 16; ++r) { const float v = o[d][r] * rli[r]; stg[crow(r, hi) * 64 + d * 32 + r32] = (bf16_t)(cvtpk(v, v) & 0xffffu); }
    bf16_t* yb = Y + (tokb + row * 64 + 32 * half + (lane >> 3)) * D + h * 64 + (lane & 7) * 8;
#pragma unroll
    for (int i = 0; i < 4; ++i) { const u32x4 v = *(const LAS u32x4*)(stg + (i * 8 + (lane >> 3)) * 64 + (lane & 7) * 8); store16_wt(yb + (size_t)i * 8 * D, v); }
    ATT_WAIT_BAR(0);
}
}

struct Args { const float* in[14]; float* out; unsigned char* ws; };
__global__ void __launch_bounds__(NWAVES * 64, 2) enc_fwd(Args args) {
    extern __shared__ __attribute__((aligned(16))) unsigned char lds[];
    Frame F;
    F.lds = (LAS unsigned char*)lds;
    F.wave = __builtin_amdgcn_readfirstlane((int)threadIdx.x >> 6); F.G = gridDim.x; { const int bx = blockIdx.x; F.vcu = (F.G % 8 == 0) ? (bx % 8) * (F.G / 8) + bx / 8 : bx; }
    F.out = args.out; F.ws = args.ws;
    unsigned char* ws = args.ws;
    volatile LAS unsigned* MISC = (volatile LAS unsigned*)(F.lds + MISC_OFF);
    for (int u = threadIdx.x; u < (LDS_BYTES - LDSCTL_OFF) / 4; u += NWAVES * 64) ((LAS unsigned*)(F.lds + LDSCTL_OFF))[u] = 0u;
    __syncthreads();
    XcdBarrier bar; bar.bar = (unsigned*)(ws + WS_CTL) + CW_BAR; bar.x = 0; bar.st = nullptr; bar.wave = F.wave;
    bar = xcd_barrier_post((unsigned*)(ws + WS_CTL) + CW_BAR, MISC + 8, F.wave);
    p0_prologue(F);
    xcd_barrier(bar);
    const unsigned xcc = bar.x;
    const int nloc = __builtin_amdgcn_readfirstlane((int)MISC[8]), nx = __builtin_amdgcn_readfirstlane((int)MISC[9]);
    const int rank = __builtin_amdgcn_readfirstlane((int)MISC[10]), xi = __builtin_amdgcn_readfirstlane((int)MISC[11]);
    unsigned* lbar = (unsigned*)(ws + WS_CTL) + CW_BAR;
    unsigned lgen = 0;
#define LSEAM() xcc_local_barrier(lbar, xcc, (unsigned)nloc, F.wave, lgen)
#pragma unroll 1
    for (int bb = xi; bb < BATCH; bb += nx) {
        unsigned char* breg = ws + WS_QKV + (size_t)bb * BREG;
        bf16_t* QKVb = (bf16_t*)breg; bf16_t* GATESb = (bf16_t*)(breg + BREG_GATES); bf16_t* MERGEDb = (bf16_t*)breg; bf16_t* HBb = (bf16_t*)breg;
        bf16_t* XBb = (bf16_t*)(ws + WS_XNY) + (size_t)bb * MB * D; float* SSb = (float*)(ws + WS_SS) + (size_t)bb * MB * 4;
        bf16_t* Yb = (bf16_t*)((unsigned char*)F.out + (size_t)bb * MB * D * 4);
        float* OUTb = F.out + (size_t)bb * MB * D;
#pragma unroll 1
        for (int L = 0; L < DEPTH; ++L) {
            unsigned char* wb = ws + WS_W + (size_t)L * W_LAYER;
            {
                pg8::Gemm g{XBb, (const bf16_t*)(wb + WO_IN), MB, NIN, D}; pg8::BatchOrder S{NIN / 256, nloc, rank};
                pg8::EpiProj E{QKVb, GATESb, SSb};
                pg8::gemm_phase<pg8::EpiProj, pg8::BatchOrder, true, true>(F.lds + RING_OFF, g, S, E, F.wave);
            }
            LSEAM();
            {
#pragma unroll 1
                for (int u = 2 * rank; u < 64; u += 2 * nloc) { att::diff_unit<8>(F, L, QKVb, Yb, u >> 4, u & 15); att::diff_unit<8>(F, L, QKVb, Yb, (u + 1) >> 4, (u + 1) & 15); }
#pragma unroll 1
                for (int u = 2 * rank; u < 64; u += 2 * nloc) { att::na_unit<8>(F, L, QKVb, Yb, u); att::na_unit<8>(F, L, QKVb, Yb, u + 1); }
            }
            LSEAM();
            {
                pg8::Gemm g{Yb, (const bf16_t*)(wb + WO_M), MB, D, D}; pg8::BatchOrder S{D / 256, nloc, rank};
                pg8::EpiMerge E{MERGEDb, GATESb};
                pg8::gemm_phase<pg8::EpiMerge, pg8::BatchOrder, true, true>(F.lds + RING_OFF, g, S, E, F.wave);
            }
            LSEAM();
            {
                pg8::Gemm g{MERGEDb, (const bf16_t*)(wb + WO_OUT), MB, D, D}; pg8::BatchOrder S{D / 256, nloc, rank};
                pg8::EpiResid E{XBb, SSb, {}};
                pg8::gemm_phase<pg8::EpiResid, pg8::BatchOrder, true, true>(F.lds + RING_OFF, g, S, E, F.wave);
            }
            LSEAM();
            {
                pg8::Gemm g{XBb, (const bf16_t*)(wb + WO_FF1), MB, FF, D}; pg8::BatchOrder S{FF / 256, nloc, rank};
                pg8::EpiFF1 E{HBb, SSb};
                pg8::gemm_phase<pg8::EpiFF1, pg8::BatchOrder, true, true>(F.lds + RING_OFF, g, S, E, F.wave);
            }
            LSEAM();
            {
                pg8::Gemm g{HBb, (const bf16_t*)(wb + WO_FF2), MB, D, FF}; pg8::BatchOrder S{D / 256, nloc, rank};
                if (L + 1 < DEPTH) { pg8::EpiResid E{XBb, SSb, {}};
                    pg8::gemm_phase<pg8::EpiResid, pg8::BatchOrder, true, true>(F.lds + RING_OFF, g, S, E, F.wave); }
                else { pg8::EpiFinal E{XBb, SSb, arg_in(2), OUTb, (unsigned*)(ws + WS_CTL) + CW_PANEL + bb * 8 * 64, {}};
                    pg8::gemm_phase<pg8::EpiFinal, pg8::BatchOrder, true, true>(F.lds + RING_OFF, g, S, E, F.wave); }
            }
            if (L + 1 < DEPTH) LSEAM();
        }
        if (bb + nx < BATCH) LSEAM();
    }
#undef LSEAM
}

extern "C" void kernel_launch(void* const* d_in, const int* in_sizes, int n_in, void* d_out, int out_size, void* d_ws, size_t ws_size, hipStream_t stream) {
    static int grid = 0;
    if (grid == 0) {
        if (n_in != 14 || in_sizes[0] != M * D || out_size != M * D || ws_size < WS_END) { fprintf(stderr, "kernel_launch: unexpected shapes (n_in %d, in0 %d, out %d, ws %zu); nothing launched\n", n_in, n_in > 0 ? in_sizes[0] : -1, out_size, ws_size); grid = -1; return; }
        int dev = 0, cus = 0;
        if (hipGetDevice(&dev) != hipSuccess || hipDeviceGetAttribute(&cus, hipDeviceAttributeMultiprocessorCount, dev) != hipSuccess) { grid = -1; return; }
        if (hipFuncSetAttribute((const void*)enc_fwd, hipFuncAttributeMaxDynamicSharedMemorySize, LDS_BYTES) != hipSuccess) { fprintf(stderr, "kernel_launch: hipFuncSetAttribute failed\n"); grid = -1; return; }
        int per_cu = 0;
        if (hipOccupancyMaxActiveBlocksPerMultiprocessor(&per_cu, (const void*)enc_fwd, NWAVES * 64, LDS_BYTES) != hipSuccess || per_cu < 1) fprintf(stderr, "kernel_launch: occupancy query reports %d per CU\n", per_cu);
        (void)hipGetLastError();
        grid = cus;
    }
    if (grid < 0) return;
    Args a{};
    for (int i = 0; i < 14; ++i) a.in[i] = (const float*)d_in[i];
    a.out = (float*)d_out; a.ws = (unsigned char*)d_ws;
    if (hipMemsetAsync((char*)d_ws + WS_CTL, 0, CTL_ZERO_BYTES, stream) != hipSuccess) { fprintf(stderr, "kernel_launch: memset failed\n"); return; }
    hipLaunchKernelGGL(enc_fwd, dim3(grid), dim3(NWAVES * 64), LDS_BYTES, stream, a);
}
```

```cpp
#include <hip/hip_runtime.h>
#include <cstdio>
#include <cstdint>

#define LAS __attribute__((address_space(3)))
#define GAS __attribute__((address_space(1)))
typedef unsigned short bf16_t;
typedef short bf16x8 __attribute__((ext_vector_type(8)));
typedef short s16x4 __attribute__((ext_vector_type(4)));
typedef float f32x4 __attribute__((ext_vector_type(4)));
typedef float f32x2 __attribute__((ext_vector_type(2)));
typedef float f32x16 __attribute__((ext_vector_type(16)));
typedef unsigned u32x4 __attribute__((ext_vector_type(4)));
typedef unsigned u32x2 __attribute__((ext_vector_type(2)));
typedef __bf16 bf16x2_t __attribute__((ext_vector_type(2)));

constexpr int BATCH = 8, SEQ = 2048, D = 1024, M = BATCH * SEQ, DEPTH = 2, FF = 4096;
constexpr int NQKV = 3072, NGATE = 2048, NIN = 5120;
constexpr int MB = SEQ;
constexpr float RMS_EPS = 1e-6f;
constexpr float LOG2E = 1.4426950408889634f;
constexpr float C2 = 0.125f * LOG2E;
constexpr int COL_QA = 0, COL_KA = 512, COL_VA = 1024, COL_QD = 1536, COL_KD = 2048, COL_VD = 2560;

__device__ __forceinline__ unsigned cvtpk(float lo, float hi) { f32x2 v = {lo, hi}; bf16x2_t b = __builtin_convertvector(v, bf16x2_t); return __builtin_bit_cast(unsigned, b); }
__device__ __forceinline__ float bf2f(unsigned short u) { return __uint_as_float((unsigned)u << 16); }
__device__ __forceinline__ float bflo(unsigned w) { return __uint_as_float(w << 16); }
__device__ __forceinline__ float bfhi(unsigned w) { return __uint_as_float(w & 0xffff0000u); }

__device__ __forceinline__ unsigned lane_id_now() { unsigned l; asm volatile("v_mbcnt_lo_u32_b32 %0, -1, 0\n\tv_mbcnt_hi_u32_b32 %0, -1, %0" : "=v"(l)); return l; }
__device__ __forceinline__ void store16_wt(void* p, u32x4 v) { asm volatile("global_store_dwordx4 %0, %1, off sc1\n\ts_nop 1" :: "v"(p), "v"(v) : "memory"); }
namespace pg8 {
constexpr int BM = 256, BK = 64, HALF = 128, HTB = HALF * BK * 2, STAGE_BYTES = 8 * HTB, NXCD = 8, WGM = 8;
__host__ __device__ __forceinline__ int lds_byte(int r, int c) { const int st = (r >> 4) * 2 + (c >> 5), rr = r & 15, cc = c & 31, ob = rr * 64 + cc * 2; return st * 1024 + (ob ^ (((ob >> 9) & 1) << 5)); }
__host__ __device__ __forceinline__ void stage_rc(int b, int& R, int& C) { const int st = b / 1024, sb = b % 1024, swz = sb ^ (((sb >> 9) & 1) << 5); R = (st >> 1) * 16 + swz / 64; C = (st & 1) * 32 + (swz % 64) / 2; }
__host__ __device__ __forceinline__ int perm32(int rho) { const int n = rho >> 4, i = rho & 15; return 8 * (i >> 2) + 4 * n + (i & 3); }

struct Unit { int pm, pn; };
struct Gemm { const bf16_t* A; const bf16_t* Bt; int M, N, K; };

struct BatchOrder {
    int nN, nloc, rank;
    __device__ bool next(int i, Unit& u) const { const int L = i * nloc + rank; if (L >= 8 * nN) return false; u.pm = L & 7; u.pn = L >> 3; return true; }
};

__device__ __forceinline__ float row_rstd(const float* ss, int row) {
    const f32x4 a = *(const f32x4*)(ss + (size_t)row * 4);
    const float s = (a[0] + a[1]) + (a[2] + a[3]);
    return 1.0f / sqrtf(s * (1.0f / (float)D) + RMS_EPS);
}

struct EpiProj {
    static constexpr bool HAS_POST = false;
    static constexpr bool PERM = true, HAS_MID = false;
    bf16_t* qkv; bf16_t* gates; const float* ss;
    __device__ __forceinline__ void mid(f32x4 (&acc)[2][2][4][2], const Unit& u, int wr, int wc, int fr, int fq) const {}
    __device__ __forceinline__ void operator()(f32x4 (&acc)[2][2][4][2], const Unit& u, int wr, int wc, int fr, int fq) const {
        const int row0 = u.pm * BM + wr * 64 + fr;
        float rs[2][4];
#pragma unroll
        for (int ai = 0; ai < 2; ++ai)
#pragma unroll
            for (int m = 0; m < 4; ++m) rs[ai][m] = row_rstd(ss, row0 + ai * HALF + m * 16);
        if (u.pn < 12) {
            const float sc = (u.pn < 2 || u.pn == 6 || u.pn == 7) ? C2 : 1.0f;
            const int col0 = u.pn * BM + wc * 32 + 8 * fq;
#pragma unroll
            for (int ai = 0; ai < 2; ++ai)
#pragma unroll
                for (int m = 0; m < 4; ++m) { const int row = row0 + ai * HALF + m * 16; const float r = rs[ai][m] * sc; bf16_t* rowp = qkv + (size_t)row * NQKV + col0;
#pragma unroll
                    for (int bj = 0; bj < 2; ++bj) { const f32x4 v0 = acc[ai][bj][m][0] * r, v1 = acc[ai][bj][m][1] * r;
                        u32x4 w; w.x = cvtpk(v0[0], v0[1]); w.y = cvtpk(v0[2], v0[3]); w.z = cvtpk(v1[0], v1[1]); w.w = cvtpk(v1[2], v1[3]);
                        store16_wt(rowp + bj * HALF, w); } }
        } else {
            const int col0 = (u.pn - 12) * HALF + wc * 32 + 8 * fq;
#pragma unroll
            for (int ai = 0; ai < 2; ++ai)
#pragma unroll
                for (int m = 0; m < 4; ++m) { const int row = row0 + ai * HALF + m * 16; const float r = rs[ai][m]; float rho[8], sg[8];
#pragma unroll
                    for (int n = 0; n < 2; ++n)
#pragma unroll
                        for (int e = 0; e < 4; ++e) { const float ga = acc[ai][0][m][n][e] * r, gd = fmaxf(acc[ai][1][m][n][e] * r, -80.f);
                            const float ed = 1.f + __expf(-gd), ea = 1.f + __expf(-ga); rho[4 * n + e] = ed * __builtin_amdgcn_rcpf(ea); sg[4 * n + e] = __builtin_amdgcn_rcpf(ed); }
                    u32x4 w; w.x = cvtpk(rho[0], rho[1]); w.y = cvtpk(rho[2], rho[3]); w.z = cvtpk(rho[4], rho[5]); w.w = cvtpk(rho[6], rho[7]);
                    store16_wt(gates + (size_t)row * D + col0, w);
                    w.x = cvtpk(sg[0], sg[1]); w.y = cvtpk(sg[2], sg[3]); w.z = cvtpk(sg[4], sg[5]); w.w = cvtpk(sg[6], sg[7]);
                    store16_wt(gates + (size_t)MB * D + (size_t)row * D + col0, w); }
        }
    }
};
struct EpiFF1 {
    static constexpr bool HAS_POST = false;
    static constexpr bool PERM = true, HAS_MID = false;
    bf16_t* H; const float* ss;
    __device__ __forceinline__ void mid(f32x4 (&acc)[2][2][4][2], const Unit& u, int wr, int wc, int fr, int fq) const {}
    __device__ __forceinline__ void operator()(f32x4 (&acc)[2][2][4][2], const Unit& u, int wr, int wc, int fr, int fq) const {
        const int row0 = u.pm * BM + wr * 64 + fr, col0 = u.pn * BM + wc * 32 + 8 * fq;
        float rs[2][4];
#pragma unroll
        for (int ai = 0; ai < 2; ++ai)
#pragma unroll
            for (int m = 0; m < 4; ++m) rs[ai][m] = row_rstd(ss, row0 + ai * HALF + m * 16);
#pragma unroll
        for (int ai = 0; ai < 2; ++ai)
#pragma unroll
            for (int m = 0; m < 4; ++m) { const int row = row0 + ai * HALF + m * 16; const float r = rs[ai][m]; bf16_t* rowp = H + (size_t)row * FF + col0;
#pragma unroll
                for (int bj = 0; bj < 2; ++bj) { f32x4 v0 = acc[ai][bj][m][0] * r, v1 = acc[ai][bj][m][1] * r;
#pragma unroll
                    for (int e = 0; e < 4; ++e) { const float a = fmaxf(v0[e], 0.f), b = fmaxf(v1[e], 0.f); v0[e] = a * a; v1[e] = b * b; }
                    u32x4 w; w.x = cvtpk(v0[0], v0[1]); w.y = cvtpk(v0[2], v0[3]); w.z = cvtpk(v1[0], v1[1]); w.w = cvtpk(v1[2], v1[3]);
                    store16_wt(rowp + bj * HALF, w); } }
    }
};
struct EpiMerge {
    static constexpr bool HAS_POST = false;
    static constexpr bool PERM = true, HAS_MID = true;
    bf16_t* O; const bf16_t* gates;
    __device__ __forceinline__ void mid(f32x4 (&acc)[2][2][4][2], const Unit& u, int wr, int wc, int fr, int fq) const {
        const int row0 = u.pm * BM + wr * 64 + fr, col0 = u.pn * BM + wc * 32 + 8 * fq;
        const bf16_t* gp = gates + (size_t)row0 * D + col0;
#pragma unroll
        for (int ai = 0; ai < 2; ++ai) {
            asm volatile("" : "+v"(gp) :: "memory");
            u32x4 g[4][2];
#pragma unroll
            for (int q = 0; q < 4; ++q)
#pragma unroll
                for (int bj = 0; bj < 2; ++bj) g[q][bj] = *(const GAS u32x4*)(gp + q * 16 * D + bj * HALF);
#pragma unroll
            for (int q = 0; q < 4; ++q)
#pragma unroll
                for (int bj = 0; bj < 2; ++bj)
#pragma unroll
                    for (int w = 0; w < 4; ++w) { acc[ai][bj][q][w >> 1][(w & 1) * 2] *= bflo(g[q][bj][w]); acc[ai][bj][q][w >> 1][(w & 1) * 2 + 1] *= bfhi(g[q][bj][w]); }
            gp += HALF * D; }
    }
    __device__ __forceinline__ void operator()(f32x4 (&acc)[2][2][4][2], const Unit& u, int wr, int wc, int fr, int fq) const {
        const int row0 = u.pm * BM + wr * 64 + fr, col0 = u.pn * BM + wc * 32 + 8 * fq;
        const bf16_t* gp = gates + (size_t)MB * D + (size_t)row0 * D + col0; bf16_t* rowp = O + (size_t)row0 * D + col0;
#pragma unroll
        for (int ai = 0; ai < 2; ++ai) {
            asm volatile("" : "+v"(gp), "+v"(rowp) :: "memory");
            u32x4 g[4][2];
#pragma unroll
            for (int q = 0; q < 4; ++q)
#pragma unroll
                for (int bj = 0; bj < 2; ++bj) g[q][bj] = *(const GAS u32x4*)(gp + q * 16 * D + bj * HALF);
#pragma unroll
            for (int q = 0; q < 4; ++q)
#pragma unroll
                for (int bj = 0; bj < 2; ++bj) { float o[8];
#pragma unroll
                    for (int w = 0; w < 4; ++w) { o[2 * w] = acc[ai][bj][q][w >> 1][(w & 1) * 2] * bflo(g[q][bj][w]); o[2 * w + 1] = acc[ai][bj][q][w >> 1][(w & 1) * 2 + 1] * bfhi(g[q][bj][w]); }
                    u32x4 w4; w4.x = cvtpk(o[0], o[1]); w4.y = cvtpk(o[2], o[3]); w4.z = cvtpk(o[4], o[5]); w4.w = cvtpk(o[6], o[7]);
                    store16_wt((void*)(rowp + q * 16 * D + bj * HALF), w4); }
            gp += HALF * D; rowp += HALF * D; }
    }
};
struct EpiResid {
    static constexpr bool HAS_POST = true;
    static constexpr bool PERM = true, HAS_MID = false;
    bf16_t* xb; float* ss; float qs[2][4];
    __device__ __forceinline__ void mid(f32x4 (&acc)[2][2][4][2], const Unit& u, int wr, int wc, int fr, int fq) const {}
    __device__ __forceinline__ void operator()(f32x4 (&acc)[2][2][4][2], const Unit& u, int wr, int wc, int fr, int fq) {
        const int row0 = u.pm * BM + wr * 64 + fr, col0 = u.pn * BM + wc * 32 + 8 * fq;
#pragma unroll
        for (int ai = 0; ai < 2; ++ai)
#pragma unroll
            for (int m = 0; m < 4; ++m) { const int row = row0 + ai * HALF + m * 16; bf16_t* rowp = xb + (size_t)row * D + col0; float q = 0.f;
#pragma unroll
                for (int bj = 0; bj < 2; ++bj) { const u32x4 xv = *(const u32x4*)(rowp + bj * HALF);
                    const f32x4 y0 = (f32x4){bflo(xv.x), bfhi(xv.x), bflo(xv.y), bfhi(xv.y)} + acc[ai][bj][m][0], y1 = (f32x4){bflo(xv.z), bfhi(xv.z), bflo(xv.w), bfhi(xv.w)} + acc[ai][bj][m][1];
                    q += (y0[0] * y0[0] + y0[1] * y0[1]) + (y0[2] * y0[2] + y0[3] * y0[3]) + (y1[0] * y1[0] + y1[1] * y1[1]) + (y1[2] * y1[2] + y1[3] * y1[3]);
                    u32x4 w; w.x = cvtpk(y0[0], y0[1]); w.y = cvtpk(y0[2], y0[3]); w.z = cvtpk(y1[0], y1[1]); w.w = cvtpk(y1[2], y1[3]);
                    *(u32x4*)(rowp + bj * HALF) = w; }
                q += __shfl_xor(q, 16); q += __shfl_xor(q, 32);
                qs[ai][m] = q; }
    }
    __device__ __forceinline__ void post(LAS unsigned char* lds, f32x4 (&acc)[2][2][4][2], const Unit& u, int wr, int wc, int fr, int fq, int tid) {
        LAS float* P = (LAS float*)lds;
        if (fq == 0) {
#pragma unroll
            for (int ai = 0; ai < 2; ++ai)
#pragma unroll
                for (int m = 0; m < 4; ++m) P[(ai * HALF + wr * 64 + m * 16 + fr) * 4 + wc] = qs[ai][m];
        }
        asm volatile("s_waitcnt lgkmcnt(0)" ::: "memory"); __builtin_amdgcn_s_barrier(); asm volatile("" ::: "memory");
        if (tid < 256) { const f32x4 v = *(const LAS f32x4*)(P + tid * 4); ss[(size_t)(u.pm * BM + tid) * 4 + u.pn] = (v[0] + v[1]) + (v[2] + v[3]); }
    }
};

struct EpiFinal {
    static constexpr bool HAS_POST = true;
    static constexpr bool PERM = true, HAS_MID = false;
    const bf16_t* xb; float* ss; const float* g; float* out; unsigned* cnt; float qs[2][4];
    __device__ __forceinline__ void mid(f32x4 (&acc)[2][2][4][2], const Unit& u, int wr, int wc, int fr, int fq) const {}
    __device__ __forceinline__ void operator()(f32x4 (&acc)[2][2][4][2], const Unit& u, int wr, int wc, int fr, int fq) {
        const int row0 = u.pm * BM + wr * 64 + fr, col0 = u.pn * BM + wc * 32 + 8 * fq;
#pragma unroll
        for (int ai = 0; ai < 2; ++ai)
#pragma unroll
            for (int m = 0; m < 4; ++m) { const int row = row0 + ai * HALF + m * 16; const bf16_t* rowp = xb + (size_t)row * D + col0; float q = 0.f;
#pragma unroll
                for (int bj = 0; bj < 2; ++bj) { const u32x4 xv = *(const u32x4*)(rowp + bj * HALF);
                    const f32x4 y0 = (f32x4){bflo(xv.x), bfhi(xv.x), bflo(xv.y), bfhi(xv.y)} + acc[ai][bj][m][0], y1 = (f32x4){bflo(xv.z), bfhi(xv.z), bflo(xv.w), bfhi(xv.w)} + acc[ai][bj][m][1];
                    q += (y0[0] * y0[0] + y0[1] * y0[1]) + (y0[2] * y0[2] + y0[3] * y0[3]) + (y1[0] * y1[0] + y1[1] * y1[1]) + (y1[2] * y1[2] + y1[3] * y1[3]);
                    acc[ai][bj][m][0] = y0; acc[ai][bj][m][1] = y1; }
                q += __shfl_xor(q, 16); q += __shfl_xor(q, 32);
                qs[ai][m] = q; }
    }
    __device__ __forceinline__ void post(LAS unsigned char* lds, f32x4 (&acc)[2][2][4][2], const Unit& u, int wr, int wc, int fr, int fq, int tid) {
        LAS float* P = (LAS float*)lds;
        LAS float* S = (LAS float*)(lds + 4096);
        LAS unsigned* flag = (LAS unsigned*)(lds + 4096 + 1024);
        if (fq == 0) {
#pragma unroll
            for (int ai = 0; ai < 2; ++ai)
#pragma unroll
                for (int m = 0; m < 4; ++m) P[(ai * HALF + wr * 64 + m * 16 + fr) * 4 + wc] = qs[ai][m];
        }
        asm volatile("s_waitcnt lgkmcnt(0)" ::: "memory"); __builtin_amdgcn_s_barrier(); asm volatile("" ::: "memory");
        unsigned* pc = cnt + 64 * u.pm;
        if (tid < 256) {
            const f32x4 v = *(const LAS f32x4*)(P + tid * 4);
            __hip_atomic_store(ss + (size_t)(u.pm * BM + tid) * 4 + u.pn, (v[0] + v[1]) + (v[2] + v[3]), __ATOMIC_RELAXED, __HIP_MEMORY_SCOPE_AGENT);
            asm volatile("s_waitcnt vmcnt(0)" ::: "memory");
            if ((tid & 63) == 0) __hip_atomic_fetch_add(pc, 1u, __ATOMIC_RELAXED, __HIP_MEMORY_SCOPE_AGENT);
        }
        if (tid < 64) {
            unsigned sp = 0;
            while ((unsigned)__builtin_amdgcn_readfirstlane(__hip_atomic_load(pc, __ATOMIC_RELAXED, __HIP_MEMORY_SCOPE_AGENT)) < 16u) { __builtin_amdgcn_s_sleep(2); if (++sp > (1u << 20)) break; }
            asm volatile("s_waitcnt vmcnt(0)" ::: "memory");
            if (tid == 0) flag[0] = 1u;
        }
        asm volatile("s_waitcnt lgkmcnt(0)" ::: "memory"); __builtin_amdgcn_s_barrier(); asm volatile("" ::: "memory");
        if (tid < 256) {
            const float* sp4 = ss + (size_t)(u.pm * BM + tid) * 4; float t = 0.f;
#pragma unroll
            for (int j = 0; j < 4; ++j) t += __hip_atomic_load(sp4 + j, __ATOMIC_RELAXED, __HIP_MEMORY_SCOPE_AGENT);
            S[tid] = 1.0f / sqrtf(t * (1.0f / (float)D) + RMS_EPS);
        }
        asm volatile("s_waitcnt vmcnt(0) lgkmcnt(0)" ::: "memory"); __builtin_amdgcn_s_barrier(); asm volatile("" ::: "memory");
        const int row0 = u.pm * BM + wr * 64 + fr, col0 = u.pn * BM + wc * 32 + 8 * fq;
        f32x4 gv[2][2];
#pragma unroll
        for (int bj = 0; bj < 2; ++bj)
#pragma unroll
            for (int n = 0; n < 2; ++n) gv[bj][n] = *(const f32x4*)(g + col0 + bj * HALF + 4 * n);
#pragma unroll
        for (int ai = 0; ai < 2; ++ai)
#pragma unroll
            for (int m = 0; m < 4; ++m) { const int rl = ai * HALF + wr * 64 + m * 16 + fr; const float r = S[rl]; float* rowp = out + (size_t)(u.pm * BM + rl) * D + col0;
#pragma unroll
                for (int bj = 0; bj < 2; ++bj) { *(f32x4*)(rowp + bj * HALF) = acc[ai][bj][m][0] * r * gv[bj][0]; *(f32x4*)(rowp + bj * HALF + 4) = acc[ai][bj][m][1] * r * gv[bj][1]; } }
    }
};

template <class Epi, class Sched, bool ALIGN_EPI, bool SP2>
__device__ __forceinline__ void gemm_phase(LAS unsigned char* lds, const Gemm g, const Sched& S, Epi& E, int wave_) {
    const int tid_ = wave_ * 64 + (int)lane_id_now();
    const int tid = tid_, wid = __builtin_amdgcn_readfirstlane(tid >> 6), lane = tid & 63, wr = wid >> 2, wc = wid & 3, fr = lane & 15, fq = lane >> 4;
    const int K = g.K, nt = K / BK;
    unsigned voffA[2], voffB[2];
#pragma unroll
    for (int i = 0; i < 2; ++i) { int R, C; stage_rc(tid * 16 + i * 8192, R, C); const int Rb = Epi::PERM ? ((R & ~31) + perm32(R & 31)) : R;
        voffA[i] = (unsigned)(R * K + C) * 2u; voffB[i] = (unsigned)(Rb * K + C) * 2u; }
    const size_t kstep = (size_t)(BK * 2);
    const size_t hstep = (size_t)HALF * K * 2;
    const size_t tstep = 2 * hstep;
    const unsigned ldsw = (unsigned)wid * 1024u;
    const int aoff = lds_byte(wr * 64 + fr, fq * 8), boff = lds_byte(wc * 32 + fr, fq * 8);
#define PG8_SA(b, h) (((b) * 2 + (h)) * HTB)
#define PG8_SB(b, h) ((4 + (b) * 2 + (h)) * HTB)
#define PG8_STAGE(bufoff, gbase, voff) do { _Pragma("unroll") for (int _i = 0; _i < 2; ++_i) \
        __builtin_amdgcn_global_load_lds((const unsigned*)((const char*)(gbase) + (voff)[_i]), (LAS unsigned*)(lds + (bufoff) + ldsw + _i * 8192), 16, 0, 0); } while (0)
#define PG8_LDA(dst, b, h) do { _Pragma("unroll") for (int m = 0; m < 4; ++m) _Pragma("unroll") for (int k = 0; k < 2; ++k) dst[m][k] = *(const LAS bf16x8*)(lds + PG8_SA(b, h) + aoff + m * 2048 + k * 1024); } while (0)
#define PG8_LDB(dst, b, h) do { _Pragma("unroll") for (int n = 0; n < 2; ++n) _Pragma("unroll") for (int k = 0; k < 2; ++k) dst[n][k] = *(const LAS bf16x8*)(lds + PG8_SB(b, h) + boff + n * 2048 + k * 1024); } while (0)
#define PG8_MMA(ai, bj, At, Bt) do { __builtin_amdgcn_s_setprio(1); _Pragma("unroll") for (int m = 0; m < 4; ++m) _Pragma("unroll") for (int n = 0; n < 2; ++n) _Pragma("unroll") for (int k = 0; k < 2; ++k) \
        acc[ai][bj][m][n] = __builtin_amdgcn_mfma_f32_16x16x32_bf16(Bt[n][k], At[m][k], acc[ai][bj][m][n], 0, 0, 0); __builtin_amdgcn_s_setprio(0); } while (0)
#define PG8_WAIT_V(n) asm volatile("s_waitcnt vmcnt(" #n ")" ::: "memory")
#define PG8_WAIT_L(n) asm volatile("s_waitcnt lgkmcnt(" #n ")" ::: "memory")
#define PG8_BAR __builtin_amdgcn_s_barrier()
#define PG8_SCHED __builtin_amdgcn_sched_barrier(0)
    Unit cur, nxt; int ui = 0;
    if (!S.next(0, cur)) return;
    f32x4 acc[2][2][4][2];
#pragma unroll
    for (int a = 0; a < 2; ++a)
#pragma unroll
        for (int b = 0; b < 2; ++b)
#pragma unroll
            for (int m = 0; m < 4; ++m)
#pragma unroll
                for (int n = 0; n < 2; ++n) acc[a][b][m][n] = (f32x4){0.f, 0.f, 0.f, 0.f};
    bf16x8 At[4][2], B0[2][2], B1[2][2];
    const char* cA = (const char*)g.A + (size_t)cur.pm * tstep; const char* cB = (const char*)g.Bt + (size_t)cur.pn * tstep;
    if constexpr (SP2) {
        PG8_STAGE(PG8_SB(0, 0), cB, voffB); PG8_STAGE(PG8_SB(0, 1), cB + hstep, voffB); PG8_STAGE(PG8_SA(0, 0), cA, voffA); PG8_STAGE(PG8_SA(0, 1), cA + hstep, voffA);
        if (wr == 1) PG8_BAR;
        PG8_WAIT_V(2); PG8_BAR;
        PG8_STAGE(PG8_SB(1, 0), cB + kstep, voffB); PG8_STAGE(PG8_SA(1, 0), cA + kstep, voffA); PG8_STAGE(PG8_SB(1, 1), cB + hstep + kstep, voffB);
        PG8_WAIT_V(6); PG8_BAR;
    } else {
        PG8_STAGE(PG8_SB(0, 0), cB, voffB); PG8_STAGE(PG8_SA(0, 0), cA, voffA); PG8_STAGE(PG8_SB(0, 1), cB + hstep, voffB); PG8_STAGE(PG8_SA(0, 1), cA + hstep, voffA);
        if (wr == 1) PG8_BAR;
        PG8_WAIT_V(4); PG8_BAR;
        PG8_STAGE(PG8_SB(1, 0), cB + kstep, voffB); PG8_STAGE(PG8_SA(1, 0), cA + kstep, voffA); PG8_STAGE(PG8_SB(1, 1), cB + hstep + kstep, voffB);
        PG8_WAIT_V(6); PG8_BAR;
    }
    for (;;) {
        const bool has_next = S.next(ui + 1, nxt);
        const char* nA = has_next ? (const char*)g.A + (size_t)nxt.pm * tstep : cA; const char* nB = has_next ? (const char*)g.Bt + (size_t)nxt.pn * tstep : cB;
        for (int t = 0; t < nt; t += 2) {
            if constexpr (Epi::HAS_MID) { if (t == nt / 2) E.mid(acc, cur, wr, wc, fr, fq); }
            const bool last = (t == nt - 2);
            const char* a1 = cA + (size_t)(t + 1) * kstep;
            const char* a2 = last ? nA : cA + (size_t)(t + 2) * kstep; const char* b2 = last ? nB : cB + (size_t)(t + 2) * kstep;
            const char* a3 = a2 + kstep; const char* b3 = b2 + kstep;
            if constexpr (SP2) {
            PG8_LDB(B0, 0, 0); PG8_LDB(B1, 0, 1); PG8_SCHED; PG8_LDA(At, 0, 0); PG8_STAGE(PG8_SA(1, 1), a1 + hstep, voffA);
            PG8_WAIT_V(8); PG8_WAIT_L(0); PG8_BAR; PG8_MMA(0, 0, At, B0); PG8_MMA(0, 1, At, B1); PG8_BAR; PG8_SCHED;
            PG8_LDA(At, 0, 1); PG8_STAGE(PG8_SB(0, 0), b2, voffB); PG8_STAGE(PG8_SB(0, 1), b2 + hstep, voffB); PG8_STAGE(PG8_SA(0, 0), a2, voffA);
            PG8_WAIT_V(8); PG8_WAIT_L(0); PG8_BAR; PG8_MMA(1, 0, At, B0); PG8_MMA(1, 1, At, B1); PG8_BAR; PG8_SCHED;
            PG8_LDB(B0, 1, 0); PG8_LDB(B1, 1, 1); PG8_SCHED; PG8_LDA(At, 1, 0); PG8_STAGE(PG8_SA(0, 1), a2 + hstep, voffA);
            PG8_WAIT_V(8); PG8_WAIT_L(0); PG8_BAR; PG8_MMA(0, 0, At, B0); PG8_MMA(0, 1, At, B1); PG8_BAR; PG8_SCHED;
            PG8_LDA(At, 1, 1); PG8_STAGE(PG8_SB(1, 0), b3, voffB); PG8_STAGE(PG8_SB(1, 1), b3 + hstep, voffB); PG8_STAGE(PG8_SA(1, 0), a3, voffA);
            PG8_WAIT_V(8); PG8_WAIT_L(0); PG8_BAR; PG8_MMA(1, 0, At, B0); PG8_MMA(1, 1, At, B1); PG8_BAR; PG8_SCHED;
            } else {
            PG8_LDB(B0, 0, 0); PG8_SCHED; PG8_LDA(At, 0, 0); PG8_STAGE(PG8_SA(1, 1), a1 + hstep, voffA);
            PG8_WAIT_L(8); PG8_BAR; PG8_WAIT_L(0); PG8_MMA(0, 0, At, B0); PG8_BAR; PG8_SCHED;
            PG8_LDB(B1, 0, 1); PG8_STAGE(PG8_SB(0, 0), b2, voffB);
            PG8_BAR; PG8_WAIT_L(0); PG8_MMA(0, 1, At, B1); PG8_BAR;
            PG8_LDA(At, 0, 1); PG8_STAGE(PG8_SA(0, 0), a2, voffA);
            PG8_BAR; PG8_WAIT_L(0); PG8_MMA(1, 0, At, B0); PG8_BAR; PG8_SCHED;
            PG8_STAGE(PG8_SB(0, 1), b2 + hstep, voffB);
            PG8_WAIT_V(6); PG8_BAR; PG8_MMA(1, 1, At, B1); PG8_BAR;
            PG8_LDB(B0, 1, 0); PG8_SCHED; PG8_LDA(At, 1, 0); PG8_STAGE(PG8_SA(0, 1), a2 + hstep, voffA);
            PG8_WAIT_L(8); PG8_BAR; PG8_WAIT_L(0); PG8_MMA(0, 0, At, B0); PG8_BAR; PG8_SCHED;
            PG8_LDB(B1, 1, 1); PG8_STAGE(PG8_SB(1, 0), b3, voffB);
            PG8_BAR; PG8_WAIT_L(0); PG8_MMA(0, 1, At, B1); PG8_BAR;
            PG8_LDA(At, 1, 1); PG8_STAGE(PG8_SA(1, 0), a3, voffA);
            PG8_BAR; PG8_WAIT_L(0); PG8_MMA(1, 0, At, B0); PG8_BAR; PG8_SCHED;
            PG8_STAGE(PG8_SB(1, 1), b3 + hstep, voffB);
            PG8_WAIT_V(6); PG8_BAR; PG8_MMA(1, 1, At, B1); PG8_BAR;
            }
        }
        if constexpr (ALIGN_EPI) { if (wr == 0) PG8_BAR; }
        E(acc, cur, wr, wc, fr, fq);
        if (!has_next) break;
#pragma unroll
        for (int a = 0; a < 2; ++a)
#pragma unroll
            for (int b = 0; b < 2; ++b)
#pragma unroll
                for (int m = 0; m < 4; ++m)
#pragma unroll
                    for (int n = 0; n < 2; ++n) acc[a][b][m][n] = (f32x4){0.f, 0.f, 0.f, 0.f};
        cur = nxt; cA = nA; cB = nB; ++ui;
        if constexpr (ALIGN_EPI) { if (wr == 1) PG8_BAR; }
    }
    PG8_WAIT_V(0);
    if constexpr (!ALIGN_EPI) { if (wr == 0) PG8_BAR; }
    PG8_BAR;
    if constexpr (Epi::HAS_POST) E.post(lds, acc, cur, wr, wc, fr, fq, tid);
#undef PG8_SA
#undef PG8_SB
#undef PG8_STAGE
#undef PG8_LDA
#undef PG8_LDB
#undef PG8_MMA
#undef PG8_WAIT_V
#undef PG8_WAIT_L
#undef PG8_BAR
#undef PG8_SCHED
}
}

constexpr size_t MiB = 1u << 20;
constexpr size_t WS_CTL = 0, CTL_ZERO_BYTES = 64 * 1024;
constexpr size_t WS_SS = 1 * MiB;
constexpr size_t WS_W = 2 * MiB, W_LAYER = 30 * MiB;
constexpr size_t WO_IN = 0, WO_M = 10 * MiB, WO_OUT = 12 * MiB, WO_FF1 = 14 * MiB, WO_FF2 = 22 * MiB;
constexpr size_t WS_XNY = 62 * MiB;
constexpr size_t WS_QKV = 94 * MiB;
constexpr size_t BREG = 20 * MiB, BREG_GATES = 12 * MiB;
constexpr size_t WS_GATES = 190 * MiB;
constexpr size_t WS_MERGED = WS_QKV;
constexpr size_t WS_H = WS_QKV;
constexpr size_t WS_END = 254 * MiB;
constexpr int CW_BAR = 1024;
constexpr int CW_PANEL = 8192;

constexpr int RING_OFF = 0, RING_BYTES = 131072;
constexpr int ATT_WSF = 131072;
constexpr int ATT_TBL = ATT_WSF + 4096;
constexpr int LDSCTL_OFF = ATT_TBL + 4096, MISC_OFF = LDSCTL_OFF + 320;
constexpr int LDS_BYTES = 147456;
static_assert(MISC_OFF + 128 <= LDS_BYTES, "LDS map");
constexpr int NWAVES = 8;

#define RLX_AGENT __ATOMIC_RELAXED, __HIP_MEMORY_SCOPE_AGENT
#define LDS_WAIT() asm volatile("s_waitcnt lgkmcnt(0)" ::: "memory")
#define VM_WAIT() asm volatile("s_waitcnt vmcnt(0)" ::: "memory")

#define XB_TMO      128
#define XB_XCNT(j)  (256  + 64 * (j))
#define XB_XSUB(j)  (1280 + 64 * (j))
#define XB_XGEN(j)  (2304 + 64 * (j))
#define XB_TOP      3328
#define XB_TOPGEN   3392
#define XCD_BAR_WORDS 3456
#define XB_SPIN_CAP (1u << 18)
__device__ __forceinline__ unsigned xb_ld(unsigned* p)              { return __hip_atomic_load(p, __ATOMIC_RELAXED, __HIP_MEMORY_SCOPE_AGENT); }
__device__ __forceinline__ unsigned xb_add(unsigned* p, unsigned v) { return __hip_atomic_fetch_add(p, v, __ATOMIC_RELAXED, __HIP_MEMORY_SCOPE_AGENT); }
__device__ __forceinline__ unsigned xb_xcc_id() { return (unsigned)__builtin_amdgcn_s_getreg((3 << 11) | 20) & 0xFu; }
#define XB_SPIN(cond, bar) do { unsigned _sp = 0; while (cond) { __builtin_amdgcn_s_sleep(1); \
    if ((++_sp & 255u) == 0u) { if (xb_ld(&(bar)[XB_TMO])) break; if (_sp > XB_SPIN_CAP) { atomicAdd(&(bar)[XB_TMO], 1u); break; } } } } while (0)
struct XcdBarrier { unsigned* bar; unsigned x; volatile LAS unsigned* st; int wave; };
__device__ __forceinline__ bool xb_leader(int wave) { return wave == 0 && lane_id_now() == 0u; }
__device__ __forceinline__ XcdBarrier xcd_barrier_post(unsigned* bar, volatile LAS unsigned* st, int wave) {
    XcdBarrier b; b.bar = bar; b.x = xb_xcc_id(); b.st = st; b.wave = wave;
    if (xb_leader(wave)) st[2] = xb_add(&bar[XB_XCNT(b.x)], 1u);
    return b;
}
__device__ __forceinline__ void xcd_barrier_complete(unsigned* bar, unsigned x, unsigned& nloc, unsigned& nx, unsigned& xi) {
    const unsigned G = gridDim.x * gridDim.y * gridDim.z;
    unsigned sum, cnt, mine, below, sp = 0u;
    for (;;) {
        sum = 0u; cnt = 0u; mine = 0u; below = 0u;
#pragma unroll
        for (unsigned j = 0; j < 16; ++j) { const unsigned c = xb_ld(&bar[XB_XCNT(j)]); sum += c; cnt += (c > 0u) ? 1u : 0u; mine = (j == x) ? c : mine; below += (c > 0u && j < x) ? 1u : 0u; }
        if (sum == G) break;
        __builtin_amdgcn_s_sleep(1);
        if ((++sp & 255u) == 0u) { if (xb_ld(&bar[XB_TMO])) break; if (sp > XB_SPIN_CAP) { atomicAdd(&bar[XB_TMO], 1u); break; } }
    }
    nloc = mine > 0u ? mine : 1u; nx = cnt > 0u ? cnt : 1u; xi = below;
}
__device__ __forceinline__ void xcd_barrier(const XcdBarrier& b) {
    asm volatile("s_waitcnt vmcnt(0)" ::: "memory");
    __syncthreads();
    if (xb_leader(b.wave)) {
        unsigned* bar = b.bar;
        __builtin_amdgcn_s_waitcnt(0);
        unsigned nloc = b.st[0], nx = b.st[1];
        if (nloc == 0u) { unsigned xi; xcd_barrier_complete(bar, b.x, nloc, nx, xi); b.st[0] = nloc; b.st[1] = nx; b.st[3] = xi; }
        const unsigned old = xb_add(&bar[XB_XSUB(b.x)], 1u);
        const unsigned gen = old / nloc;
        if (old + 1u == (gen + 1u) * nloc) {
            __builtin_amdgcn_fence(__ATOMIC_RELEASE, "agent");
            asm volatile("s_waitcnt vmcnt(0)" ::: "memory");
            const unsigned og = xb_add(&bar[XB_TOP], 1u);
            const unsigned tg = og / nx;
            if (og + 1u == (tg + 1u) * nx) xb_add(&bar[XB_TOPGEN], 1u);
            else XB_SPIN(xb_ld(&bar[XB_TOPGEN]) == tg, bar);
            __builtin_amdgcn_fence(__ATOMIC_ACQUIRE, "agent");
            xb_add(&bar[XB_XGEN(b.x)], 1u);
            asm volatile("s_waitcnt vmcnt(0)" ::: "memory");
        } else {
            XB_SPIN(xb_ld(&bar[XB_XGEN(b.x)]) == gen, bar);
            __builtin_amdgcn_fence(__ATOMIC_ACQUIRE, "agent");
            asm volatile("s_waitcnt vmcnt(0)" ::: "memory");
        }
    }
    __syncthreads();
}

#define XL_SUB(j) (3584 + 64 * (j))
#define XL_GEN(j) (4608 + 64 * (j))
__device__ __forceinline__ void xcc_local_barrier(unsigned* bar, unsigned x, unsigned nloc, int wave, unsigned& gen) {
    if (wave == 0) asm volatile("buffer_inv sc1" ::: "memory");
    asm volatile("s_waitcnt vmcnt(0)" ::: "memory");
    __syncthreads();
    if (xb_leader(wave)) {
        __builtin_amdgcn_s_waitcnt(0);
        const unsigned old = xb_add(&bar[XL_SUB(x)], 1u);
        if (old + 1u == (gen + 1u) * nloc) xb_add(&bar[XL_GEN(x)], 1u);
        else XB_SPIN(xb_ld(&bar[XL_GEN(x)]) == gen, bar);
        asm volatile("s_waitcnt vmcnt(0)" ::: "memory");
    }
    ++gen;
    __syncthreads();
}

struct Frame {
    LAS unsigned char* lds;
    int vcu, G, wave;
    float* out; unsigned char* ws;
};
__device__ __forceinline__ int phase_tid(int wave) { return wave * 64 + (int)lane_id_now(); }
#define PHASE_IDS() const int tid_ = phase_tid(F.wave); const int tid = tid_, lane = tid & 63, wave = __builtin_amdgcn_readfirstlane(tid >> 6); (void)tid; (void)lane; (void)wave
__device__ __forceinline__ const float* arg_in(int k) { asm volatile("" : "+s"(k)); return ((const float* const __attribute__((address_space(4)))*)__builtin_amdgcn_kernarg_segment_ptr())[k]; }

__device__ __forceinline__ float wave_sum(float v) {
#pragma unroll
    for (int o = 1; o < 64; o <<= 1) v += __shfl_xor(v, o);
    return v;
}
__device__ __forceinline__ void p0_transpose_item(const float* W, int N, bf16_t* WT, int ldk, int koff, LAS float* scr, int item, int lane, const float* gk = nullptr, bool gate_remap = false) {
    const int nblk = N / 32, kb = item / nblk, nb = item % nblk, k0 = 64 * kb, n0 = 32 * nb;
    int nd = n0;
    if (gate_remap && n0 >= NQKV) { const int gcol = n0 - NQKV, isd = gcol >= D, c = isd ? gcol - D : gcol; nd = NQKV + (c >> 7) * 256 + isd * 128 + (c & 127); }
    const float* src = W + (size_t)(k0 + (lane >> 3)) * N + n0 + (lane & 7) * 4;
    f32x4 v[8];
#pragma unroll
    for (int i = 0; i < 8; ++i) v[i] = *(const f32x4*)(src + (size_t)(8 * i) * N);
    if (gk) {
#pragma unroll
        for (int i = 0; i < 8; ++i) v[i] = v[i] * gk[k0 + 8 * i + (lane >> 3)]; }
#pragma unroll
    for (int i = 0; i < 8; ++i) { LAS float* d = scr + (8 * i + (lane >> 3)) * 33 + (lane & 7) * 4; d[0] = v[i][0]; d[1] = v[i][1]; d[2] = v[i][2]; d[3] = v[i][3]; }
    LDS_WAIT(); asm volatile("" ::: "memory");
    const int c = lane & 7;
#pragma unroll
    for (int j = 0; j < 4; ++j) { const int n = (lane >> 3) + 8 * j; const LAS float* s = scr + (8 * c) * 33 + n;
        u32x4 o; o.x = cvtpk(s[0 * 33], s[1 * 33]); o.y = cvtpk(s[2 * 33], s[3 * 33]); o.z = cvtpk(s[4 * 33], s[5 * 33]); o.w = cvtpk(s[6 * 33], s[7 * 33]);
        *(u32x4*)(WT + (size_t)(nd + n) * ldk + koff + k0 + 8 * c) = o; }
    LDS_WAIT(); asm volatile("" ::: "memory");
}
__device__ __forceinline__ void p0_prologue(Frame& F) {
    PHASE_IDS();
    LAS float* scr = (LAS float*)(F.lds + RING_OFF + wave * 16384);
    const int gw = F.vcu * NWAVES + wave, NGW = F.G * NWAVES;
    constexpr int I_IN = (D / 64) * (NIN / 32), I_B = (512 / 64) * (D / 32), I_O = (D / 64) * (D / 32), I_1 = (D / 64) * (FF / 32), I_2 = (FF / 64) * (D / 32);
    constexpr int NL = I_IN + 2 * I_B + I_O + I_1 + I_2, NITEMS = DEPTH * NL;
    for (int it = gw; it < NITEMS; it += NGW) {
        const int L = it / NL; int r = it % NL;
        unsigned char* wb = F.ws + WS_W + (size_t)L * W_LAYER;
        if (r < I_IN) { p0_transpose_item(arg_in(4) + (size_t)L * D * NIN, NIN, (bf16_t*)(wb + WO_IN), D, 0, scr, r, lane, arg_in(3) + L * D, true); continue; } r -= I_IN;
        if (r < I_B) { p0_transpose_item(arg_in(8) + (size_t)L * 512 * D, D, (bf16_t*)(wb + WO_M), D, 0, scr, r, lane); continue; } r -= I_B;
        if (r < I_B) { p0_transpose_item(arg_in(9) + (size_t)L * 512 * D, D, (bf16_t*)(wb + WO_M), D, 512, scr, r, lane); continue; } r -= I_B;
        if (r < I_O) { p0_transpose_item(arg_in(10) + (size_t)L * D * D, D, (bf16_t*)(wb + WO_OUT), D, 0, scr, r, lane); continue; } r -= I_O;
        if (r < I_1) { p0_transpose_item(arg_in(12) + (size_t)L * D * FF, FF, (bf16_t*)(wb + WO_FF1), D, 0, scr, r, lane, arg_in(11) + L * D); continue; } r -= I_1;
        p0_transpose_item(arg_in(13) + (size_t)L * FF * D, D, (bf16_t*)(wb + WO_FF2), FF, 0, scr, r, lane);
    }
    const float* x = arg_in(0); bf16_t* XN = (bf16_t*)(F.ws + WS_XNY); float* SS = (float*)(F.ws + WS_SS);
    for (int m0 = 2 * gw; m0 < M; m0 += 2 * NGW) {
        f32x4 v[2][4];
#pragma unroll
        for (int q = 0; q < 2; ++q)
#pragma unroll
            for (int j = 0; j < 4; ++j) v[q][j] = ((const f32x4*)(x + (size_t)(m0 + q) * D) + lane)[64 * j];
#pragma unroll
        for (int q = 0; q < 2; ++q) { const int m = m0 + q; u32x2* o8 = (u32x2*)(XN + (size_t)m * D) + lane; float s = 0.f;
#pragma unroll
            for (int j = 0; j < 4; ++j) { const f32x4 vv = v[q][j]; s += (vv[0] * vv[0] + vv[1] * vv[1]) + (vv[2] * vv[2] + vv[3] * vv[3]);
                u32x2 w; w.x = cvtpk(vv[0], vv[1]); w.y = cvtpk(vv[2], vv[3]); o8[64 * j] = w; }
            s = wave_sum(s);
            if (lane < 4) SS[(size_t)m * 4 + lane] = (lane == 0) ? s : 0.f; }
    }
}
namespace att {
typedef LAS const char* lcp;
__device__ __forceinline__ int crow(int r, int hi) { return (r & 3) + 8 * (r >> 2) + 4 * hi; }
typedef short v4i16_t __attribute__((ext_vector_type(4)));
__device__ __forceinline__ s16x4 vtr(lcp p) { return __builtin_bit_cast(s16x4, __builtin_amdgcn_ds_read_tr16_b64_v4i16((LAS v4i16_t*)p)); }
#define MFMA32(a, b, c) __builtin_amdgcn_mfma_f32_32x32x16_bf16(a, b, c, 0, 0, 0)
#define ATT_WAIT_BAR(N) asm volatile("s_waitcnt vmcnt(" #N ") lgkmcnt(0)\n\ts_barrier" ::: "memory")
__device__ __forceinline__ void glds16(const void* gsrc, unsigned lds_dst) { unsigned keep;
    asm volatile("s_mov_b32 %0, m0\n\ts_mov_b32 m0, %2\n\ts_nop 0\n\tglobal_load_lds_dwordx4 %1, off\n\ts_mov_b32 m0, %0" : "=&s"(keep) : "v"(gsrc), "s"(lds_dst) : "memory"); }
#define GLDS16(gsrc, ldsdst) glds16((const void*)(gsrc), (unsigned)__builtin_amdgcn_readfirstlane((int)(unsigned)(uintptr_t)(ldsdst)))
__device__ __forceinline__ void glds16s(unsigned voff, const void* sbase, unsigned lds_dst) { unsigned keep;
    asm volatile("s_mov_b32 %0, m0\n\ts_mov_b32 m0, %2\n\ts_nop 2\n\tglobal_load_lds_dwordx4 %1, %3\n\ts_mov_b32 m0, %0" : "=&s"(keep) : "v"(voff), "s"(lds_dst), "s"(sbase) : "memory"); }
#define GLDS16S(voff, sbase, ldsdst) glds16s((voff), (const void*)(sbase), (unsigned)__builtin_amdgcn_readfirstlane((int)(unsigned)(uintptr_t)(ldsdst)))
#define ATT_BAR_IF(cond, N) do { if (cond) ATT_WAIT_BAR(N); } while (0)
#define MX3(a, b, c) __builtin_fmaxf(__builtin_fmaxf((a), (b)), (c))

__device__ __forceinline__ void kload(bf16x8 (&kf)[8], lcp kslot, const int (&koff)[4]) {
#pragma unroll
    for (int d0 = 0; d0 < 4; ++d0) { kf[2 * d0] = *(const LAS bf16x8*)(kslot + koff[d0]); kf[2 * d0 + 1] = *(const LAS bf16x8*)(kslot + koff[d0] + 4096); }
}
__device__ __forceinline__ void qk_mfma(f32x16& p0, f32x16& p1, const bf16x8 (&kf)[8], const bf16x8* qr, const f32x16& cinit) {
    p0 = MFMA32(kf[0], qr[0], cinit); p1 = MFMA32(kf[1], qr[0], cinit);
#pragma unroll
    for (int d0 = 1; d0 < 4; ++d0) { p0 = MFMA32(kf[2 * d0], qr[d0], p0); p1 = MFMA32(kf[2 * d0 + 1], qr[d0], p1); }
}
__device__ __forceinline__ float rowmax32(const f32x16& p0, const f32x16& p1) {
    float a = MX3(p0[0], p0[1], p1[0]), b = MX3(p0[2], p0[3], p1[1]); a = MX3(a, p1[2], p1[3]);
#pragma unroll
    for (int r = 4; r < 16; r += 4) { a = MX3(a, p0[r], p0[r + 1]); b = MX3(b, p0[r + 2], p0[r + 3]); a = MX3(a, p1[r], p1[r + 1]); b = MX3(b, p1[r + 2], p1[r + 3]); }
    a = __builtin_fmaxf(a, b);
    auto rr = __builtin_amdgcn_permlane32_swap(__float_as_uint(a), __float_as_uint(a), false, false);
    return __builtin_fmaxf(__uint_as_float(rr[0]), __uint_as_float(rr[1]));
}
template <int NB, int THR>
__device__ __forceinline__ bool softmax_part(f32x16& p0, f32x16& p1, f32x16 (&o)[NB], float& mhat, float& l, bool first, LAS float* wsf, int r32, int hi, u32x4 (&pw)[4]) {
    const float rm = rowmax32(p0, p1);
    bool resc = false, moved = false;
    if (first) {
        mhat += rm; moved = true;
#pragma unroll
        for (int r = 0; r < 16; ++r) { p0[r] -= rm; p1[r] -= rm; }
    } else if (__any(rm > (float)THR)) {
        const float dl = fmaxf(rm, 0.f); mhat += dl; moved = true; resc = true;
#pragma unroll
        for (int r = 0; r < 16; ++r) { p0[r] -= dl; p1[r] -= dl; }
        const float f = __builtin_amdgcn_exp2f(-dl); l *= f; if (hi == 0) wsf[r32] = f;
    }
    float s = 0.f;
#pragma unroll
    for (int r = 0; r < 16; ++r) { p0[r] = __builtin_amdgcn_exp2f(p0[r]); p1[r] = __builtin_amdgcn_exp2f(p1[r]); s += p0[r] + p1[r]; }
    l += s;
    pw[0] = (u32x4){cvtpk(p0[0], p0[1]), cvtpk(p0[2], p0[3]), cvtpk(p0[4], p0[5]), cvtpk(p0[6], p0[7])};
    pw[1] = (u32x4){cvtpk(p0[8], p0[9]), cvtpk(p0[10], p0[11]), cvtpk(p0[12], p0[13]), cvtpk(p0[14], p0[15])};
    pw[2] = (u32x4){cvtpk(p1[0], p1[1]), cvtpk(p1[2], p1[3]), cvtpk(p1[4], p1[5]), cvtpk(p1[6], p1[7])};
    pw[3] = (u32x4){cvtpk(p1[8], p1[9]), cvtpk(p1[10], p1[11]), cvtpk(p1[12], p1[13]), cvtpk(p1[14], p1[15])};
    if (resc) {
        float fr[16];
#pragma unroll
        for (int r = 0; r < 16; ++r) fr[r] = wsf[crow(r, hi)];
#pragma unroll
        for (int d = 0; d < NB; ++d)
#pragma unroll
            for (int r = 0; r < 16; ++r) o[d][r] *= fr[r];
    }
    return moved;
}
__device__ __forceinline__ void vload0(s16x4 (&lo)[4], s16x4 (&hh)[4], lcp vb) {
#pragma unroll
    for (int ks = 0; ks < 4; ++ks) { lo[ks] = vtr(vb + ks * 1024); hh[ks] = vtr(vb + ks * 1024 + 512); }
}
template <int NB>
__device__ __forceinline__ void pv_part(f32x16 (&o)[NB], lcp vb, const u32x4 (&pw)[4], const s16x4 (&lo0)[4], const s16x4 (&hh0)[4]) {
    s16x4 lo[2][4], hh[2][4];
#pragma unroll
    for (int ks = 0; ks < 4; ++ks) { lo[0][ks] = lo0[ks]; hh[0][ks] = hh0[ks]; }
#pragma unroll
    for (int d0 = 0; d0 < NB; ++d0) {
        if (d0 + 1 < NB) {
#pragma unroll
            for (int ks = 0; ks < 4; ++ks) { lo[(d0 + 1) & 1][ks] = vtr(vb + (d0 + 1) * 4096 + ks * 1024); hh[(d0 + 1) & 1][ks] = vtr(vb + (d0 + 1) * 4096 + ks * 1024 + 512); }
        }
        __builtin_amdgcn_sched_barrier(0);
#define ATT_PK(k) (bf16x8){lo[d0 & 1][k][0], lo[d0 & 1][k][1], lo[d0 & 1][k][2], lo[d0 & 1][k][3], hh[d0 & 1][k][0], hh[d0 & 1][k][1], hh[d0 & 1][k][2], hh[d0 & 1][k][3]}
        o[d0] = MFMA32(__builtin_bit_cast(bf16x8, pw[0]), ATT_PK(0), o[d0]);
        o[d0] = MFMA32(__builtin_bit_cast(bf16x8, pw[1]), ATT_PK(1), o[d0]);
        o[d0] = MFMA32(__builtin_bit_cast(bf16x8, pw[2]), ATT_PK(2), o[d0]);
        o[d0] = MFMA32(__builtin_bit_cast(bf16x8, pw[3]), ATT_PK(3), o[d0]);
#undef ATT_PK
        __builtin_amdgcn_sched_barrier(0);
    }
}
__device__ __forceinline__ void row_inv_l(float l, float (&rli)[16], LAS float* wsf, int r32, int hi) {
    auto rr = __builtin_amdgcn_permlane32_swap(__float_as_uint(l), __float_as_uint(l), false, false);
    const float lt = __uint_as_float(rr[0]) + __uint_as_float(rr[1]);
    if (hi == 0) wsf[32 + r32] = lt;
#pragma unroll
    for (int r = 0; r < 16; ++r) rli[r] = __builtin_amdgcn_rcpf(wsf[32 + crow(r, hi)]);
}
__device__ __forceinline__ int t5_bucket(int rel) {
    const int n = rel < 0 ? -rel : rel;
    const int large = 8 + (n >= 12) + (n >= 16) + (n >= 23) + (n >= 32) + (n >= 46) + (n >= 64) + (n >= 91);
    return (rel > 0 ? 16 : 0) + (n < 8 ? n : large);
}


template <int THR>
__device__ __forceinline__ void diff_unit(Frame& F, int layer, const bf16_t* qkv, bf16_t* Y, int h, int qb) {
    const int tid = phase_tid(F.wave), wid = F.wave;
    const int mp = wid >> 2, wq = wid & 3;
    const size_t tokb = 0;
    LAS unsigned char* lds = F.lds;
    LAS float* wsf = (LAS float*)(lds + ATT_WSF) + wid * 128;
    LAS float* TBL = (LAS float*)(lds + ATT_TBL);
    constexpr int NT = SEQ / 64;
    f32x16 o[4]; float l = 0.f;
    {
    const int lane = tid & 63, r32 = lane & 31, hi = lane >> 5;
    const bf16_t* kbase = qkv + tokb * NQKV + COL_KD + h * 128; const bf16_t* vbase_g = qkv + tokb * NQKV + COL_VD + h * 128;
#define DIFF_KVO(L_) ((unsigned)((8 * wid + ((L_) >> 3)) * NQKV + (((L_) & 7) ^ ((L_) >> 3)) * 8) * 2u)
#define DIFF_VVO(L_) ((unsigned)((16 * (wid & 3) + ((L_) >> 2)) * NQKV + (wid >> 2) * 32 + ((L_) & 3) * 8) * 2u)
#define DIFF_DMA_K(t) do { const int tt_ = (t) < NT ? (t) : NT - 1; const size_t go_ = (size_t)tt_ * 64 * NQKV; LAS unsigned char* rb_ = lds + ((t) & 3) * 16384 + wid * 1024; \
        int ld_ = lane; asm volatile("" : "+v"(ld_)); const unsigned kvo_ = DIFF_KVO(ld_); GLDS16S(kvo_, kbase + go_, rb_); GLDS16S(kvo_, kbase + go_ + 64, rb_ + 8192); } while (0)
#define DIFF_DMA_V(t) do { const int tt_ = (t) < NT ? (t) : NT - 1; const size_t go_ = (size_t)tt_ * 64 * NQKV; LAS unsigned char* rb_ = lds + 65536 + ((t) & 3) * 16384 + wid * 1024; \
        int ld_ = lane; asm volatile("" : "+v"(ld_)); const unsigned vvo_ = DIFF_VVO(ld_); GLDS16S(vvo_, vbase_g + go_, rb_); GLDS16S(vvo_, vbase_g + go_ + 64, rb_ + 8192); } while (0)
    DIFF_DMA_K(0); DIFF_DMA_K(1); DIFF_DMA_V(0); DIFF_DMA_K(2); DIFF_DMA_V(1);
    if (tid < 257) TBL[tid] = arg_in(1)[t5_bucket(tid - 128) * 4 + h] * LOG2E;
    bf16x8 qr[4];
    { const bf16_t* Qw = qkv + (tokb + qb * 128 + wq * 32 + r32) * NQKV + COL_QD + h * 128 + mp * 64 + hi * 8;
#pragma unroll
      for (int d0 = 0; d0 < 4; ++d0) qr[d0] = *(const bf16x8*)(Qw + d0 * 16); }
    asm volatile("" : "+v"(qr[0]), "+v"(qr[1]), "+v"(qr[2]), "+v"(qr[3]));
    const int voff = ((lane >> 4) & 1) * 32 + (lane & 3) * 8 + (4 * hi + ((lane & 15) >> 2)) * 64;
    o[0] = f32x16{}; o[1] = f32x16{}; o[2] = f32x16{}; o[3] = f32x16{};
    float mhat = 0.f;
    const int qw0 = qb * 128 + wq * 32;
    ATT_WAIT_BAR(8);
    const float tL = __uint_as_float((unsigned)__builtin_amdgcn_readfirstlane((int)__float_as_uint(TBL[0]))), tR = __uint_as_float((unsigned)__builtin_amdgcn_readfirstlane((int)__float_as_uint(TBL[256])));
    bf16x8 kf[8]; f32x16 p0, p1, cinit; u32x4 pwA[4], pwB[4]; s16x4 vlo[2][4], vhh[2][4]; bool moved = false; int zc_id;
    { const int dk0 = 0 - qw0; zc_id = (dk0 >= 122) ? 1 : 2; const float c0 = (zc_id == 1 ? tR : tL);
#pragma unroll
      for (int r = 0; r < 16; ++r) cinit[r] = c0; }
#define SBAR() __builtin_amdgcn_sched_barrier(0)
#define PIN(x) asm volatile("" : "+v"(x))
#define DIFF_SCORES(t, FIRST) do { \
        { int rk_ = r32; asm volatile("" : "+v"(rk_)); int koff[4];                       \
          _Pragma("unroll") for (int d0 = 0; d0 < 4; ++d0) koff[d0] = rk_ * 128 + (((2 * d0 + hi) ^ (rk_ & 7)) << 4); \
          kload(kf, (lcp)(lds + ((t) & 3) * 16384 + mp * 8192), koff); } \
        SBAR();                                                                     \
        qk_mfma(p0, p1, kf, qr, cinit); \
        SBAR(); \
        DIFF_DMA_K((t) + 3); DIFF_DMA_V((t) + 2); \
        const int dk_ = (t) * 64 - qw0; const int zone_ = (dk_ >= 122) ? 1 : ((dk_ <= -154) ? 2 : 0); \
        if (zone_ == 0) { int rq_ = r32; asm volatile("" : "+v"(rq_)); const int base_ = dk_ - rq_ + 128; const float zc_ = (zc_id == 1) ? tR : tL; \
            _Pragma("unroll") for (int r = 0; r < 16; ++r) { int i0 = base_ + crow(r, hi), i1 = i0 + 32; \
                i0 = i0 < 0 ? 0 : (i0 > 256 ? 256 : i0); i1 = i1 < 0 ? 0 : (i1 > 256 ? 256 : i1); \
                p0[r] += TBL[i0] - zc_; p1[r] += TBL[i1] - zc_; if ((r & 3) == 3) SBAR(); } } \
        const float rm_ = rowmax32(p0, p1); \
        bool shift_ = FIRST; float dl_ = rm_; moved = false; \
        if (!(FIRST)) { moved = __any(rm_ > (float)THR); shift_ = moved; dl_ = fmaxf(rm_, 0.f); } \
        if (shift_) { mhat += dl_; \
            _Pragma("unroll") for (int r = 0; r < 16; ++r) { float a_ = p0[r], b_ = p1[r]; asm volatile("v_sub_f32_e32 %0, %0, %2\n\tv_sub_f32_e32 %1, %1, %2" : "+v"(a_), "+v"(b_) : "v"(dl_)); p0[r] = a_; p1[r] = b_; } \
            if (!(FIRST)) { const float f_ = __builtin_amdgcn_exp2f(-dl_); l *= f_; if (hi == 0) wsf[r32] = f_; } } \
        { const int dn_ = dk_ + 64; const int zn_ = (dn_ >= 122) ? 1 : ((dn_ <= -154) ? 2 : 0); \
          if (shift_ || (zn_ != 0 && zn_ != zc_id)) { if (zn_ != 0) zc_id = zn_; const float cb_ = ((zc_id == 1) ? tR : tL) - mhat; \
              _Pragma("unroll") for (int r = 0; r < 16; ++r) cinit[r] = cb_; } } \
        SBAR(); } while (0)
#define DIFF_EXP2(g, PWN, SACC) do { \
        float x0_ = ((g) < 8 ? p0[2 * ((g) & 7)] : p1[2 * ((g) & 7)]), x1_ = ((g) < 8 ? p0[2 * ((g) & 7) + 1] : p1[2 * ((g) & 7) + 1]); \
        x0_ = __builtin_amdgcn_exp2f(x0_); x1_ = __builtin_amdgcn_exp2f(x1_); SACC += x0_; SACC += x1_; PWN[(g) >> 2][(g) & 3] = cvtpk(x0_, x1_); } while (0)
#define VFRAG(B, i) (bf16x8){vlo[B][i][0], vlo[B][i][1], vlo[B][i][2], vlo[B][i][3], vhh[B][i][0], vhh[B][i][1], vhh[B][i][2], vhh[B][i][3]}
#define DIFF_GAP(g, PWC, PWN, VB) do { \
        o[(g) >> 2] = MFMA32(__builtin_bit_cast(bf16x8, PWC[(g) & 3]), VFRAG(((g) >> 2) & 1, (g) & 3), o[(g) >> 2]); \
        if ((g) < 12) { vlo[(((g) >> 2) + 1) & 1][(g) & 3] = vtr(VB + (((g) >> 2) + 1) * 4096 + ((g) & 3) * 1024); vhh[(((g) >> 2) + 1) & 1][(g) & 3] = vtr(VB + (((g) >> 2) + 1) * 4096 + ((g) & 3) * 1024 + 512); } \
        DIFF_EXP2(g, PWN, sacc_); PIN(sacc_); PIN(PWN[(g) >> 2]); SBAR(); } while (0)
#define DIFF_STEP(t, PWC, PWN) do { \
        lcp vb_ = (lcp)(lds + 65536 + (((t) - 1) & 3) * 16384 + voff); \
        _Pragma("unroll") for (int i = 0; i < 4; ++i) { vlo[0][i] = vtr(vb_ + i * 1024); vhh[0][i] = vtr(vb_ + i * 1024 + 512); } \
        DIFF_SCORES(t, false); \
        float sacc_ = 0.f; \
        DIFF_GAP(0, PWC, PWN, vb_); DIFF_GAP(1, PWC, PWN, vb_); DIFF_GAP(2, PWC, PWN, vb_); DIFF_GAP(3, PWC, PWN, vb_); \
        DIFF_GAP(4, PWC, PWN, vb_); DIFF_GAP(5, PWC, PWN, vb_); DIFF_GAP(6, PWC, PWN, vb_); DIFF_GAP(7, PWC, PWN, vb_); \
        DIFF_GAP(8, PWC, PWN, vb_); DIFF_GAP(9, PWC, PWN, vb_); DIFF_GAP(10, PWC, PWN, vb_); DIFF_GAP(11, PWC, PWN, vb_); \
        DIFF_GAP(12, PWC, PWN, vb_); DIFF_GAP(13, PWC, PWN, vb_); DIFF_GAP(14, PWC, PWN, vb_); DIFF_GAP(15, PWC, PWN, vb_); \
        l += sacc_; \
        ATT_WAIT_BAR(8); \
        if (moved) { float fr_[16]; \
            _Pragma("unroll") for (int r = 0; r < 16; ++r) fr_[r] = wsf[crow(r, hi)]; \
            _Pragma("unroll") for (int d = 0; d < 4; ++d) _Pragma("unroll") for (int r = 0; r < 16; ++r) o[d][r] *= fr_[r]; \
} \
    } while (0)
    if (wid >= 4) __builtin_amdgcn_s_setprio(1);
    DIFF_SCORES(0, true);
    { float sacc_ = 0.f;
#pragma unroll
      for (int g = 0; g < 16; ++g) DIFF_EXP2(g, pwA, sacc_);
      l += sacc_; }
    ATT_WAIT_BAR(8);
#pragma unroll 1
    for (int t = 1; t + 1 < NT; t += 2) { DIFF_STEP(t, pwA, pwB); DIFF_STEP(t + 1, pwB, pwA); }
    DIFF_STEP(NT - 1, pwA, pwB);
    { lcp vb_ = (lcp)(lds + 65536 + ((NT - 1) & 3) * 16384 + voff); s16x4 l0[4], h0[4]; vload0(l0, h0, vb_); pv_part<4>(o, vb_, pwB, l0, h0); }
    __builtin_amdgcn_s_setprio(0);
    ATT_WAIT_BAR(0);
#undef DIFF_DMA_K
#undef DIFF_DMA_V
#undef DIFF_KVO
#undef DIFF_VVO
#undef DIFF_SCORES
#undef DIFF_EXP2
#undef DIFF_GAP
#undef DIFF_STEP
#undef VFRAG
#undef SBAR
#undef PIN
    }
    const int tid2_ = phase_tid(F.wave);
    const int lane = tid2_ & 63, r32 = lane & 31, hi = lane >> 5;
    const float* lp = arg_in(6) + layer * 256;
    const float lpa = lp[lane] * lp[64 + lane], lpb = lp[128 + lane] * lp[192 + lane];
    const float* sg = arg_in(7) + layer * 128;
    float sgv[4];
#pragma unroll
    for (int d = 0; d < 4; ++d) sgv[d] = sg[d * 32 + r32];
    float rli[16]; row_inv_l(l, rli, wsf, r32, hi);
#pragma unroll
    for (int d = 0; d < 4; ++d)
#pragma unroll
        for (int r = 0; r < 16; ++r) o[d][r] *= rli[r];
    LAS float* xch = (LAS float*)(lds) + wq * 4096;
    if (mp == 1) {
#pragma unroll
        for (int d = 0; d < 4; ++d)
#pragma unroll
            for (int r4 = 0; r4 < 4; ++r4) *(LAS f32x4*)(xch + ((d * 4 + r4) * 64 + lane) * 4) = (f32x4){o[d][4 * r4], o[d][4 * r4 + 1], o[d][4 * r4 + 2], o[d][4 * r4 + 3]};
    }
    ATT_WAIT_BAR(0);
    if (mp == 0) {
        const float s1 = wave_sum(lpa), s2 = wave_sum(lpb);
        unsigned lbits_ = (layer == 0) ? 0x3E4CCCCDu : 0x3EB60549u; asm volatile("" : "+s"(lbits_));
        const float lam_init = __uint_as_float(lbits_);
        const float lam = expf(s1) - expf(s2) + lam_init;
        float ssq[16];
#pragma unroll
        for (int r = 0; r < 16; ++r) ssq[r] = 0.f;
#pragma unroll
        for (int d = 0; d < 4; ++d)
#pragma unroll
            for (int r4 = 0; r4 < 4; ++r4) { const f32x4 x2 = *(const LAS f32x4*)(xch + ((d * 4 + r4) * 64 + lane) * 4);
#pragma unroll
                for (int e = 0; e < 4; ++e) { const int r = 4 * r4 + e; const float v = o[d][r] - lam * x2[e]; o[d][r] = v; ssq[r] += v * v; } }
#pragma unroll
        for (int r = 0; r < 16; ++r) {
            float v = ssq[r];
            v += __shfl_xor(v, 1); v += __shfl_xor(v, 2); v += __shfl_xor(v, 4); v += __shfl_xor(v, 8); v += __shfl_xor(v, 16);
            ssq[r] = (1.0f - lam_init) * __builtin_amdgcn_rsqf(v * (1.0f / 128.0f) + RMS_EPS);
        }
        LAS bf16_t* stg = (LAS bf16_t*)(lds + 65536) + wq * 4096;
#pragma unroll
        for (int d = 0; d < 4; ++d) { const float gg = sgv[d];
#pragma unroll
            for (int r = 0; r < 16; ++r) { const float v = o[d][r] * ssq[r] * gg; stg[crow(r, hi) * 128 + d * 32 + r32] = (bf16_t)(cvtpk(v, v) & 0xffffu); } }
        bf16_t* yb = Y + (tokb + qb * 128 + wq * 32 + (lane >> 4)) * D + 512 + h * 128 + (lane & 15) * 8;
#pragma unroll
        for (int i = 0; i < 8; ++i) { const u32x4 v = *(const LAS u32x4*)(stg + (i * 4 + (lane >> 4)) * 128 + (lane & 15) * 8); store16_wt(yb + (size_t)i * 4 * D, v); }
    }
    ATT_WAIT_BAR(0);
}

template <int HALF> __device__ __forceinline__ void na_vload(s16x4 (&lo)[2][3], s16x4 (&hh)[2][3], lcp vb);
template <int HALF>
__device__ __forceinline__ void na_cinit(f32x16& cF, float mhat, int vbase) {
    constexpr int FO = HALF ? 32 : 0;
#pragma unroll
    for (int r = 0; r < 16; ++r) { const int e = (r & 3) + 8 * (r >> 2) + FO; cF[r] = ((unsigned)(vbase + e) < 16u) ? -mhat : -INFINITY; }
}
template <int HALF, int THR>
__device__ __forceinline__ void na_scores(f32x16& p0, f32x16& p1, const bf16x8 (&kf)[8], const bf16x8* qr, f32x16& cF, f32x16 (&o)[2], float& mhat, float& l, bool first,
                                           const LAS float* rp, int vbase, LAS float* wsf, int r32, int hi, u32x4 (&pw)[4], lcp vb, s16x4 (&vlo)[2][3], s16x4 (&vhh)[2][3]) {
    { const f32x16 z = f32x16{};
      if (HALF) { p0 = MFMA32(kf[0], qr[0], z); p1 = MFMA32(kf[1], qr[0], cF); } else { p0 = MFMA32(kf[0], qr[0], cF); p1 = MFMA32(kf[1], qr[0], z); } }
#pragma unroll
    for (int d0 = 1; d0 < 4; ++d0) { p0 = MFMA32(kf[2 * d0], qr[d0], p0); p1 = MFMA32(kf[2 * d0 + 1], qr[d0], p1); }
    na_vload<HALF>(vlo, vhh, vb);
    __builtin_amdgcn_sched_barrier(0);
    f32x16& FB = HALF ? p1 : p0; f32x16& PB = HALF ? p0 : p1;
    constexpr int PR = HALF ? 12 : 0, FO = HALF ? 32 : 0, PO = HALF ? 0 : 32;
#pragma unroll
    for (int r = 0; r < 16; ++r) { const int e = (r & 3) + 8 * (r >> 2) + FO; FB[r] += rp[e]; }
#pragma unroll
    for (int r = PR; r < PR + 4; ++r) { const int e = (r & 3) + 8 * (r >> 2) + PO; PB[r] = ((unsigned)(vbase + e) < 16u) ? PB[r] + (rp[e] - mhat) : -INFINITY; }
    float a = MX3(FB[0], FB[1], FB[2]), c = MX3(FB[3], FB[4], FB[5]);
    a = MX3(a, FB[6], FB[7]); c = MX3(c, FB[8], FB[9]); a = MX3(a, FB[10], FB[11]); c = MX3(c, FB[12], FB[13]); a = MX3(a, FB[14], FB[15]); c = MX3(c, PB[PR], PB[PR + 1]); a = MX3(a, PB[PR + 2], PB[PR + 3]);
    a = __builtin_fmaxf(a, c);
    { auto rr = __builtin_amdgcn_permlane32_swap(__float_as_uint(a), __float_as_uint(a), false, false); a = __builtin_fmaxf(__uint_as_float(rr[0]), __uint_as_float(rr[1])); }
    const float rm = a; bool resc = false, shift = first; float dl = rm;
    if (!first) { shift = __any(rm > (float)THR); resc = shift; dl = fmaxf(rm, 0.f); }
    if (shift) { mhat += dl;
#pragma unroll
        for (int r = 0; r < 16; ++r) FB[r] -= dl;
#pragma unroll
        for (int r = PR; r < PR + 4; ++r) PB[r] -= dl;
        na_cinit<HALF>(cF, mhat, vbase);
        if (resc) { const float f = __builtin_amdgcn_exp2f(-dl); l *= f; if (hi == 0) wsf[r32] = f; } }
    float s = 0.f;
#pragma unroll
    for (int r = 0; r < 16; ++r) { FB[r] = __builtin_amdgcn_exp2f(FB[r]); s += FB[r]; }
#pragma unroll
    for (int r = PR; r < PR + 4; ++r) { PB[r] = __builtin_amdgcn_exp2f(PB[r]); s += PB[r]; }
    l += s;
    const u32x4 f0 = (u32x4){cvtpk(FB[0], FB[1]), cvtpk(FB[2], FB[3]), cvtpk(FB[4], FB[5]), cvtpk(FB[6], FB[7])};
    const u32x4 f1 = (u32x4){cvtpk(FB[8], FB[9]), cvtpk(FB[10], FB[11]), cvtpk(FB[12], FB[13]), cvtpk(FB[14], FB[15])};
    if (HALF == 0) { pw[0] = f0; pw[1] = f1; pw[2] = (u32x4){cvtpk(PB[0], PB[1]), cvtpk(PB[2], PB[3]), 0u, 0u}; }
    else { pw[2] = f0; pw[3] = f1; pw[1] = (u32x4){0u, 0u, cvtpk(PB[12], PB[13]), cvtpk(PB[14], PB[15])}; }
    if (resc) {
        float fr[16];
#pragma unroll
        for (int r = 0; r < 16; ++r) fr[r] = wsf[crow(r, hi)];
#pragma unroll
        for (int d = 0; d < 2; ++d)
#pragma unroll
            for (int r = 0; r < 16; ++r) o[d][r] *= fr[r];
    }
}
template <int HALF>
__device__ __forceinline__ void na_vload(s16x4 (&lo)[2][3], s16x4 (&hh)[2][3], lcp vb) {
    constexpr int K0 = HALF ? 1 : 0;
#pragma unroll
    for (int d0 = 0; d0 < 2; ++d0)
#pragma unroll
        for (int k = 0; k < 3; ++k) { lo[d0][k] = vtr(vb + d0 * 4096 + (K0 + k) * 1024); hh[d0][k] = vtr(vb + d0 * 4096 + (K0 + k) * 1024 + 512); }
}
template <int HALF>
__device__ __forceinline__ void na_pv(f32x16 (&o)[2], const u32x4 (&pw)[4], const s16x4 (&lo)[2][3], const s16x4 (&hh)[2][3]) {
    constexpr int K0 = HALF ? 1 : 0;
#pragma unroll
    for (int d0 = 0; d0 < 2; ++d0)
#pragma unroll
        for (int k = 0; k < 3; ++k)
            o[d0] = MFMA32(__builtin_bit_cast(bf16x8, pw[K0 + k]), ((bf16x8){lo[d0][k][0], lo[d0][k][1], lo[d0][k][2], lo[d0][k][3], hh[d0][k][0], hh[d0][k][1], hh[d0][k][2], hh[d0][k][3]}), o[d0]);
}
template <int THR>
__device__ __forceinline__ void na_unit(Frame& F, int layer, const bf16_t* qkv, bf16_t* Y, int idx) {
    const int tid = phase_tid(F.wave), lane = tid & 63, wid = F.wave, r32 = lane & 31, hi = lane >> 5;
    const int hp = (idx >> 4) & 3, rp2 = idx & 15, grp = wid >> 2;
    const int h = 2 * hp + (wid >> 2), row = 2 * rp2 + ((wid >> 1) & 1), half = wid & 1, c = 32 * half + r32;
    const size_t tokb = 0;
    LAS unsigned char* lds = F.lds;
    LAS float* wsf = (LAS float*)(lds + ATT_WSF) + wid * 128;
    LAS float* RPB = (LAS float*)(lds + ATT_TBL);
    const int rA = 2 * rp2, rB = 2 * rp2 + 1;
    const int lo = (rA - 4) < 0 ? 0 : ((rA - 4) > 24 ? 24 : (rA - 4));
    const int hr = ((rB - 4) < 0 ? 0 : ((rB - 4) > 24 ? 24 : (rB - 4))) + 7;
    const int ntile = hr - lo + 1;
    const int r0 = (row - 4) < 0 ? 0 : ((row - 4) > 24 ? 24 : (row - 4));
    const bf16_t* kbase = qkv + tokb * NQKV + COL_KA + (2 * hp) * 64; const bf16_t* vbase_g = qkv + tokb * NQKV + COL_VA + (2 * hp) * 64;
    const unsigned kvo = (unsigned)((8 * wid + (lane >> 3)) * NQKV + ((lane & 7) ^ (lane >> 3)) * 8) * 2u;
    const unsigned vvo = (unsigned)((16 * (wid & 3) + (lane >> 2)) * NQKV + (wid >> 2) * 32 + (lane & 3) * 8) * 2u;
#define NA_DMA(tt) do { const int t2_ = (tt) < ntile ? (tt) : ntile - 1; const size_t go_ = (size_t)(lo + t2_) * 64 * NQKV; LAS unsigned char* rb_ = lds + ((tt) & 3) * 32768 + wid * 1024; \
        GLDS16S(kvo, kbase + go_, rb_); GLDS16S(kvo, kbase + go_ + 64, rb_ + 8192); GLDS16S(vvo, vbase_g + go_, rb_ + 16384); GLDS16S(vvo, vbase_g + go_ + 64, rb_ + 24576); } while (0)
    NA_DMA(0); NA_DMA(1); NA_DMA(2);
    if (tid < 480) { const int dr = tid >> 5, i = tid & 31;
        RPB[tid] = (i < 31) ? arg_in(5)[((size_t)(layer * 8 + 2 * hp) * 15 + dr) * 31 + i] * LOG2E : 0.f;
        RPB[480 + tid] = (i < 31) ? arg_in(5)[((size_t)(layer * 8 + 2 * hp + 1) * 15 + dr) * 31 + i] * LOG2E : 0.f; }
    bf16x8 qr[4];
    { const bf16_t* Qw = qkv + (tokb + row * 64 + c) * NQKV + COL_QA + h * 64 + hi * 8;
#pragma unroll
      for (int d0 = 0; d0 < 4; ++d0) qr[d0] = *(const bf16x8*)(Qw + d0 * 16); }
    asm volatile("" : "+v"(qr[0]), "+v"(qr[1]), "+v"(qr[2]), "+v"(qr[3]));
    const int voff = ((lane >> 4) & 1) * 32 + (lane & 3) * 8 + (4 * hi + ((lane & 15) >> 2)) * 64 + grp * 8192;
    int koff[4];
#pragma unroll
    for (int d0 = 0; d0 < 4; ++d0) koff[d0] = r32 * 128 + (((2 * d0 + hi) ^ (r32 & 7)) << 4) + grp * 8192;
    f32x16 o[2]; o[0] = f32x16{}; o[1] = f32x16{};
    float mhat = 0.f, l = 0.f;
    u32x4 pw[4];
    ATT_WAIT_BAR(8);
    bf16x8 kf[8];
    kload(kf, (lcp)(lds), koff);
    const int c0 = (c - 8) < 0 ? 0 : ((c - 8) > 48 ? 48 : (c - 8));
    const int vbase = 4 * hi - c0;
    const int rpoff = grp * 480 + (4 * hi - c + 15);
    f32x16 cF;
    if (half == 0) na_cinit<0>(cF, 0.f, vbase); else na_cinit<1>(cF, 0.f, vbase);
#pragma unroll 1
    for (int t = 0; t < ntile; ++t) {
        const int kr = lo + t; const bool act = (kr >= r0 && kr < r0 + 8);
        lcp vb = (lcp)(lds + (t & 3) * 32768 + 16384 + voff);
        s16x4 vlo[2][3], vhh[2][3];
        if (act) {
            f32x16 p0, p1;
            int ro = rpoff; asm volatile("" : "+v"(ro));
            const LAS float* rp = RPB + (kr - row + 7) * 32 + ro;
            if (half == 0) na_scores<0, THR>(p0, p1, kf, qr, cF, o, mhat, l, kr == r0, rp, vbase, wsf, r32, hi, pw, vb, vlo, vhh);
            else           na_scores<1, THR>(p0, p1, kf, qr, cF, o, mhat, l, kr == r0, rp, vbase, wsf, r32, hi, pw, vb, vlo, vhh);
        }
        if (grp == 1) { ATT_WAIT_BAR(4); NA_DMA(t + 3); if (t + 1 < ntile) kload(kf, (lcp)(lds + ((t + 1) & 3) * 32768), koff); }
        __builtin_amdgcn_sched_barrier(0);
        if (act) { if (half == 0) na_pv<0>(o, pw, vlo, vhh); else na_pv<1>(o, pw, vlo, vhh); }
        if (grp == 0) { ATT_WAIT_BAR(4); NA_DMA(t + 3); if (t + 1 < ntile) kload(kf, (lcp)(lds + ((t + 1) & 3) * 32768), koff); }
    }
    ATT_WAIT_BAR(0);
#undef NA_DMA
    float rli[16]; row_inv_l(l, rli, wsf, r32, hi);
    LAS bf16_t* stg = (LAS bf16_t*)(lds + 65536) + wid * 2048;
#pragma unroll
    for (int d = 0; d < 2; ++d)
#pragma unroll
        for (int r = 0; r < 16; ++r) { const float v = o[d][r] * rli[r]; stg[crow(r, hi) * 64 + d * 32 + r32] = (bf16_t)(cvtpk(v, v) & 0xffffu); }
    bf16_t* yb = Y + (tokb + row * 64 + 32 * half + (lane >> 3)) * D + h * 64 + (lane & 7) * 8;
#pragma unroll
    for (int i = 0; i < 4; ++i) { const u32x4 v = *(const LAS u32x4*)(stg + (i * 8 + (lane >> 3)) * 64 + (lane & 7) * 8); store16_wt(yb + (size_t)i * 8 * D, v); }
    ATT_WAIT_BAR(0);
}
}

struct Args { const float* in[14]; float* out; unsigned char* ws; };
__global__ void __launch_bounds__(NWAVES * 64, 2) enc_fwd(Args args) {
    extern __shared__ __attribute__((aligned(16))) unsigned char lds[];
    Frame F;
    F.lds = (LAS unsigned char*)lds;
    F.wave = __builtin_amdgcn_readfirstlane((int)threadIdx.x >> 6); F.G = gridDim.x; { const int bx = blockIdx.x; F.vcu = (F.G % 8 == 0) ? (bx % 8) * (F.G / 8) + bx / 8 : bx; }
    F.out = args.out; F.ws = args.ws;
    unsigned char* ws = args.ws;
    volatile LAS unsigned* MISC = (volatile LAS unsigned*)(F.lds + MISC_OFF);
    for (int u = threadIdx.x; u < (LDS_BYTES - LDSCTL_OFF) / 4; u += NWAVES * 64) ((LAS unsigned*)(F.lds + LDSCTL_OFF))[u] = 0u;
    __syncthreads();
    XcdBarrier bar; bar.bar = (unsigned*)(ws + WS_CTL) + CW_BAR; bar.x = 0; bar.st = nullptr; bar.wave = F.wave;
    bar = xcd_barrier_post((unsigned*)(ws + WS_CTL) + CW_BAR, MISC + 8, F.wave);
    p0_prologue(F);
    xcd_barrier(bar);
    const unsigned xcc = bar.x;
    const int nloc = __builtin_amdgcn_readfirstlane((int)MISC[8]), nx = __builtin_amdgcn_readfirstlane((int)MISC[9]);
    const int rank = __builtin_amdgcn_readfirstlane((int)MISC[10]), xi = __builtin_amdgcn_readfirstlane((int)MISC[11]);
    unsigned* lbar = (unsigned*)(ws + WS_CTL) + CW_BAR;
    unsigned lgen = 0;
#define LSEAM() xcc_local_barrier(lbar, xcc, (unsigned)nloc, F.wave, lgen)
#pragma unroll 1
    for (int bb = xi; bb < BATCH; bb += nx) {
        unsigned char* breg = ws + WS_QKV + (size_t)bb * BREG;
        bf16_t* QKVb = (bf16_t*)breg; bf16_t* GATESb = (bf16_t*)(breg + BREG_GATES); bf16_t* MERGEDb = (bf16_t*)breg; bf16_t* HBb = (bf16_t*)breg;
        bf16_t* XBb = (bf16_t*)(ws + WS_XNY) + (size_t)bb * MB * D; float* SSb = (float*)(ws + WS_SS) + (size_t)bb * MB * 4;
        bf16_t* Yb = (bf16_t*)((unsigned char*)F.out + (size_t)bb * MB * D * 4);
        float* OUTb = F.out + (size_t)bb * MB * D;
#pragma unroll 1
        for (int L = 0; L < DEPTH; ++L) {
            unsigned char* wb = ws + WS_W + (size_t)L * W_LAYER;
            {
                pg8::Gemm g{XBb, (const bf16_t*)(wb + WO_IN), MB, NIN, D}; pg8::BatchOrder S{NIN / 256, nloc, rank};
                pg8::EpiProj E{QKVb, GATESb, SSb};
                pg8::gemm_phase<pg8::EpiProj, pg8::BatchOrder, true, true>(F.lds + RING_OFF, g, S, E, F.wave);
            }
            LSEAM();
            {
#pragma unroll 1
                for (int u = 2 * rank; u < 64; u += 2 * nloc) { att::diff_unit<8>(F, L, QKVb, Yb, u >> 4, u & 15); att::diff_unit<8>(F, L, QKVb, Yb, (u + 1) >> 4, (u + 1) & 15); }
#pragma unroll 1
                for (int u = 2 * rank; u < 64; u += 2 * nloc) { att::na_unit<8>(F, L, QKVb, Yb, u); att::na_unit<8>(F, L, QKVb, Yb, u + 1); }
            }
            LSEAM();
            {
                pg8::Gemm g{Yb, (const bf16_t*)(wb + WO_M), MB, D, D}; pg8::BatchOrder S{D / 256, nloc, rank};
                pg8::EpiMerge E{MERGEDb, GATESb};
                pg8::gemm_phase<pg8::EpiMerge, pg8::BatchOrder, true, true>(F.lds + RING_OFF, g, S, E, F.wave);
            }
            LSEAM();
            {
                pg8::Gemm g{MERGEDb, (const bf16_t*)(wb + WO_OUT), MB, D, D}; pg8::BatchOrder S{D / 256, nloc, rank};
                pg8::EpiResid E{XBb, SSb, {}};
                pg8::gemm_phase<pg8::EpiResid, pg8::BatchOrder, true, true>(F.lds + RING_OFF, g, S, E, F.wave);
            }
            LSEAM();
            {
                pg8::Gemm g{XBb, (const bf16_t*)(wb + WO_FF1), MB, FF, D}; pg8::BatchOrder S{FF / 256, nloc, rank};
                pg8::EpiFF1 E{HBb, SSb};
                pg8::gemm_phase<pg8::EpiFF1, pg8::BatchOrder, true, true>(F.lds + RING_OFF, g, S, E, F.wave);
            }
            LSEAM();
            {
                pg8::Gemm g{HBb, (const bf16_t*)(wb + WO_FF2), MB, D, FF}; pg8::BatchOrder S{D / 256, nloc, rank};
                if (L + 1 < DEPTH) { pg8::EpiResid E{XBb, SSb, {}};
                    pg8::gemm_phase<pg8::EpiResid, pg8::BatchOrder, true, true>(F.lds + RING_OFF, g, S, E, F.wave); }
                else { pg8::EpiFinal E{XBb, SSb, arg_in(2), OUTb, (unsigned*)(ws + WS_CTL) + CW_PANEL + bb * 8 * 64, {}};
                    pg8::gemm_phase<pg8::EpiFinal, pg8::BatchOrder, true, true>(F.lds + RING_OFF, g, S, E, F.wave); }
            }
            if (L + 1 < DEPTH) LSEAM();
        }
        if (bb + nx < BATCH) LSEAM();
    }
#undef LSEAM
}

extern "C" void kernel_launch(void* const* d_in, const int* in_sizes, int n_in, void* d_out, int out_size, void* d_ws, size_t ws_size, hipStream_t stream) {
    static int grid = 0;
    if (grid == 0) {
        if (n_in != 14 || in_sizes[0] != M * D || out_size != M * D || ws_size < WS_END) { fprintf(stderr, "kernel_launch: unexpected shapes (n_in %d, in0 %d, out %d, ws %zu); nothing launched\n", n_in, n_in > 0 ? in_sizes[0] : -1, out_size, ws_size); grid = -1; return; }
        int dev = 0, cus = 0;
        if (hipGetDevice(&dev) != hipSuccess || hipDeviceGetAttribute(&cus, hipDeviceAttributeMultiprocessorCount, dev) != hipSuccess) { grid = -1; return; }
        if (hipFuncSetAttribute((const void*)enc_fwd, hipFuncAttributeMaxDynamicSharedMemorySize, LDS_BYTES) != hipSuccess) { fprintf(stderr, "kernel_launch: hipFuncSetAttribute failed\n"); grid = -1; return; }
        int per_cu = 0;
        if (hipOccupancyMaxActiveBlocksPerMultiprocessor(&per_cu, (const void*)enc_fwd, NWAVES * 64, LDS_BYTES) != hipSuccess || per_cu < 1) fprintf(stderr, "kernel_launch: occupancy query reports %d per CU\n", per_cu);
        (void)hipGetLastError();
        grid = cus;
    }
    if (grid < 0) return;
    Args a{};
    for (int i = 0; i < 14; ++i) a.in[i] = (const float*)d_in[i];
    a.out = (float*)d_out; a.ws = (unsigned char*)d_ws;
    if (hipMemsetAsync((char*)d_ws + WS_CTL, 0, CTL_ZERO_BYTES, stream) != hipSuccess) { fprintf(stderr, "kernel_launch: memset failed\n"); return; }
    hipLaunchKernelGGL(enc_fwd, dim3(grid), dim3(NWAVES * 64), LDS_BYTES, stream, a);
}
```

```cpp
#include <hip/hip_runtime.h>
#include <cstdio>
#include <cstdint>

#define LAS __attribute__((address_space(3)))
#define GAS __attribute__((address_space(1)))
typedef unsigned short bf16_t;
typedef short bf16x8 __attribute__((ext_vector_type(8)));
typedef short s16x4 __attribute__((ext_vector_type(4)));
typedef float f32x4 __attribute__((ext_vector_type(4)));
typedef float f32x2 __attribute__((ext_vector_type(2)));
typedef float f32x16 __attribute__((ext_vector_type(16)));
typedef unsigned u32x4 __attribute__((ext_vector_type(4)));
typedef unsigned u32x2 __attribute__((ext_vector_type(2)));
typedef __bf16 bf16x2_t __attribute__((ext_vector_type(2)));

constexpr int BATCH = 8, SEQ = 2048, D = 1024, M = BATCH * SEQ, DEPTH = 2, FF = 4096;
constexpr int NQKV = 3072, NGATE = 2048, NIN = 5120;
constexpr int MB = SEQ;
constexpr float RMS_EPS = 1e-6f;
constexpr float LOG2E = 1.4426950408889634f;
constexpr float C2 = 0.125f * LOG2E;
constexpr int COL_QA = 0, COL_KA = 512, COL_VA = 1024, COL_QD = 1536, COL_KD = 2048, COL_VD = 2560;

__device__ __forceinline__ unsigned cvtpk(float lo, float hi) { f32x2 v = {lo, hi}; bf16x2_t b = __builtin_convertvector(v, bf16x2_t); return __builtin_bit_cast(unsigned, b); }
__device__ __forceinline__ float bf2f(unsigned short u) { return __uint_as_float((unsigned)u << 16); }
__device__ __forceinline__ float bflo(unsigned w) { return __uint_as_float(w << 16); }
__device__ __forceinline__ float bfhi(unsigned w) { return __uint_as_float(w & 0xffff0000u); }

__device__ __forceinline__ unsigned lane_id_now() { unsigned l; asm volatile("v_mbcnt_lo_u32_b32 %0, -1, 0\n\tv_mbcnt_hi_u32_b32 %0, -1, %0" : "=v"(l)); return l; }
__device__ __forceinline__ void store16_wt(void* p, u32x4 v) { asm volatile("global_store_dwordx4 %0, %1, off sc1\n\ts_nop 1" :: "v"(p), "v"(v) : "memory"); }
#define DPP_ADD(v, ctrl) ((v) + __uint_as_float((unsigned)__builtin_amdgcn_update_dpp(0, (int)__float_as_uint(v), (ctrl), 0xF, 0xF, true)))
__device__ __forceinline__ float sum_row16(float v) {
    v = DPP_ADD(v, 0xB1); v = DPP_ADD(v, 0x4E); v = DPP_ADD(v, 0x141); v = DPP_ADD(v, 0x140); return v; }
__device__ __forceinline__ float sum_xor16(float v) { auto rr = __builtin_amdgcn_permlane16_swap(__float_as_uint(v), __float_as_uint(v), false, false); return __uint_as_float(rr[0]) + __uint_as_float(rr[1]); }
__device__ __forceinline__ float sum_xor32(float v) { auto rr = __builtin_amdgcn_permlane32_swap(__float_as_uint(v), __float_as_uint(v), false, false); return __uint_as_float(rr[0]) + __uint_as_float(rr[1]); }
__device__ __forceinline__ float sum_half32(float v) { return sum_xor16(sum_row16(v)); }
namespace pg8 {
constexpr int BM = 256, BK = 64, HALF = 128, HTB = HALF * BK * 2, STAGE_BYTES = 8 * HTB, NXCD = 8, WGM = 8;
__host__ __device__ __forceinline__ int lds_byte(int r, int c) { const int st = (r >> 4) * 2 + (c >> 5), rr = r & 15, cc = c & 31, ob = rr * 64 + cc * 2; return st * 1024 + (ob ^ (((ob >> 9) & 1) << 5)); }
__host__ __device__ __forceinline__ void stage_rc(int b, int& R, int& C) { const int st = b / 1024, sb = b % 1024, swz = sb ^ (((sb >> 9) & 1) << 5); R = (st >> 1) * 16 + swz / 64; C = (st & 1) * 32 + (swz % 64) / 2; }
__host__ __device__ __forceinline__ int perm32(int rho) { const int n = rho >> 4, i = rho & 15; return 8 * (i >> 2) + 4 * n + (i & 3); }

struct Unit { int pm, pn; };
struct Gemm { const bf16_t* A; const bf16_t* Bt; int M, N, K; };

struct BatchOrder {
    int nN, nloc, rank;
    __device__ bool next(int i, Unit& u) const { const int L = i * nloc + rank; if (L >= 8 * nN) return false; u.pm = L & 7; u.pn = L >> 3; return true; }
};

__device__ __forceinline__ float row_rstd(const float* ss, int row) {
    const f32x4 a = *(const f32x4*)(ss + (size_t)row * 4);
    const float s = (a[0] + a[1]) + (a[2] + a[3]);
    return 1.0f / sqrtf(s * (1.0f / (float)D) + RMS_EPS);
}

struct EpiProj {
    static constexpr bool HAS_POST = false, HAS_RTAB = true;
    static constexpr bool PERM = true, HAS_MID = false;
    bf16_t* qkv; bf16_t* gates; const float* ss; LAS float* rtab;
    __device__ __forceinline__ void mid(f32x4 (&acc)[2][2][4][2], const Unit& u, int wr, int wc, int fr, int fq) const {}
    __device__ __forceinline__ void operator()(f32x4 (&acc)[2][2][4][2], const Unit& u, int wr, int wc, int fr, int fq) const {
        const int row0 = u.pm * BM + wr * 64 + fr;
        float rs[2][4];
        if (rtab) {
#pragma unroll
            for (int ai = 0; ai < 2; ++ai)
#pragma unroll
                for (int m = 0; m < 4; ++m) rs[ai][m] = rtab[wr * 64 + fr + ai * HALF + m * 16];
        } else {
#pragma unroll
            for (int ai = 0; ai < 2; ++ai)
#pragma unroll
                for (int m = 0; m < 4; ++m) rs[ai][m] = row_rstd(ss, row0 + ai * HALF + m * 16);
        }
        if (u.pn < 12) {
            const float sc = (u.pn < 2 || u.pn == 6 || u.pn == 7) ? C2 : 1.0f;
            const int col0 = u.pn * BM + wc * 32 + 8 * fq;
#pragma unroll
            for (int ai = 0; ai < 2; ++ai)
#pragma unroll
                for (int m = 0; m < 4; ++m) { const int row = row0 + ai * HALF + m * 16; const float r = rs[ai][m] * sc; bf16_t* rowp = qkv + (size_t)row * NQKV + col0;
#pragma unroll
                    for (int bj = 0; bj < 2; ++bj) { const f32x4 v0 = acc[ai][bj][m][0] * r, v1 = acc[ai][bj][m][1] * r;
                        u32x4 w; w.x = cvtpk(v0[0], v0[1]); w.y = cvtpk(v0[2], v0[3]); w.z = cvtpk(v1[0], v1[1]); w.w = cvtpk(v1[2], v1[3]);
                        store16_wt(rowp + bj * HALF, w); } }
        } else {
            const int col0 = (u.pn - 12) * HALF + wc * 32 + 8 * fq;
#pragma unroll
            for (int ai = 0; ai < 2; ++ai)
#pragma unroll
                for (int m = 0; m < 4; ++m) { const int row = row0 + ai * HALF + m * 16; const float r = rs[ai][m]; float rho[8], sg[8];
#pragma unroll
                    for (int n = 0; n < 2; ++n)
#pragma unroll
                        for (int e = 0; e < 4; ++e) { const float ga = acc[ai][0][m][n][e] * r, gd = fmaxf(acc[ai][1][m][n][e] * r, -80.f);
                            const float ed = 1.f + __expf(-gd), ea = 1.f + __expf(-ga); rho[4 * n + e] = ed * __builtin_amdgcn_rcpf(ea); sg[4 * n + e] = __builtin_amdgcn_rcpf(ed); }
                    u32x4 w; w.x = cvtpk(rho[0], rho[1]); w.y = cvtpk(rho[2], rho[3]); w.z = cvtpk(rho[4], rho[5]); w.w = cvtpk(rho[6], rho[7]);
                    store16_wt(gates + (size_t)row * D + col0, w);
                    w.x = cvtpk(sg[0], sg[1]); w.y = cvtpk(sg[2], sg[3]); w.z = cvtpk(sg[4], sg[5]); w.w = cvtpk(sg[6], sg[7]);
                    store16_wt(gates + (size_t)MB * D + (size_t)row * D + col0, w); }
        }
    }
};
struct EpiFF1 {
    static constexpr bool HAS_POST = false, HAS_RTAB = true;
    static constexpr bool PERM = true, HAS_MID = false;
    bf16_t* H; const float* ss; LAS float* rtab;
    __device__ __forceinline__ void mid(f32x4 (&acc)[2][2][4][2], const Unit& u, int wr, int wc, int fr, int fq) const {}
    __device__ __forceinline__ void operator()(f32x4 (&acc)[2][2][4][2], const Unit& u, int wr, int wc, int fr, int fq) const {
        const int row0 = u.pm * BM + wr * 64 + fr, col0 = u.pn * BM + wc * 32 + 8 * fq;
        float rs[2][4];
        if (rtab) {
#pragma unroll
            for (int ai = 0; ai < 2; ++ai)
#pragma unroll
                for (int m = 0; m < 4; ++m) rs[ai][m] = rtab[wr * 64 + fr + ai * HALF + m * 16];
        } else {
#pragma unroll
            for (int ai = 0; ai < 2; ++ai)
#pragma unroll
                for (int m = 0; m < 4; ++m) rs[ai][m] = row_rstd(ss, row0 + ai * HALF + m * 16);
        }
#pragma unroll
        for (int ai = 0; ai < 2; ++ai)
#pragma unroll
            for (int m = 0; m < 4; ++m) { const int row = row0 + ai * HALF + m * 16; const float r = rs[ai][m]; bf16_t* rowp = H + (size_t)row * FF + col0;
#pragma unroll
                for (int bj = 0; bj < 2; ++bj) { f32x4 v0 = acc[ai][bj][m][0] * r, v1 = acc[ai][bj][m][1] * r;
#pragma unroll
                    for (int e = 0; e < 4; ++e) { const float a = fmaxf(v0[e], 0.f), b = fmaxf(v1[e], 0.f); v0[e] = a * a; v1[e] = b * b; }
                    u32x4 w; w.x = cvtpk(v0[0], v0[1]); w.y = cvtpk(v0[2], v0[3]); w.z = cvtpk(v1[0], v1[1]); w.w = cvtpk(v1[2], v1[3]);
                    store16_wt(rowp + bj * HALF, w); } }
    }
};
struct EpiMerge {
    static constexpr bool HAS_POST = false, HAS_RTAB = false;
    static constexpr bool PERM = true, HAS_MID = true;
    bf16_t* O; const bf16_t* gates;
    __device__ __forceinline__ void mid(f32x4 (&acc)[2][2][4][2], const Unit& u, int wr, int wc, int fr, int fq) const {
        const int row0 = u.pm * BM + wr * 64 + fr, col0 = u.pn * BM + wc * 32 + 8 * fq;
        const bf16_t* gp = gates + (size_t)row0 * D + col0;
        asm volatile("" : "+v"(gp) :: "memory");
        u32x4 g[2][4][2];
#pragma unroll
        for (int ai = 0; ai < 2; ++ai)
#pragma unroll
            for (int q = 0; q < 4; ++q)
#pragma unroll
                for (int bj = 0; bj < 2; ++bj) g[ai][q][bj] = *(const GAS u32x4*)(gp + (ai * HALF + q * 16) * D + bj * HALF);
        __builtin_amdgcn_sched_barrier(0);
#pragma unroll
        for (int ai = 0; ai < 2; ++ai)
#pragma unroll
            for (int q = 0; q < 4; ++q)
#pragma unroll
                for (int bj = 0; bj < 2; ++bj)
#pragma unroll
                    for (int w = 0; w < 4; ++w) { acc[ai][bj][q][w >> 1][(w & 1) * 2] *= bflo(g[ai][q][bj][w]); acc[ai][bj][q][w >> 1][(w & 1) * 2 + 1] *= bfhi(g[ai][q][bj][w]); }
    }
    __device__ __forceinline__ void operator()(f32x4 (&acc)[2][2][4][2], const Unit& u, int wr, int wc, int fr, int fq) const {
        const int row0 = u.pm * BM + wr * 64 + fr, col0 = u.pn * BM + wc * 32 + 8 * fq;
        const bf16_t* gp = gates + (size_t)MB * D + (size_t)row0 * D + col0; bf16_t* rowp = O + (size_t)row0 * D + col0;
        asm volatile("" : "+v"(gp), "+v"(rowp) :: "memory");
        u32x4 g[2][4][2];
#pragma unroll
        for (int ai = 0; ai < 2; ++ai)
#pragma unroll
            for (int q = 0; q < 4; ++q)
#pragma unroll
                for (int bj = 0; bj < 2; ++bj) g[ai][q][bj] = *(const GAS u32x4*)(gp + (ai * HALF + q * 16) * D + bj * HALF);
        __builtin_amdgcn_sched_barrier(0);
#pragma unroll
        for (int ai = 0; ai < 2; ++ai)
#pragma unroll
            for (int q = 0; q < 4; ++q)
#pragma unroll
                for (int bj = 0; bj < 2; ++bj) { float o[8];
#pragma unroll
                    for (int w = 0; w < 4; ++w) { o[2 * w] = acc[ai][bj][q][w >> 1][(w & 1) * 2] * bflo(g[ai][q][bj][w]); o[2 * w + 1] = acc[ai][bj][q][w >> 1][(w & 1) * 2 + 1] * bfhi(g[ai][q][bj][w]); }
                    u32x4 w4; w4.x = cvtpk(o[0], o[1]); w4.y = cvtpk(o[2], o[3]); w4.z = cvtpk(o[4], o[5]); w4.w = cvtpk(o[6], o[7]);
                    store16_wt((void*)(rowp + (ai * HALF + q * 16) * D + bj * HALF), w4); }
    }
};
struct EpiResid {
    static constexpr bool HAS_POST = true, HAS_RTAB = false;
    static constexpr bool PERM = true, HAS_MID = false;
    bf16_t* xb; float* ss; float qs[2][4];
    __device__ __forceinline__ void mid(f32x4 (&acc)[2][2][4][2], const Unit& u, int wr, int wc, int fr, int fq) const {}
    __device__ __forceinline__ void operator()(f32x4 (&acc)[2][2][4][2], const Unit& u, int wr, int wc, int fr, int fq) {
        const int row0 = u.pm * BM + wr * 64 + fr, col0 = u.pn * BM + wc * 32 + 8 * fq;
        u32x4 xv[2][4][2];
#pragma unroll
        for (int ai = 0; ai < 2; ++ai)
#pragma unroll
            for (int m = 0; m < 4; ++m)
#pragma unroll
                for (int bj = 0; bj < 2; ++bj) xv[ai][m][bj] = *(const GAS u32x4*)(xb + (size_t)(row0 + ai * HALF + m * 16) * D + col0 + bj * HALF);
        __builtin_amdgcn_sched_barrier(0);
#pragma unroll
        for (int ai = 0; ai < 2; ++ai) {
#pragma unroll
            for (int m = 0; m < 4; ++m) { const int row = row0 + ai * HALF + m * 16; bf16_t* rowp = xb + (size_t)row * D + col0; float q = 0.f;
#pragma unroll
                for (int bj = 0; bj < 2; ++bj) { const u32x4 x4 = xv[ai][m][bj];
                    const f32x4 y0 = (f32x4){bflo(x4.x), bfhi(x4.x), bflo(x4.y), bfhi(x4.y)} + acc[ai][bj][m][0], y1 = (f32x4){bflo(x4.z), bfhi(x4.z), bflo(x4.w), bfhi(x4.w)} + acc[ai][bj][m][1];
                    q += (y0[0] * y0[0] + y0[1] * y0[1]) + (y0[2] * y0[2] + y0[3] * y0[3]) + (y1[0] * y1[0] + y1[1] * y1[1]) + (y1[2] * y1[2] + y1[3] * y1[3]);
                    u32x4 w; w.x = cvtpk(y0[0], y0[1]); w.y = cvtpk(y0[2], y0[3]); w.z = cvtpk(y1[0], y1[1]); w.w = cvtpk(y1[2], y1[3]);
                    *(GAS u32x4*)(rowp + bj * HALF) = w; }
                q = sum_xor32(sum_xor16(q));
                qs[ai][m] = q; }
            __builtin_amdgcn_sched_barrier(0);
        }
    }
    __device__ __forceinline__ void post(LAS unsigned char* lds, f32x4 (&acc)[2][2][4][2], const Unit& u, int wr, int wc, int fr, int fq, int tid) {
        LAS float* P = (LAS float*)lds;
        if (fq == 0) {
#pragma unroll
            for (int ai = 0; ai < 2; ++ai)
#pragma unroll
                for (int m = 0; m < 4; ++m) P[(ai * HALF + wr * 64 + m * 16 + fr) * 4 + wc] = qs[ai][m];
        }
        asm volatile("s_waitcnt lgkmcnt(0)" ::: "memory"); __builtin_amdgcn_s_barrier(); asm volatile("" ::: "memory");
        if (tid < 256) { const f32x4 v = *(const LAS f32x4*)(P + tid * 4); ss[(size_t)(u.pm * BM + tid) * 4 + u.pn] = (v[0] + v[1]) + (v[2] + v[3]); }
    }
};

struct EpiFinal {
    static constexpr bool HAS_POST = true, HAS_RTAB = false;
    static constexpr bool PERM = true, HAS_MID = false;
    const bf16_t* xb; float* ss; const float* g; float* out; unsigned* cnt; float qs[2][4];
    __device__ __forceinline__ void mid(f32x4 (&acc)[2][2][4][2], const Unit& u, int wr, int wc, int fr, int fq) const {}
    __device__ __forceinline__ void operator()(f32x4 (&acc)[2][2][4][2], const Unit& u, int wr, int wc, int fr, int fq) {
        const int row0 = u.pm * BM + wr * 64 + fr, col0 = u.pn * BM + wc * 32 + 8 * fq;
        u32x4 xq[2][4][2];
#pragma unroll
        for (int ai = 0; ai < 2; ++ai)
#pragma unroll
            for (int m = 0; m < 4; ++m)
#pragma unroll
                for (int bj = 0; bj < 2; ++bj) xq[ai][m][bj] = *(const GAS u32x4*)(xb + (size_t)(row0 + ai * HALF + m * 16) * D + col0 + bj * HALF);
        __builtin_amdgcn_sched_barrier(0);
#pragma unroll
        for (int ai = 0; ai < 2; ++ai)
#pragma unroll
            for (int m = 0; m < 4; ++m) { float q = 0.f;
#pragma unroll
                for (int bj = 0; bj < 2; ++bj) { const u32x4 xv = xq[ai][m][bj];
                    const f32x4 y0 = (f32x4){bflo(xv.x), bfhi(xv.x), bflo(xv.y), bfhi(xv.y)} + acc[ai][bj][m][0], y1 = (f32x4){bflo(xv.z), bfhi(xv.z), bflo(xv.w), bfhi(xv.w)} + acc[ai][bj][m][1];
                    q += (y0[0] * y0[0] + y0[1] * y0[1]) + (y0[2] * y0[2] + y0[3] * y0[3]) + (y1[0] * y1[0] + y1[1] * y1[1]) + (y1[2] * y1[2] + y1[3] * y1[3]);
                    acc[ai][bj][m][0] = y0; acc[ai][bj][m][1] = y1; }
                q = sum_xor32(sum_xor16(q));
                qs[ai][m] = q; }
    }
    __device__ __forceinline__ void post(LAS unsigned char* lds, f32x4 (&acc)[2][2][4][2], const Unit& u, int wr, int wc, int fr, int fq, int tid) {
        LAS float* P = (LAS float*)lds;
        LAS float* S = (LAS float*)(lds + 4096);
        LAS unsigned* flag = (LAS unsigned*)(lds + 4096 + 1024);
        if (fq == 0) {
#pragma unroll
            for (int ai = 0; ai < 2; ++ai)
#pragma unroll
                for (int m = 0; m < 4; ++m) P[(ai * HALF + wr * 64 + m * 16 + fr) * 4 + wc] = qs[ai][m];
        }
        asm volatile("s_waitcnt lgkmcnt(0)" ::: "memory"); __builtin_amdgcn_s_barrier(); asm volatile("" ::: "memory");
        unsigned* pc = cnt + 64 * u.pm;
        if (tid < 256) {
            const f32x4 v = *(const LAS f32x4*)(P + tid * 4);
            __hip_atomic_store(ss + (size_t)(u.pm * BM + tid) * 4 + u.pn, (v[0] + v[1]) + (v[2] + v[3]), __ATOMIC_RELAXED, __HIP_MEMORY_SCOPE_AGENT);
            asm volatile("s_waitcnt vmcnt(0)" ::: "memory");
            if ((tid & 63) == 0) __hip_atomic_fetch_add(pc, 1u, __ATOMIC_RELAXED, __HIP_MEMORY_SCOPE_AGENT);
        }
        if (tid < 64) {
            unsigned sp = 0;
            while ((unsigned)__builtin_amdgcn_readfirstlane(__hip_atomic_load(pc, __ATOMIC_RELAXED, __HIP_MEMORY_SCOPE_AGENT)) < 16u) { __builtin_amdgcn_s_sleep(2); if (++sp > (1u << 20)) break; }
            asm volatile("s_waitcnt vmcnt(0)" ::: "memory");
            if (tid == 0) flag[0] = 1u;
        }
        asm volatile("s_waitcnt lgkmcnt(0)" ::: "memory"); __builtin_amdgcn_s_barrier(); asm volatile("" ::: "memory");
        if (tid < 256) {
            const float* sp4 = ss + (size_t)(u.pm * BM + tid) * 4; float t = 0.f;
#pragma unroll
            for (int j = 0; j < 4; ++j) t += __hip_atomic_load(sp4 + j, __ATOMIC_RELAXED, __HIP_MEMORY_SCOPE_AGENT);
            S[tid] = 1.0f / sqrtf(t * (1.0f / (float)D) + RMS_EPS);
        }
        asm volatile("s_waitcnt vmcnt(0) lgkmcnt(0)" ::: "memory"); __builtin_amdgcn_s_barrier(); asm volatile("" ::: "memory");
        const int row0 = u.pm * BM + wr * 64 + fr, col0 = u.pn * BM + wc * 32 + 8 * fq;
        f32x4 gv[2][2];
#pragma unroll
        for (int bj = 0; bj < 2; ++bj)
#pragma unroll
            for (int n = 0; n < 2; ++n) gv[bj][n] = *(const f32x4*)(g + col0 + bj * HALF + 4 * n);
#pragma unroll
        for (int ai = 0; ai < 2; ++ai)
#pragma unroll
            for (int m = 0; m < 4; ++m) { const int rl = ai * HALF + wr * 64 + m * 16 + fr; const float r = S[rl]; float* rowp = out + (size_t)(u.pm * BM + rl) * D + col0;
#pragma unroll
                for (int bj = 0; bj < 2; ++bj) { *(f32x4*)(rowp + bj * HALF) = acc[ai][bj][m][0] * r * gv[bj][0]; *(f32x4*)(rowp + bj * HALF + 4) = acc[ai][bj][m][1] * r * gv[bj][1]; } }
    }
};

template <class Epi, class Sched, bool ALIGN_EPI, bool SP2>
__device__ __forceinline__ void gemm_phase(LAS unsigned char* lds, const Gemm g, const Sched& S, Epi& E, int wave_) {
    const int tid_ = wave_ * 64 + (int)lane_id_now();
    const int tid = tid_, wid = __builtin_amdgcn_readfirstlane(tid >> 6), lane = tid & 63, wr = wid >> 2, wc = wid & 3, fr = lane & 15, fq = lane >> 4;
    const int K = g.K, nt = K / BK;
    unsigned voffA[2], voffB[2];
#pragma unroll
    for (int i = 0; i < 2; ++i) { int R, C; stage_rc(tid * 16 + i * 8192, R, C); const int Rb = Epi::PERM ? ((R & ~31) + perm32(R & 31)) : R;
        voffA[i] = (unsigned)(R * K + C) * 2u; voffB[i] = (unsigned)(Rb * K + C) * 2u; }
    const size_t kstep = (size_t)(BK * 2);
    const size_t hstep = (size_t)HALF * K * 2;
    const size_t tstep = 2 * hstep;
    const unsigned ldsw = (unsigned)wid * 1024u;
    const int aoff = lds_byte(wr * 64 + fr, fq * 8), boff = lds_byte(wc * 32 + fr, fq * 8);
#define PG8_SA(b, h) (((b) * 2 + (h)) * HTB)
#define PG8_SB(b, h) ((4 + (b) * 2 + (h)) * HTB)
#define PG8_STAGE(bufoff, gbase, voff) do { _Pragma("unroll") for (int _i = 0; _i < 2; ++_i) \
        __builtin_amdgcn_global_load_lds((const unsigned*)((const char*)(gbase) + (voff)[_i]), (LAS unsigned*)(lds + (bufoff) + ldsw + _i * 8192), 16, 0, 0); } while (0)
#define PG8_LDA(dst, b, h) do { _Pragma("unroll") for (int m = 0; m < 4; ++m) _Pragma("unroll") for (int k = 0; k < 2; ++k) dst[m][k] = *(const LAS bf16x8*)(lds + PG8_SA(b, h) + aoff + m * 2048 + k * 1024); } while (0)
#define PG8_LDB(dst, b, h) do { _Pragma("unroll") for (int n = 0; n < 2; ++n) _Pragma("unroll") for (int k = 0; k < 2; ++k) dst[n][k] = *(const LAS bf16x8*)(lds + PG8_SB(b, h) + boff + n * 2048 + k * 1024); } while (0)
#define PG8_MMA(ai, bj, At, Bt) do { __builtin_amdgcn_s_setprio(1); _Pragma("unroll") for (int m = 0; m < 4; ++m) _Pragma("unroll") for (int n = 0; n < 2; ++n) _Pragma("unroll") for (int k = 0; k < 2; ++k) \
        acc[ai][bj][m][n] = __builtin_amdgcn_mfma_f32_16x16x32_bf16(Bt[n][k], At[m][k], acc[ai][bj][m][n], 0, 0, 0); __builtin_amdgcn_s_setprio(0); } while (0)
#define PG8_WAIT_V(n) asm volatile("s_waitcnt vmcnt(" #n ")" ::: "memory")
#define PG8_WAIT_L(n) asm volatile("s_waitcnt lgkmcnt(" #n ")" ::: "memory")
#define PG8_BAR __builtin_amdgcn_s_barrier()
#define PG8_SCHED __builtin_amdgcn_sched_barrier(0)
    Unit cur, nxt; int ui = 0;
    if (!S.next(0, cur)) return;
    f32x4 acc[2][2][4][2];
#pragma unroll
    for (int a = 0; a < 2; ++a)
#pragma unroll
        for (int b = 0; b < 2; ++b)
#pragma unroll
            for (int m = 0; m < 4; ++m)
#pragma unroll
                for (int n = 0; n < 2; ++n) acc[a][b][m][n] = (f32x4){0.f, 0.f, 0.f, 0.f};
    bf16x8 At[4][2], B0[2][2], B1[2][2];
    const char* cA = (const char*)g.A + (size_t)cur.pm * tstep; const char* cB = (const char*)g.Bt + (size_t)cur.pn * tstep;
    if constexpr (SP2) {
        PG8_STAGE(PG8_SB(0, 0), cB, voffB); PG8_STAGE(PG8_SB(0, 1), cB + hstep, voffB); PG8_STAGE(PG8_SA(0, 0), cA, voffA); PG8_STAGE(PG8_SA(0, 1), cA + hstep, voffA);
        if constexpr (Epi::HAS_RTAB) { if (E.rtab && tid < 256) E.rtab[tid] = row_rstd(E.ss, cur.pm * BM + tid); }
        if (wr == 1) PG8_BAR;
        PG8_WAIT_V(2); PG8_BAR;
        PG8_STAGE(PG8_SB(1, 0), cB + kstep, voffB); PG8_STAGE(PG8_SA(1, 0), cA + kstep, voffA); PG8_STAGE(PG8_SB(1, 1), cB + hstep + kstep, voffB);
        PG8_WAIT_V(6); PG8_BAR;
    } else {
        PG8_STAGE(PG8_SB(0, 0), cB, voffB); PG8_STAGE(PG8_SA(0, 0), cA, voffA); PG8_STAGE(PG8_SB(0, 1), cB + hstep, voffB); PG8_STAGE(PG8_SA(0, 1), cA + hstep, voffA);
        if (wr == 1) PG8_BAR;
        PG8_WAIT_V(4); PG8_BAR;
        PG8_STAGE(PG8_SB(1, 0), cB + kstep, voffB); PG8_STAGE(PG8_SA(1, 0), cA + kstep, voffA); PG8_STAGE(PG8_SB(1, 1), cB + hstep + kstep, voffB);
        PG8_WAIT_V(6); PG8_BAR;
    }
    for (;;) {
        const bool has_next = S.next(ui + 1, nxt);
        const char* nA = has_next ? (const char*)g.A + (size_t)nxt.pm * tstep : cA; const char* nB = has_next ? (const char*)g.Bt + (size_t)nxt.pn * tstep : cB;
        for (int t = 0; t < nt; t += 2) {
            if constexpr (Epi::HAS_MID) { if (t == nt / 2) E.mid(acc, cur, wr, wc, fr, fq); }
            const bool last = (t == nt - 2);
            const char* a1 = cA + (size_t)(t + 1) * kstep;
            const char* a2 = last ? nA : cA + (size_t)(t + 2) * kstep; const char* b2 = last ? nB : cB + (size_t)(t + 2) * kstep;
            const char* a3 = a2 + kstep; const char* b3 = b2 + kstep;
            if constexpr (SP2) {
            PG8_LDB(B0, 0, 0); PG8_LDB(B1, 0, 1); PG8_SCHED; PG8_LDA(At, 0, 0); PG8_STAGE(PG8_SA(1, 1), a1 + hstep, voffA);
            PG8_WAIT_V(8); PG8_WAIT_L(0); PG8_BAR; PG8_MMA(0, 0, At, B0); PG8_MMA(0, 1, At, B1); PG8_BAR; PG8_SCHED;
            PG8_LDA(At, 0, 1); PG8_STAGE(PG8_SB(0, 0), b2, voffB); PG8_STAGE(PG8_SB(0, 1), b2 + hstep, voffB); PG8_STAGE(PG8_SA(0, 0), a2, voffA);
            PG8_WAIT_V(8); PG8_WAIT_L(0); PG8_BAR; PG8_MMA(1, 0, At, B0); PG8_MMA(1, 1, At, B1); PG8_BAR; PG8_SCHED;
            PG8_LDB(B0, 1, 0); PG8_LDB(B1, 1, 1); PG8_SCHED; PG8_LDA(At, 1, 0); PG8_STAGE(PG8_SA(0, 1), a2 + hstep, voffA);
            PG8_WAIT_V(8); PG8_WAIT_L(0); PG8_BAR; PG8_MMA(0, 0, At, B0); PG8_MMA(0, 1, At, B1); PG8_BAR; PG8_SCHED;
            PG8_LDA(At, 1, 1); PG8_STAGE(PG8_SB(1, 0), b3, voffB); PG8_STAGE(PG8_SB(1, 1), b3 + hstep, voffB); PG8_STAGE(PG8_SA(1, 0), a3, voffA);
            PG8_WAIT_V(8); PG8_WAIT_L(0); PG8_BAR; PG8_MMA(1, 0, At, B0); PG8_MMA(1, 1, At, B1); PG8_BAR; PG8_SCHED;
            } else {
            PG8_LDB(B0, 0, 0); PG8_SCHED; PG8_LDA(At, 0, 0); PG8_STAGE(PG8_SA(1, 1), a1 + hstep, voffA);
            PG8_WAIT_L(8); PG8_BAR; PG8_WAIT_L(0); PG8_MMA(0, 0, At, B0); PG8_BAR; PG8_SCHED;
            PG8_LDB(B1, 0, 1); PG8_STAGE(PG8_SB(0, 0), b2, voffB);
            PG8_BAR; PG8_WAIT_L(0); PG8_MMA(0, 1, At, B1); PG8_BAR;
            PG8_LDA(At, 0, 1); PG8_STAGE(PG8_SA(0, 0), a2, voffA);
            PG8_BAR; PG8_WAIT_L(0); PG8_MMA(1, 0, At, B0); PG8_BAR; PG8_SCHED;
            PG8_STAGE(PG8_SB(0, 1), b2 + hstep, voffB);
            PG8_WAIT_V(6); PG8_BAR; PG8_MMA(1, 1, At, B1); PG8_BAR;
            PG8_LDB(B0, 1, 0); PG8_SCHED; PG8_LDA(At, 1, 0); PG8_STAGE(PG8_SA(0, 1), a2 + hstep, voffA);
            PG8_WAIT_L(8); PG8_BAR; PG8_WAIT_L(0); PG8_MMA(0, 0, At, B0); PG8_BAR; PG8_SCHED;
            PG8_LDB(B1, 1, 1); PG8_STAGE(PG8_SB(1, 0), b3, voffB);
            PG8_BAR; PG8_WAIT_L(0); PG8_MMA(0, 1, At, B1); PG8_BAR;
            PG8_LDA(At, 1, 1); PG8_STAGE(PG8_SA(1, 0), a3, voffA);
            PG8_BAR; PG8_WAIT_L(0); PG8_MMA(1, 0, At, B0); PG8_BAR; PG8_SCHED;
            PG8_STAGE(PG8_SB(1, 1), b3 + hstep, voffB);
            PG8_WAIT_V(6); PG8_BAR; PG8_MMA(1, 1, At, B1); PG8_BAR;
            }
        }
        if constexpr (ALIGN_EPI) { if (wr == 0) PG8_BAR; }
        E(acc, cur, wr, wc, fr, fq);
        if (!has_next) break;
#pragma unroll
        for (int a = 0; a < 2; ++a)
#pragma unroll
            for (int b = 0; b < 2; ++b)
#pragma unroll
                for (int m = 0; m < 4; ++m)
#pragma unroll
                    for (int n = 0; n < 2; ++n) acc[a][b][m][n] = (f32x4){0.f, 0.f, 0.f, 0.f};
        cur = nxt; cA = nA; cB = nB; ++ui;
        if constexpr (ALIGN_EPI) { if (wr == 1) PG8_BAR; }
    }
    PG8_WAIT_V(0);
    if constexpr (!ALIGN_EPI) { if (wr == 0) PG8_BAR; }
    PG8_BAR;
    if constexpr (Epi::HAS_POST) E.post(lds, acc, cur, wr, wc, fr, fq, tid);
#undef PG8_SA
#undef PG8_SB
#undef PG8_STAGE
#undef PG8_LDA
#undef PG8_LDB
#undef PG8_MMA
#undef PG8_WAIT_V
#undef PG8_WAIT_L
#undef PG8_BAR
#undef PG8_SCHED
}
}

constexpr size_t MiB = 1u << 20;
constexpr size_t WS_CTL = 0, CTL_ZERO_BYTES = 64 * 1024;
constexpr size_t WS_SS = 1 * MiB;
constexpr size_t WS_W = 2 * MiB, W_LAYER = 30 * MiB;
constexpr size_t WO_IN = 0, WO_M = 10 * MiB, WO_OUT = 12 * MiB, WO_FF1 = 14 * MiB, WO_FF2 = 22 * MiB;
constexpr size_t WS_XNY = 62 * MiB;
constexpr size_t WS_QKV = 94 * MiB;
constexpr size_t BREG = 20 * MiB, BREG_GATES = 12 * MiB;
constexpr size_t WS_GATES = 190 * MiB;
constexpr size_t WS_MERGED = WS_QKV;
constexpr size_t WS_H = WS_QKV;
constexpr size_t WS_END = 254 * MiB;
constexpr int CW_BAR = 1024;
constexpr int CW_PANEL = 8192;

constexpr int RING_OFF = 0, RING_BYTES = 131072;
constexpr int ATT_WSF = 131072;
constexpr int ATT_TBL = ATT_WSF + 4096;
constexpr int LDSCTL_OFF = ATT_TBL + 4096, MISC_OFF = LDSCTL_OFF + 320;
constexpr int LDS_BYTES = 147456;
static_assert(MISC_OFF + 128 <= LDS_BYTES, "LDS map");
constexpr int NWAVES = 8;

#define RLX_AGENT __ATOMIC_RELAXED, __HIP_MEMORY_SCOPE_AGENT
#define LDS_WAIT() asm volatile("s_waitcnt lgkmcnt(0)" ::: "memory")
#define VM_WAIT() asm volatile("s_waitcnt vmcnt(0)" ::: "memory")

#define XB_TMO      128
#define XB_XCNT(j)  (256  + 64 * (j))
#define XB_XSUB(j)  (1280 + 64 * (j))
#define XB_XGEN(j)  (2304 + 64 * (j))
#define XB_TOP      3328
#define XB_TOPGEN   3392
#define XCD_BAR_WORDS 3456
#define XB_SPIN_CAP (1u << 18)
__device__ __forceinline__ unsigned xb_ld(unsigned* p)              { return __hip_atomic_load(p, __ATOMIC_RELAXED, __HIP_MEMORY_SCOPE_AGENT); }
__device__ __forceinline__ unsigned xb_add(unsigned* p, unsigned v) { return __hip_atomic_fetch_add(p, v, __ATOMIC_RELAXED, __HIP_MEMORY_SCOPE_AGENT); }
__device__ __forceinline__ unsigned xb_xcc_id() { return (unsigned)__builtin_amdgcn_s_getreg((3 << 11) | 20) & 0xFu; }
#define XB_SPIN(cond, bar) do { unsigned _sp = 0; while (cond) { __builtin_amdgcn_s_sleep(1); \
    if ((++_sp & 255u) == 0u) { if (xb_ld(&(bar)[XB_TMO])) break; if (_sp > XB_SPIN_CAP) { atomicAdd(&(bar)[XB_TMO], 1u); break; } } } } while (0)
struct XcdBarrier { unsigned* bar; unsigned x; volatile LAS unsigned* st; int wave; };
__device__ __forceinline__ bool xb_leader(int wave) { return wave == 0 && lane_id_now() == 0u; }
__device__ __forceinline__ XcdBarrier xcd_barrier_post(unsigned* bar, volatile LAS unsigned* st, int wave) {
    XcdBarrier b; b.bar = bar; b.x = xb_xcc_id(); b.st = st; b.wave = wave;
    if (xb_leader(wave)) st[2] = xb_add(&bar[XB_XCNT(b.x)], 1u);
    return b;
}
__device__ __forceinline__ void xcd_barrier_complete(unsigned* bar, unsigned x, unsigned& nloc, unsigned& nx, unsigned& xi) {
    const unsigned G = gridDim.x * gridDim.y * gridDim.z;
    unsigned sum, cnt, mine, below, sp = 0u;
    for (;;) {
        sum = 0u; cnt = 0u; mine = 0u; below = 0u;
#pragma unroll
        for (unsigned j = 0; j < 16; ++j) { const unsigned c = xb_ld(&bar[XB_XCNT(j)]); sum += c; cnt += (c > 0u) ? 1u : 0u; mine = (j == x) ? c : mine; below += (c > 0u && j < x) ? 1u : 0u; }
        if (sum == G) break;
        __builtin_amdgcn_s_sleep(1);
        if ((++sp & 255u) == 0u) { if (xb_ld(&bar[XB_TMO])) break; if (sp > XB_SPIN_CAP) { atomicAdd(&bar[XB_TMO], 1u); break; } }
    }
    nloc = mine > 0u ? mine : 1u; nx = cnt > 0u ? cnt : 1u; xi = below;
}
__device__ __forceinline__ void xcd_barrier(const XcdBarrier& b) {
    asm volatile("s_waitcnt vmcnt(0)" ::: "memory");
    __syncthreads();
    if (xb_leader(b.wave)) {
        unsigned* bar = b.bar;
        __builtin_amdgcn_s_waitcnt(0);
        unsigned nloc = b.st[0], nx = b.st[1];
        if (nloc == 0u) { unsigned xi; xcd_barrier_complete(bar, b.x, nloc, nx, xi); b.st[0] = nloc; b.st[1] = nx; b.st[3] = xi; }
        const unsigned old = xb_add(&bar[XB_XSUB(b.x)], 1u);
        const unsigned gen = old / nloc;
        if (old + 1u == (gen + 1u) * nloc) {
            __builtin_amdgcn_fence(__ATOMIC_RELEASE, "agent");
            asm volatile("s_waitcnt vmcnt(0)" ::: "memory");
            const unsigned og = xb_add(&bar[XB_TOP], 1u);
            const unsigned tg = og / nx;
            if (og + 1u == (tg + 1u) * nx) xb_add(&bar[XB_TOPGEN], 1u);
            else XB_SPIN(xb_ld(&bar[XB_TOPGEN]) == tg, bar);
            __builtin_amdgcn_fence(__ATOMIC_ACQUIRE, "agent");
            xb_add(&bar[XB_XGEN(b.x)], 1u);
            asm volatile("s_waitcnt vmcnt(0)" ::: "memory");
        } else {
            XB_SPIN(xb_ld(&bar[XB_XGEN(b.x)]) == gen, bar);
            __builtin_amdgcn_fence(__ATOMIC_ACQUIRE, "agent");
            asm volatile("s_waitcnt vmcnt(0)" ::: "memory");
        }
    }
    __syncthreads();
}

#define XL_SUB(j) (3584 + 64 * (j))
#define XL_GEN(j) (4608 + 64 * (j))
__device__ __forceinline__ void xcc_local_barrier(unsigned* bar, unsigned x, unsigned nloc, int wave, unsigned& gen) {
    if (wave == 0) asm volatile("buffer_inv sc1" ::: "memory");
    asm volatile("s_waitcnt vmcnt(0)" ::: "memory");
    __syncthreads();
    if (xb_leader(wave)) {
        __builtin_amdgcn_s_waitcnt(0);
        const unsigned old = xb_add(&bar[XL_SUB(x)], 1u);
        if (old + 1u == (gen + 1u) * nloc) xb_add(&bar[XL_GEN(x)], 1u);
        else XB_SPIN(xb_ld(&bar[XL_GEN(x)]) == gen, bar);
        asm volatile("s_waitcnt vmcnt(0)" ::: "memory");
    }
    ++gen;
    __syncthreads();
}

struct Frame {
    LAS unsigned char* lds;
    int vcu, G, wave;
    float* out; unsigned char* ws;
};
__device__ __forceinline__ int phase_tid(int wave) { return wave * 64 + (int)lane_id_now(); }
#define PHASE_IDS() const int tid_ = phase_tid(F.wave); const int tid = tid_, lane = tid & 63, wave = __builtin_amdgcn_readfirstlane(tid >> 6); (void)tid; (void)lane; (void)wave
__device__ __forceinline__ const float* arg_in(int k) { asm volatile("" : "+s"(k)); return ((const float* const __attribute__((address_space(4)))*)__builtin_amdgcn_kernarg_segment_ptr())[k]; }

__device__ __forceinline__ float wave_sum(float v) { return sum_xor32(sum_half32(v)); }
__device__ __forceinline__ void p0_transpose_item(const float* W, int N, bf16_t* WT, int ldk, int koff, LAS float* scr, int item, int lane, const float* gk = nullptr, bool gate_remap = false) {
    const int nblk = N / 32, kb = item / nblk, nb = item % nblk, k0 = 64 * kb, n0 = 32 * nb;
    int nd = n0;
    if (gate_remap && n0 >= NQKV) { const int gcol = n0 - NQKV, isd = gcol >= D, c = isd ? gcol - D : gcol; nd = NQKV + (c >> 7) * 256 + isd * 128 + (c & 127); }
    const float* src = W + (size_t)(k0 + (lane >> 3)) * N + n0 + (lane & 7) * 4;
    f32x4 v[8];
#pragma unroll
    for (int i = 0; i < 8; ++i) v[i] = *(const f32x4*)(src + (size_t)(8 * i) * N);
    if (gk) {
#pragma unroll
        for (int i = 0; i < 8; ++i) v[i] = v[i] * gk[k0 + 8 * i + (lane >> 3)]; }
#pragma unroll
    for (int i = 0; i < 8; ++i) { LAS float* d = scr + (8 * i + (lane >> 3)) * 33 + (lane & 7) * 4; d[0] = v[i][0]; d[1] = v[i][1]; d[2] = v[i][2]; d[3] = v[i][3]; }
    LDS_WAIT(); asm volatile("" ::: "memory");
    const int c = lane & 7;
#pragma unroll
    for (int j = 0; j < 4; ++j) { const int n = (lane >> 3) + 8 * j; const LAS float* s = scr + (8 * c) * 33 + n;
        u32x4 o; o.x = cvtpk(s[0 * 33], s[1 * 33]); o.y = cvtpk(s[2 * 33], s[3 * 33]); o.z = cvtpk(s[4 * 33], s[5 * 33]); o.w = cvtpk(s[6 * 33], s[7 * 33]);
        *(u32x4*)(WT + (size_t)(nd + n) * ldk + koff + k0 + 8 * c) = o; }
    LDS_WAIT(); asm volatile("" ::: "memory");
}
__device__ __forceinline__ void p0_prologue(Frame& F) {
    PHASE_IDS();
    LAS float* scr = (LAS float*)(F.lds + RING_OFF + wave * 16384);
    const int gw = F.vcu * NWAVES + wave, NGW = F.G * NWAVES;
    constexpr int I_IN = (D / 64) * (NIN / 32), I_B = (512 / 64) * (D / 32), I_O = (D / 64) * (D / 32), I_1 = (D / 64) * (FF / 32), I_2 = (FF / 64) * (D / 32);
    constexpr int NL = I_IN + 2 * I_B + I_O + I_1 + I_2, NITEMS = DEPTH * NL;
    for (int it = gw; it < NITEMS; it += NGW) {
        const int L = it / NL; int r = it % NL;
        unsigned char* wb = F.ws + WS_W + (size_t)L * W_LAYER;
        if (r < I_IN) { p0_transpose_item(arg_in(4) + (size_t)L * D * NIN, NIN, (bf16_t*)(wb + WO_IN), D, 0, scr, r, lane, arg_in(3) + L * D, true); continue; } r -= I_IN;
        if (r < I_B) { p0_transpose_item(arg_in(8) + (size_t)L * 512 * D, D, (bf16_t*)(wb + WO_M), D, 0, scr, r, lane); continue; } r -= I_B;
        if (r < I_B) { p0_transpose_item(arg_in(9) + (size_t)L * 512 * D, D, (bf16_t*)(wb + WO_M), D, 512, scr, r, lane); continue; } r -= I_B;
        if (r < I_O) { p0_transpose_item(arg_in(10) + (size_t)L * D * D, D, (bf16_t*)(wb + WO_OUT), D, 0, scr, r, lane); continue; } r -= I_O;
        if (r < I_1) { p0_transpose_item(arg_in(12) + (size_t)L * D * FF, FF, (bf16_t*)(wb + WO_FF1), D, 0, scr, r, lane, arg_in(11) + L * D); continue; } r -= I_1;
        p0_transpose_item(arg_in(13) + (size_t)L * FF * D, D, (bf16_t*)(wb + WO_FF2), FF, 0, scr, r, lane);
    }
    const float* x = arg_in(0); bf16_t* XN = (bf16_t*)(F.ws + WS_XNY); float* SS = (float*)(F.ws + WS_SS);
    for (int m0 = 2 * gw; m0 < M; m0 += 2 * NGW) {
        f32x4 v[2][4];
#pragma unroll
        for (int q = 0; q < 2; ++q)
#pragma unroll
            for (int j = 0; j < 4; ++j) v[q][j] = ((const f32x4*)(x + (size_t)(m0 + q) * D) + lane)[64 * j];
#pragma unroll
        for (int q = 0; q < 2; ++q) { const int m = m0 + q; u32x2* o8 = (u32x2*)(XN + (size_t)m * D) + lane; float s = 0.f;
#pragma unroll
            for (int j = 0; j < 4; ++j) { const f32x4 vv = v[q][j]; s += (vv[0] * vv[0] + vv[1] * vv[1]) + (vv[2] * vv[2] + vv[3] * vv[3]);
                u32x2 w; w.x = cvtpk(vv[0], vv[1]); w.y = cvtpk(vv[2], vv[3]); o8[64 * j] = w; }
            s = wave_sum(s);
            if (lane < 4) SS[(size_t)m * 4 + lane] = (lane == 0) ? s : 0.f; }
    }
}
namespace att {
typedef LAS const char* lcp;
__device__ __forceinline__ int crow(int r, int hi) { return (r & 3) + 8 * (r >> 2) + 4 * hi; }
typedef short v4i16_t __attribute__((ext_vector_type(4)));
__device__ __forceinline__ s16x4 vtr(lcp p) { return __builtin_bit_cast(s16x4, __builtin_amdgcn_ds_read_tr16_b64_v4i16((LAS v4i16_t*)p)); }
#define MFMA32(a, b, c) __builtin_amdgcn_mfma_f32_32x32x16_bf16(a, b, c, 0, 0, 0)
#define ATT_WAIT_BAR(N) asm volatile("s_waitcnt vmcnt(" #N ") lgkmcnt(0)\n\ts_barrier" ::: "memory")
#define ATT_LDS_BAR() asm volatile("s_waitcnt lgkmcnt(0)\n\ts_barrier" ::: "memory")
__device__ __forceinline__ void glds16(const void* gsrc, unsigned lds_dst) { unsigned keep;
    asm volatile("s_mov_b32 %0, m0\n\ts_mov_b32 m0, %2\n\ts_nop 0\n\tglobal_load_lds_dwordx4 %1, off\n\ts_mov_b32 m0, %0" : "=&s"(keep) : "v"(gsrc), "s"(lds_dst) : "memory"); }
#define GLDS16(gsrc, ldsdst) glds16((const void*)(gsrc), (unsigned)__builtin_amdgcn_readfirstlane((int)(unsigned)(uintptr_t)(ldsdst)))
__device__ __forceinline__ void glds16s(unsigned voff, const void* sbase, unsigned lds_dst) { unsigned keep;
    asm volatile("s_mov_b32 %0, m0\n\ts_mov_b32 m0, %2\n\ts_nop 2\n\tglobal_load_lds_dwordx4 %1, %3\n\ts_mov_b32 m0, %0" : "=&s"(keep) : "v"(voff), "s"(lds_dst), "s"(sbase) : "memory"); }
#define GLDS16S(voff, sbase, ldsdst) glds16s((voff), (const void*)(sbase), (unsigned)__builtin_amdgcn_readfirstlane((int)(unsigned)(uintptr_t)(ldsdst)))
#define ATT_BAR_IF(cond, N) do { if (cond) ATT_WAIT_BAR(N); } while (0)
#define MX3(a, b, c) __builtin_fmaxf(__builtin_fmaxf((a), (b)), (c))

__device__ __forceinline__ void kload(bf16x8 (&kf)[8], lcp kslot, const int (&koff)[4]) {
#pragma unroll
    for (int d0 = 0; d0 < 4; ++d0) { kf[2 * d0] = *(const LAS bf16x8*)(kslot + koff[d0]); kf[2 * d0 + 1] = *(const LAS bf16x8*)(kslot + koff[d0] + 4096); }
}
__device__ __forceinline__ void qk_mfma(f32x16& p0, f32x16& p1, const bf16x8 (&kf)[8], const bf16x8* qr, const f32x16& cinit) {
    p0 = MFMA32(kf[0], qr[0], cinit); p1 = MFMA32(kf[1], qr[0], cinit);
#pragma unroll
    for (int d0 = 1; d0 < 4; ++d0) { p0 = MFMA32(kf[2 * d0], qr[d0], p0); p1 = MFMA32(kf[2 * d0 + 1], qr[d0], p1); }
}
__device__ __forceinline__ float rowmax32(const f32x16& p0, const f32x16& p1) {
    float a = MX3(p0[0], p0[1], p1[0]), b = MX3(p0[2], p0[3], p1[1]); a = MX3(a, p1[2], p1[3]);
#pragma unroll
    for (int r = 4; r < 16; r += 4) { a = MX3(a, p0[r], p0[r + 1]); b = MX3(b, p0[r + 2], p0[r + 3]); a = MX3(a, p1[r], p1[r + 1]); b = MX3(b, p1[r + 2], p1[r + 3]); }
    a = __builtin_fmaxf(a, b);
    auto rr = __builtin_amdgcn_permlane32_swap(__float_as_uint(a), __float_as_uint(a), false, false);
    return __builtin_fmaxf(__uint_as_float(rr[0]), __uint_as_float(rr[1]));
}
template <int NB, int THR>
__device__ __forceinline__ bool softmax_part(f32x16& p0, f32x16& p1, f32x16 (&o)[NB], float& mhat, float& l, bool first, LAS float* wsf, int r32, int hi, u32x4 (&pw)[4]) {
    const float rm = rowmax32(p0, p1);
    bool resc = false, moved = false;
    if (first) {
        mhat += rm; moved = true;
#pragma unroll
        for (int r = 0; r < 16; ++r) { p0[r] -= rm; p1[r] -= rm; }
    } else if (__any(rm > (float)THR)) {
        const float dl = fmaxf(rm, 0.f); mhat += dl; moved = true; resc = true;
#pragma unroll
        for (int r = 0; r < 16; ++r) { p0[r] -= dl; p1[r] -= dl; }
        const float f = __builtin_amdgcn_exp2f(-dl); l *= f; if (hi == 0) wsf[r32] = f;
    }
    float s = 0.f;
#pragma unroll
    for (int r = 0; r < 16; ++r) { p0[r] = __builtin_amdgcn_exp2f(p0[r]); p1[r] = __builtin_amdgcn_exp2f(p1[r]); s += p0[r] + p1[r]; }
    l += s;
    pw[0] = (u32x4){cvtpk(p0[0], p0[1]), cvtpk(p0[2], p0[3]), cvtpk(p0[4], p0[5]), cvtpk(p0[6], p0[7])};
    pw[1] = (u32x4){cvtpk(p0[8], p0[9]), cvtpk(p0[10], p0[11]), cvtpk(p0[12], p0[13]), cvtpk(p0[14], p0[15])};
    pw[2] = (u32x4){cvtpk(p1[0], p1[1]), cvtpk(p1[2], p1[3]), cvtpk(p1[4], p1[5]), cvtpk(p1[6], p1[7])};
    pw[3] = (u32x4){cvtpk(p1[8], p1[9]), cvtpk(p1[10], p1[11]), cvtpk(p1[12], p1[13]), cvtpk(p1[14], p1[15])};
    if (resc) {
        float fr[16];
#pragma unroll
        for (int r = 0; r < 16; ++r) fr[r] = wsf[crow(r, hi)];
#pragma unroll
        for (int d = 0; d < NB; ++d)
#pragma unroll
            for (int r = 0; r < 16; ++r) o[d][r] *= fr[r];
    }
    return moved;
}
__device__ __forceinline__ void vload0(s16x4 (&lo)[4], s16x4 (&hh)[4], lcp vb) {
#pragma unroll
    for (int ks = 0; ks < 4; ++ks) { lo[ks] = vtr(vb + ks * 1024); hh[ks] = vtr(vb + ks * 1024 + 512); }
}
template <int NB>
__device__ __forceinline__ void pv_part(f32x16 (&o)[NB], lcp vb, const u32x4 (&pw)[4], const s16x4 (&lo0)[4], const s16x4 (&hh0)[4]) {
    s16x4 lo[2][4], hh[2][4];
#pragma unroll
    for (int ks = 0; ks < 4; ++ks) { lo[0][ks] = lo0[ks]; hh[0][ks] = hh0[ks]; }
#pragma unroll
    for (int d0 = 0; d0 < NB; ++d0) {
        if (d0 + 1 < NB) {
#pragma unroll
            for (int ks = 0; ks < 4; ++ks) { lo[(d0 + 1) & 1][ks] = vtr(vb + (d0 + 1) * 4096 + ks * 1024); hh[(d0 + 1) & 1][ks] = vtr(vb + (d0 + 1) * 4096 + ks * 1024 + 512); }
        }
        __builtin_amdgcn_sched_barrier(0);
#define ATT_PK(k) (bf16x8){lo[d0 & 1][k][0], lo[d0 & 1][k][1], lo[d0 & 1][k][2], lo[d0 & 1][k][3], hh[d0 & 1][k][0], hh[d0 & 1][k][1], hh[d0 & 1][k][2], hh[d0 & 1][k][3]}
        o[d0] = MFMA32(__builtin_bit_cast(bf16x8, pw[0]), ATT_PK(0), o[d0]);
        o[d0] = MFMA32(__builtin_bit_cast(bf16x8, pw[1]), ATT_PK(1), o[d0]);
        o[d0] = MFMA32(__builtin_bit_cast(bf16x8, pw[2]), ATT_PK(2), o[d0]);
        o[d0] = MFMA32(__builtin_bit_cast(bf16x8, pw[3]), ATT_PK(3), o[d0]);
#undef ATT_PK
        __builtin_amdgcn_sched_barrier(0);
    }
}
__device__ __forceinline__ void row_inv_l(float l, float (&rli)[16], LAS float* wsf, int r32, int hi) {
    auto rr = __builtin_amdgcn_permlane32_swap(__float_as_uint(l), __float_as_uint(l), false, false);
    const float lt = __uint_as_float(rr[0]) + __uint_as_float(rr[1]);
    if (hi == 0) wsf[32 + r32] = lt;
#pragma unroll
    for (int r = 0; r < 16; ++r) rli[r] = __builtin_amdgcn_rcpf(wsf[32 + crow(r, hi)]);
}
__device__ __forceinline__ int t5_bucket(int rel) {
    const int n = rel < 0 ? -rel : rel;
    const int large = 8 + (n >= 12) + (n >= 16) + (n >= 23) + (n >= 32) + (n >= 46) + (n >= 64) + (n >= 91);
    return (rel > 0 ? 16 : 0) + (n < 8 ? n : large);
}


template <int THR>
__device__ __forceinline__ void diff_unit(Frame& F, int layer, const bf16_t* qkv, bf16_t* Y, int h, int qb) {
    const int tid = phase_tid(F.wave), wid = F.wave;
    const int mp = wid >> 2, wq = wid & 3;
    const size_t tokb = 0;
    LAS unsigned char* lds = F.lds;
    LAS float* wsf = (LAS float*)(lds + ATT_WSF) + wid * 128;
    LAS float* TBL = (LAS float*)(lds + ATT_TBL);
    constexpr int NT = SEQ / 64;
    f32x16 o[4]; float l = 0.f;
    float lpv[4], sgv[4];
    {
    const int lane = tid & 63, r32 = lane & 31, hi = lane >> 5;
    const bf16_t* kbase = qkv + tokb * NQKV + COL_KD + h * 128; const bf16_t* vbase_g = qkv + tokb * NQKV + COL_VD + h * 128;
#define DIFF_KVO(L_) ((unsigned)((8 * wid + ((L_) >> 3)) * NQKV + (((L_) & 7) ^ ((L_) >> 3)) * 8) * 2u)
#define DIFF_VVO(L_) ((unsigned)((16 * (wid & 3) + ((L_) >> 2)) * NQKV + (wid >> 2) * 32 + ((L_) & 3) * 8) * 2u)
#define DIFF_DMA_K(t) do { if ((t) < NT) { const size_t go_ = (size_t)(t) * 64 * NQKV; LAS unsigned char* rb_ = lds + ((t) & 3) * 16384 + wid * 1024; \
        int ld_ = lane; asm volatile("" : "+v"(ld_)); const unsigned kvo_ = DIFF_KVO(ld_); GLDS16S(kvo_, kbase + go_, rb_); GLDS16S(kvo_, kbase + go_ + 64, rb_ + 8192); } } while (0)
#define DIFF_DMA_V(t) do { if ((t) < NT) { const size_t go_ = (size_t)(t) * 64 * NQKV; LAS unsigned char* rb_ = lds + 65536 + ((t) & 3) * 16384 + wid * 1024; \
        int ld_ = lane; asm volatile("" : "+v"(ld_)); const unsigned vvo_ = DIFF_VVO(ld_); GLDS16S(vvo_, vbase_g + go_, rb_); GLDS16S(vvo_, vbase_g + go_ + 64, rb_ + 8192); } } while (0)
#define DIFF_WAIT_BAR(t) asm volatile("s_waitcnt vmcnt(8)\n\ts_cmp_lt_i32 %0, %1\n\ts_cbranch_scc1 .Ldw%=\n\ts_waitcnt vmcnt(6)\n\ts_cmp_lt_i32 %0, %2\n\ts_cbranch_scc1 .Ldw%=\n\ts_waitcnt vmcnt(2)\n\ts_cmp_lt_i32 %0, %3\n\ts_cbranch_scc1 .Ldw%=\n\ts_waitcnt vmcnt(0)\n.Ldw%=:\n\ts_waitcnt lgkmcnt(0)\n\ts_barrier" \
        :: "s"((int)(t)), "n"(NT - 3), "n"(NT - 2), "n"(NT - 1) : "scc", "memory")
    DIFF_DMA_K(0); DIFF_DMA_K(1); DIFF_DMA_V(0); DIFF_DMA_K(2); DIFF_DMA_V(1);
    float tv = arg_in(1)[t5_bucket((tid < 257 ? tid : 256) - 128) * 4 + h];
    bf16x8 qr[4];
    { const bf16_t* Qw = qkv + (tokb + qb * 128 + wq * 32 + r32) * NQKV + COL_QD + h * 128 + mp * 64 + hi * 8;
#pragma unroll
      for (int d0 = 0; d0 < 4; ++d0) qr[d0] = *(const bf16x8*)(Qw + d0 * 16); }
    asm volatile("" : "+v"(tv), "+v"(qr[0]), "+v"(qr[1]), "+v"(qr[2]), "+v"(qr[3]));
    if (tid < 257) TBL[tid] = tv * LOG2E;
    const int voff = ((lane >> 4) & 1) * 32 + (lane & 3) * 8 + (4 * hi + ((lane & 15) >> 2)) * 64;
    o[0] = f32x16{}; o[1] = f32x16{}; o[2] = f32x16{}; o[3] = f32x16{};
    float mhat = 0.f;
    const int qw0 = qb * 128 + wq * 32;
    ATT_WAIT_BAR(8);
    const float tL = __uint_as_float((unsigned)__builtin_amdgcn_readfirstlane((int)__float_as_uint(TBL[0]))), tR = __uint_as_float((unsigned)__builtin_amdgcn_readfirstlane((int)__float_as_uint(TBL[256])));
    bf16x8 kf[8]; f32x16 p0, p1, cinit; u32x4 pwA[4], pwB[4]; s16x4 vlo[2][4], vhh[2][4]; bool moved = false; int zc_id;
    { const int dk0 = 0 - qw0; zc_id = (dk0 >= 122) ? 1 : 2; const float c0 = (zc_id == 1 ? tR : tL);
#pragma unroll
      for (int r = 0; r < 16; ++r) cinit[r] = c0; }
#define SBAR() __builtin_amdgcn_sched_barrier(0)
#define PIN(x) asm volatile("" : "+v"(x))
#define DIFF_SCORES(t, FIRST) do { \
        { int rk_ = r32; asm volatile("" : "+v"(rk_)); int koff[4];                       \
          _Pragma("unroll") for (int d0 = 0; d0 < 4; ++d0) koff[d0] = rk_ * 128 + (((2 * d0 + hi) ^ (rk_ & 7)) << 4); \
          kload(kf, (lcp)(lds + ((t) & 3) * 16384 + mp * 8192), koff); } \
        SBAR();                                                                     \
        qk_mfma(p0, p1, kf, qr, cinit); \
        SBAR(); \
        DIFF_DMA_K((t) + 3); DIFF_DMA_V((t) + 2); \
        const int dk_ = (t) * 64 - qw0; const int zone_ = (dk_ >= 122) ? 1 : ((dk_ <= -154) ? 2 : 0); \
        if (zone_ == 0) { int rq_ = r32; asm volatile("" : "+v"(rq_)); const int base_ = dk_ - rq_ + 128; const float zc_ = (zc_id == 1) ? tR : tL; \
            _Pragma("unroll") for (int r = 0; r < 16; ++r) { int i0 = base_ + crow(r, hi), i1 = i0 + 32; \
                i0 = i0 < 0 ? 0 : (i0 > 256 ? 256 : i0); i1 = i1 < 0 ? 0 : (i1 > 256 ? 256 : i1); \
                p0[r] += TBL[i0] - zc_; p1[r] += TBL[i1] - zc_; if ((r & 3) == 3) SBAR(); } } \
        const float rm_ = rowmax32(p0, p1); \
        bool shift_ = FIRST; float dl_ = rm_; moved = false; \
        if (!(FIRST)) { moved = __any(rm_ > (float)THR); shift_ = moved; dl_ = fmaxf(rm_, 0.f); } \
        if (shift_) { mhat += dl_; \
            _Pragma("unroll") for (int r = 0; r < 16; ++r) { float a_ = p0[r], b_ = p1[r]; asm volatile("v_sub_f32_e32 %0, %0, %2\n\tv_sub_f32_e32 %1, %1, %2" : "+v"(a_), "+v"(b_) : "v"(dl_)); p0[r] = a_; p1[r] = b_; } \
            if (!(FIRST)) { const float f_ = __builtin_amdgcn_exp2f(-dl_); l *= f_; if (hi == 0) wsf[r32] = f_; } } \
        { const int dn_ = dk_ + 64; const int zn_ = (dn_ >= 122) ? 1 : ((dn_ <= -154) ? 2 : 0); \
          if (shift_ || (zn_ != 0 && zn_ != zc_id)) { if (zn_ != 0) zc_id = zn_; const float cb_ = ((zc_id == 1) ? tR : tL) - mhat; \
              _Pragma("unroll") for (int r = 0; r < 16; ++r) cinit[r] = cb_; } } \
        SBAR(); } while (0)
#define DIFF_EXP2(g, PWN, SACC) do { \
        float x0_ = ((g) < 8 ? p0[2 * ((g) & 7)] : p1[2 * ((g) & 7)]), x1_ = ((g) < 8 ? p0[2 * ((g) & 7) + 1] : p1[2 * ((g) & 7) + 1]); \
        x0_ = __builtin_amdgcn_exp2f(x0_); x1_ = __builtin_amdgcn_exp2f(x1_); SACC += x0_; SACC += x1_; PWN[(g) >> 2][(g) & 3] = cvtpk(x0_, x1_); } while (0)
#define VFRAG(B, i) (bf16x8){vlo[B][i][0], vlo[B][i][1], vlo[B][i][2], vlo[B][i][3], vhh[B][i][0], vhh[B][i][1], vhh[B][i][2], vhh[B][i][3]}
#define DIFF_GAP(g, PWC, PWN, VB) do { \
        o[(g) >> 2] = MFMA32(__builtin_bit_cast(bf16x8, PWC[(g) & 3]), VFRAG(((g) >> 2) & 1, (g) & 3), o[(g) >> 2]); \
        if ((g) < 12) { vlo[(((g) >> 2) + 1) & 1][(g) & 3] = vtr(VB + (((g) >> 2) + 1) * 4096 + ((g) & 3) * 1024); vhh[(((g) >> 2) + 1) & 1][(g) & 3] = vtr(VB + (((g) >> 2) + 1) * 4096 + ((g) & 3) * 1024 + 512); } \
        DIFF_EXP2(g, PWN, sacc_); PIN(sacc_); PIN(PWN[(g) >> 2]); SBAR(); } while (0)
#define DIFF_STEP(t, PWC, PWN) do { \
        lcp vb_ = (lcp)(lds + 65536 + (((t) - 1) & 3) * 16384 + voff); \
        _Pragma("unroll") for (int i = 0; i < 4; ++i) { vlo[0][i] = vtr(vb_ + i * 1024); vhh[0][i] = vtr(vb_ + i * 1024 + 512); } \
        DIFF_SCORES(t, false); \
        float sacc_ = 0.f; \
        DIFF_GAP(0, PWC, PWN, vb_); DIFF_GAP(1, PWC, PWN, vb_); DIFF_GAP(2, PWC, PWN, vb_); DIFF_GAP(3, PWC, PWN, vb_); \
        DIFF_GAP(4, PWC, PWN, vb_); DIFF_GAP(5, PWC, PWN, vb_); DIFF_GAP(6, PWC, PWN, vb_); DIFF_GAP(7, PWC, PWN, vb_); \
        DIFF_GAP(8, PWC, PWN, vb_); DIFF_GAP(9, PWC, PWN, vb_); DIFF_GAP(10, PWC, PWN, vb_); DIFF_GAP(11, PWC, PWN, vb_); \
        DIFF_GAP(12, PWC, PWN, vb_); DIFF_GAP(13, PWC, PWN, vb_); DIFF_GAP(14, PWC, PWN, vb_); DIFF_GAP(15, PWC, PWN, vb_); \
        l += sacc_; \
        DIFF_WAIT_BAR(t); \
        if (moved) { float fr_[16]; \
            _Pragma("unroll") for (int r = 0; r < 16; ++r) fr_[r] = wsf[crow(r, hi)]; \
            _Pragma("unroll") for (int d = 0; d < 4; ++d) _Pragma("unroll") for (int r = 0; r < 16; ++r) o[d][r] *= fr_[r]; \
} \
    } while (0)
    if (wid >= 4) __builtin_amdgcn_s_setprio(1);
    DIFF_SCORES(0, true);
    { float sacc_ = 0.f;
#pragma unroll
      for (int g = 0; g < 16; ++g) DIFF_EXP2(g, pwA, sacc_);
      l += sacc_; }
    ATT_WAIT_BAR(8);
#pragma unroll 1
    for (int t = 1; t + 1 < NT; t += 2) { DIFF_STEP(t, pwA, pwB); DIFF_STEP(t + 1, pwB, pwA); }
    DIFF_STEP(NT - 1, pwA, pwB);
    { const float* lp = arg_in(6) + layer * 256; const float* sg = arg_in(7) + layer * 128;
#pragma unroll
      for (int j = 0; j < 4; ++j) { lpv[j] = lp[64 * j + lane]; sgv[j] = sg[j * 32 + r32]; } }
    { lcp vb_ = (lcp)(lds + 65536 + ((NT - 1) & 3) * 16384 + voff); s16x4 l0[4], h0[4]; vload0(l0, h0, vb_); pv_part<4>(o, vb_, pwB, l0, h0); }
    __builtin_amdgcn_s_setprio(0);
    ATT_LDS_BAR();
#undef DIFF_WAIT_BAR
#undef DIFF_DMA_K
#undef DIFF_DMA_V
#undef DIFF_KVO
#undef DIFF_VVO
#undef DIFF_SCORES
#undef DIFF_EXP2
#undef DIFF_GAP
#undef DIFF_STEP
#undef VFRAG
#undef SBAR
#undef PIN
    }
    const int tid2_ = phase_tid(F.wave);
    const int lane = tid2_ & 63, r32 = lane & 31, hi = lane >> 5;
    float rli[16]; row_inv_l(l, rli, wsf, r32, hi);
#pragma unroll
    for (int d = 0; d < 4; ++d)
#pragma unroll
        for (int r = 0; r < 16; ++r) o[d][r] *= rli[r];
    LAS float* xch = (LAS float*)(lds) + wq * 4096;
    if (mp == 1) {
#pragma unroll
        for (int d = 0; d < 4; ++d)
#pragma unroll
            for (int r4 = 0; r4 < 4; ++r4) *(LAS f32x4*)(xch + ((d * 4 + r4) * 64 + lane) * 4) = (f32x4){o[d][4 * r4], o[d][4 * r4 + 1], o[d][4 * r4 + 2], o[d][4 * r4 + 3]};
    }
    ATT_LDS_BAR();
    if (mp == 0) {
        const float lpa = lpv[0] * lpv[1], lpb = lpv[2] * lpv[3];
        const float s1 = wave_sum(lpa), s2 = wave_sum(lpb);
        unsigned lbits_ = (layer == 0) ? 0x3E4CCCCDu : 0x3EB60549u; asm volatile("" : "+s"(lbits_));
        const float lam_init = __uint_as_float(lbits_);
        const float lam = expf(s1) - expf(s2) + lam_init;
        float ssq[16];
#pragma unroll
        for (int r = 0; r < 16; ++r) ssq[r] = 0.f;
#pragma unroll
        for (int d = 0; d < 4; ++d) { f32x4 x2[4];
#pragma unroll
            for (int r4 = 0; r4 < 4; ++r4) x2[r4] = *(const LAS f32x4*)(xch + ((d * 4 + r4) * 64 + lane) * 4);
            __builtin_amdgcn_sched_barrier(0);
#pragma unroll
            for (int r4 = 0; r4 < 4; ++r4)
#pragma unroll
                for (int e = 0; e < 4; ++e) { const int r = 4 * r4 + e; const float v = o[d][r] - lam * x2[r4][e]; o[d][r] = v; ssq[r] += v * v; } }
#pragma unroll
        for (int r = 0; r < 16; ++r) {
            float v = ssq[r];
            v = sum_half32(v);
            ssq[r] = (1.0f - lam_init) * __builtin_amdgcn_rsqf(v * (1.0f / 128.0f) + RMS_EPS);
        }
        LAS bf16_t* stg = (LAS bf16_t*)(lds + 65536) + wq * 4096;
#pragma unroll
        for (int d = 0; d < 4; ++d) { const float gg = sgv[d];
#pragma unroll
            for (int r = 0; r < 16; ++r) { const float v = o[d][r] * ssq[r] * gg; stg[crow(r, hi) * 128 + d * 32 + r32] = (bf16_t)(cvtpk(v, v) & 0xffffu); } }
        bf16_t* yb = Y + (tokb + qb * 128 + wq * 32 + (lane >> 4)) * D + 512 + h * 128 + (lane & 15) * 8;
        u32x4 sv[8];
#pragma unroll
        for (int i = 0; i < 8; ++i) sv[i] = *(const LAS u32x4*)(stg + (i * 4 + (lane >> 4)) * 128 + (lane & 15) * 8);
#pragma unroll
        for (int i = 0; i < 8; ++i) store16_wt(yb + (size_t)i * 4 * D, sv[i]);
    }
    ATT_WAIT_BAR(0);
}

template <int HALF> __device__ __forceinline__ void na_vload(s16x4 (&lo)[2][3], s16x4 (&hh)[2][3], lcp vb);
template <int HALF>
__device__ __forceinline__ void na_cinit(f32x16& cF, float mhat, int vbase) {
    constexpr int FO = HALF ? 32 : 0;
#pragma unroll
    for (int r = 0; r < 16; ++r) { const int e = (r & 3) + 8 * (r >> 2) + FO; cF[r] = ((unsigned)(vbase + e) < 16u) ? -mhat : -INFINITY; }
}
template <int HALF, int THR>
__device__ __forceinline__ void na_scores(f32x16& p0, f32x16& p1, const bf16x8 (&kf)[8], const bf16x8* qr, f32x16& cF, f32x16 (&o)[2], float& mhat, float& l, bool first,
                                           const LAS float* rp, int vbase, LAS float* wsf, int r32, int hi, u32x4 (&pw)[4], lcp vb, s16x4 (&vlo)[2][3], s16x4 (&vhh)[2][3]) {
    { const f32x16 z = f32x16{};
      if (HALF) { p0 = MFMA32(kf[0], qr[0], z); p1 = MFMA32(kf[1], qr[0], cF); } else { p0 = MFMA32(kf[0], qr[0], cF); p1 = MFMA32(kf[1], qr[0], z); } }
#pragma unroll
    for (int d0 = 1; d0 < 4; ++d0) { p0 = MFMA32(kf[2 * d0], qr[d0], p0); p1 = MFMA32(kf[2 * d0 + 1], qr[d0], p1); }
    na_vload<HALF>(vlo, vhh, vb);
    __builtin_amdgcn_sched_barrier(0);
    f32x16& FB = HALF ? p1 : p0; f32x16& PB = HALF ? p0 : p1;
    constexpr int PR = HALF ? 12 : 0, FO = HALF ? 32 : 0, PO = HALF ? 0 : 32;
#pragma unroll
    for (int r = 0; r < 16; ++r) { const int e = (r & 3) + 8 * (r >> 2) + FO; FB[r] += rp[e]; }
#pragma unroll
    for (int r = PR; r < PR + 4; ++r) { const int e = (r & 3) + 8 * (r >> 2) + PO; PB[r] = ((unsigned)(vbase + e) < 16u) ? PB[r] + (rp[e] - mhat) : -INFINITY; }
    float a = MX3(FB[0], FB[1], FB[2]), c = MX3(FB[3], FB[4], FB[5]);
    a = MX3(a, FB[6], FB[7]); c = MX3(c, FB[8], FB[9]); a = MX3(a, FB[10], FB[11]); c = MX3(c, FB[12], FB[13]); a = MX3(a, FB[14], FB[15]); c = MX3(c, PB[PR], PB[PR + 1]); a = MX3(a, PB[PR + 2], PB[PR + 3]);
    a = __builtin_fmaxf(a, c);
    { auto rr = __builtin_amdgcn_permlane32_swap(__float_as_uint(a), __float_as_uint(a), false, false); a = __builtin_fmaxf(__uint_as_float(rr[0]), __uint_as_float(rr[1])); }
    const float rm = a; bool resc = false, shift = first; float dl = rm;
    if (!first) { shift = __any(rm > (float)THR); resc = shift; dl = fmaxf(rm, 0.f); }
    if (shift) { mhat += dl;
#pragma unroll
        for (int r = 0; r < 16; ++r) FB[r] -= dl;
#pragma unroll
        for (int r = PR; r < PR + 4; ++r) PB[r] -= dl;
        na_cinit<HALF>(cF, mhat, vbase);
        if (resc) { const float f = __builtin_amdgcn_exp2f(-dl); l *= f; if (hi == 0) wsf[r32] = f; } }
    float s = 0.f;
#pragma unroll
    for (int r = 0; r < 16; ++r) { FB[r] = __builtin_amdgcn_exp2f(FB[r]); s += FB[r]; }
#pragma unroll
    for (int r = PR; r < PR + 4; ++r) { PB[r] = __builtin_amdgcn_exp2f(PB[r]); s += PB[r]; }
    l += s;
    const u32x4 f0 = (u32x4){cvtpk(FB[0], FB[1]), cvtpk(FB[2], FB[3]), cvtpk(FB[4], FB[5]), cvtpk(FB[6], FB[7])};
    const u32x4 f1 = (u32x4){cvtpk(FB[8], FB[9]), cvtpk(FB[10], FB[11]), cvtpk(FB[12], FB[13]), cvtpk(FB[14], FB[15])};
    if (HALF == 0) { pw[0] = f0; pw[1] = f1; pw[2] = (u32x4){cvtpk(PB[0], PB[1]), cvtpk(PB[2], PB[3]), 0u, 0u}; }
    else { pw[2] = f0; pw[3] = f1; pw[1] = (u32x4){0u, 0u, cvtpk(PB[12], PB[13]), cvtpk(PB[14], PB[15])}; }
    if (resc) {
        float fr[16];
#pragma unroll
        for (int r = 0; r < 16; ++r) fr[r] = wsf[crow(r, hi)];
#pragma unroll
        for (int d = 0; d < 2; ++d)
#pragma unroll
            for (int r = 0; r < 16; ++r) o[d][r] *= fr[r];
    }
}
template <int HALF>
__device__ __forceinline__ void na_vload(s16x4 (&lo)[2][3], s16x4 (&hh)[2][3], lcp vb) {
    constexpr int K0 = HALF ? 1 : 0;
#pragma unroll
    for (int d0 = 0; d0 < 2; ++d0)
#pragma unroll
        for (int k = 0; k < 3; ++k) { lo[d0][k] = vtr(vb + d0 * 4096 + (K0 + k) * 1024); hh[d0][k] = vtr(vb + d0 * 4096 + (K0 + k) * 1024 + 512); }
}
template <int HALF>
__device__ __forceinline__ void na_pv(f32x16 (&o)[2], const u32x4 (&pw)[4], const s16x4 (&lo)[2][3], const s16x4 (&hh)[2][3]) {
    constexpr int K0 = HALF ? 1 : 0;
#pragma unroll
    for (int d0 = 0; d0 < 2; ++d0)
#pragma unroll
        for (int k = 0; k < 3; ++k)
            o[d0] = MFMA32(__builtin_bit_cast(bf16x8, pw[K0 + k]), ((bf16x8){lo[d0][k][0], lo[d0][k][1], lo[d0][k][2], lo[d0][k][3], hh[d0][k][0], hh[d0][k][1], hh[d0][k][2], hh[d0][k][3]}), o[d0]);
}
template <int THR>
__device__ __forceinline__ void na_unit(Frame& F, int layer, const bf16_t* qkv, bf16_t* Y, int idx) {
    const int tid = phase_tid(F.wave), lane = tid & 63, wid = F.wave, r32 = lane & 31, hi = lane >> 5;
    const int hp = (idx >> 4) & 3, rp2 = idx & 15, grp = wid >> 2;
    const int h = 2 * hp + (wid >> 2), row = 2 * rp2 + ((wid >> 1) & 1), half = wid & 1, c = 32 * half + r32;
    const size_t tokb = 0;
    LAS unsigned char* lds = F.lds;
    LAS float* wsf = (LAS float*)(lds + ATT_WSF) + wid * 128;
    LAS float* RPB = (LAS float*)(lds + ATT_TBL);
    const int rA = 2 * rp2, rB = 2 * rp2 + 1;
    const int lo = (rA - 4) < 0 ? 0 : ((rA - 4) > 24 ? 24 : (rA - 4));
    const int hr = ((rB - 4) < 0 ? 0 : ((rB - 4) > 24 ? 24 : (rB - 4))) + 7;
    const int ntile = hr - lo + 1;
    const int r0 = (row - 4) < 0 ? 0 : ((row - 4) > 24 ? 24 : (row - 4));
    const bf16_t* kbase = qkv + tokb * NQKV + COL_KA + (2 * hp) * 64; const bf16_t* vbase_g = qkv + tokb * NQKV + COL_VA + (2 * hp) * 64;
    const unsigned kvo = (unsigned)((8 * wid + (lane >> 3)) * NQKV + ((lane & 7) ^ (lane >> 3)) * 8) * 2u;
    const unsigned vvo = (unsigned)((16 * (wid & 3) + (lane >> 2)) * NQKV + (wid >> 2) * 32 + (lane & 3) * 8) * 2u;
#define NA_DMA(tt) do { if ((tt) < ntile) { const size_t go_ = (size_t)(lo + (tt)) * 64 * NQKV; LAS unsigned char* rb_ = lds + ((tt) & 3) * 32768 + wid * 1024; \
        GLDS16S(kvo, kbase + go_, rb_); GLDS16S(kvo, kbase + go_ + 64, rb_ + 8192); GLDS16S(vvo, vbase_g + go_, rb_ + 16384); GLDS16S(vvo, vbase_g + go_ + 64, rb_ + 24576); } } while (0)
#define NA_WAIT_BAR(t) asm volatile("s_waitcnt vmcnt(4)\n\ts_cmp_lt_i32 %0, %1\n\ts_cbranch_scc1 .Lnw%=\n\ts_waitcnt vmcnt(0)\n.Lnw%=:\n\ts_waitcnt lgkmcnt(0)\n\ts_barrier" :: "s"((t) + 2), "s"(ntile) : "scc", "memory")
    NA_DMA(0); NA_DMA(1); NA_DMA(2);
    const int tdr = (tid >> 5) < 15 ? (tid >> 5) : 14, ti = (tid & 31) < 31 ? (tid & 31) : 30;
    const float* rpbg = arg_in(5) + ((size_t)(layer * 8 + 2 * hp) * 15 + tdr) * 31 + ti;
    float tv0 = rpbg[0], tv1 = rpbg[15 * 31];
    bf16x8 qr[4];
    { const bf16_t* Qw = qkv + (tokb + row * 64 + c) * NQKV + COL_QA + h * 64 + hi * 8;
#pragma unroll
      for (int d0 = 0; d0 < 4; ++d0) qr[d0] = *(const bf16x8*)(Qw + d0 * 16); }
    asm volatile("" : "+v"(tv0), "+v"(tv1), "+v"(qr[0]), "+v"(qr[1]), "+v"(qr[2]), "+v"(qr[3]));
    if (tid < 480) { const bool in = (tid & 31) < 31; RPB[tid] = in ? tv0 * LOG2E : 0.f; RPB[480 + tid] = in ? tv1 * LOG2E : 0.f; }
    const int voff = ((lane >> 4) & 1) * 32 + (lane & 3) * 8 + (4 * hi + ((lane & 15) >> 2)) * 64 + grp * 8192;
    int koff[4];
#pragma unroll
    for (int d0 = 0; d0 < 4; ++d0) koff[d0] = r32 * 128 + (((2 * d0 + hi) ^ (r32 & 7)) << 4) + grp * 8192;
    f32x16 o[2]; o[0] = f32x16{}; o[1] = f32x16{};
    float mhat = 0.f, l = 0.f;
    u32x4 pw[4];
    ATT_WAIT_BAR(8);
    bf16x8 kf[8];
    kload(kf, (lcp)(lds), koff);
    const int c0 = (c - 8) < 0 ? 0 : ((c - 8) > 48 ? 48 : (c - 8));
    const int vbase = 4 * hi - c0;
    const int rpoff = grp * 480 + (4 * hi - c + 15);
    f32x16 cF;
    if (half == 0) na_cinit<0>(cF, 0.f, vbase); else na_cinit<1>(cF, 0.f, vbase);
#pragma unroll 1
    for (int t = 0; t < ntile; ++t) {
        const int kr = lo + t; const bool act = (kr >= r0 && kr < r0 + 8);
        lcp vb = (lcp)(lds + (t & 3) * 32768 + 16384 + voff);
        s16x4 vlo[2][3], vhh[2][3];
        if (act) {
            f32x16 p0, p1;
            int ro = rpoff; asm volatile("" : "+v"(ro));
            const LAS float* rp = RPB + (kr - row + 7) * 32 + ro;
            if (half == 0) na_scores<0, THR>(p0, p1, kf, qr, cF, o, mhat, l, kr == r0, rp, vbase, wsf, r32, hi, pw, vb, vlo, vhh);
            else           na_scores<1, THR>(p0, p1, kf, qr, cF, o, mhat, l, kr == r0, rp, vbase, wsf, r32, hi, pw, vb, vlo, vhh);
        }
        if (grp == 1) { NA_WAIT_BAR(t); NA_DMA(t + 3); if (t + 1 < ntile) kload(kf, (lcp)(lds + ((t + 1) & 3) * 32768), koff); }
        __builtin_amdgcn_sched_barrier(0);
        if (act) { if (half == 0) na_pv<0>(o, pw, vlo, vhh); else na_pv<1>(o, pw, vlo, vhh); }
        if (grp == 0) { NA_WAIT_BAR(t); NA_DMA(t + 3); if (t + 1 < ntile) kload(kf, (lcp)(lds + ((t + 1) & 3) * 32768), koff); }
    }
    ATT_WAIT_BAR(0);
#undef NA_DMA
#undef NA_WAIT_BAR
    float rli[16]; row_inv_l(l, rli, wsf, r32, hi);
    LAS bf16_t* stg = (LAS bf16_t*)(lds + 65536) + wid * 2048;
#pragma unroll
    for (int d = 0; d < 2; ++d)
#pragma unroll
        for (int r = 0; r < 16; ++r) { const float v = o[d][r] * rli[r]; stg[crow(r, hi) * 64 + d * 32 + r32] = (bf16_t)(cvtpk(v, v) & 0xffffu); }
    bf16_t* yb = Y + (tokb + row * 64 + 32 * half + (lane >> 3)) * D + h * 64 + (lane & 7) * 8;
    u32x4 sv[4];
#pragma unroll
    for (int i = 0; i < 4; ++i) sv[i] = *(const LAS u32x4*)(stg + (i * 8 + (lane >> 3)) * 64 + (lane & 7) * 8);
#pragma unroll
    for (int i = 0; i < 4; ++i) store16_wt(yb + (size_t)i * 8 * D, sv[i]);
    ATT_WAIT_BAR(0);
}

__device__ __forceinline__ void naq_mfma(f32x16& p0, f32x16& p1, const bf16x8 (&kf)[8], const bf16x8* qr, const f32x16& cM, float mhat) {
    { const f32x16 z = f32x16{}; p0 = MFMA32(kf[0], qr[0], cM); p1 = MFMA32(kf[1], qr[0], z); }
#pragma unroll
    for (int d0 = 1; d0 < 4; ++d0) { p0 = MFMA32(kf[2 * d0], qr[d0], p0); p1 = MFMA32(kf[2 * d0 + 1], qr[d0], p1); }
}
__device__ __forceinline__ void naq_vload(s16x4 (&lo)[2][3], s16x4 (&hh)[2][3], lcp vbF, lcp vbP) {
#pragma unroll
    for (int d0 = 0; d0 < 2; ++d0) {
#pragma unroll
        for (int k = 0; k < 2; ++k) { lo[d0][k] = vtr(vbF + d0 * 4096 + k * 1024); hh[d0][k] = vtr(vbF + d0 * 4096 + k * 1024 + 512); }
        lo[d0][2] = vtr(vbP + d0 * 4096); hh[d0][2] = vtr(vbP + d0 * 4096 + 512); }
}
template <int THR>
__device__ __forceinline__ void naq_softmax(f32x16& p0, f32x16& p1, f32x16 (&o)[2], float& mhat, float& l, bool first, float mh, const LAS float* rp, int vbase, int fo, int pk0,
                                            LAS float* wsf, int r32, int hi, u32x4 (&pw)[3]) {
    const LAS float* rpF = rp + fo; const LAS float* rpP = rp + pk0;
    float pbv[4];
#pragma unroll
    for (int r = 0; r < 4; ++r) pbv[r] = rpP[r];
#pragma unroll
    for (int r = 0; r < 16; ++r) { const int e = (r & 3) + 8 * (r >> 2); p0[r] += rpF[e] - mh; }
#pragma unroll
    for (int r = 0; r < 4; ++r) p1[r] = ((unsigned)(vbase + pk0 + r) < 16u) ? p1[r] + (pbv[r] - mh) : -INFINITY;
    float a = MX3(p0[0], p0[1], p0[2]), c = MX3(p0[3], p0[4], p0[5]);
    a = MX3(a, p0[6], p0[7]); c = MX3(c, p0[8], p0[9]); a = MX3(a, p0[10], p0[11]); c = MX3(c, p0[12], p0[13]); a = MX3(a, p0[14], p0[15]); c = MX3(c, p1[0], p1[1]); a = MX3(a, p1[2], p1[3]);
    a = __builtin_fmaxf(a, c);
    { auto rr = __builtin_amdgcn_permlane32_swap(__float_as_uint(a), __float_as_uint(a), false, false); a = __builtin_fmaxf(__uint_as_float(rr[0]), __uint_as_float(rr[1])); }
    const float rm = a; bool resc = false, shift = first; float dl = rm;
    if (!first) { shift = __any(rm > (float)THR); resc = shift; dl = fmaxf(rm, 0.f); }
    if (shift) { mhat += dl;
#pragma unroll
        for (int r = 0; r < 16; ++r) p0[r] -= dl;
#pragma unroll
        for (int r = 0; r < 4; ++r) p1[r] -= dl;
        if (resc) { const float f = __builtin_amdgcn_exp2f(-dl); l *= f; if (hi == 0) wsf[r32] = f; } }
    float sa = 0.f;
#pragma unroll
    for (int r = 0; r < 16; ++r) { p0[r] = __builtin_amdgcn_exp2f(p0[r]); sa += p0[r]; }
#pragma unroll
    for (int r = 0; r < 4; ++r) { p1[r] = __builtin_amdgcn_exp2f(p1[r]); sa += p1[r]; }
    l += sa;
    pw[0] = (u32x4){cvtpk(p0[0], p0[1]), cvtpk(p0[2], p0[3]), cvtpk(p0[4], p0[5]), cvtpk(p0[6], p0[7])};
    pw[1] = (u32x4){cvtpk(p0[8], p0[9]), cvtpk(p0[10], p0[11]), cvtpk(p0[12], p0[13]), cvtpk(p0[14], p0[15])};
    pw[2] = (u32x4){cvtpk(p1[0], p1[1]), cvtpk(p1[2], p1[3]), 0u, 0u};
    if (resc) {
        float fr[16];
#pragma unroll
        for (int r = 0; r < 16; ++r) fr[r] = wsf[crow(r, hi)];
#pragma unroll
        for (int d = 0; d < 2; ++d)
#pragma unroll
            for (int r = 0; r < 16; ++r) o[d][r] *= fr[r];
    }
}
__device__ __forceinline__ void naq_pv(f32x16 (&o)[2], const u32x4 (&pw)[3], const s16x4 (&lo)[2][3], const s16x4 (&hh)[2][3]) {
#pragma unroll
    for (int d0 = 0; d0 < 2; ++d0)
#pragma unroll
        for (int k = 0; k < 3; ++k)
            o[d0] = MFMA32(__builtin_bit_cast(bf16x8, pw[k]), ((bf16x8){lo[d0][k][0], lo[d0][k][1], lo[d0][k][2], lo[d0][k][3], hh[d0][k][0], hh[d0][k][1], hh[d0][k][2], hh[d0][k][3]}), o[d0]);
}
template <int THR>
__device__ __forceinline__ void na_quad_unit(Frame& F, int layer, const bf16_t* qkv, bf16_t* Y, int idx) {
    const int tid = phase_tid(F.wave), lane = tid & 63, wid = F.wave, r32 = lane & 31, hi = lane >> 5;
    const int hp = (idx >> 3) & 3, rq = idx & 7, grp = wid >> 2;
    const int h = 2 * hp + (wid >> 2), half = wid & 1, c = 32 * half + r32;
    const int rowA = 4 * rq + ((wid >> 1) & 1), rowB = rowA + 2;
    LAS unsigned char* lds = F.lds;
    LAS float* wsf = (LAS float*)(lds + ATT_WSF) + wid * 128;
    LAS float* RPB = (LAS float*)(lds + ATT_TBL);
    const int rF = 4 * rq, rL = 4 * rq + 3;
    const int lo = (rF - 4) < 0 ? 0 : ((rF - 4) > 24 ? 24 : (rF - 4));
    const int hr = ((rL - 4) < 0 ? 0 : ((rL - 4) > 24 ? 24 : (rL - 4))) + 7;
    const int ntile = hr - lo + 1;
    const int r0A = (rowA - 4) < 0 ? 0 : ((rowA - 4) > 24 ? 24 : (rowA - 4)), r0B = (rowB - 4) < 0 ? 0 : ((rowB - 4) > 24 ? 24 : (rowB - 4));
    const bf16_t* kbase = qkv + COL_KA + (2 * hp) * 64; const bf16_t* vbase_g = qkv + COL_VA + (2 * hp) * 64;
    const unsigned kvo = (unsigned)((8 * wid + (lane >> 3)) * NQKV + ((lane & 7) ^ (lane >> 3)) * 8) * 2u;
    const unsigned vvo = (unsigned)((16 * (wid & 3) + (lane >> 2)) * NQKV + (wid >> 2) * 32 + (lane & 3) * 8) * 2u;
#define NA_DMA(tt) do { if ((tt) < ntile) { const size_t go_ = (size_t)(lo + (tt)) * 64 * NQKV; LAS unsigned char* rb_ = lds + ((tt) & 3) * 32768 + wid * 1024; \
        GLDS16S(kvo, kbase + go_, rb_); GLDS16S(kvo, kbase + go_ + 64, rb_ + 8192); GLDS16S(vvo, vbase_g + go_, rb_ + 16384); GLDS16S(vvo, vbase_g + go_ + 64, rb_ + 24576); } } while (0)
#define NA_WAIT_BAR(t) asm volatile("s_waitcnt vmcnt(4)\n\ts_cmp_lt_i32 %0, %1\n\ts_cbranch_scc1 .Lnq%=\n\ts_waitcnt vmcnt(0)\n.Lnq%=:\n\ts_waitcnt lgkmcnt(0)\n\ts_barrier" :: "s"((t) + 2), "s"(ntile) : "scc", "memory")
    NA_DMA(0); NA_DMA(1); NA_DMA(2);
    const int tdr = (tid >> 5) < 15 ? (tid >> 5) : 14, ti = (tid & 31) < 31 ? (tid & 31) : 30;
    const float* rpbg = arg_in(5) + ((size_t)(layer * 8 + 2 * hp) * 15 + tdr) * 31 + ti;
    float tv0 = rpbg[0], tv1 = rpbg[15 * 31];
    bf16x8 qA[4], qB[4];
    { const bf16_t* Qw = qkv + (size_t)(rowA * 64 + c) * NQKV + COL_QA + h * 64 + hi * 8;
#pragma unroll
      for (int d0 = 0; d0 < 4; ++d0) { qA[d0] = *(const bf16x8*)(Qw + d0 * 16); qB[d0] = *(const bf16x8*)(Qw + (size_t)128 * NQKV + d0 * 16); } }
    asm volatile("" : "+v"(tv0), "+v"(tv1), "+v"(qA[0]), "+v"(qA[1]), "+v"(qA[2]), "+v"(qA[3]), "+v"(qB[0]), "+v"(qB[1]), "+v"(qB[2]), "+v"(qB[3]));
    if (tid < 480) { const bool in = (tid & 31) < 31; RPB[tid] = in ? tv0 * LOG2E : 0.f; RPB[480 + tid] = in ? tv1 * LOG2E : 0.f; }
    const int voff = ((lane >> 4) & 1) * 32 + (lane & 3) * 8 + (4 * hi + ((lane & 15) >> 2)) * 64 + grp * 8192;
    int koff[4];
#pragma unroll
    for (int d0 = 0; d0 < 4; ++d0) koff[d0] = r32 * 128 + (((2 * d0 + hi) ^ (r32 & 7)) << 4) + grp * 8192;
    const int dF = half * 4096, dP = half ? ((((r32 + 24) & 31) - r32) * 128) : 4096;
    const int fo = 32 * half, pk0 = half ? 24 : 32;
#define NA_KLOAD(slot_) do { lcp ks_ = (lcp)(lds + (slot_) * 32768); \
        _Pragma("unroll") for (int d0 = 0; d0 < 4; ++d0) { kf[2 * d0] = *(const LAS bf16x8*)(ks_ + koff[d0] + dF); kf[2 * d0 + 1] = *(const LAS bf16x8*)(ks_ + koff[d0] + dP); } } while (0)
    f32x16 oA[2], oB[2]; oA[0] = f32x16{}; oA[1] = f32x16{}; oB[0] = f32x16{}; oB[1] = f32x16{};
    float mhatA = 0.f, lA = 0.f, mhatB = 0.f, lB = 0.f;
    ATT_WAIT_BAR(8);
    bf16x8 kf[8];
    NA_KLOAD(0);
    const int c0 = (c - 8) < 0 ? 0 : ((c - 8) > 48 ? 48 : (c - 8));
    const int vbase = 4 * hi - c0;
    const int rpoff = grp * 480 + (4 * hi - c + 15);
    f32x16 cM;
#pragma unroll
    for (int r = 0; r < 16; ++r) { const int e = (r & 3) + 8 * (r >> 2) + fo; cM[r] = ((unsigned)(vbase + e) < 16u) ? 0.f : -INFINITY; }
#pragma unroll 1
    for (int t = 0; t < ntile; ++t) {
        const int kr = lo + t; const bool actA = (kr >= r0A && kr < r0A + 8), actB = (kr >= r0B && kr < r0B + 8);
        lcp vb = (lcp)(lds + (t & 3) * 32768 + 16384 + voff);
        lcp vbF = vb + half * 2048, vbP = vb + (half ? 1536 : 2048);
        s16x4 vlo[2][3], vhh[2][3]; f32x16 pA0, pA1, pB0, pB1; u32x4 pwA[3], pwB[3];
        const float mhA = actA ? mhatA : INFINITY, mhB = actB ? mhatB : INFINITY;
        const int drA = (kr - rowA + 7) < 0 ? 0 : ((kr - rowA + 7) > 14 ? 14 : (kr - rowA + 7)), drB = (kr - rowB + 7) < 0 ? 0 : ((kr - rowB + 7) > 14 ? 14 : (kr - rowB + 7));
        int ro = rpoff; asm volatile("" : "+v"(ro));
        naq_mfma(pA0, pA1, kf, qA, cM, mhA);
        naq_mfma(pB0, pB1, kf, qB, cM, mhB);
        __builtin_amdgcn_sched_barrier(0);
        if (actA) naq_softmax<THR>(pA0, pA1, oA, mhatA, lA, kr == r0A, mhA, RPB + drA * 32 + ro, vbase, fo, pk0, wsf, r32, hi, pwA);
        if (actB) naq_softmax<THR>(pB0, pB1, oB, mhatB, lB, kr == r0B, mhB, RPB + drB * 32 + ro, vbase, fo, pk0, wsf, r32, hi, pwB);
        __builtin_amdgcn_sched_barrier(0);
        naq_vload(vlo, vhh, vbF, vbP);
        if (grp == 1) { NA_WAIT_BAR(t); NA_DMA(t + 3); if (t + 1 < ntile) NA_KLOAD((t + 1) & 3); }
        __builtin_amdgcn_sched_barrier(0);
        if (actA) naq_pv(oA, pwA, vlo, vhh);
        if (actB) naq_pv(oB, pwB, vlo, vhh);
        if (grp == 0) { NA_WAIT_BAR(t); NA_DMA(t + 3); if (t + 1 < ntile) NA_KLOAD((t + 1) & 3); }
    }
    ATT_WAIT_BAR(0);
#undef NA_DMA
#undef NA_WAIT_BAR
#undef NA_KLOAD
    const int hie = (int)(lane_id_now() >> 5);
    LAS bf16_t* stg = (LAS bf16_t*)(lds + 65536) + wid * 4096;
    { float rli[16]; row_inv_l(lA, rli, wsf, r32, hie);
#pragma unroll
      for (int d = 0; d < 2; ++d)
#pragma unroll
        for (int r = 0; r < 16; ++r) { const float v = oA[d][r] * rli[r]; stg[crow(r, hie) * 64 + d * 32 + r32] = (bf16_t)(cvtpk(v, v) & 0xffffu); } }
    { float rli[16]; row_inv_l(lB, rli, wsf, r32, hie);
#pragma unroll
      for (int d = 0; d < 2; ++d)
#pragma unroll
        for (int r = 0; r < 16; ++r) { const float v = oB[d][r] * rli[r]; stg[2048 + crow(r, hie) * 64 + d * 32 + r32] = (bf16_t)(cvtpk(v, v) & 0xffffu); } }
    bf16_t* yb = Y + (size_t)(rowA * 64 + 32 * half + (lane >> 3)) * D + h * 64 + (lane & 7) * 8;
    u32x4 sv[8];
#pragma unroll
    for (int i = 0; i < 8; ++i) sv[i] = *(const LAS u32x4*)(stg + (i >> 2) * 2048 + ((i & 3) * 8 + (lane >> 3)) * 64 + (lane & 7) * 8);
#pragma unroll
    for (int i = 0; i < 8; ++i) store16_wt(yb + (size_t)((i >> 2) * 128 + (i & 3) * 8) * D, sv[i]);
    ATT_WAIT_BAR(0);
}
}

struct Args { const float* in[14]; float* out; unsigned char* ws; };
__global__ void __launch_bounds__(NWAVES * 64, 2) enc_fwd(Args args) {
    extern __shared__ __attribute__((aligned(16))) unsigned char lds[];
    Frame F;
    F.lds = (LAS unsigned char*)lds;
    F.wave = __builtin_amdgcn_readfirstlane((int)threadIdx.x >> 6); F.G = gridDim.x; { const int bx = blockIdx.x; F.vcu = (F.G % 8 == 0) ? (bx % 8) * (F.G / 8) + bx / 8 : bx; }
    F.out = args.out; F.ws = args.ws;
    unsigned char* ws = args.ws;
    volatile LAS unsigned* MISC = (volatile LAS unsigned*)(F.lds + MISC_OFF);
    for (int u = threadIdx.x; u < (LDS_BYTES - LDSCTL_OFF) / 4; u += NWAVES * 64) ((LAS unsigned*)(F.lds + LDSCTL_OFF))[u] = 0u;
    __syncthreads();
    XcdBarrier bar; bar.bar = (unsigned*)(ws + WS_CTL) + CW_BAR; bar.x = 0; bar.st = nullptr; bar.wave = F.wave;
    bar = xcd_barrier_post((unsigned*)(ws + WS_CTL) + CW_BAR, MISC + 8, F.wave);
    p0_prologue(F);
    xcd_barrier(bar);
    const unsigned xcc = bar.x;
    const int nloc = __builtin_amdgcn_readfirstlane((int)MISC[8]), nx = __builtin_amdgcn_readfirstlane((int)MISC[9]);
    const int rank = __builtin_amdgcn_readfirstlane((int)MISC[10]), xi = __builtin_amdgcn_readfirstlane((int)MISC[11]);
    unsigned* lbar = (unsigned*)(ws + WS_CTL) + CW_BAR;
    unsigned lgen = 0;
#define LSEAM() xcc_local_barrier(lbar, xcc, (unsigned)nloc, F.wave, lgen)
#pragma unroll 1
    for (int bb = xi; bb < BATCH; bb += nx) {
        unsigned char* breg = ws + WS_QKV + (size_t)bb * BREG;
        bf16_t* QKVb = (bf16_t*)breg; bf16_t* GATESb = (bf16_t*)(breg + BREG_GATES); bf16_t* MERGEDb = (bf16_t*)breg; bf16_t* HBb = (bf16_t*)breg;
        bf16_t* XBb = (bf16_t*)(ws + WS_XNY) + (size_t)bb * MB * D; float* SSb = (float*)(ws + WS_SS) + (size_t)bb * MB * 4;
        bf16_t* Yb = (bf16_t*)((unsigned char*)F.out + (size_t)bb * MB * D * 4);
        float* OUTb = F.out + (size_t)bb * MB * D;
#pragma unroll 1
        for (int L = 0; L < DEPTH; ++L) {
            unsigned char* wb = ws + WS_W + (size_t)L * W_LAYER;
            {
                pg8::Gemm g{XBb, (const bf16_t*)(wb + WO_IN), MB, NIN, D}; pg8::BatchOrder S{NIN / 256, nloc, rank};
                pg8::EpiProj E{QKVb, GATESb, SSb, ((nloc & 7) == 0) ? (LAS float*)(F.lds + ATT_WSF) : (LAS float*)nullptr};
                pg8::gemm_phase<pg8::EpiProj, pg8::BatchOrder, true, true>(F.lds + RING_OFF, g, S, E, F.wave);
            }
            LSEAM();
            {
#pragma unroll 1
                for (int u = 2 * rank; u < 64; u += 2 * nloc) { att::diff_unit<8>(F, L, QKVb, Yb, u >> 4, u & 15); att::diff_unit<8>(F, L, QKVb, Yb, (u + 1) >> 4, (u + 1) & 15); }
#pragma unroll 1
                for (int u = rank; u < 32; u += nloc) att::na_quad_unit<8>(F, L, QKVb, Yb, u);
            }
            LSEAM();
            {
                pg8::Gemm g{Yb, (const bf16_t*)(wb + WO_M), MB, D, D}; pg8::BatchOrder S{D / 256, nloc, rank};
                pg8::EpiMerge E{MERGEDb, GATESb};
                pg8::gemm_phase<pg8::EpiMerge, pg8::BatchOrder, true, true>(F.lds + RING_OFF, g, S, E, F.wave);
            }
            LSEAM();
            {
                pg8::Gemm g{MERGEDb, (const bf16_t*)(wb + WO_OUT), MB, D, D}; pg8::BatchOrder S{D / 256, nloc, rank};
                pg8::EpiResid E{XBb, SSb, {}};
                pg8::gemm_phase<pg8::EpiResid, pg8::BatchOrder, true, true>(F.lds + RING_OFF, g, S, E, F.wave);
            }
            LSEAM();
            {
                pg8::Gemm g{XBb, (const bf16_t*)(wb + WO_FF1), MB, FF, D}; pg8::BatchOrder S{FF / 256, nloc, rank};
                pg8::EpiFF1 E{HBb, SSb, ((nloc & 7) == 0) ? (LAS float*)(F.lds + ATT_WSF) : (LAS float*)nullptr};
                pg8::gemm_phase<pg8::EpiFF1, pg8::BatchOrder, true, true>(F.lds + RING_OFF, g, S, E, F.wave);
            }
            LSEAM();
            {
                pg8::Gemm g{HBb, (const bf16_t*)(wb + WO_FF2), MB, D, FF}; pg8::BatchOrder S{D / 256, nloc, rank};
                if (L + 1 < DEPTH) { pg8::EpiResid E{XBb, SSb, {}};
                    pg8::gemm_phase<pg8::EpiResid, pg8::BatchOrder, true, true>(F.lds + RING_OFF, g, S, E, F.wave); }
                else { pg8::EpiFinal E{XBb, SSb, arg_in(2), OUTb, (unsigned*)(ws + WS_CTL) + CW_PANEL + bb * 8 * 64, {}};
                    pg8::gemm_phase<pg8::EpiFinal, pg8::BatchOrder, true, true>(F.lds + RING_OFF, g, S, E, F.wave); }
            }
            if (L + 1 < DEPTH) LSEAM();
        }
        if (bb + nx < BATCH) LSEAM();
    }
#undef LSEAM
}

extern "C" void kernel_launch(void* const* d_in, const int* in_sizes, int n_in, void* d_out, int out_size, void* d_ws, size_t ws_size, hipStream_t stream) {
    static int grid = 0;
    if (grid == 0) {
        if (n_in != 14 || in_sizes[0] != M * D || out_size != M * D || ws_size < WS_END) { fprintf(stderr, "kernel_launch: unexpected shapes (n_in %d, in0 %d, out %d, ws %zu); nothing launched\n", n_in, n_in > 0 ? in_sizes[0] : -1, out_size, ws_size); grid = -1; return; }
        int dev = 0, cus = 0;
        if (hipGetDevice(&dev) != hipSuccess || hipDeviceGetAttribute(&cus, hipDeviceAttributeMultiprocessorCount, dev) != hipSuccess) { grid = -1; return; }
        if (hipFuncSetAttribute((const void*)enc_fwd, hipFuncAttributeMaxDynamicSharedMemorySize, LDS_BYTES) != hipSuccess) { fprintf(stderr, "kernel_launch: hipFuncSetAttribute failed\n"); grid = -1; return; }
        int per_cu = 0;
        if (hipOccupancyMaxActiveBlocksPerMultiprocessor(&per_cu, (const void*)enc_fwd, NWAVES * 64, LDS_BYTES) != hipSuccess || per_cu < 1) fprintf(stderr, "kernel_launch: occupancy query reports %d per CU\n", per_cu);
        (void)hipGetLastError();
        grid = cus;
    }
    if (grid < 0) return;
    Args a{};
    for (int i = 0; i < 14; ++i) a.in[i] = (const float*)d_in[i];
    a.out = (float*)d_out; a.ws = (unsigned char*)d_ws;
    if (hipMemsetAsync((char*)d_ws + WS_CTL, 0, CTL_ZERO_BYTES, stream) != hipSuccess) { fprintf(stderr, "kernel_launch: memset failed\n"); return; }
    hipLaunchKernelGGL(enc_fwd, dim3(grid), dim3(NWAVES * 64), LDS_BYTES, stream, a);
}
```

```cpp
#include <hip/hip_runtime.h>
#include <cstdio>
#include <cstdint>

#define LAS __attribute__((address_space(3)))
#define GAS __attribute__((address_space(1)))
typedef unsigned short bf16_t;
typedef short bf16x8 __attribute__((ext_vector_type(8)));
typedef short s16x4 __attribute__((ext_vector_type(4)));
typedef float f32x4 __attribute__((ext_vector_type(4)));
typedef float f32x2 __attribute__((ext_vector_type(2)));
typedef float f32x16 __attribute__((ext_vector_type(16)));
typedef unsigned u32x4 __attribute__((ext_vector_type(4)));
typedef unsigned u32x2 __attribute__((ext_vector_type(2)));
typedef __bf16 bf16x2_t __attribute__((ext_vector_type(2)));

constexpr int BATCH = 8, SEQ = 2048, D = 1024, M = BATCH * SEQ, DEPTH = 2, FF = 4096;
constexpr int NQKV = 3072, NGATE = 2048, NIN = 5120;
constexpr int MB = SEQ;
constexpr float RMS_EPS = 1e-6f;
constexpr float LOG2E = 1.4426950408889634f;
constexpr float C2 = 0.125f * LOG2E;
constexpr int COL_QA = 0, COL_KA = 512, COL_VA = 1024, COL_QD = 1536, COL_KD = 2048, COL_VD = 2560;

__device__ __forceinline__ unsigned cvtpk(float lo, float hi) { f32x2 v = {lo, hi}; bf16x2_t b = __builtin_convertvector(v, bf16x2_t); return __builtin_bit_cast(unsigned, b); }
__device__ __forceinline__ float bf2f(unsigned short u) { return __uint_as_float((unsigned)u << 16); }
__device__ __forceinline__ float bflo(unsigned w) { return __uint_as_float(w << 16); }
__device__ __forceinline__ float bfhi(unsigned w) { return __uint_as_float(w & 0xffff0000u); }

__device__ __forceinline__ unsigned lane_id_now() { unsigned l; asm volatile("v_mbcnt_lo_u32_b32 %0, -1, 0\n\tv_mbcnt_hi_u32_b32 %0, -1, %0" : "=v"(l)); return l; }
__device__ __forceinline__ void store16_wt(void* p, u32x4 v) { asm volatile("global_store_dwordx4 %0, %1, off sc1\n\ts_nop 1" :: "v"(p), "v"(v) : "memory"); }
#define DPP_ADD(v, ctrl) ((v) + __uint_as_float((unsigned)__builtin_amdgcn_update_dpp(0, (int)__float_as_uint(v), (ctrl), 0xF, 0xF, true)))
__device__ __forceinline__ float sum_row16(float v) {
    v = DPP_ADD(v, 0xB1); v = DPP_ADD(v, 0x4E); v = DPP_ADD(v, 0x141); v = DPP_ADD(v, 0x140); return v; }
__device__ __forceinline__ float sum_xor16(float v) { auto rr = __builtin_amdgcn_permlane16_swap(__float_as_uint(v), __float_as_uint(v), false, false); return __uint_as_float(rr[0]) + __uint_as_float(rr[1]); }
__device__ __forceinline__ float sum_xor32(float v) { auto rr = __builtin_amdgcn_permlane32_swap(__float_as_uint(v), __float_as_uint(v), false, false); return __uint_as_float(rr[0]) + __uint_as_float(rr[1]); }
__device__ __forceinline__ float sum_half32(float v) { return sum_xor16(sum_row16(v)); }
namespace pg8 {
constexpr int BM = 256, BK = 64, HALF = 128, HTB = HALF * BK * 2, STAGE_BYTES = 8 * HTB, NXCD = 8, WGM = 8;
__host__ __device__ __forceinline__ int lds_byte(int r, int c) { const int st = (r >> 4) * 2 + (c >> 5), rr = r & 15, cc = c & 31, ob = rr * 64 + cc * 2; return st * 1024 + (ob ^ (((ob >> 9) & 1) << 5)); }
__host__ __device__ __forceinline__ void stage_rc(int b, int& R, int& C) { const int st = b / 1024, sb = b % 1024, swz = sb ^ (((sb >> 9) & 1) << 5); R = (st >> 1) * 16 + swz / 64; C = (st & 1) * 32 + (swz % 64) / 2; }
__host__ __device__ __forceinline__ int perm32(int rho) { const int n = rho >> 4, i = rho & 15; return 8 * (i >> 2) + 4 * n + (i & 3); }

struct Unit { int pm, pn; };
struct Gemm { const bf16_t* A; const bf16_t* Bt; int M, N, K; };

struct BatchOrder {
    int nN, nloc, rank;
    __device__ bool next(int i, Unit& u) const { const int L = i * nloc + rank; if (L >= 8 * nN) return false; u.pm = L & 7; u.pn = L >> 3; return true; }
};

__device__ __forceinline__ float row_rstd(const float* ss, int row) {
    const f32x4 a = *(const f32x4*)(ss + (size_t)row * 4);
    const float s = (a[0] + a[1]) + (a[2] + a[3]);
    return 1.0f / sqrtf(s * (1.0f / (float)D) + RMS_EPS);
}

struct EpiProj {
    static constexpr bool HAS_POST = false, HAS_RTAB = true;
    static constexpr bool PERM = true, HAS_MID = false;
    bf16_t* qkv; bf16_t* gates; const float* ss; LAS float* rtab;
    __device__ __forceinline__ void mid(f32x4 (&acc)[2][2][4][2], const Unit& u, int wr, int wc, int fr, int fq) const {}
    __device__ __forceinline__ void operator()(f32x4 (&acc)[2][2][4][2], const Unit& u, int wr, int wc, int fr, int fq) const {
        const int row0 = u.pm * BM + wr * 64 + fr;
        float rs[2][4];
        if (rtab) {
#pragma unroll
            for (int ai = 0; ai < 2; ++ai)
#pragma unroll
                for (int m = 0; m < 4; ++m) rs[ai][m] = rtab[wr * 64 + fr + ai * HALF + m * 16];
        } else {
#pragma unroll
            for (int ai = 0; ai < 2; ++ai)
#pragma unroll
                for (int m = 0; m < 4; ++m) rs[ai][m] = row_rstd(ss, row0 + ai * HALF + m * 16);
        }
        if (u.pn < 12) {
            const float sc = (u.pn < 2 || u.pn == 6 || u.pn == 7) ? C2 : 1.0f;
            const int col0 = u.pn * BM + wc * 32 + 8 * fq;
#pragma unroll
            for (int ai = 0; ai < 2; ++ai)
#pragma unroll
                for (int m = 0; m < 4; ++m) { const int row = row0 + ai * HALF + m * 16; const float r = rs[ai][m] * sc; bf16_t* rowp = qkv + (size_t)row * NQKV + col0;
#pragma unroll
                    for (int bj = 0; bj < 2; ++bj) { const f32x4 v0 = acc[ai][bj][m][0] * r, v1 = acc[ai][bj][m][1] * r;
                        u32x4 w; w.x = cvtpk(v0[0], v0[1]); w.y = cvtpk(v0[2], v0[3]); w.z = cvtpk(v1[0], v1[1]); w.w = cvtpk(v1[2], v1[3]);
                        store16_wt(rowp + bj * HALF, w); } }
        } else {
            const int col0 = (u.pn - 12) * HALF + wc * 32 + 8 * fq;
#pragma unroll
            for (int ai = 0; ai < 2; ++ai)
#pragma unroll
                for (int m = 0; m < 4; ++m) { const int row = row0 + ai * HALF + m * 16; const float r = rs[ai][m]; float rho[8], sg[8];
#pragma unroll
                    for (int n = 0; n < 2; ++n)
#pragma unroll
                        for (int e = 0; e < 4; ++e) { const float ga = acc[ai][0][m][n][e] * r, gd = fmaxf(acc[ai][1][m][n][e] * r, -80.f);
                            const float ed = 1.f + __expf(-gd), ea = 1.f + __expf(-ga); rho[4 * n + e] = ed * __builtin_amdgcn_rcpf(ea); sg[4 * n + e] = __builtin_amdgcn_rcpf(ed); }
                    u32x4 w; w.x = cvtpk(rho[0], rho[1]); w.y = cvtpk(rho[2], rho[3]); w.z = cvtpk(rho[4], rho[5]); w.w = cvtpk(rho[6], rho[7]);
                    store16_wt(gates + (size_t)row * D + col0, w);
                    w.x = cvtpk(sg[0], sg[1]); w.y = cvtpk(sg[2], sg[3]); w.z = cvtpk(sg[4], sg[5]); w.w = cvtpk(sg[6], sg[7]);
                    store16_wt(gates + (size_t)MB * D + (size_t)row * D + col0, w); }
        }
    }
};
struct EpiFF1 {
    static constexpr bool HAS_POST = false, HAS_RTAB = true;
    static constexpr bool PERM = true, HAS_MID = false;
    bf16_t* H; const float* ss; LAS float* rtab;
    __device__ __forceinline__ void mid(f32x4 (&acc)[2][2][4][2], const Unit& u, int wr, int wc, int fr, int fq) const {}
    __device__ __forceinline__ void operator()(f32x4 (&acc)[2][2][4][2], const Unit& u, int wr, int wc, int fr, int fq) const {
        const int row0 = u.pm * BM + wr * 64 + fr, col0 = u.pn * BM + wc * 32 + 8 * fq;
        float rs[2][4];
        if (rtab) {
#pragma unroll
            for (int ai = 0; ai < 2; ++ai)
#pragma unroll
                for (int m = 0; m < 4; ++m) rs[ai][m] = rtab[wr * 64 + fr + ai * HALF + m * 16];
        } else {
#pragma unroll
            for (int ai = 0; ai < 2; ++ai)
#pragma unroll
                for (int m = 0; m < 4; ++m) rs[ai][m] = row_rstd(ss, row0 + ai * HALF + m * 16);
        }
#pragma unroll
        for (int ai = 0; ai < 2; ++ai)
#pragma unroll
            for (int m = 0; m < 4; ++m) { const int row = row0 + ai * HALF + m * 16; const float r = rs[ai][m]; bf16_t* rowp = H + (size_t)row * FF + col0;
#pragma unroll
                for (int bj = 0; bj < 2; ++bj) { f32x4 v0 = acc[ai][bj][m][0] * r, v1 = acc[ai][bj][m][1] * r;
#pragma unroll
                    for (int e = 0; e < 4; ++e) { const float a = fmaxf(v0[e], 0.f), b = fmaxf(v1[e], 0.f); v0[e] = a * a; v1[e] = b * b; }
                    u32x4 w; w.x = cvtpk(v0[0], v0[1]); w.y = cvtpk(v0[2], v0[3]); w.z = cvtpk(v1[0], v1[1]); w.w = cvtpk(v1[2], v1[3]);
                    store16_wt(rowp + bj * HALF, w); } }
    }
};
struct EpiMerge {
    static constexpr bool HAS_POST = false, HAS_RTAB = false;
    static constexpr bool PERM = true, HAS_MID = true;
    bf16_t* O; const bf16_t* gates;
    __device__ __forceinline__ void mid(f32x4 (&acc)[2][2][4][2], const Unit& u, int wr, int wc, int fr, int fq) const {
        const int row0 = u.pm * BM + wr * 64 + fr, col0 = u.pn * BM + wc * 32 + 8 * fq;
        const bf16_t* gp = gates + (size_t)row0 * D + col0;
        asm volatile("" : "+v"(gp) :: "memory");
        u32x4 g[2][4][2];
#pragma unroll
        for (int ai = 0; ai < 2; ++ai)
#pragma unroll
            for (int q = 0; q < 4; ++q)
#pragma unroll
                for (int bj = 0; bj < 2; ++bj) g[ai][q][bj] = *(const GAS u32x4*)(gp + (ai * HALF + q * 16) * D + bj * HALF);
        __builtin_amdgcn_sched_barrier(0);
#pragma unroll
        for (int ai = 0; ai < 2; ++ai)
#pragma unroll
            for (int q = 0; q < 4; ++q)
#pragma unroll
                for (int bj = 0; bj < 2; ++bj)
#pragma unroll
                    for (int w = 0; w < 4; ++w) { acc[ai][bj][q][w >> 1][(w & 1) * 2] *= bflo(g[ai][q][bj][w]); acc[ai][bj][q][w >> 1][(w & 1) * 2 + 1] *= bfhi(g[ai][q][bj][w]); }
    }
    __device__ __forceinline__ void operator()(f32x4 (&acc)[2][2][4][2], const Unit& u, int wr, int wc, int fr, int fq) const {
        const int row0 = u.pm * BM + wr * 64 + fr, col0 = u.pn * BM + wc * 32 + 8 * fq;
        const bf16_t* gp = gates + (size_t)MB * D + (size_t)row0 * D + col0; bf16_t* rowp = O + (size_t)row0 * D + col0;
        asm volatile("" : "+v"(gp), "+v"(rowp) :: "memory");
        u32x4 g[2][4][2];
#pragma unroll
        for (int ai = 0; ai < 2; ++ai)
#pragma unroll
            for (int q = 0; q < 4; ++q)
#pragma unroll
                for (int bj = 0; bj < 2; ++bj) g[ai][q][bj] = *(const GAS u32x4*)(gp + (ai * HALF + q * 16) * D + bj * HALF);
        __builtin_amdgcn_sched_barrier(0);
#pragma unroll
        for (int ai = 0; ai < 2; ++ai)
#pragma unroll
            for (int q = 0; q < 4; ++q)
#pragma unroll
                for (int bj = 0; bj < 2; ++bj) { float o[8];
#pragma unroll
                    for (int w = 0; w < 4; ++w) { o[2 * w] = acc[ai][bj][q][w >> 1][(w & 1) * 2] * bflo(g[ai][q][bj][w]); o[2 * w + 1] = acc[ai][bj][q][w >> 1][(w & 1) * 2 + 1] * bfhi(g[ai][q][bj][w]); }
                    u32x4 w4; w4.x = cvtpk(o[0], o[1]); w4.y = cvtpk(o[2], o[3]); w4.z = cvtpk(o[4], o[5]); w4.w = cvtpk(o[6], o[7]);
                    store16_wt((void*)(rowp + (ai * HALF + q * 16) * D + bj * HALF), w4); }
    }
};
struct EpiResid {
    static constexpr bool HAS_POST = true, HAS_RTAB = false;
    static constexpr bool PERM = true, HAS_MID = false;
    bf16_t* xb; float* ss; float qs[2][4];
    __device__ __forceinline__ void mid(f32x4 (&acc)[2][2][4][2], const Unit& u, int wr, int wc, int fr, int fq) const {}
    __device__ __forceinline__ void operator()(f32x4 (&acc)[2][2][4][2], const Unit& u, int wr, int wc, int fr, int fq) {
        const int row0 = u.pm * BM + wr * 64 + fr, col0 = u.pn * BM + wc * 32 + 8 * fq;
        u32x4 xv[2][4][2];
#pragma unroll
        for (int ai = 0; ai < 2; ++ai)
#pragma unroll
            for (int m = 0; m < 4; ++m)
#pragma unroll
                for (int bj = 0; bj < 2; ++bj) xv[ai][m][bj] = *(const GAS u32x4*)(xb + (size_t)(row0 + ai * HALF + m * 16) * D + col0 + bj * HALF);
        __builtin_amdgcn_sched_barrier(0);
#pragma unroll
        for (int ai = 0; ai < 2; ++ai) {
#pragma unroll
            for (int m = 0; m < 4; ++m) { const int row = row0 + ai * HALF + m * 16; bf16_t* rowp = xb + (size_t)row * D + col0; float q = 0.f;
#pragma unroll
                for (int bj = 0; bj < 2; ++bj) { const u32x4 x4 = xv[ai][m][bj];
                    const f32x4 y0 = (f32x4){bflo(x4.x), bfhi(x4.x), bflo(x4.y), bfhi(x4.y)} + acc[ai][bj][m][0], y1 = (f32x4){bflo(x4.z), bfhi(x4.z), bflo(x4.w), bfhi(x4.w)} + acc[ai][bj][m][1];
                    q += (y0[0] * y0[0] + y0[1] * y0[1]) + (y0[2] * y0[2] + y0[3] * y0[3]) + (y1[0] * y1[0] + y1[1] * y1[1]) + (y1[2] * y1[2] + y1[3] * y1[3]);
                    u32x4 w; w.x = cvtpk(y0[0], y0[1]); w.y = cvtpk(y0[2], y0[3]); w.z = cvtpk(y1[0], y1[1]); w.w = cvtpk(y1[2], y1[3]);
                    *(GAS u32x4*)(rowp + bj * HALF) = w; }
                q = sum_xor32(sum_xor16(q));
                qs[ai][m] = q; }
            __builtin_amdgcn_sched_barrier(0);
        }
    }
    __device__ __forceinline__ void post(LAS unsigned char* lds, f32x4 (&acc)[2][2][4][2], const Unit& u, int wr, int wc, int fr, int fq, int tid) {
        LAS float* P = (LAS float*)lds;
        if (fq == 0) {
#pragma unroll
            for (int ai = 0; ai < 2; ++ai)
#pragma unroll
                for (int m = 0; m < 4; ++m) P[(ai * HALF + wr * 64 + m * 16 + fr) * 4 + wc] = qs[ai][m];
        }
        asm volatile("s_waitcnt lgkmcnt(0)" ::: "memory"); __builtin_amdgcn_s_barrier(); asm volatile("" ::: "memory");
        if (tid < 256) { const f32x4 v = *(const LAS f32x4*)(P + tid * 4); ss[(size_t)(u.pm * BM + tid) * 4 + u.pn] = (v[0] + v[1]) + (v[2] + v[3]); }
    }
};

struct EpiFinal {
    static constexpr bool HAS_POST = true, HAS_RTAB = false;
    static constexpr bool PERM = true, HAS_MID = false;
    const bf16_t* xb; float* ss; const float* g; float* out; unsigned* cnt; float qs[2][4];
    __device__ __forceinline__ void mid(f32x4 (&acc)[2][2][4][2], const Unit& u, int wr, int wc, int fr, int fq) const {}
    __device__ __forceinline__ void operator()(f32x4 (&acc)[2][2][4][2], const Unit& u, int wr, int wc, int fr, int fq) {
        const int row0 = u.pm * BM + wr * 64 + fr, col0 = u.pn * BM + wc * 32 + 8 * fq;
        u32x4 xq[2][4][2];
#pragma unroll
        for (int ai = 0; ai < 2; ++ai)
#pragma unroll
            for (int m = 0; m < 4; ++m)
#pragma unroll
                for (int bj = 0; bj < 2; ++bj) xq[ai][m][bj] = *(const GAS u32x4*)(xb + (size_t)(row0 + ai * HALF + m * 16) * D + col0 + bj * HALF);
        __builtin_amdgcn_sched_barrier(0);
#pragma unroll
        for (int ai = 0; ai < 2; ++ai)
#pragma unroll
            for (int m = 0; m < 4; ++m) { float q = 0.f;
#pragma unroll
                for (int bj = 0; bj < 2; ++bj) { const u32x4 xv = xq[ai][m][bj];
                    const f32x4 y0 = (f32x4){bflo(xv.x), bfhi(xv.x), bflo(xv.y), bfhi(xv.y)} + acc[ai][bj][m][0], y1 = (f32x4){bflo(xv.z), bfhi(xv.z), bflo(xv.w), bfhi(xv.w)} + acc[ai][bj][m][1];
                    q += (y0[0] * y0[0] + y0[1] * y0[1]) + (y0[2] * y0[2] + y0[3] * y0[3]) + (y1[0] * y1[0] + y1[1] * y1[1]) + (y1[2] * y1[2] + y1[3] * y1[3]);
                    acc[ai][bj][m][0] = y0; acc[ai][bj][m][1] = y1; }
                q = sum_xor32(sum_xor16(q));
                qs[ai][m] = q; }
    }
    __device__ __forceinline__ void post(LAS unsigned char* lds, f32x4 (&acc)[2][2][4][2], const Unit& u, int wr, int wc, int fr, int fq, int tid) {
        LAS float* P = (LAS float*)lds;
        LAS float* S = (LAS float*)(lds + 4096);
        LAS unsigned* flag = (LAS unsigned*)(lds + 4096 + 1024);
        if (fq == 0) {
#pragma unroll
            for (int ai = 0; ai < 2; ++ai)
#pragma unroll
                for (int m = 0; m < 4; ++m) P[(ai * HALF + wr * 64 + m * 16 + fr) * 4 + wc] = qs[ai][m];
        }
        asm volatile("s_waitcnt lgkmcnt(0)" ::: "memory"); __builtin_amdgcn_s_barrier(); asm volatile("" ::: "memory");
        unsigned* pc = cnt + 64 * u.pm;
        if (tid < 256) {
            const f32x4 v = *(const LAS f32x4*)(P + tid * 4);
            __hip_atomic_store(ss + (size_t)(u.pm * BM + tid) * 4 + u.pn, (v[0] + v[1]) + (v[2] + v[3]), __ATOMIC_RELAXED, __HIP_MEMORY_SCOPE_AGENT);
            asm volatile("s_waitcnt vmcnt(0)" ::: "memory");
            if ((tid & 63) == 0) __hip_atomic_fetch_add(pc, 1u, __ATOMIC_RELAXED, __HIP_MEMORY_SCOPE_AGENT);
        }
        if (tid < 64) {
            unsigned sp = 0;
            while ((unsigned)__builtin_amdgcn_readfirstlane(__hip_atomic_load(pc, __ATOMIC_RELAXED, __HIP_MEMORY_SCOPE_AGENT)) < 16u) { __builtin_amdgcn_s_sleep(2); if (++sp > (1u << 20)) break; }
            asm volatile("s_waitcnt vmcnt(0)" ::: "memory");
            if (tid == 0) flag[0] = 1u;
        }
        asm volatile("s_waitcnt lgkmcnt(0)" ::: "memory"); __builtin_amdgcn_s_barrier(); asm volatile("" ::: "memory");
        if (tid < 256) {
            const float* sp4 = ss + (size_t)(u.pm * BM + tid) * 4; float t = 0.f;
#pragma unroll
            for (int j = 0; j < 4; ++j) t += __hip_atomic_load(sp4 + j, __ATOMIC_RELAXED, __HIP_MEMORY_SCOPE_AGENT);
            S[tid] = 1.0f / sqrtf(t * (1.0f / (float)D) + RMS_EPS);
        }
        asm volatile("s_waitcnt vmcnt(0) lgkmcnt(0)" ::: "memory"); __builtin_amdgcn_s_barrier(); asm volatile("" ::: "memory");
        const int row0 = u.pm * BM + wr * 64 + fr, col0 = u.pn * BM + wc * 32 + 8 * fq;
        f32x4 gv[2][2];
#pragma unroll
        for (int bj = 0; bj < 2; ++bj)
#pragma unroll
            for (int n = 0; n < 2; ++n) gv[bj][n] = *(const f32x4*)(g + col0 + bj * HALF + 4 * n);
#pragma unroll
        for (int ai = 0; ai < 2; ++ai)
#pragma unroll
            for (int m = 0; m < 4; ++m) { const int rl = ai * HALF + wr * 64 + m * 16 + fr; const float r = S[rl]; float* rowp = out + (size_t)(u.pm * BM + rl) * D + col0;
#pragma unroll
                for (int bj = 0; bj < 2; ++bj) { *(f32x4*)(rowp + bj * HALF) = acc[ai][bj][m][0] * r * gv[bj][0]; *(f32x4*)(rowp + bj * HALF + 4) = acc[ai][bj][m][1] * r * gv[bj][1]; } }
    }
};

template <class Epi, class Sched, bool ALIGN_EPI, bool SP2>
__device__ __forceinline__ void gemm_phase(LAS unsigned char* lds, const Gemm g, const Sched& S, Epi& E, int wave_) {
    const int tid_ = wave_ * 64 + (int)lane_id_now();
    const int tid = tid_, wid = __builtin_amdgcn_readfirstlane(tid >> 6), lane = tid & 63, wr = wid >> 2, wc = wid & 3, fr = lane & 15, fq = lane >> 4;
    const int K = g.K, nt = K / BK;
    unsigned voffA[2], voffB[2];
#pragma unroll
    for (int i = 0; i < 2; ++i) { int R, C; stage_rc(tid * 16 + i * 8192, R, C); const int Rb = Epi::PERM ? ((R & ~31) + perm32(R & 31)) : R;
        voffA[i] = (unsigned)(R * K + C) * 2u; voffB[i] = (unsigned)(Rb * K + C) * 2u; }
    const size_t kstep = (size_t)(BK * 2);
    const size_t hstep = (size_t)HALF * K * 2;
    const size_t tstep = 2 * hstep;
    const unsigned ldsw = (unsigned)wid * 1024u;
    const int aoff = lds_byte(wr * 64 + fr, fq * 8), boff = lds_byte(wc * 32 + fr, fq * 8);
#define PG8_SA(b, h) (((b) * 2 + (h)) * HTB)
#define PG8_SB(b, h) ((4 + (b) * 2 + (h)) * HTB)
#define PG8_STAGE(bufoff, gbase, voff) do { _Pragma("unroll") for (int _i = 0; _i < 2; ++_i) \
        __builtin_amdgcn_global_load_lds((const unsigned*)((const char*)(gbase) + (voff)[_i]), (LAS unsigned*)(lds + (bufoff) + ldsw + _i * 8192), 16, 0, 0); } while (0)
#define PG8_LDA(dst, b, h) do { _Pragma("unroll") for (int m = 0; m < 4; ++m) _Pragma("unroll") for (int k = 0; k < 2; ++k) dst[m][k] = *(const LAS bf16x8*)(lds + PG8_SA(b, h) + aoff + m * 2048 + k * 1024); } while (0)
#define PG8_LDB(dst, b, h) do { _Pragma("unroll") for (int n = 0; n < 2; ++n) _Pragma("unroll") for (int k = 0; k < 2; ++k) dst[n][k] = *(const LAS bf16x8*)(lds + PG8_SB(b, h) + boff + n * 2048 + k * 1024); } while (0)
#define PG8_MMA(ai, bj, At, Bt) do { __builtin_amdgcn_s_setprio(1); _Pragma("unroll") for (int m = 0; m < 4; ++m) _Pragma("unroll") for (int n = 0; n < 2; ++n) _Pragma("unroll") for (int k = 0; k < 2; ++k) \
        acc[ai][bj][m][n] = __builtin_amdgcn_mfma_f32_16x16x32_bf16(Bt[n][k], At[m][k], acc[ai][bj][m][n], 0, 0, 0); __builtin_amdgcn_s_setprio(0); } while (0)
#define PG8_WAIT_V(n) asm volatile("s_waitcnt vmcnt(" #n ")" ::: "memory")
#define PG8_WAIT_L(n) asm volatile("s_waitcnt lgkmcnt(" #n ")" ::: "memory")
#define PG8_BAR __builtin_amdgcn_s_barrier()
#define PG8_SCHED __builtin_amdgcn_sched_barrier(0)
    Unit cur, nxt; int ui = 0;
    if (!S.next(0, cur)) return;
    f32x4 acc[2][2][4][2];
#pragma unroll
    for (int a = 0; a < 2; ++a)
#pragma unroll
        for (int b = 0; b < 2; ++b)
#pragma unroll
            for (int m = 0; m < 4; ++m)
#pragma unroll
                for (int n = 0; n < 2; ++n) acc[a][b][m][n] = (f32x4){0.f, 0.f, 0.f, 0.f};
    bf16x8 At[4][2], B0[2][2], B1[2][2];
    const char* cA = (const char*)g.A + (size_t)cur.pm * tstep; const char* cB = (const char*)g.Bt + (size_t)cur.pn * tstep;
    if constexpr (SP2) {
        PG8_STAGE(PG8_SB(0, 0), cB, voffB); PG8_STAGE(PG8_SB(0, 1), cB + hstep, voffB); PG8_STAGE(PG8_SA(0, 0), cA, voffA); PG8_STAGE(PG8_SA(0, 1), cA + hstep, voffA);
        if constexpr (Epi::HAS_RTAB) { if (E.rtab && tid < 256) E.rtab[tid] = row_rstd(E.ss, cur.pm * BM + tid); }
        if (wr == 1) PG8_BAR;
        PG8_WAIT_V(2); PG8_BAR;
        PG8_STAGE(PG8_SB(1, 0), cB + kstep, voffB); PG8_STAGE(PG8_SA(1, 0), cA + kstep, voffA); PG8_STAGE(PG8_SB(1, 1), cB + hstep + kstep, voffB);
        PG8_WAIT_V(6); PG8_BAR;
    } else {
        PG8_STAGE(PG8_SB(0, 0), cB, voffB); PG8_STAGE(PG8_SA(0, 0), cA, voffA); PG8_STAGE(PG8_SB(0, 1), cB + hstep, voffB); PG8_STAGE(PG8_SA(0, 1), cA + hstep, voffA);
        if (wr == 1) PG8_BAR;
        PG8_WAIT_V(4); PG8_BAR;
        PG8_STAGE(PG8_SB(1, 0), cB + kstep, voffB); PG8_STAGE(PG8_SA(1, 0), cA + kstep, voffA); PG8_STAGE(PG8_SB(1, 1), cB + hstep + kstep, voffB);
        PG8_WAIT_V(6); PG8_BAR;
    }
    for (;;) {
        const bool has_next = S.next(ui + 1, nxt);
        const char* nA = has_next ? (const char*)g.A + (size_t)nxt.pm * tstep : cA; const char* nB = has_next ? (const char*)g.Bt + (size_t)nxt.pn * tstep : cB;
        for (int t = 0; t < nt; t += 2) {
            if constexpr (Epi::HAS_MID) { if (t == nt / 2) E.mid(acc, cur, wr, wc, fr, fq); }
            const bool last = (t == nt - 2);
            const char* a1 = cA + (size_t)(t + 1) * kstep;
            const char* a2 = last ? nA : cA + (size_t)(t + 2) * kstep; const char* b2 = last ? nB : cB + (size_t)(t + 2) * kstep;
            const char* a3 = a2 + kstep; const char* b3 = b2 + kstep;
            if constexpr (SP2) {
            PG8_LDB(B0, 0, 0); PG8_LDB(B1, 0, 1); PG8_SCHED; PG8_LDA(At, 0, 0); PG8_STAGE(PG8_SA(1, 1), a1 + hstep, voffA);
            PG8_WAIT_V(8); PG8_WAIT_L(0); PG8_BAR; PG8_MMA(0, 0, At, B0); PG8_MMA(0, 1, At, B1); PG8_BAR; PG8_SCHED;
            PG8_LDA(At, 0, 1); PG8_STAGE(PG8_SB(0, 0), b2, voffB); PG8_STAGE(PG8_SB(0, 1), b2 + hstep, voffB); PG8_STAGE(PG8_SA(0, 0), a2, voffA);
            PG8_WAIT_V(8); PG8_WAIT_L(0); PG8_BAR; PG8_MMA(1, 0, At, B0); PG8_MMA(1, 1, At, B1); PG8_BAR; PG8_SCHED;
            PG8_LDB(B0, 1, 0); PG8_LDB(B1, 1, 1); PG8_SCHED; PG8_LDA(At, 1, 0); PG8_STAGE(PG8_SA(0, 1), a2 + hstep, voffA);
            PG8_WAIT_V(8); PG8_WAIT_L(0); PG8_BAR; PG8_MMA(0, 0, At, B0); PG8_MMA(0, 1, At, B1); PG8_BAR; PG8_SCHED;
            PG8_LDA(At, 1, 1); PG8_STAGE(PG8_SB(1, 0), b3, voffB); PG8_STAGE(PG8_SB(1, 1), b3 + hstep, voffB); PG8_STAGE(PG8_SA(1, 0), a3, voffA);
            PG8_WAIT_V(8); PG8_WAIT_L(0); PG8_BAR; PG8_MMA(1, 0, At, B0); PG8_MMA(1, 1, At, B1); PG8_BAR; PG8_SCHED;
            } else {
            PG8_LDB(B0, 0, 0); PG8_SCHED; PG8_LDA(At, 0, 0); PG8_STAGE(PG8_SA(1, 1), a1 + hstep, voffA);
            PG8_WAIT_L(8); PG8_BAR; PG8_WAIT_L(0); PG8_MMA(0, 0, At, B0); PG8_BAR; PG8_SCHED;
            PG8_LDB(B1, 0, 1); PG8_STAGE(PG8_SB(0, 0), b2, voffB);
            PG8_BAR; PG8_WAIT_L(0); PG8_MMA(0, 1, At, B1); PG8_BAR;
            PG8_LDA(At, 0, 1); PG8_STAGE(PG8_SA(0, 0), a2, voffA);
            PG8_BAR; PG8_WAIT_L(0); PG8_MMA(1, 0, At, B0); PG8_BAR; PG8_SCHED;
            PG8_STAGE(PG8_SB(0, 1), b2 + hstep, voffB);
            PG8_WAIT_V(6); PG8_BAR; PG8_MMA(1, 1, At, B1); PG8_BAR;
            PG8_LDB(B0, 1, 0); PG8_SCHED; PG8_LDA(At, 1, 0); PG8_STAGE(PG8_SA(0, 1), a2 + hstep, voffA);
            PG8_WAIT_L(8); PG8_BAR; PG8_WAIT_L(0); PG8_MMA(0, 0, At, B0); PG8_BAR; PG8_SCHED;
            PG8_LDB(B1, 1, 1); PG8_STAGE(PG8_SB(1, 0), b3, voffB);
            PG8_BAR; PG8_WAIT_L(0); PG8_MMA(0, 1, At, B1); PG8_BAR;
            PG8_LDA(At, 1, 1); PG8_STAGE(PG8_SA(1, 0), a3, voffA);
            PG8_BAR; PG8_WAIT_L(0); PG8_MMA(1, 0, At, B0); PG8_BAR; PG8_SCHED;
            PG8_STAGE(PG8_SB(1, 1), b3 + hstep, voffB);
            PG8_WAIT_V(6); PG8_BAR; PG8_MMA(1, 1, At, B1); PG8_BAR;
            }
        }
        if constexpr (ALIGN_EPI) { if (wr == 0) PG8_BAR; }
        E(acc, cur, wr, wc, fr, fq);
        if (!has_next) break;
#pragma unroll
        for (int a = 0; a < 2; ++a)
#pragma unroll
            for (int b = 0; b < 2; ++b)
#pragma unroll
                for (int m = 0; m < 4; ++m)
#pragma unroll
                    for (int n = 0; n < 2; ++n) acc[a][b][m][n] = (f32x4){0.f, 0.f, 0.f, 0.f};
        cur = nxt; cA = nA; cB = nB; ++ui;
        if constexpr (ALIGN_EPI) { if (wr == 1) PG8_BAR; }
    }
    PG8_WAIT_V(0);
    if constexpr (!ALIGN_EPI) { if (wr == 0) PG8_BAR; }
    PG8_BAR;
    if constexpr (Epi::HAS_POST) E.post(lds, acc, cur, wr, wc, fr, fq, tid);
#undef PG8_SA
#undef PG8_SB
#undef PG8_STAGE
#undef PG8_LDA
#undef PG8_LDB
#undef PG8_MMA
#undef PG8_WAIT_V
#undef PG8_WAIT_L
#undef PG8_BAR
#undef PG8_SCHED
}
}

constexpr size_t MiB = 1u << 20;
constexpr size_t WS_CTL = 0, CTL_ZERO_BYTES = 64 * 1024;
constexpr size_t WS_SS = 1 * MiB;
constexpr size_t WS_W = 2 * MiB, W_LAYER = 30 * MiB;
constexpr size_t WO_IN = 0, WO_M = 10 * MiB, WO_OUT = 12 * MiB, WO_FF1 = 14 * MiB, WO_FF2 = 22 * MiB;
constexpr size_t WS_XNY = 62 * MiB;
constexpr size_t WS_QKV = 94 * MiB;
constexpr size_t BREG = 20 * MiB, BREG_GATES = 12 * MiB;
constexpr size_t WS_GATES = 190 * MiB;
constexpr size_t WS_MERGED = WS_QKV;
constexpr size_t WS_H = WS_QKV;
constexpr size_t WS_END = 254 * MiB;
constexpr int CW_BAR = 1024;
constexpr int CW_PANEL = 8192;

constexpr int RING_OFF = 0, RING_BYTES = 131072;
constexpr int ATT_WSF = 131072;
constexpr int ATT_TBL = ATT_WSF + 4096;
constexpr int LDSCTL_OFF = ATT_TBL + 4096, MISC_OFF = LDSCTL_OFF + 320;
constexpr int LDS_BYTES = 147456;
static_assert(MISC_OFF + 128 <= LDS_BYTES, "LDS map");
constexpr int NWAVES = 8;

#define RLX_AGENT __ATOMIC_RELAXED, __HIP_MEMORY_SCOPE_AGENT
#define LDS_WAIT() asm volatile("s_waitcnt lgkmcnt(0)" ::: "memory")
#define VM_WAIT() asm volatile("s_waitcnt vmcnt(0)" ::: "memory")

#define XB_TMO      128
#define XB_XCNT(j)  (256  + 64 * (j))
#define XB_XSUB(j)  (1280 + 64 * (j))
#define XB_XGEN(j)  (2304 + 64 * (j))
#define XB_TOP      3328
#define XB_TOPGEN   3392
#define XCD_BAR_WORDS 3456
#define XB_SPIN_CAP (1u << 18)
__device__ __forceinline__ unsigned xb_ld(unsigned* p)              { return __hip_atomic_load(p, __ATOMIC_RELAXED, __HIP_MEMORY_SCOPE_AGENT); }
__device__ __forceinline__ unsigned xb_add(unsigned* p, unsigned v) { return __hip_atomic_fetch_add(p, v, __ATOMIC_RELAXED, __HIP_MEMORY_SCOPE_AGENT); }
__device__ __forceinline__ unsigned xb_xcc_id() { return (unsigned)__builtin_amdgcn_s_getreg((3 << 11) | 20) & 0xFu; }
#define XB_SPIN(cond, bar) do { unsigned _sp = 0; while (cond) { __builtin_amdgcn_s_sleep(1); \
    if ((++_sp & 255u) == 0u) { if (xb_ld(&(bar)[XB_TMO])) break; if (_sp > XB_SPIN_CAP) { atomicAdd(&(bar)[XB_TMO], 1u); break; } } } } while (0)
struct XcdBarrier { unsigned* bar; unsigned x; volatile LAS unsigned* st; int wave; };
__device__ __forceinline__ bool xb_leader(int wave) { return wave == 0 && lane_id_now() == 0u; }
__device__ __forceinline__ XcdBarrier xcd_barrier_post(unsigned* bar, volatile LAS unsigned* st, int wave) {
    XcdBarrier b; b.bar = bar; b.x = xb_xcc_id(); b.st = st; b.wave = wave;
    if (xb_leader(wave)) st[2] = xb_add(&bar[XB_XCNT(b.x)], 1u);
    return b;
}
__device__ __forceinline__ void xcd_barrier_complete(unsigned* bar, unsigned x, unsigned& nloc, unsigned& nx, unsigned& xi) {
    const unsigned G = gridDim.x * gridDim.y * gridDim.z;
    unsigned sum, cnt, mine, below, sp = 0u;
    for (;;) {
        sum = 0u; cnt = 0u; mine = 0u; below = 0u;
#pragma unroll
        for (unsigned j = 0; j < 16; ++j) { const unsigned c = xb_ld(&bar[XB_XCNT(j)]); sum += c; cnt += (c > 0u) ? 1u : 0u; mine = (j == x) ? c : mine; below += (c > 0u && j < x) ? 1u : 0u; }
        if (sum == G) break;
        __builtin_amdgcn_s_sleep(1);
        if ((++sp & 255u) == 0u) { if (xb_ld(&bar[XB_TMO])) break; if (sp > XB_SPIN_CAP) { atomicAdd(&bar[XB_TMO], 1u); break; } }
    }
    nloc = mine > 0u ? mine : 1u; nx = cnt > 0u ? cnt : 1u; xi = below;
}
__device__ __forceinline__ void xcd_barrier(const XcdBarrier& b) {
    asm volatile("s_waitcnt vmcnt(0)" ::: "memory");
    __syncthreads();
    if (xb_leader(b.wave)) {
        unsigned* bar = b.bar;
        __builtin_amdgcn_s_waitcnt(0);
        unsigned nloc = b.st[0], nx = b.st[1];
        if (nloc == 0u) { unsigned xi; xcd_barrier_complete(bar, b.x, nloc, nx, xi); b.st[0] = nloc; b.st[1] = nx; b.st[3] = xi; }
        const unsigned old = xb_add(&bar[XB_XSUB(b.x)], 1u);
        const unsigned gen = old / nloc;
        if (old + 1u == (gen + 1u) * nloc) {
            __builtin_amdgcn_fence(__ATOMIC_RELEASE, "agent");
            asm volatile("s_waitcnt vmcnt(0)" ::: "memory");
            const unsigned og = xb_add(&bar[XB_TOP], 1u);
            const unsigned tg = og / nx;
            if (og + 1u == (tg + 1u) * nx) xb_add(&bar[XB_TOPGEN], 1u);
            else XB_SPIN(xb_ld(&bar[XB_TOPGEN]) == tg, bar);
            __builtin_amdgcn_fence(__ATOMIC_ACQUIRE, "agent");
            xb_add(&bar[XB_XGEN(b.x)], 1u);
            asm volatile("s_waitcnt vmcnt(0)" ::: "memory");
        } else {
            XB_SPIN(xb_ld(&bar[XB_XGEN(b.x)]) == gen, bar);
            __builtin_amdgcn_fence(__ATOMIC_ACQUIRE, "agent");
            asm volatile("s_waitcnt vmcnt(0)" ::: "memory");
        }
    }
    __syncthreads();
}

#define XL_SUB(j) (3584 + 64 * (j))
#define XL_GEN(j) (4608 + 64 * (j))
__device__ __forceinline__ void xcc_local_barrier(unsigned* bar, unsigned x, unsigned nloc, int wave, unsigned& gen) {
    if (wave == 0) asm volatile("buffer_inv sc1" ::: "memory");
    asm volatile("s_waitcnt vmcnt(0)" ::: "memory");
    __syncthreads();
    if (xb_leader(wave)) {
        __builtin_amdgcn_s_waitcnt(0);
        const unsigned old = xb_add(&bar[XL_SUB(x)], 1u);
        if (old + 1u == (gen + 1u) * nloc) xb_add(&bar[XL_GEN(x)], 1u);
        else XB_SPIN(xb_ld(&bar[XL_GEN(x)]) == gen, bar);
        asm volatile("s_waitcnt vmcnt(0)" ::: "memory");
    }
    ++gen;
    __syncthreads();
}

struct Frame {
    LAS unsigned char* lds;
    int vcu, G, wave;
    float* out; unsigned char* ws;
};
__device__ __forceinline__ int phase_tid(int wave) { return wave * 64 + (int)lane_id_now(); }
#define PHASE_IDS() const int tid_ = phase_tid(F.wave); const int tid = tid_, lane = tid & 63, wave = __builtin_amdgcn_readfirstlane(tid >> 6); (void)tid; (void)lane; (void)wave
__device__ __forceinline__ const float* arg_in(int k) { asm volatile("" : "+s"(k)); return ((const float* const __attribute__((address_space(4)))*)__builtin_amdgcn_kernarg_segment_ptr())[k]; }

__device__ __forceinline__ float wave_sum(float v) { return sum_xor32(sum_half32(v)); }
__device__ __forceinline__ void p0_transpose_item(const float* W, int N, bf16_t* WT, int ldk, int koff, LAS float* scr, int item, int lane, const float* gk = nullptr, bool gate_remap = false) {
    const int nblk = N / 32, kb = item / nblk, nb = item % nblk, k0 = 64 * kb, n0 = 32 * nb;
    int nd = n0;
    if (gate_remap && n0 >= NQKV) { const int gcol = n0 - NQKV, isd = gcol >= D, c = isd ? gcol - D : gcol; nd = NQKV + (c >> 7) * 256 + isd * 128 + (c & 127); }
    const float* src = W + (size_t)(k0 + (lane >> 3)) * N + n0 + (lane & 7) * 4;
    f32x4 v[8];
#pragma unroll
    for (int i = 0; i < 8; ++i) v[i] = *(const f32x4*)(src + (size_t)(8 * i) * N);
    if (gk) {
#pragma unroll
        for (int i = 0; i < 8; ++i) v[i] = v[i] * gk[k0 + 8 * i + (lane >> 3)]; }
#pragma unroll
    for (int i = 0; i < 8; ++i) { LAS float* d = scr + (8 * i + (lane >> 3)) * 33 + (lane & 7) * 4; d[0] = v[i][0]; d[1] = v[i][1]; d[2] = v[i][2]; d[3] = v[i][3]; }
    LDS_WAIT(); asm volatile("" ::: "memory");
    const int c = lane & 7;
#pragma unroll
    for (int j = 0; j < 4; ++j) { const int n = (lane >> 3) + 8 * j; const LAS float* s = scr + (8 * c) * 33 + n;
        u32x4 o; o.x = cvtpk(s[0 * 33], s[1 * 33]); o.y = cvtpk(s[2 * 33], s[3 * 33]); o.z = cvtpk(s[4 * 33], s[5 * 33]); o.w = cvtpk(s[6 * 33], s[7 * 33]);
        *(u32x4*)(WT + (size_t)(nd + n) * ldk + koff + k0 + 8 * c) = o; }
    LDS_WAIT(); asm volatile("" ::: "memory");
}
__device__ __forceinline__ void p0_prologue(Frame& F) {
    PHASE_IDS();
    LAS float* scr = (LAS float*)(F.lds + RING_OFF + wave * 16384);
    const int gw = F.vcu * NWAVES + wave, NGW = F.G * NWAVES;
    constexpr int I_IN = (D / 64) * (NIN / 32), I_B = (512 / 64) * (D / 32), I_O = (D / 64) * (D / 32), I_1 = (D / 64) * (FF / 32), I_2 = (FF / 64) * (D / 32);
    constexpr int NL = I_IN + 2 * I_B + I_O + I_1 + I_2, NITEMS = DEPTH * NL;
    for (int it = gw; it < NITEMS; it += NGW) {
        const int L = it / NL; int r = it % NL;
        unsigned char* wb = F.ws + WS_W + (size_t)L * W_LAYER;
        if (r < I_IN) { p0_transpose_item(arg_in(4) + (size_t)L * D * NIN, NIN, (bf16_t*)(wb + WO_IN), D, 0, scr, r, lane, arg_in(3) + L * D, true); continue; } r -= I_IN;
        if (r < I_B) { p0_transpose_item(arg_in(8) + (size_t)L * 512 * D, D, (bf16_t*)(wb + WO_M), D, 0, scr, r, lane); continue; } r -= I_B;
        if (r < I_B) { p0_transpose_item(arg_in(9) + (size_t)L * 512 * D, D, (bf16_t*)(wb + WO_M), D, 512, scr, r, lane); continue; } r -= I_B;
        if (r < I_O) { p0_transpose_item(arg_in(10) + (size_t)L * D * D, D, (bf16_t*)(wb + WO_OUT), D, 0, scr, r, lane); continue; } r -= I_O;
        if (r < I_1) { p0_transpose_item(arg_in(12) + (size_t)L * D * FF, FF, (bf16_t*)(wb + WO_FF1), D, 0, scr, r, lane, arg_in(11) + L * D); continue; } r -= I_1;
        p0_transpose_item(arg_in(13) + (size_t)L * FF * D, D, (bf16_t*)(wb + WO_FF2), FF, 0, scr, r, lane);
    }
    const float* x = arg_in(0); bf16_t* XN = (bf16_t*)(F.ws + WS_XNY); float* SS = (float*)(F.ws + WS_SS);
    for (int m0 = 2 * gw; m0 < M; m0 += 2 * NGW) {
        f32x4 v[2][4];
#pragma unroll
        for (int q = 0; q < 2; ++q)
#pragma unroll
            for (int j = 0; j < 4; ++j) v[q][j] = ((const f32x4*)(x + (size_t)(m0 + q) * D) + lane)[64 * j];
#pragma unroll
        for (int q = 0; q < 2; ++q) { const int m = m0 + q; u32x2* o8 = (u32x2*)(XN + (size_t)m * D) + lane; float s = 0.f;
#pragma unroll
            for (int j = 0; j < 4; ++j) { const f32x4 vv = v[q][j]; s += (vv[0] * vv[0] + vv[1] * vv[1]) + (vv[2] * vv[2] + vv[3] * vv[3]);
                u32x2 w; w.x = cvtpk(vv[0], vv[1]); w.y = cvtpk(vv[2], vv[3]); o8[64 * j] = w; }
            s = wave_sum(s);
            if (lane < 4) SS[(size_t)m * 4 + lane] = (lane == 0) ? s : 0.f; }
    }
}
namespace att {
typedef LAS const char* lcp;
__device__ __forceinline__ int crow(int r, int hi) { return (r & 3) + 8 * (r >> 2) + 4 * hi; }
typedef short v4i16_t __attribute__((ext_vector_type(4)));
__device__ __forceinline__ s16x4 vtr(lcp p) { return __builtin_bit_cast(s16x4, __builtin_amdgcn_ds_read_tr16_b64_v4i16((LAS v4i16_t*)p)); }
#define MFMA32(a, b, c) __builtin_amdgcn_mfma_f32_32x32x16_bf16(a, b, c, 0, 0, 0)
#define ATT_WAIT_BAR(N) asm volatile("s_waitcnt vmcnt(" #N ") lgkmcnt(0)\n\ts_barrier" ::: "memory")
#define ATT_LDS_BAR() asm volatile("s_waitcnt lgkmcnt(0)\n\ts_barrier" ::: "memory")
__device__ __forceinline__ void glds16(const void* gsrc, unsigned lds_dst) { unsigned keep;
    asm volatile("s_mov_b32 %0, m0\n\ts_mov_b32 m0, %2\n\ts_nop 0\n\tglobal_load_lds_dwordx4 %1, off\n\ts_mov_b32 m0, %0" : "=&s"(keep) : "v"(gsrc), "s"(lds_dst) : "memory"); }
#define GLDS16(gsrc, ldsdst) glds16((const void*)(gsrc), (unsigned)__builtin_amdgcn_readfirstlane((int)(unsigned)(uintptr_t)(ldsdst)))
__device__ __forceinline__ void glds16s(unsigned voff, const void* sbase, unsigned lds_dst) { unsigned keep;
    asm volatile("s_mov_b32 %0, m0\n\ts_mov_b32 m0, %2\n\ts_nop 2\n\tglobal_load_lds_dwordx4 %1, %3\n\ts_mov_b32 m0, %0" : "=&s"(keep) : "v"(voff), "s"(lds_dst), "s"(sbase) : "memory"); }
#define GLDS16S(voff, sbase, ldsdst) glds16s((voff), (const void*)(sbase), (unsigned)__builtin_amdgcn_readfirstlane((int)(unsigned)(uintptr_t)(ldsdst)))
#define ATT_BAR_IF(cond, N) do { if (cond) ATT_WAIT_BAR(N); } while (0)
#define MX3(a, b, c) __builtin_fmaxf(__builtin_fmaxf((a), (b)), (c))

__device__ __forceinline__ void kload(bf16x8 (&kf)[8], lcp kslot, const int (&koff)[4]) {
#pragma unroll
    for (int d0 = 0; d0 < 4; ++d0) { kf[2 * d0] = *(const LAS bf16x8*)(kslot + koff[d0]); kf[2 * d0 + 1] = *(const LAS bf16x8*)(kslot + koff[d0] + 4096); }
}
__device__ __forceinline__ void qk_mfma(f32x16& p0, f32x16& p1, const bf16x8 (&kf)[8], const bf16x8* qr, const f32x16& cinit) {
    p0 = MFMA32(kf[0], qr[0], cinit); p1 = MFMA32(kf[1], qr[0], cinit);
#pragma unroll
    for (int d0 = 1; d0 < 4; ++d0) { p0 = MFMA32(kf[2 * d0], qr[d0], p0); p1 = MFMA32(kf[2 * d0 + 1], qr[d0], p1); }
}
__device__ __forceinline__ float rowmax32(const f32x16& p0, const f32x16& p1) {
    float a = MX3(p0[0], p0[1], p1[0]), b = MX3(p0[2], p0[3], p1[1]); a = MX3(a, p1[2], p1[3]);
#pragma unroll
    for (int r = 4; r < 16; r += 4) { a = MX3(a, p0[r], p0[r + 1]); b = MX3(b, p0[r + 2], p0[r + 3]); a = MX3(a, p1[r], p1[r + 1]); b = MX3(b, p1[r + 2], p1[r + 3]); }
    a = __builtin_fmaxf(a, b);
    auto rr = __builtin_amdgcn_permlane32_swap(__float_as_uint(a), __float_as_uint(a), false, false);
    return __builtin_fmaxf(__uint_as_float(rr[0]), __uint_as_float(rr[1]));
}
template <int NB, int THR>
__device__ __forceinline__ bool softmax_part(f32x16& p0, f32x16& p1, f32x16 (&o)[NB], float& mhat, float& l, bool first, LAS float* wsf, int r32, int hi, u32x4 (&pw)[4]) {
    const float rm = rowmax32(p0, p1);
    bool resc = false, moved = false;
    if (first) {
        mhat += rm; moved = true;
#pragma unroll
        for (int r = 0; r < 16; ++r) { p0[r] -= rm; p1[r] -= rm; }
    } else if (__any(rm > (float)THR)) {
        const float dl = fmaxf(rm, 0.f); mhat += dl; moved = true; resc = true;
#pragma unroll
        for (int r = 0; r < 16; ++r) { p0[r] -= dl; p1[r] -= dl; }
        const float f = __builtin_amdgcn_exp2f(-dl); l *= f; if (hi == 0) wsf[r32] = f;
    }
    float s = 0.f;
#pragma unroll
    for (int r = 0; r < 16; ++r) { p0[r] = __builtin_amdgcn_exp2f(p0[r]); p1[r] = __builtin_amdgcn_exp2f(p1[r]); s += p0[r] + p1[r]; }
    l += s;
    pw[0] = (u32x4){cvtpk(p0[0], p0[1]), cvtpk(p0[2], p0[3]), cvtpk(p0[4], p0[5]), cvtpk(p0[6], p0[7])};
    pw[1] = (u32x4){cvtpk(p0[8], p0[9]), cvtpk(p0[10], p0[11]), cvtpk(p0[12], p0[13]), cvtpk(p0[14], p0[15])};
    pw[2] = (u32x4){cvtpk(p1[0], p1[1]), cvtpk(p1[2], p1[3]), cvtpk(p1[4], p1[5]), cvtpk(p1[6], p1[7])};
    pw[3] = (u32x4){cvtpk(p1[8], p1[9]), cvtpk(p1[10], p1[11]), cvtpk(p1[12], p1[13]), cvtpk(p1[14], p1[15])};
    if (resc) {
        float fr[16];
#pragma unroll
        for (int r = 0; r < 16; ++r) fr[r] = wsf[crow(r, hi)];
#pragma unroll
        for (int d = 0; d < NB; ++d)
#pragma unroll
            for (int r = 0; r < 16; ++r) o[d][r] *= fr[r];
    }
    return moved;
}
__device__ __forceinline__ void vload0(s16x4 (&lo)[4], s16x4 (&hh)[4], lcp vb) {
#pragma unroll
    for (int ks = 0; ks < 4; ++ks) { lo[ks] = vtr(vb + ks * 1024); hh[ks] = vtr(vb + ks * 1024 + 512); }
}
template <int NB>
__device__ __forceinline__ void pv_part(f32x16 (&o)[NB], lcp vb, const u32x4 (&pw)[4], const s16x4 (&lo0)[4], const s16x4 (&hh0)[4]) {
    s16x4 lo[2][4], hh[2][4];
#pragma unroll
    for (int ks = 0; ks < 4; ++ks) { lo[0][ks] = lo0[ks]; hh[0][ks] = hh0[ks]; }
#pragma unroll
    for (int d0 = 0; d0 < NB; ++d0) {
        if (d0 + 1 < NB) {
#pragma unroll
            for (int ks = 0; ks < 4; ++ks) { lo[(d0 + 1) & 1][ks] = vtr(vb + (d0 + 1) * 4096 + ks * 1024); hh[(d0 + 1) & 1][ks] = vtr(vb + (d0 + 1) * 4096 + ks * 1024 + 512); }
        }
        __builtin_amdgcn_sched_barrier(0);
#define ATT_PK(k) (bf16x8){lo[d0 & 1][k][0], lo[d0 & 1][k][1], lo[d0 & 1][k][2], lo[d0 & 1][k][3], hh[d0 & 1][k][0], hh[d0 & 1][k][1], hh[d0 & 1][k][2], hh[d0 & 1][k][3]}
        o[d0] = MFMA32(__builtin_bit_cast(bf16x8, pw[0]), ATT_PK(0), o[d0]);
        o[d0] = MFMA32(__builtin_bit_cast(bf16x8, pw[1]), ATT_PK(1), o[d0]);
        o[d0] = MFMA32(__builtin_bit_cast(bf16x8, pw[2]), ATT_PK(2), o[d0]);
        o[d0] = MFMA32(__builtin_bit_cast(bf16x8, pw[3]), ATT_PK(3), o[d0]);
#undef ATT_PK
        __builtin_amdgcn_sched_barrier(0);
    }
}
__device__ __forceinline__ void row_inv_l(float l, float (&rli)[16], LAS float* wsf, int r32, int hi) {
    auto rr = __builtin_amdgcn_permlane32_swap(__float_as_uint(l), __float_as_uint(l), false, false);
    const float lt = __uint_as_float(rr[0]) + __uint_as_float(rr[1]);
    if (hi == 0) wsf[32 + r32] = lt;
#pragma unroll
    for (int r = 0; r < 16; ++r) rli[r] = __builtin_amdgcn_rcpf(wsf[32 + crow(r, hi)]);
}
__device__ __forceinline__ int t5_bucket(int rel) {
    const int n = rel < 0 ? -rel : rel;
    const int large = 8 + (n >= 12) + (n >= 16) + (n >= 23) + (n >= 32) + (n >= 46) + (n >= 64) + (n >= 91);
    return (rel > 0 ? 16 : 0) + (n < 8 ? n : large);
}


template <int THR>
__device__ __forceinline__ void diff_unit(Frame& F, int layer, const bf16_t* qkv, bf16_t* Y, int h, int qb) {
    const int tid = phase_tid(F.wave), wid = F.wave;
    const int mp = wid >> 2, wq = wid & 3;
    const size_t tokb = 0;
    LAS unsigned char* lds = F.lds;
    LAS float* wsf = (LAS float*)(lds + ATT_WSF) + wid * 128;
    LAS float* TBL = (LAS float*)(lds + ATT_TBL);
    constexpr int NT = SEQ / 64;
    f32x16 o[4]; float l = 0.f;
    float lpv[4], sgv[4];
    {
    const int lane = tid & 63, r32 = lane & 31, hi = lane >> 5;
    const bf16_t* kbase = qkv + tokb * NQKV + COL_KD + h * 128; const bf16_t* vbase_g = qkv + tokb * NQKV + COL_VD + h * 128;
#define DIFF_KVO(L_) ((unsigned)((8 * wid + ((L_) >> 3)) * NQKV + (((L_) & 7) ^ ((L_) >> 3)) * 8) * 2u)
#define DIFF_VVO(L_) ((unsigned)((16 * (wid & 3) + ((L_) >> 2)) * NQKV + (wid >> 2) * 32 + ((L_) & 3) * 8) * 2u)
#define DIFF_DMA_K(t) do { if ((t) < NT) { const size_t go_ = (size_t)(t) * 64 * NQKV; LAS unsigned char* rb_ = lds + ((t) & 3) * 16384 + wid * 1024; \
        int ld_ = lane; asm volatile("" : "+v"(ld_)); const unsigned kvo_ = DIFF_KVO(ld_); GLDS16S(kvo_, kbase + go_, rb_); GLDS16S(kvo_, kbase + go_ + 64, rb_ + 8192); } } while (0)
#define DIFF_DMA_V(t) do { if ((t) < NT) { const size_t go_ = (size_t)(t) * 64 * NQKV; LAS unsigned char* rb_ = lds + 65536 + ((t) & 3) * 16384 + wid * 1024; \
        int ld_ = lane; asm volatile("" : "+v"(ld_)); const unsigned vvo_ = DIFF_VVO(ld_); GLDS16S(vvo_, vbase_g + go_, rb_); GLDS16S(vvo_, vbase_g + go_ + 64, rb_ + 8192); } } while (0)
#define DIFF_WAIT_BAR(t) asm volatile("s_waitcnt vmcnt(8)\n\ts_cmp_lt_i32 %0, %1\n\ts_cbranch_scc1 .Ldw%=\n\ts_waitcnt vmcnt(6)\n\ts_cmp_lt_i32 %0, %2\n\ts_cbranch_scc1 .Ldw%=\n\ts_waitcnt vmcnt(2)\n\ts_cmp_lt_i32 %0, %3\n\ts_cbranch_scc1 .Ldw%=\n\ts_waitcnt vmcnt(0)\n.Ldw%=:\n\ts_waitcnt lgkmcnt(0)\n\ts_barrier" \
        :: "s"((int)(t)), "n"(NT - 3), "n"(NT - 2), "n"(NT - 1) : "scc", "memory")
    DIFF_DMA_K(0); DIFF_DMA_K(1); DIFF_DMA_V(0); DIFF_DMA_K(2); DIFF_DMA_V(1);
    float tv = arg_in(1)[t5_bucket((tid < 257 ? tid : 256) - 128) * 4 + h];
    bf16x8 qr[4];
    { const bf16_t* Qw = qkv + (tokb + qb * 128 + wq * 32 + r32) * NQKV + COL_QD + h * 128 + mp * 64 + hi * 8;
#pragma unroll
      for (int d0 = 0; d0 < 4; ++d0) qr[d0] = *(const bf16x8*)(Qw + d0 * 16); }
    asm volatile("" : "+v"(tv), "+v"(qr[0]), "+v"(qr[1]), "+v"(qr[2]), "+v"(qr[3]));
    if (tid < 257) TBL[tid] = tv * LOG2E;
    const int voff = ((lane >> 4) & 1) * 32 + (lane & 3) * 8 + (4 * hi + ((lane & 15) >> 2)) * 64;
    o[0] = f32x16{}; o[1] = f32x16{}; o[2] = f32x16{}; o[3] = f32x16{};
    float mhat = 0.f;
    const int qw0 = qb * 128 + wq * 32;
    ATT_WAIT_BAR(8);
    const float tL = __uint_as_float((unsigned)__builtin_amdgcn_readfirstlane((int)__float_as_uint(TBL[0]))), tR = __uint_as_float((unsigned)__builtin_amdgcn_readfirstlane((int)__float_as_uint(TBL[256])));
    bf16x8 kf[8]; f32x16 p0, p1, cinit; u32x4 pwA[4], pwB[4]; s16x4 vlo[2][4], vhh[2][4]; bool moved = false; int zc_id;
    { const int dk0 = 0 - qw0; zc_id = (dk0 >= 122) ? 1 : 2; const float c0 = (zc_id == 1 ? tR : tL);
#pragma unroll
      for (int r = 0; r < 16; ++r) cinit[r] = c0; }
#define SBAR() __builtin_amdgcn_sched_barrier(0)
#define PIN(x) asm volatile("" : "+v"(x))
#define DIFF_SCORES(t, FIRST) do { \
        { int rk_ = r32; asm volatile("" : "+v"(rk_)); int koff[4];                       \
          _Pragma("unroll") for (int d0 = 0; d0 < 4; ++d0) koff[d0] = rk_ * 128 + (((2 * d0 + hi) ^ (rk_ & 7)) << 4); \
          kload(kf, (lcp)(lds + ((t) & 3) * 16384 + mp * 8192), koff); } \
        SBAR();                                                                     \
        qk_mfma(p0, p1, kf, qr, cinit); \
        SBAR(); \
        DIFF_DMA_K((t) + 3); DIFF_DMA_V((t) + 2); \
        const int dk_ = (t) * 64 - qw0; const int zone_ = (dk_ >= 122) ? 1 : ((dk_ <= -154) ? 2 : 0); \
        if (zone_ == 0) { int rq_ = r32; asm volatile("" : "+v"(rq_)); const int base_ = dk_ - rq_ + 128; const float zc_ = (zc_id == 1) ? tR : tL; \
            _Pragma("unroll") for (int r = 0; r < 16; ++r) { int i0 = base_ + crow(r, hi), i1 = i0 + 32; \
                i0 = i0 < 0 ? 0 : (i0 > 256 ? 256 : i0); i1 = i1 < 0 ? 0 : (i1 > 256 ? 256 : i1); \
                p0[r] += TBL[i0] - zc_; p1[r] += TBL[i1] - zc_; if ((r & 3) == 3) SBAR(); } } \
        const float rm_ = rowmax32(p0, p1); \
        bool shift_ = FIRST; float dl_ = rm_; moved = false; \
        if (!(FIRST)) { moved = __any(rm_ > (float)THR); shift_ = moved; dl_ = fmaxf(rm_, 0.f); } \
        if (shift_) { mhat += dl_; \
            _Pragma("unroll") for (int r = 0; r < 16; ++r) { float a_ = p0[r], b_ = p1[r]; asm volatile("v_sub_f32_e32 %0, %0, %2\n\tv_sub_f32_e32 %1, %1, %2" : "+v"(a_), "+v"(b_) : "v"(dl_)); p0[r] = a_; p1[r] = b_; } \
            if (!(FIRST)) { const float f_ = __builtin_amdgcn_exp2f(-dl_); l *= f_; if (hi == 0) wsf[r32] = f_; } } \
        { const int dn_ = dk_ + 64; const int zn_ = (dn_ >= 122) ? 1 : ((dn_ <= -154) ? 2 : 0); \
          if (shift_ || (zn_ != 0 && zn_ != zc_id)) { if (zn_ != 0) zc_id = zn_; const float cb_ = ((zc_id == 1) ? tR : tL) - mhat; \
              _Pragma("unroll") for (int r = 0; r < 16; ++r) cinit[r] = cb_; } } \
        SBAR(); } while (0)
#define DIFF_EXP2(g, PWN, SACC) do { \
        float x0_ = ((g) < 8 ? p0[2 * ((g) & 7)] : p1[2 * ((g) & 7)]), x1_ = ((g) < 8 ? p0[2 * ((g) & 7) + 1] : p1[2 * ((g) & 7) + 1]); \
        x0_ = __builtin_amdgcn_exp2f(x0_); x1_ = __builtin_amdgcn_exp2f(x1_); SACC += x0_; SACC += x1_; PWN[(g) >> 2][(g) & 3] = cvtpk(x0_, x1_); } while (0)
#define VFRAG(B, i) (bf16x8){vlo[B][i][0], vlo[B][i][1], vlo[B][i][2], vlo[B][i][3], vhh[B][i][0], vhh[B][i][1], vhh[B][i][2], vhh[B][i][3]}
#define DIFF_GAP(g, PWC, PWN, VB) do { \
        o[(g) >> 2] = MFMA32(__builtin_bit_cast(bf16x8, PWC[(g) & 3]), VFRAG(((g) >> 2) & 1, (g) & 3), o[(g) >> 2]); \
        if ((g) < 12) { vlo[(((g) >> 2) + 1) & 1][(g) & 3] = vtr(VB + (((g) >> 2) + 1) * 4096 + ((g) & 3) * 1024); vhh[(((g) >> 2) + 1) & 1][(g) & 3] = vtr(VB + (((g) >> 2) + 1) * 4096 + ((g) & 3) * 1024 + 512); } \
        DIFF_EXP2(g, PWN, sacc_); PIN(sacc_); PIN(PWN[(g) >> 2]); SBAR(); } while (0)
#define DIFF_STEP(t, PWC, PWN) do { \
        lcp vb_ = (lcp)(lds + 65536 + (((t) - 1) & 3) * 16384 + voff); \
        _Pragma("unroll") for (int i = 0; i < 4; ++i) { vlo[0][i] = vtr(vb_ + i * 1024); vhh[0][i] = vtr(vb_ + i * 1024 + 512); } \
        DIFF_SCORES(t, false); \
        float sacc_ = 0.f; \
        DIFF_GAP(0, PWC, PWN, vb_); DIFF_GAP(1, PWC, PWN, vb_); DIFF_GAP(2, PWC, PWN, vb_); DIFF_GAP(3, PWC, PWN, vb_); \
        DIFF_GAP(4, PWC, PWN, vb_); DIFF_GAP(5, PWC, PWN, vb_); DIFF_GAP(6, PWC, PWN, vb_); DIFF_GAP(7, PWC, PWN, vb_); \
        DIFF_GAP(8, PWC, PWN, vb_); DIFF_GAP(9, PWC, PWN, vb_); DIFF_GAP(10, PWC, PWN, vb_); DIFF_GAP(11, PWC, PWN, vb_); \
        DIFF_GAP(12, PWC, PWN, vb_); DIFF_GAP(13, PWC, PWN, vb_); DIFF_GAP(14, PWC, PWN, vb_); DIFF_GAP(15, PWC, PWN, vb_); \
        l += sacc_; \
        DIFF_WAIT_BAR(t); \
        if (moved) { float fr_[16]; \
            _Pragma("unroll") for (int r = 0; r < 16; ++r) fr_[r] = wsf[crow(r, hi)]; \
            _Pragma("unroll") for (int d = 0; d < 4; ++d) _Pragma("unroll") for (int r = 0; r < 16; ++r) o[d][r] *= fr_[r]; \
} \
    } while (0)
    if (wid >= 4) __builtin_amdgcn_s_setprio(1);
    DIFF_SCORES(0, true);
    { float sacc_ = 0.f;
#pragma unroll
      for (int g = 0; g < 16; ++g) DIFF_EXP2(g, pwA, sacc_);
      l += sacc_; }
    ATT_WAIT_BAR(8);
#pragma unroll 1
    for (int t = 1; t + 1 < NT; t += 2) { DIFF_STEP(t, pwA, pwB); DIFF_STEP(t + 1, pwB, pwA); }
    DIFF_STEP(NT - 1, pwA, pwB);
    { const float* lp = arg_in(6) + layer * 256; const float* sg = arg_in(7) + layer * 128;
#pragma unroll
      for (int j = 0; j < 4; ++j) { lpv[j] = lp[64 * j + lane]; sgv[j] = sg[j * 32 + r32]; } }
    { lcp vb_ = (lcp)(lds + 65536 + ((NT - 1) & 3) * 16384 + voff); s16x4 l0[4], h0[4]; vload0(l0, h0, vb_); pv_part<4>(o, vb_, pwB, l0, h0); }
    __builtin_amdgcn_s_setprio(0);
    ATT_LDS_BAR();
#undef DIFF_WAIT_BAR
#undef DIFF_DMA_K
#undef DIFF_DMA_V
#undef DIFF_KVO
#undef DIFF_VVO
#undef DIFF_SCORES
#undef DIFF_EXP2
#undef DIFF_GAP
#undef DIFF_STEP
#undef VFRAG
#undef SBAR
#undef PIN
    }
    const int tid2_ = phase_tid(F.wave);
    const int lane = tid2_ & 63, r32 = lane & 31, hi = lane >> 5;
    float rli[16]; row_inv_l(l, rli, wsf, r32, hi);
#pragma unroll
    for (int d = 0; d < 4; ++d)
#pragma unroll
        for (int r = 0; r < 16; ++r) o[d][r] *= rli[r];
    LAS float* xch = (LAS float*)(lds) + wq * 4096;
    if (mp == 1) {
#pragma unroll
        for (int d = 0; d < 4; ++d)
#pragma unroll
            for (int r4 = 0; r4 < 4; ++r4) *(LAS f32x4*)(xch + ((d * 4 + r4) * 64 + lane) * 4) = (f32x4){o[d][4 * r4], o[d][4 * r4 + 1], o[d][4 * r4 + 2], o[d][4 * r4 + 3]};
    }
    ATT_LDS_BAR();
    if (mp == 0) {
        const float lpa = lpv[0] * lpv[1], lpb = lpv[2] * lpv[3];
        const float s1 = wave_sum(lpa), s2 = wave_sum(lpb);
        unsigned lbits_ = (layer == 0) ? 0x3E4CCCCDu : 0x3EB60549u; asm volatile("" : "+s"(lbits_));
        const float lam_init = __uint_as_float(lbits_);
        const float lam = expf(s1) - expf(s2) + lam_init;
        float ssq[16];
#pragma unroll
        for (int r = 0; r < 16; ++r) ssq[r] = 0.f;
#pragma unroll
        for (int d = 0; d < 4; ++d) { f32x4 x2[4];
#pragma unroll
            for (int r4 = 0; r4 < 4; ++r4) x2[r4] = *(const LAS f32x4*)(xch + ((d * 4 + r4) * 64 + lane) * 4);
            __builtin_amdgcn_sched_barrier(0);
#pragma unroll
            for (int r4 = 0; r4 < 4; ++r4)
#pragma unroll
                for (int e = 0; e < 4; ++e) { const int r = 4 * r4 + e; const float v = o[d][r] - lam * x2[r4][e]; o[d][r] = v; ssq[r] += v * v; } }
#pragma unroll
        for (int r = 0; r < 16; ++r) {
            float v = ssq[r];
            v = sum_half32(v);
            ssq[r] = (1.0f - lam_init) * __builtin_amdgcn_rsqf(v * (1.0f / 128.0f) + RMS_EPS);
        }
        LAS bf16_t* stg = (LAS bf16_t*)(lds + 65536) + wq * 4096;
#pragma unroll
        for (int d = 0; d < 4; ++d) { const float gg = sgv[d];
#pragma unroll
            for (int r = 0; r < 16; ++r) { const float v = o[d][r] * ssq[r] * gg; stg[crow(r, hi) * 128 + d * 32 + r32] = (bf16_t)(cvtpk(v, v) & 0xffffu); } }
        bf16_t* yb = Y + (tokb + qb * 128 + wq * 32 + (lane >> 4)) * D + 512 + h * 128 + (lane & 15) * 8;
        u32x4 sv[8];
#pragma unroll
        for (int i = 0; i < 8; ++i) sv[i] = *(const LAS u32x4*)(stg + (i * 4 + (lane >> 4)) * 128 + (lane & 15) * 8);
#pragma unroll
        for (int i = 0; i < 8; ++i) store16_wt(yb + (size_t)i * 4 * D, sv[i]);
    }
    ATT_WAIT_BAR(0);
}

__device__ __forceinline__ void naq_mfma(f32x16& p0, f32x16& p1, const bf16x8 (&kf)[8], const bf16x8* qr, const f32x16& cM, float mhat) {
    { const f32x16 z = f32x16{}; p0 = MFMA32(kf[0], qr[0], cM); p1 = MFMA32(kf[1], qr[0], z); }
#pragma unroll
    for (int d0 = 1; d0 < 4; ++d0) { p0 = MFMA32(kf[2 * d0], qr[d0], p0); p1 = MFMA32(kf[2 * d0 + 1], qr[d0], p1); }
}
__device__ __forceinline__ void naq_vload(s16x4 (&lo)[2][3], s16x4 (&hh)[2][3], lcp vbF, lcp vbP) {
#pragma unroll
    for (int d0 = 0; d0 < 2; ++d0) {
#pragma unroll
        for (int k = 0; k < 2; ++k) { lo[d0][k] = vtr(vbF + d0 * 4096 + k * 1024); hh[d0][k] = vtr(vbF + d0 * 4096 + k * 1024 + 512); }
        lo[d0][2] = vtr(vbP + d0 * 4096); hh[d0][2] = vtr(vbP + d0 * 4096 + 512); }
}
template <int THR>
__device__ __forceinline__ void naq_softmax(f32x16& p0, f32x16& p1, f32x16 (&o)[2], float& mhat, float& l, bool first, float mh, const LAS float* rp, int vbase, int fo, int pk0,
                                            LAS float* wsf, int r32, int hi, u32x4 (&pw)[3]) {
    const LAS float* rpF = rp + fo; const LAS float* rpP = rp + pk0;
    float pbv[4];
#pragma unroll
    for (int r = 0; r < 4; ++r) pbv[r] = rpP[r];
#pragma unroll
    for (int r = 0; r < 16; ++r) { const int e = (r & 3) + 8 * (r >> 2); p0[r] += rpF[e] - mh; }
#pragma unroll
    for (int r = 0; r < 4; ++r) p1[r] = ((unsigned)(vbase + pk0 + r) < 16u) ? p1[r] + (pbv[r] - mh) : -INFINITY;
    float a = MX3(p0[0], p0[1], p0[2]), c = MX3(p0[3], p0[4], p0[5]);
    a = MX3(a, p0[6], p0[7]); c = MX3(c, p0[8], p0[9]); a = MX3(a, p0[10], p0[11]); c = MX3(c, p0[12], p0[13]); a = MX3(a, p0[14], p0[15]); c = MX3(c, p1[0], p1[1]); a = MX3(a, p1[2], p1[3]);
    a = __builtin_fmaxf(a, c);
    { auto rr = __builtin_amdgcn_permlane32_swap(__float_as_uint(a), __float_as_uint(a), false, false); a = __builtin_fmaxf(__uint_as_float(rr[0]), __uint_as_float(rr[1])); }
    const float rm = a; bool resc = false, shift = first; float dl = rm;
    if (!first) { shift = __any(rm > (float)THR); resc = shift; dl = fmaxf(rm, 0.f); }
    if (shift) { mhat += dl;
#pragma unroll
        for (int r = 0; r < 16; ++r) p0[r] -= dl;
#pragma unroll
        for (int r = 0; r < 4; ++r) p1[r] -= dl;
        if (resc) { const float f = __builtin_amdgcn_exp2f(-dl); l *= f; if (hi == 0) wsf[r32] = f; } }
    float sa = 0.f;
#pragma unroll
    for (int r = 0; r < 16; ++r) { p0[r] = __builtin_amdgcn_exp2f(p0[r]); sa += p0[r]; }
#pragma unroll
    for (int r = 0; r < 4; ++r) { p1[r] = __builtin_amdgcn_exp2f(p1[r]); sa += p1[r]; }
    l += sa;
    pw[0] = (u32x4){cvtpk(p0[0], p0[1]), cvtpk(p0[2], p0[3]), cvtpk(p0[4], p0[5]), cvtpk(p0[6], p0[7])};
    pw[1] = (u32x4){cvtpk(p0[8], p0[9]), cvtpk(p0[10], p0[11]), cvtpk(p0[12], p0[13]), cvtpk(p0[14], p0[15])};
    pw[2] = (u32x4){cvtpk(p1[0], p1[1]), cvtpk(p1[2], p1[3]), 0u, 0u};
    if (resc) {
        float fr[16];
#pragma unroll
        for (int r = 0; r < 16; ++r) fr[r] = wsf[crow(r, hi)];
#pragma unroll
        for (int d = 0; d < 2; ++d)
#pragma unroll
            for (int r = 0; r < 16; ++r) o[d][r] *= fr[r];
    }
}
__device__ __forceinline__ void naq_pv(f32x16 (&o)[2], const u32x4 (&pw)[3], const s16x4 (&lo)[2][3], const s16x4 (&hh)[2][3]) {
#pragma unroll
    for (int d0 = 0; d0 < 2; ++d0)
#pragma unroll
        for (int k = 0; k < 3; ++k)
            o[d0] = MFMA32(__builtin_bit_cast(bf16x8, pw[k]), ((bf16x8){lo[d0][k][0], lo[d0][k][1], lo[d0][k][2], lo[d0][k][3], hh[d0][k][0], hh[d0][k][1], hh[d0][k][2], hh[d0][k][3]}), o[d0]);
}
template <int THR>
__device__ __forceinline__ void na_quad_unit(Frame& F, int layer, const bf16_t* qkv, bf16_t* Y, int idx) {
    const int tid = phase_tid(F.wave), lane = tid & 63, wid = F.wave, r32 = lane & 31, hi = lane >> 5;
    const int hp = (idx >> 3) & 3, rq = idx & 7, grp = wid >> 2;
    const int h = 2 * hp + (wid >> 2), half = wid & 1, c = 32 * half + r32;
    const int rowA = 4 * rq + ((wid >> 1) & 1), rowB = rowA + 2;
    LAS unsigned char* lds = F.lds;
    LAS float* wsf = (LAS float*)(lds + ATT_WSF) + wid * 128;
    LAS float* RPB = (LAS float*)(lds + ATT_TBL);
    const int rF = 4 * rq, rL = 4 * rq + 3;
    const int lo = (rF - 4) < 0 ? 0 : ((rF - 4) > 24 ? 24 : (rF - 4));
    const int hr = ((rL - 4) < 0 ? 0 : ((rL - 4) > 24 ? 24 : (rL - 4))) + 7;
    const int ntile = hr - lo + 1;
    const int r0A = (rowA - 4) < 0 ? 0 : ((rowA - 4) > 24 ? 24 : (rowA - 4)), r0B = (rowB - 4) < 0 ? 0 : ((rowB - 4) > 24 ? 24 : (rowB - 4));
    const bf16_t* kbase = qkv + COL_KA + (2 * hp) * 64; const bf16_t* vbase_g = qkv + COL_VA + (2 * hp) * 64;
    const unsigned kvo = (unsigned)((8 * wid + (lane >> 3)) * NQKV + ((lane & 7) ^ (lane >> 3)) * 8) * 2u;
    const unsigned vvo = (unsigned)((16 * (wid & 3) + (lane >> 2)) * NQKV + (wid >> 2) * 32 + (lane & 3) * 8) * 2u;
#define NA_DMA(tt) do { if ((tt) < ntile) { const size_t go_ = (size_t)(lo + (tt)) * 64 * NQKV; LAS unsigned char* rb_ = lds + ((tt) & 3) * 32768 + wid * 1024; \
        GLDS16S(kvo, kbase + go_, rb_); GLDS16S(kvo, kbase + go_ + 64, rb_ + 8192); GLDS16S(vvo, vbase_g + go_, rb_ + 16384); GLDS16S(vvo, vbase_g + go_ + 64, rb_ + 24576); } } while (0)
#define NA_WAIT_BAR(t) asm volatile("s_waitcnt vmcnt(4)\n\ts_cmp_lt_i32 %0, %1\n\ts_cbranch_scc1 .Lnq%=\n\ts_waitcnt vmcnt(0)\n.Lnq%=:\n\ts_waitcnt lgkmcnt(0)\n\ts_barrier" :: "s"((t) + 2), "s"(ntile) : "scc", "memory")
    NA_DMA(0); NA_DMA(1); NA_DMA(2);
    const int tdr = (tid >> 5) < 15 ? (tid >> 5) : 14, ti = (tid & 31) < 31 ? (tid & 31) : 30;
    const float* rpbg = arg_in(5) + ((size_t)(layer * 8 + 2 * hp) * 15 + tdr) * 31 + ti;
    float tv0 = rpbg[0], tv1 = rpbg[15 * 31];
    bf16x8 qA[4], qB[4];
    { const bf16_t* Qw = qkv + (size_t)(rowA * 64 + c) * NQKV + COL_QA + h * 64 + hi * 8;
#pragma unroll
      for (int d0 = 0; d0 < 4; ++d0) { qA[d0] = *(const bf16x8*)(Qw + d0 * 16); qB[d0] = *(const bf16x8*)(Qw + (size_t)128 * NQKV + d0 * 16); } }
    asm volatile("" : "+v"(tv0), "+v"(tv1), "+v"(qA[0]), "+v"(qA[1]), "+v"(qA[2]), "+v"(qA[3]), "+v"(qB[0]), "+v"(qB[1]), "+v"(qB[2]), "+v"(qB[3]));
    if (tid < 480) { const bool in = (tid & 31) < 31; RPB[tid] = in ? tv0 * LOG2E : 0.f; RPB[480 + tid] = in ? tv1 * LOG2E : 0.f; }
    const int voff = ((lane >> 4) & 1) * 32 + (lane & 3) * 8 + (4 * hi + ((lane & 15) >> 2)) * 64 + grp * 8192;
    int koff[4];
#pragma unroll
    for (int d0 = 0; d0 < 4; ++d0) koff[d0] = r32 * 128 + (((2 * d0 + hi) ^ (r32 & 7)) << 4) + grp * 8192;
    const int dF = half * 4096, dP = half ? ((((r32 + 24) & 31) - r32) * 128) : 4096;
    const int fo = 32 * half, pk0 = half ? 24 : 32;
#define NA_KLOAD(slot_) do { lcp ks_ = (lcp)(lds + (slot_) * 32768); \
        _Pragma("unroll") for (int d0 = 0; d0 < 4; ++d0) { kf[2 * d0] = *(const LAS bf16x8*)(ks_ + koff[d0] + dF); kf[2 * d0 + 1] = *(const LAS bf16x8*)(ks_ + koff[d0] + dP); } } while (0)
    f32x16 oA[2], oB[2]; oA[0] = f32x16{}; oA[1] = f32x16{}; oB[0] = f32x16{}; oB[1] = f32x16{};
    float mhatA = 0.f, lA = 0.f, mhatB = 0.f, lB = 0.f;
    ATT_WAIT_BAR(8);
    bf16x8 kf[8];
    NA_KLOAD(0);
    const int c0 = (c - 8) < 0 ? 0 : ((c - 8) > 48 ? 48 : (c - 8));
    const int vbase = 4 * hi - c0;
    const int rpoff = grp * 480 + (4 * hi - c + 15);
    f32x16 cM;
#pragma unroll
    for (int r = 0; r < 16; ++r) { const int e = (r & 3) + 8 * (r >> 2) + fo; cM[r] = ((unsigned)(vbase + e) < 16u) ? 0.f : -INFINITY; }
#pragma unroll 1
    for (int t = 0; t < ntile; ++t) {
        const int kr = lo + t; const bool actA = (kr >= r0A && kr < r0A + 8), actB = (kr >= r0B && kr < r0B + 8);
        lcp vb = (lcp)(lds + (t & 3) * 32768 + 16384 + voff);
        lcp vbF = vb + half * 2048, vbP = vb + (half ? 1536 : 2048);
        s16x4 vlo[2][3], vhh[2][3]; f32x16 pA0, pA1, pB0, pB1; u32x4 pwA[3], pwB[3];
        const float mhA = actA ? mhatA : INFINITY, mhB = actB ? mhatB : INFINITY;
        const int drA = (kr - rowA + 7) < 0 ? 0 : ((kr - rowA + 7) > 14 ? 14 : (kr - rowA + 7)), drB = (kr - rowB + 7) < 0 ? 0 : ((kr - rowB + 7) > 14 ? 14 : (kr - rowB + 7));
        int ro = rpoff; asm volatile("" : "+v"(ro));
        naq_mfma(pA0, pA1, kf, qA, cM, mhA);
        naq_mfma(pB0, pB1, kf, qB, cM, mhB);
        __builtin_amdgcn_sched_barrier(0);
        if (actA) naq_softmax<THR>(pA0, pA1, oA, mhatA, lA, kr == r0A, mhA, RPB + drA * 32 + ro, vbase, fo, pk0, wsf, r32, hi, pwA);
        if (actB) naq_softmax<THR>(pB0, pB1, oB, mhatB, lB, kr == r0B, mhB, RPB + drB * 32 + ro, vbase, fo, pk0, wsf, r32, hi, pwB);
        __builtin_amdgcn_sched_barrier(0);
        naq_vload(vlo, vhh, vbF, vbP);
        if (grp == 1) { NA_WAIT_BAR(t); NA_DMA(t + 3); if (t + 1 < ntile) NA_KLOAD((t + 1) & 3); }
        __builtin_amdgcn_sched_barrier(0);
        if (actA) naq_pv(oA, pwA, vlo, vhh);
        if (actB) naq_pv(oB, pwB, vlo, vhh);
        if (grp == 0) { NA_WAIT_BAR(t); NA_DMA(t + 3); if (t + 1 < ntile) NA_KLOAD((t + 1) & 3); }
    }
    ATT_WAIT_BAR(0);
#undef NA_DMA
#undef NA_WAIT_BAR
#undef NA_KLOAD
    const int hie = (int)(lane_id_now() >> 5);
    LAS bf16_t* stg = (LAS bf16_t*)(lds + 65536) + wid * 4096;
    { float rli[16]; row_inv_l(lA, rli, wsf, r32, hie);
#pragma unroll
      for (int d = 0; d < 2; ++d)
#pragma unroll
        for (int r = 0; r < 16; ++r) { const float v = oA[d][r] * rli[r]; stg[crow(r, hie) * 64 + d * 32 + r32] = (bf16_t)(cvtpk(v, v) & 0xffffu); } }
    { float rli[16]; row_inv_l(lB, rli, wsf, r32, hie);
#pragma unroll
      for (int d = 0; d < 2; ++d)
#pragma unroll
        for (int r = 0; r < 16; ++r) { const float v = oB[d][r] * rli[r]; stg[2048 + crow(r, hie) * 64 + d * 32 + r32] = (bf16_t)(cvtpk(v, v) & 0xffffu); } }
    bf16_t* yb = Y + (size_t)(rowA * 64 + 32 * half + (lane >> 3)) * D + h * 64 + (lane & 7) * 8;
    u32x4 sv[8];
#pragma unroll
    for (int i = 0; i < 8; ++i) sv[i] = *(const LAS u32x4*)(stg + (i >> 2) * 2048 + ((i & 3) * 8 + (lane >> 3)) * 64 + (lane & 7) * 8);
#pragma unroll
    for (int i = 0; i < 8; ++i) store16_wt(yb + (size_t)((i >> 2) * 128 + (i & 3) * 8) * D, sv[i]);
    ATT_WAIT_BAR(0);
}
}

struct Args { const float* in[14]; float* out; unsigned char* ws; };
__global__ void __launch_bounds__(NWAVES * 64, 2) enc_fwd(Args args) {
    extern __shared__ __attribute__((aligned(16))) unsigned char lds[];
    Frame F;
    F.lds = (LAS unsigned char*)lds;
    F.wave = __builtin_amdgcn_readfirstlane((int)threadIdx.x >> 6); F.G = gridDim.x; { const int bx = blockIdx.x; F.vcu = (F.G % 8 == 0) ? (bx % 8) * (F.G / 8) + bx / 8 : bx; }
    F.out = args.out; F.ws = args.ws;
    unsigned char* ws = args.ws;
    volatile LAS unsigned* MISC = (volatile LAS unsigned*)(F.lds + MISC_OFF);
    for (int u = threadIdx.x; u < (LDS_BYTES - LDSCTL_OFF) / 4; u += NWAVES * 64) ((LAS unsigned*)(F.lds + LDSCTL_OFF))[u] = 0u;
    __syncthreads();
    XcdBarrier bar; bar.bar = (unsigned*)(ws + WS_CTL) + CW_BAR; bar.x = 0; bar.st = nullptr; bar.wave = F.wave;
    bar = xcd_barrier_post((unsigned*)(ws + WS_CTL) + CW_BAR, MISC + 8, F.wave);
    p0_prologue(F);
    xcd_barrier(bar);
    const unsigned xcc = bar.x;
    const int nloc = __builtin_amdgcn_readfirstlane((int)MISC[8]), nx = __builtin_amdgcn_readfirstlane((int)MISC[9]);
    const int rank = __builtin_amdgcn_readfirstlane((int)MISC[10]), xi = __builtin_amdgcn_readfirstlane((int)MISC[11]);
    unsigned* lbar = (unsigned*)(ws + WS_CTL) + CW_BAR;
    unsigned lgen = 0;
#define LSEAM() xcc_local_barrier(lbar, xcc, (unsigned)nloc, F.wave, lgen)
#pragma unroll 1
    for (int bb = xi; bb < BATCH; bb += nx) {
        unsigned char* breg = ws + WS_QKV + (size_t)bb * BREG;
        bf16_t* QKVb = (bf16_t*)breg; bf16_t* GATESb = (bf16_t*)(breg + BREG_GATES); bf16_t* MERGEDb = (bf16_t*)breg; bf16_t* HBb = (bf16_t*)breg;
        bf16_t* XBb = (bf16_t*)(ws + WS_XNY) + (size_t)bb * MB * D; float* SSb = (float*)(ws + WS_SS) + (size_t)bb * MB * 4;
        bf16_t* Yb = (bf16_t*)((unsigned char*)F.out + (size_t)bb * MB * D * 4);
        float* OUTb = F.out + (size_t)bb * MB * D;
#pragma unroll 1
        for (int L = 0; L < DEPTH; ++L) {
            unsigned char* wb = ws + WS_W + (size_t)L * W_LAYER;
            {
                pg8::Gemm g{XBb, (const bf16_t*)(wb + WO_IN), MB, NIN, D}; pg8::BatchOrder S{NIN / 256, nloc, rank};
                pg8::EpiProj E{QKVb, GATESb, SSb, ((nloc & 7) == 0) ? (LAS float*)(F.lds + ATT_WSF) : (LAS float*)nullptr};
                pg8::gemm_phase<pg8::EpiProj, pg8::BatchOrder, true, true>(F.lds + RING_OFF, g, S, E, F.wave);
            }
            LSEAM();
            {
#pragma unroll 1
                for (int u = 2 * rank; u < 64; u += 2 * nloc) { att::diff_unit<8>(F, L, QKVb, Yb, u >> 4, u & 15); att::diff_unit<8>(F, L, QKVb, Yb, (u + 1) >> 4, (u + 1) & 15); }
#pragma unroll 1
                for (int u = rank; u < 32; u += nloc) att::na_quad_unit<8>(F, L, QKVb, Yb, u);
            }
            LSEAM();
            {
                pg8::Gemm g{Yb, (const bf16_t*)(wb + WO_M), MB, D, D}; pg8::BatchOrder S{D / 256, nloc, rank};
                pg8::EpiMerge E{MERGEDb, GATESb};
                pg8::gemm_phase<pg8::EpiMerge, pg8::BatchOrder, true, true>(F.lds + RING_OFF, g, S, E, F.wave);
            }
            LSEAM();
            {
                pg8::Gemm g{MERGEDb, (const bf16_t*)(wb + WO_OUT), MB, D, D}; pg8::BatchOrder S{D / 256, nloc, rank};
                pg8::EpiResid E{XBb, SSb, {}};
                pg8::gemm_phase<pg8::EpiResid, pg8::BatchOrder, true, true>(F.lds + RING_OFF, g, S, E, F.wave);
            }
            LSEAM();
            {
                pg8::Gemm g{XBb, (const bf16_t*)(wb + WO_FF1), MB, FF, D}; pg8::BatchOrder S{FF / 256, nloc, rank};
                pg8::EpiFF1 E{HBb, SSb, ((nloc & 7) == 0) ? (LAS float*)(F.lds + ATT_WSF) : (LAS float*)nullptr};
                pg8::gemm_phase<pg8::EpiFF1, pg8::BatchOrder, true, true>(F.lds + RING_OFF, g, S, E, F.wave);
            }
            LSEAM();
            {
                pg8::Gemm g{HBb, (const bf16_t*)(wb + WO_FF2), MB, D, FF}; pg8::BatchOrder S{D / 256, nloc, rank};
                if (L + 1 < DEPTH) { pg8::EpiResid E{XBb, SSb, {}};
                    pg8::gemm_phase<pg8::EpiResid, pg8::BatchOrder, true, true>(F.lds + RING_OFF, g, S, E, F.wave); }
                else { pg8::EpiFinal E{XBb, SSb, arg_in(2), OUTb, (unsigned*)(ws + WS_CTL) + CW_PANEL + bb * 8 * 64, {}};
                    pg8::gemm_phase<pg8::EpiFinal, pg8::BatchOrder, true, true>(F.lds + RING_OFF, g, S, E, F.wave); }
            }
            if (L + 1 < DEPTH) LSEAM();
        }
        if (bb + nx < BATCH) LSEAM();
    }
#undef LSEAM
}

extern "C" void kernel_launch(void* const* d_in, const int* in_sizes, int n_in, void* d_out, int out_size, void* d_ws, size_t ws_size, hipStream_t stream) {
    static int grid = 0;
    if (grid == 0) {
        if (n_in != 14 || in_sizes[0] != M * D || out_size != M * D || ws_size < WS_END) { fprintf(stderr, "kernel_launch: unexpected shapes (n_in %d, in0 %d, out %d, ws %zu); nothing launched\n", n_in, n_in > 0 ? in_sizes[0] : -1, out_size, ws_size); grid = -1; return; }
        int dev = 0, cus = 0;
        if (hipGetDevice(&dev) != hipSuccess || hipDeviceGetAttribute(&cus, hipDeviceAttributeMultiprocessorCount, dev) != hipSuccess) { grid = -1; return; }
        if (hipFuncSetAttribute((const void*)enc_fwd, hipFuncAttributeMaxDynamicSharedMemorySize, LDS_BYTES) != hipSuccess) { fprintf(stderr, "kernel_launch: hipFuncSetAttribute failed\n"); grid = -1; return; }
        int per_cu = 0;
        if (hipOccupancyMaxActiveBlocksPerMultiprocessor(&per_cu, (const void*)enc_fwd, NWAVES * 64, LDS_BYTES) != hipSuccess || per_cu < 1) fprintf(stderr, "kernel_launch: occupancy query reports %d per CU\n", per_cu);
        (void)hipGetLastError();
        grid = cus;
    }
    if (grid < 0) return;
    Args a{};
    for (int i = 0; i < 14; ++i) a.in[i] = (const float*)d_in[i];
    a.out = (float*)d_out; a.ws = (unsigned char*)d_ws;
    if (hipMemsetAsync((char*)d_ws + WS_CTL, 0, CTL_ZERO_BYTES, stream) != hipSuccess) { fprintf(stderr, "kernel_launch: memset failed\n"); return; }
    hipLaunchKernelGGL(enc_fwd, dim3(grid), dim3(NWAVES * 64), LDS_BYTES, stream, a);
}
```

```cpp
#include <hip/hip_runtime.h>
#include <cstdio>
#include <cstdint>

#define LAS __attribute__((address_space(3)))
#define GAS __attribute__((address_space(1)))
typedef unsigned short bf16_t;
typedef short bf16x8 __attribute__((ext_vector_type(8)));
typedef short s16x4 __attribute__((ext_vector_type(4)));
typedef float f32x4 __attribute__((ext_vector_type(4)));
typedef float f32x2 __attribute__((ext_vector_type(2)));
typedef float f32x16 __attribute__((ext_vector_type(16)));
typedef unsigned u32x4 __attribute__((ext_vector_type(4)));
typedef unsigned u32x2 __attribute__((ext_vector_type(2)));
typedef __bf16 bf16x2_t __attribute__((ext_vector_type(2)));

constexpr int BATCH = 8, SEQ = 2048, D = 1024, M = BATCH * SEQ, DEPTH = 2, FF = 4096;
constexpr int NQKV = 3072, NGATE = 2048, NIN = 5120;
constexpr int MB = SEQ;
constexpr float RMS_EPS = 1e-6f;
constexpr float LOG2E = 1.4426950408889634f;
constexpr float C2 = 0.125f * LOG2E;
constexpr int COL_QA = 0, COL_KA = 512, COL_VA = 1024, COL_QD = 1536, COL_KD = 2048, COL_VD = 2560;

__device__ __forceinline__ unsigned cvtpk(float lo, float hi) { f32x2 v = {lo, hi}; bf16x2_t b = __builtin_convertvector(v, bf16x2_t); return __builtin_bit_cast(unsigned, b); }
__device__ __forceinline__ float bf2f(unsigned short u) { return __uint_as_float((unsigned)u << 16); }
__device__ __forceinline__ float bflo(unsigned w) { return __uint_as_float(w << 16); }
__device__ __forceinline__ float bfhi(unsigned w) { return __uint_as_float(w & 0xffff0000u); }

__device__ __forceinline__ unsigned lane_id_now() { unsigned l; asm volatile("v_mbcnt_lo_u32_b32 %0, -1, 0\n\tv_mbcnt_hi_u32_b32 %0, -1, %0" : "=v"(l)); return l; }
__device__ __forceinline__ void store16_wt(void* p, u32x4 v) { asm volatile("global_store_dwordx4 %0, %1, off sc1\n\ts_nop 1" :: "v"(p), "v"(v) : "memory"); }
#define DPP_ADD(v, ctrl) ((v) + __uint_as_float((unsigned)__builtin_amdgcn_update_dpp(0, (int)__float_as_uint(v), (ctrl), 0xF, 0xF, true)))
__device__ __forceinline__ float sum_row16(float v) {
    v = DPP_ADD(v, 0xB1); v = DPP_ADD(v, 0x4E); v = DPP_ADD(v, 0x141); v = DPP_ADD(v, 0x140); return v; }
__device__ __forceinline__ float sum_xor16(float v) { auto rr = __builtin_amdgcn_permlane16_swap(__float_as_uint(v), __float_as_uint(v), false, false); return __uint_as_float(rr[0]) + __uint_as_float(rr[1]); }
__device__ __forceinline__ float sum_xor32(float v) { auto rr = __builtin_amdgcn_permlane32_swap(__float_as_uint(v), __float_as_uint(v), false, false); return __uint_as_float(rr[0]) + __uint_as_float(rr[1]); }
__device__ __forceinline__ float sum_half32(float v) { return sum_xor16(sum_row16(v)); }
namespace pg8 {
constexpr int BM = 256, BK = 64, HALF = 128, HTB = HALF * BK * 2, STAGE_BYTES = 8 * HTB, NXCD = 8, WGM = 8;
__host__ __device__ __forceinline__ int lds_byte(int r, int c) { const int st = (r >> 4) * 2 + (c >> 5), rr = r & 15, cc = c & 31, ob = rr * 64 + cc * 2; return st * 1024 + (ob ^ (((ob >> 9) & 1) << 5)); }
__host__ __device__ __forceinline__ void stage_rc(int b, int& R, int& C) { const int st = b / 1024, sb = b % 1024, swz = sb ^ (((sb >> 9) & 1) << 5); R = (st >> 1) * 16 + swz / 64; C = (st & 1) * 32 + (swz % 64) / 2; }
__host__ __device__ __forceinline__ int perm32(int rho) { const int n = rho >> 4, i = rho & 15; return 8 * (i >> 2) + 4 * n + (i & 3); }

struct Unit { int pm, pn; };
struct Gemm { const bf16_t* A; const bf16_t* Bt; int M, N, K; };

struct BatchOrder {
    int nN, nloc, rank, rot;
    __device__ bool next(int i, Unit& u) const { const int L = i * nloc + rank; if (L >= 8 * nN) return false; u.pm = L & 7; int pn = (L >> 3) + rot; u.pn = pn >= nN ? pn - nN : pn; return true; }
};

__device__ __forceinline__ float row_rstd(const float* ss, int row) {
    const f32x4 a = *(const f32x4*)(ss + (size_t)row * 4);
    const float s = (a[0] + a[1]) + (a[2] + a[3]);
    return 1.0f / sqrtf(s * (1.0f / (float)D) + RMS_EPS);
}

struct EpiProj {
    static constexpr bool HAS_POST = false, HAS_RTAB = true;
    static constexpr bool PERM = true, HAS_MID = false;
    bf16_t* qkv; bf16_t* gates; const float* ss; LAS float* rtab;
    __device__ __forceinline__ void mid(f32x4 (&acc)[2][2][4][2], const Unit& u, int wr, int wc, int fr, int fq) const {}
    __device__ __forceinline__ void operator()(f32x4 (&acc)[2][2][4][2], const Unit& u, int wr, int wc, int fr, int fq) const {
        const int row0 = u.pm * BM + wr * 64 + fr;
        float rs[2][4];
        if (rtab) {
#pragma unroll
            for (int ai = 0; ai < 2; ++ai)
#pragma unroll
                for (int m = 0; m < 4; ++m) rs[ai][m] = rtab[wr * 64 + fr + ai * HALF + m * 16];
        } else {
#pragma unroll
            for (int ai = 0; ai < 2; ++ai)
#pragma unroll
                for (int m = 0; m < 4; ++m) rs[ai][m] = row_rstd(ss, row0 + ai * HALF + m * 16);
        }
        if (u.pn < 12) {
            const float sc = (u.pn < 2 || u.pn == 6 || u.pn == 7) ? C2 : 1.0f;
            const int col0 = u.pn * BM + wc * 32 + 8 * fq;
#pragma unroll
            for (int ai = 0; ai < 2; ++ai)
#pragma unroll
                for (int m = 0; m < 4; ++m) { const int row = row0 + ai * HALF + m * 16; const float r = rs[ai][m] * sc; bf16_t* rowp = qkv + (size_t)row * NQKV + col0;
#pragma unroll
                    for (int bj = 0; bj < 2; ++bj) { const f32x4 v0 = acc[ai][bj][m][0] * r, v1 = acc[ai][bj][m][1] * r;
                        u32x4 w; w.x = cvtpk(v0[0], v0[1]); w.y = cvtpk(v0[2], v0[3]); w.z = cvtpk(v1[0], v1[1]); w.w = cvtpk(v1[2], v1[3]);
                        store16_wt(rowp + bj * HALF, w); } }
        } else {
            const int col0 = (u.pn - 12) * HALF + wc * 32 + 8 * fq;
#pragma unroll
            for (int ai = 0; ai < 2; ++ai)
#pragma unroll
                for (int m = 0; m < 4; ++m) { const int row = row0 + ai * HALF + m * 16; const float r = rs[ai][m]; float rho[8], sg[8];
#pragma unroll
                    for (int n = 0; n < 2; ++n)
#pragma unroll
                        for (int e = 0; e < 4; ++e) { const float ga = acc[ai][0][m][n][e] * r, gd = fmaxf(acc[ai][1][m][n][e] * r, -80.f);
                            const float ed = 1.f + __expf(-gd), ea = 1.f + __expf(-ga); rho[4 * n + e] = ed * __builtin_amdgcn_rcpf(ea); sg[4 * n + e] = __builtin_amdgcn_rcpf(ed); }
                    u32x4 w; w.x = cvtpk(rho[0], rho[1]); w.y = cvtpk(rho[2], rho[3]); w.z = cvtpk(rho[4], rho[5]); w.w = cvtpk(rho[6], rho[7]);
                    store16_wt(gates + (size_t)row * D + col0, w);
                    w.x = cvtpk(sg[0], sg[1]); w.y = cvtpk(sg[2], sg[3]); w.z = cvtpk(sg[4], sg[5]); w.w = cvtpk(sg[6], sg[7]);
                    store16_wt(gates + (size_t)MB * D + (size_t)row * D + col0, w); }
        }
    }
};
struct EpiFF1 {
    static constexpr bool HAS_POST = false, HAS_RTAB = true;
    static constexpr bool PERM = true, HAS_MID = false;
    bf16_t* H; const float* ss; LAS float* rtab;
    __device__ __forceinline__ void mid(f32x4 (&acc)[2][2][4][2], const Unit& u, int wr, int wc, int fr, int fq) const {}
    __device__ __forceinline__ void operator()(f32x4 (&acc)[2][2][4][2], const Unit& u, int wr, int wc, int fr, int fq) const {
        const int row0 = u.pm * BM + wr * 64 + fr, col0 = u.pn * BM + wc * 32 + 8 * fq;
        float rs[2][4];
        if (rtab) {
#pragma unroll
            for (int ai = 0; ai < 2; ++ai)
#pragma unroll
                for (int m = 0; m < 4; ++m) rs[ai][m] = rtab[wr * 64 + fr + ai * HALF + m * 16];
        } else {
#pragma unroll
            for (int ai = 0; ai < 2; ++ai)
#pragma unroll
                for (int m = 0; m < 4; ++m) rs[ai][m] = row_rstd(ss, row0 + ai * HALF + m * 16);
        }
#pragma unroll
        for (int ai = 0; ai < 2; ++ai)
#pragma unroll
            for (int m = 0; m < 4; ++m) { const int row = row0 + ai * HALF + m * 16; const float r = rs[ai][m]; bf16_t* rowp = H + (size_t)row * FF + col0;
#pragma unroll
                for (int bj = 0; bj < 2; ++bj) { f32x4 v0 = acc[ai][bj][m][0] * r, v1 = acc[ai][bj][m][1] * r;
#pragma unroll
                    for (int e = 0; e < 4; ++e) { const float a = fmaxf(v0[e], 0.f), b = fmaxf(v1[e], 0.f); v0[e] = a * a; v1[e] = b * b; }
                    u32x4 w; w.x = cvtpk(v0[0], v0[1]); w.y = cvtpk(v0[2], v0[3]); w.z = cvtpk(v1[0], v1[1]); w.w = cvtpk(v1[2], v1[3]);
                    store16_wt(rowp + bj * HALF, w); } }
    }
};
struct EpiMerge {
    static constexpr bool HAS_POST = false, HAS_RTAB = false;
    static constexpr bool PERM = true, HAS_MID = true;
    bf16_t* O; const bf16_t* gates;
    __device__ __forceinline__ void mid(f32x4 (&acc)[2][2][4][2], const Unit& u, int wr, int wc, int fr, int fq) const {
        const int row0 = u.pm * BM + wr * 64 + fr, col0 = u.pn * BM + wc * 32 + 8 * fq;
        const bf16_t* gp = gates + (size_t)row0 * D + col0;
        asm volatile("" : "+v"(gp) :: "memory");
        u32x4 g[2][4][2];
#pragma unroll
        for (int ai = 0; ai < 2; ++ai)
#pragma unroll
            for (int q = 0; q < 4; ++q)
#pragma unroll
                for (int bj = 0; bj < 2; ++bj) g[ai][q][bj] = *(const GAS u32x4*)(gp + (ai * HALF + q * 16) * D + bj * HALF);
        __builtin_amdgcn_sched_barrier(0);
#pragma unroll
        for (int ai = 0; ai < 2; ++ai)
#pragma unroll
            for (int q = 0; q < 4; ++q)
#pragma unroll
                for (int bj = 0; bj < 2; ++bj)
#pragma unroll
                    for (int w = 0; w < 4; ++w) { acc[ai][bj][q][w >> 1][(w & 1) * 2] *= bflo(g[ai][q][bj][w]); acc[ai][bj][q][w >> 1][(w & 1) * 2 + 1] *= bfhi(g[ai][q][bj][w]); }
    }
    __device__ __forceinline__ void operator()(f32x4 (&acc)[2][2][4][2], const Unit& u, int wr, int wc, int fr, int fq) const {
        const int row0 = u.pm * BM + wr * 64 + fr, col0 = u.pn * BM + wc * 32 + 8 * fq;
        const bf16_t* gp = gates + (size_t)MB * D + (size_t)row0 * D + col0; bf16_t* rowp = O + (size_t)row0 * D + col0;
        asm volatile("" : "+v"(gp), "+v"(rowp) :: "memory");
        u32x4 g[2][4][2];
#pragma unroll
        for (int ai = 0; ai < 2; ++ai)
#pragma unroll
            for (int q = 0; q < 4; ++q)
#pragma unroll
                for (int bj = 0; bj < 2; ++bj) g[ai][q][bj] = *(const GAS u32x4*)(gp + (ai * HALF + q * 16) * D + bj * HALF);
        __builtin_amdgcn_sched_barrier(0);
#pragma unroll
        for (int ai = 0; ai < 2; ++ai)
#pragma unroll
            for (int q = 0; q < 4; ++q)
#pragma unroll
                for (int bj = 0; bj < 2; ++bj) { float o[8];
#pragma unroll
                    for (int w = 0; w < 4; ++w) { o[2 * w] = acc[ai][bj][q][w >> 1][(w & 1) * 2] * bflo(g[ai][q][bj][w]); o[2 * w + 1] = acc[ai][bj][q][w >> 1][(w & 1) * 2 + 1] * bfhi(g[ai][q][bj][w]); }
                    u32x4 w4; w4.x = cvtpk(o[0], o[1]); w4.y = cvtpk(o[2], o[3]); w4.z = cvtpk(o[4], o[5]); w4.w = cvtpk(o[6], o[7]);
                    store16_wt((void*)(rowp + (ai * HALF + q * 16) * D + bj * HALF), w4); }
    }
};
struct EpiResid {
    static constexpr bool HAS_POST = true, HAS_RTAB = false;
    static constexpr bool PERM = true, HAS_MID = false;
    bf16_t* xb; float* ss; float qs[2][4];
    __device__ __forceinline__ void mid(f32x4 (&acc)[2][2][4][2], const Unit& u, int wr, int wc, int fr, int fq) const {}
    __device__ __forceinline__ void operator()(f32x4 (&acc)[2][2][4][2], const Unit& u, int wr, int wc, int fr, int fq) {
        const int row0 = u.pm * BM + wr * 64 + fr, col0 = u.pn * BM + wc * 32 + 8 * fq;
        u32x4 xv[2][4][2];
#pragma unroll
        for (int ai = 0; ai < 2; ++ai)
#pragma unroll
            for (int m = 0; m < 4; ++m)
#pragma unroll
                for (int bj = 0; bj < 2; ++bj) xv[ai][m][bj] = *(const GAS u32x4*)(xb + (size_t)(row0 + ai * HALF + m * 16) * D + col0 + bj * HALF);
        __builtin_amdgcn_sched_barrier(0);
#pragma unroll
        for (int ai = 0; ai < 2; ++ai) {
#pragma unroll
            for (int m = 0; m < 4; ++m) { const int row = row0 + ai * HALF + m * 16; bf16_t* rowp = xb + (size_t)row * D + col0; float q = 0.f;
#pragma unroll
                for (int bj = 0; bj < 2; ++bj) { const u32x4 x4 = xv[ai][m][bj];
                    const f32x4 y0 = (f32x4){bflo(x4.x), bfhi(x4.x), bflo(x4.y), bfhi(x4.y)} + acc[ai][bj][m][0], y1 = (f32x4){bflo(x4.z), bfhi(x4.z), bflo(x4.w), bfhi(x4.w)} + acc[ai][bj][m][1];
                    q += (y0[0] * y0[0] + y0[1] * y0[1]) + (y0[2] * y0[2] + y0[3] * y0[3]) + (y1[0] * y1[0] + y1[1] * y1[1]) + (y1[2] * y1[2] + y1[3] * y1[3]);
                    u32x4 w; w.x = cvtpk(y0[0], y0[1]); w.y = cvtpk(y0[2], y0[3]); w.z = cvtpk(y1[0], y1[1]); w.w = cvtpk(y1[2], y1[3]);
                    *(GAS u32x4*)(rowp + bj * HALF) = w; }
                q = sum_xor32(sum_xor16(q));
                qs[ai][m] = q; }
            __builtin_amdgcn_sched_barrier(0);
        }
    }
    __device__ __forceinline__ void post(LAS unsigned char* lds, f32x4 (&acc)[2][2][4][2], const Unit& u, int wr, int wc, int fr, int fq, int tid) {
        LAS float* P = (LAS float*)lds;
        if (fq == 0) {
#pragma unroll
            for (int ai = 0; ai < 2; ++ai)
#pragma unroll
                for (int m = 0; m < 4; ++m) P[(ai * HALF + wr * 64 + m * 16 + fr) * 4 + wc] = qs[ai][m];
        }
        asm volatile("s_waitcnt lgkmcnt(0)" ::: "memory"); __builtin_amdgcn_s_barrier(); asm volatile("" ::: "memory");
        if (tid < 256) { const f32x4 v = *(const LAS f32x4*)(P + tid * 4); ss[(size_t)(u.pm * BM + tid) * 4 + u.pn] = (v[0] + v[1]) + (v[2] + v[3]); }
    }
};

struct EpiFinal {
    static constexpr bool HAS_POST = true, HAS_RTAB = false;
    static constexpr bool PERM = true, HAS_MID = false;
    const bf16_t* xb; float* ss; const float* g; float* out; unsigned* cnt; float qs[2][4];
    __device__ __forceinline__ void mid(f32x4 (&acc)[2][2][4][2], const Unit& u, int wr, int wc, int fr, int fq) const {}
    __device__ __forceinline__ void operator()(f32x4 (&acc)[2][2][4][2], const Unit& u, int wr, int wc, int fr, int fq) {
        const int row0 = u.pm * BM + wr * 64 + fr, col0 = u.pn * BM + wc * 32 + 8 * fq;
        u32x4 xq[2][4][2];
#pragma unroll
        for (int ai = 0; ai < 2; ++ai)
#pragma unroll
            for (int m = 0; m < 4; ++m)
#pragma unroll
                for (int bj = 0; bj < 2; ++bj) xq[ai][m][bj] = *(const GAS u32x4*)(xb + (size_t)(row0 + ai * HALF + m * 16) * D + col0 + bj * HALF);
        __builtin_amdgcn_sched_barrier(0);
#pragma unroll
        for (int ai = 0; ai < 2; ++ai)
#pragma unroll
            for (int m = 0; m < 4; ++m) { float q = 0.f;
#pragma unroll
                for (int bj = 0; bj < 2; ++bj) { const u32x4 xv = xq[ai][m][bj];
                    const f32x4 y0 = (f32x4){bflo(xv.x), bfhi(xv.x), bflo(xv.y), bfhi(xv.y)} + acc[ai][bj][m][0], y1 = (f32x4){bflo(xv.z), bfhi(xv.z), bflo(xv.w), bfhi(xv.w)} + acc[ai][bj][m][1];
                    q += (y0[0] * y0[0] + y0[1] * y0[1]) + (y0[2] * y0[2] + y0[3] * y0[3]) + (y1[0] * y1[0] + y1[1] * y1[1]) + (y1[2] * y1[2] + y1[3] * y1[3]);
                    acc[ai][bj][m][0] = y0; acc[ai][bj][m][1] = y1; }
                q = sum_xor32(sum_xor16(q));
                qs[ai][m] = q; }
    }
    __device__ __forceinline__ void post(LAS unsigned char* lds, f32x4 (&acc)[2][2][4][2], const Unit& u, int wr, int wc, int fr, int fq, int tid) {
        LAS float* P = (LAS float*)lds;
        LAS float* S = (LAS float*)(lds + 4096);
        LAS unsigned* flag = (LAS unsigned*)(lds + 4096 + 1024);
        if (fq == 0) {
#pragma unroll
            for (int ai = 0; ai < 2; ++ai)
#pragma unroll
                for (int m = 0; m < 4; ++m) P[(ai * HALF + wr * 64 + m * 16 + fr) * 4 + wc] = qs[ai][m];
        }
        asm volatile("s_waitcnt lgkmcnt(0)" ::: "memory"); __builtin_amdgcn_s_barrier(); asm volatile("" ::: "memory");
        unsigned* pc = cnt + 64 * u.pm;
        if (tid < 256) {
            const f32x4 v = *(const LAS f32x4*)(P + tid * 4);
            __hip_atomic_store(ss + (size_t)(u.pm * BM + tid) * 4 + u.pn, (v[0] + v[1]) + (v[2] + v[3]), __ATOMIC_RELAXED, __HIP_MEMORY_SCOPE_AGENT);
            asm volatile("s_waitcnt vmcnt(0)" ::: "memory");
            if ((tid & 63) == 0) __hip_atomic_fetch_add(pc, 1u, __ATOMIC_RELAXED, __HIP_MEMORY_SCOPE_AGENT);
        }
        if (tid < 64) {
            unsigned sp = 0;
            while ((unsigned)__builtin_amdgcn_readfirstlane(__hip_atomic_load(pc, __ATOMIC_RELAXED, __HIP_MEMORY_SCOPE_AGENT)) < 16u) { __builtin_amdgcn_s_sleep(2); if (++sp > (1u << 20)) break; }
            asm volatile("s_waitcnt vmcnt(0)" ::: "memory");
            if (tid == 0) flag[0] = 1u;
        }
        asm volatile("s_waitcnt lgkmcnt(0)" ::: "memory"); __builtin_amdgcn_s_barrier(); asm volatile("" ::: "memory");
        if (tid < 256) {
            const float* sp4 = ss + (size_t)(u.pm * BM + tid) * 4; float t = 0.f;
#pragma unroll
            for (int j = 0; j < 4; ++j) t += __hip_atomic_load(sp4 + j, __ATOMIC_RELAXED, __HIP_MEMORY_SCOPE_AGENT);
            S[tid] = 1.0f / sqrtf(t * (1.0f / (float)D) + RMS_EPS);
        }
        asm volatile("s_waitcnt vmcnt(0) lgkmcnt(0)" ::: "memory"); __builtin_amdgcn_s_barrier(); asm volatile("" ::: "memory");
        const int row0 = u.pm * BM + wr * 64 + fr, col0 = u.pn * BM + wc * 32 + 8 * fq;
        f32x4 gv[2][2];
#pragma unroll
        for (int bj = 0; bj < 2; ++bj)
#pragma unroll
            for (int n = 0; n < 2; ++n) gv[bj][n] = *(const f32x4*)(g + col0 + bj * HALF + 4 * n);
#pragma unroll
        for (int ai = 0; ai < 2; ++ai)
#pragma unroll
            for (int m = 0; m < 4; ++m) { const int rl = ai * HALF + wr * 64 + m * 16 + fr; const float r = S[rl]; float* rowp = out + (size_t)(u.pm * BM + rl) * D + col0;
#pragma unroll
                for (int bj = 0; bj < 2; ++bj) { *(f32x4*)(rowp + bj * HALF) = acc[ai][bj][m][0] * r * gv[bj][0]; *(f32x4*)(rowp + bj * HALF + 4) = acc[ai][bj][m][1] * r * gv[bj][1]; } }
    }
};

template <class Epi, class Sched, bool ALIGN_EPI, bool SP2>
__device__ __forceinline__ void gemm_phase(LAS unsigned char* lds, const Gemm g, const Sched& S, Epi& E, int wave_) {
    const int tid_ = wave_ * 64 + (int)lane_id_now();
    const int tid = tid_, wid = __builtin_amdgcn_readfirstlane(tid >> 6), lane = tid & 63, wr = wid >> 2, wc = wid & 3, fr = lane & 15, fq = lane >> 4;
    const int K = g.K, nt = K / BK;
    unsigned voffA[2], voffB[2];
#pragma unroll
    for (int i = 0; i < 2; ++i) { int R, C; stage_rc(tid * 16 + i * 8192, R, C); const int Rb = Epi::PERM ? ((R & ~31) + perm32(R & 31)) : R;
        voffA[i] = (unsigned)(R * K + C) * 2u; voffB[i] = (unsigned)(Rb * K + C) * 2u; }
    const size_t kstep = (size_t)(BK * 2);
    const size_t hstep = (size_t)HALF * K * 2;
    const size_t tstep = 2 * hstep;
    const unsigned ldsw = (unsigned)wid * 1024u;
    const int aoff = lds_byte(wr * 64 + fr, fq * 8), boff = lds_byte(wc * 32 + fr, fq * 8);
#define PG8_SA(b, h) (((b) * 2 + (h)) * HTB)
#define PG8_SB(b, h) ((4 + (b) * 2 + (h)) * HTB)
#define PG8_STAGE(bufoff, gbase, voff) do { _Pragma("unroll") for (int _i = 0; _i < 2; ++_i) \
        __builtin_amdgcn_global_load_lds((const unsigned*)((const char*)(gbase) + (voff)[_i]), (LAS unsigned*)(lds + (bufoff) + ldsw + _i * 8192), 16, 0, 0); } while (0)
#define PG8_LDA(dst, b, h) do { _Pragma("unroll") for (int m = 0; m < 4; ++m) _Pragma("unroll") for (int k = 0; k < 2; ++k) dst[m][k] = *(const LAS bf16x8*)(lds + PG8_SA(b, h) + aoff + m * 2048 + k * 1024); } while (0)
#define PG8_LDB(dst, b, h) do { _Pragma("unroll") for (int n = 0; n < 2; ++n) _Pragma("unroll") for (int k = 0; k < 2; ++k) dst[n][k] = *(const LAS bf16x8*)(lds + PG8_SB(b, h) + boff + n * 2048 + k * 1024); } while (0)
#define PG8_MMA(ai, bj, At, Bt) do { __builtin_amdgcn_s_setprio(1); _Pragma("unroll") for (int m = 0; m < 4; ++m) _Pragma("unroll") for (int n = 0; n < 2; ++n) _Pragma("unroll") for (int k = 0; k < 2; ++k) \
        acc[ai][bj][m][n] = __builtin_amdgcn_mfma_f32_16x16x32_bf16(Bt[n][k], At[m][k], acc[ai][bj][m][n], 0, 0, 0); __builtin_amdgcn_s_setprio(0); } while (0)
#define PG8_WAIT_V(n) asm volatile("s_waitcnt vmcnt(" #n ")" ::: "memory")
#define PG8_WAIT_L(n) asm volatile("s_waitcnt lgkmcnt(" #n ")" ::: "memory")
#define PG8_BAR __builtin_amdgcn_s_barrier()
#define PG8_SCHED __builtin_amdgcn_sched_barrier(0)
    Unit cur, nxt; int ui = 0;
    if (!S.next(0, cur)) return;
    f32x4 acc[2][2][4][2];
#pragma unroll
    for (int a = 0; a < 2; ++a)
#pragma unroll
        for (int b = 0; b < 2; ++b)
#pragma unroll
            for (int m = 0; m < 4; ++m)
#pragma unroll
                for (int n = 0; n < 2; ++n) acc[a][b][m][n] = (f32x4){0.f, 0.f, 0.f, 0.f};
    bf16x8 At[4][2], B0[2][2], B1[2][2];
    const char* cA = (const char*)g.A + (size_t)cur.pm * tstep; const char* cB = (const char*)g.Bt + (size_t)cur.pn * tstep;
    if constexpr (SP2) {
        PG8_STAGE(PG8_SB(0, 0), cB, voffB); PG8_STAGE(PG8_SB(0, 1), cB + hstep, voffB); PG8_STAGE(PG8_SA(0, 0), cA, voffA); PG8_STAGE(PG8_SA(0, 1), cA + hstep, voffA);
        if constexpr (Epi::HAS_RTAB) { if (E.rtab && tid < 256) E.rtab[tid] = row_rstd(E.ss, cur.pm * BM + tid); }
        if (wr == 1) PG8_BAR;
        PG8_WAIT_V(2); PG8_BAR;
        PG8_STAGE(PG8_SB(1, 0), cB + kstep, voffB); PG8_STAGE(PG8_SA(1, 0), cA + kstep, voffA); PG8_STAGE(PG8_SB(1, 1), cB + hstep + kstep, voffB);
        PG8_WAIT_V(6); PG8_BAR;
    } else {
        PG8_STAGE(PG8_SB(0, 0), cB, voffB); PG8_STAGE(PG8_SA(0, 0), cA, voffA); PG8_STAGE(PG8_SB(0, 1), cB + hstep, voffB); PG8_STAGE(PG8_SA(0, 1), cA + hstep, voffA);
        if (wr == 1) PG8_BAR;
        PG8_WAIT_V(4); PG8_BAR;
        PG8_STAGE(PG8_SB(1, 0), cB + kstep, voffB); PG8_STAGE(PG8_SA(1, 0), cA + kstep, voffA); PG8_STAGE(PG8_SB(1, 1), cB + hstep + kstep, voffB);
        PG8_WAIT_V(6); PG8_BAR;
    }
    for (;;) {
        const bool has_next = S.next(ui + 1, nxt);
        const char* nA = has_next ? (const char*)g.A + (size_t)nxt.pm * tstep : cA; const char* nB = has_next ? (const char*)g.Bt + (size_t)nxt.pn * tstep : cB;
        for (int t = 0; t < nt; t += 2) {
            if constexpr (Epi::HAS_MID) { if (t == nt / 2) E.mid(acc, cur, wr, wc, fr, fq); }
            const bool last = (t == nt - 2);
            const char* a1 = cA + (size_t)(t + 1) * kstep;
            const char* a2 = last ? nA : cA + (size_t)(t + 2) * kstep; const char* b2 = last ? nB : cB + (size_t)(t + 2) * kstep;
            const char* a3 = a2 + kstep; const char* b3 = b2 + kstep;
            if constexpr (SP2) {
            PG8_LDB(B0, 0, 0); PG8_LDB(B1, 0, 1); PG8_SCHED; PG8_LDA(At, 0, 0); PG8_STAGE(PG8_SA(1, 1), a1 + hstep, voffA);
            PG8_WAIT_V(8); PG8_WAIT_L(0); PG8_BAR; PG8_MMA(0, 0, At, B0); PG8_MMA(0, 1, At, B1); PG8_BAR; PG8_SCHED;
            PG8_LDA(At, 0, 1); PG8_STAGE(PG8_SB(0, 0), b2, voffB); PG8_STAGE(PG8_SB(0, 1), b2 + hstep, voffB); PG8_STAGE(PG8_SA(0, 0), a2, voffA);
            PG8_WAIT_V(8); PG8_WAIT_L(0); PG8_BAR; PG8_MMA(1, 0, At, B0); PG8_MMA(1, 1, At, B1); PG8_BAR; PG8_SCHED;
            PG8_LDB(B0, 1, 0); PG8_LDB(B1, 1, 1); PG8_SCHED; PG8_LDA(At, 1, 0); PG8_STAGE(PG8_SA(0, 1), a2 + hstep, voffA);
            PG8_WAIT_V(8); PG8_WAIT_L(0); PG8_BAR; PG8_MMA(0, 0, At, B0); PG8_MMA(0, 1, At, B1); PG8_BAR; PG8_SCHED;
            PG8_LDA(At, 1, 1); PG8_STAGE(PG8_SB(1, 0), b3, voffB); PG8_STAGE(PG8_SB(1, 1), b3 + hstep, voffB); PG8_STAGE(PG8_SA(1, 0), a3, voffA);
            PG8_WAIT_V(8); PG8_WAIT_L(0); PG8_BAR; PG8_MMA(1, 0, At, B0); PG8_MMA(1, 1, At, B1); PG8_BAR; PG8_SCHED;
            } else {
            PG8_LDB(B0, 0, 0); PG8_SCHED; PG8_LDA(At, 0, 0); PG8_STAGE(PG8_SA(1, 1), a1 + hstep, voffA);
            PG8_WAIT_L(8); PG8_BAR; PG8_WAIT_L(0); PG8_MMA(0, 0, At, B0); PG8_BAR; PG8_SCHED;
            PG8_LDB(B1, 0, 1); PG8_STAGE(PG8_SB(0, 0), b2, voffB);
            PG8_BAR; PG8_WAIT_L(0); PG8_MMA(0, 1, At, B1); PG8_BAR;
            PG8_LDA(At, 0, 1); PG8_STAGE(PG8_SA(0, 0), a2, voffA);
            PG8_BAR; PG8_WAIT_L(0); PG8_MMA(1, 0, At, B0); PG8_BAR; PG8_SCHED;
            PG8_STAGE(PG8_SB(0, 1), b2 + hstep, voffB);
            PG8_WAIT_V(6); PG8_BAR; PG8_MMA(1, 1, At, B1); PG8_BAR;
            PG8_LDB(B0, 1, 0); PG8_SCHED; PG8_LDA(At, 1, 0); PG8_STAGE(PG8_SA(0, 1), a2 + hstep, voffA);
            PG8_WAIT_L(8); PG8_BAR; PG8_WAIT_L(0); PG8_MMA(0, 0, At, B0); PG8_BAR; PG8_SCHED;
            PG8_LDB(B1, 1, 1); PG8_STAGE(PG8_SB(1, 0), b3, voffB);
            PG8_BAR; PG8_WAIT_L(0); PG8_MMA(0, 1, At, B1); PG8_BAR;
            PG8_LDA(At, 1, 1); PG8_STAGE(PG8_SA(1, 0), a3, voffA);
            PG8_BAR; PG8_WAIT_L(0); PG8_MMA(1, 0, At, B0); PG8_BAR; PG8_SCHED;
            PG8_STAGE(PG8_SB(1, 1), b3 + hstep, voffB);
            PG8_WAIT_V(6); PG8_BAR; PG8_MMA(1, 1, At, B1); PG8_BAR;
            }
        }
        if constexpr (ALIGN_EPI) { if (wr == 0) PG8_BAR; }
        E(acc, cur, wr, wc, fr, fq);
        if (!has_next) break;
#pragma unroll
        for (int a = 0; a < 2; ++a)
#pragma unroll
            for (int b = 0; b < 2; ++b)
#pragma unroll
                for (int m = 0; m < 4; ++m)
#pragma unroll
                    for (int n = 0; n < 2; ++n) acc[a][b][m][n] = (f32x4){0.f, 0.f, 0.f, 0.f};
        cur = nxt; cA = nA; cB = nB; ++ui;
        if constexpr (ALIGN_EPI) { if (wr == 1) PG8_BAR; }
    }
    PG8_WAIT_V(0);
    if constexpr (!ALIGN_EPI) { if (wr == 0) PG8_BAR; }
    PG8_BAR;
    if constexpr (Epi::HAS_POST) E.post(lds, acc, cur, wr, wc, fr, fq, tid);
#undef PG8_SA
#undef PG8_SB
#undef PG8_STAGE
#undef PG8_LDA
#undef PG8_LDB
#undef PG8_MMA
#undef PG8_WAIT_V
#undef PG8_WAIT_L
#undef PG8_BAR
#undef PG8_SCHED
}
}

constexpr size_t MiB = 1u << 20;
constexpr size_t WS_CTL = 0, CTL_ZERO_BYTES = 64 * 1024;
constexpr size_t WS_SS = 1 * MiB;
constexpr size_t WS_W = 2 * MiB, W_LAYER = 30 * MiB;
constexpr size_t WO_IN = 0, WO_M = 10 * MiB, WO_OUT = 12 * MiB, WO_FF1 = 14 * MiB, WO_FF2 = 22 * MiB;
constexpr size_t WS_XNY = 62 * MiB;
constexpr size_t WS_QKV = 94 * MiB;
constexpr size_t BREG = 20 * MiB, BREG_GATES = 12 * MiB;
constexpr size_t WS_GATES = 190 * MiB;
constexpr size_t WS_MERGED = WS_QKV;
constexpr size_t WS_H = WS_QKV;
constexpr size_t WS_END = 254 * MiB;
constexpr int CW_BAR = 1024;
constexpr int CW_PANEL = 8192;

constexpr int RING_OFF = 0, RING_BYTES = 131072;
constexpr int ATT_WSF = 131072;
constexpr int ATT_TBL = ATT_WSF + 4096;
constexpr int LDSCTL_OFF = ATT_TBL + 4096, MISC_OFF = LDSCTL_OFF + 320;
constexpr int LDS_BYTES = 147456;
static_assert(MISC_OFF + 128 <= LDS_BYTES, "LDS map");
constexpr int NWAVES = 8;

#define RLX_AGENT __ATOMIC_RELAXED, __HIP_MEMORY_SCOPE_AGENT
#define LDS_WAIT() asm volatile("s_waitcnt lgkmcnt(0)" ::: "memory")
#define VM_WAIT() asm volatile("s_waitcnt vmcnt(0)" ::: "memory")

#define XB_TMO      128
#define XB_XCNT(j)  (256  + 64 * (j))
#define XB_XSUB(j)  (1280 + 64 * (j))
#define XB_XGEN(j)  (2304 + 64 * (j))
#define XB_TOP      3328
#define XB_TOPGEN   3392
#define XCD_BAR_WORDS 3456
#define XB_SPIN_CAP (1u << 18)
__device__ __forceinline__ unsigned xb_ld(unsigned* p)              { return __hip_atomic_load(p, __ATOMIC_RELAXED, __HIP_MEMORY_SCOPE_AGENT); }
__device__ __forceinline__ unsigned xb_add(unsigned* p, unsigned v) { return __hip_atomic_fetch_add(p, v, __ATOMIC_RELAXED, __HIP_MEMORY_SCOPE_AGENT); }
__device__ __forceinline__ unsigned xb_xcc_id() { return (unsigned)__builtin_amdgcn_s_getreg((3 << 11) | 20) & 0xFu; }
#define XB_SPIN(cond, bar) do { unsigned _sp = 0; while (cond) { __builtin_amdgcn_s_sleep(1); \
    if ((++_sp & 255u) == 0u) { if (xb_ld(&(bar)[XB_TMO])) break; if (_sp > XB_SPIN_CAP) { atomicAdd(&(bar)[XB_TMO], 1u); break; } } } } while (0)
struct XcdBarrier { unsigned* bar; unsigned x; volatile LAS unsigned* st; int wave; };
__device__ __forceinline__ bool xb_leader(int wave) { return wave == 0 && lane_id_now() == 0u; }
__device__ __forceinline__ XcdBarrier xcd_barrier_post(unsigned* bar, volatile LAS unsigned* st, int wave) {
    XcdBarrier b; b.bar = bar; b.x = xb_xcc_id(); b.st = st; b.wave = wave;
    if (xb_leader(wave)) st[2] = xb_add(&bar[XB_XCNT(b.x)], 1u);
    return b;
}
__device__ __forceinline__ void xcd_barrier_complete(unsigned* bar, unsigned x, unsigned& nloc, unsigned& nx, unsigned& xi) {
    const unsigned G = gridDim.x * gridDim.y * gridDim.z;
    unsigned sum, cnt, mine, below, sp = 0u;
    for (;;) {
        sum = 0u; cnt = 0u; mine = 0u; below = 0u;
#pragma unroll
        for (unsigned j = 0; j < 16; ++j) { const unsigned c = xb_ld(&bar[XB_XCNT(j)]); sum += c; cnt += (c > 0u) ? 1u : 0u; mine = (j == x) ? c : mine; below += (c > 0u && j < x) ? 1u : 0u; }
        if (sum == G) break;
        __builtin_amdgcn_s_sleep(1);
        if ((++sp & 255u) == 0u) { if (xb_ld(&bar[XB_TMO])) break; if (sp > XB_SPIN_CAP) { atomicAdd(&bar[XB_TMO], 1u); break; } }
    }
    nloc = mine > 0u ? mine : 1u; nx = cnt > 0u ? cnt : 1u; xi = below;
}
__device__ __forceinline__ void xcd_barrier(const XcdBarrier& b) {
    asm volatile("s_waitcnt vmcnt(0)" ::: "memory");
    __syncthreads();
    if (xb_leader(b.wave)) {
        unsigned* bar = b.bar;
        __builtin_amdgcn_s_waitcnt(0);
        unsigned nloc = b.st[0], nx = b.st[1];
        if (nloc == 0u) { unsigned xi; xcd_barrier_complete(bar, b.x, nloc, nx, xi); b.st[0] = nloc; b.st[1] = nx; b.st[3] = xi; }
        const unsigned old = xb_add(&bar[XB_XSUB(b.x)], 1u);
        const unsigned gen = old / nloc;
        if (old + 1u == (gen + 1u) * nloc) {
            __builtin_amdgcn_fence(__ATOMIC_RELEASE, "agent");
            asm volatile("s_waitcnt vmcnt(0)" ::: "memory");
            const unsigned og = xb_add(&bar[XB_TOP], 1u);
            const unsigned tg = og / nx;
            if (og + 1u == (tg + 1u) * nx) xb_add(&bar[XB_TOPGEN], 1u);
            else XB_SPIN(xb_ld(&bar[XB_TOPGEN]) == tg, bar);
            __builtin_amdgcn_fence(__ATOMIC_ACQUIRE, "agent");
            xb_add(&bar[XB_XGEN(b.x)], 1u);
            asm volatile("s_waitcnt vmcnt(0)" ::: "memory");
        } else {
            XB_SPIN(xb_ld(&bar[XB_XGEN(b.x)]) == gen, bar);
            __builtin_amdgcn_fence(__ATOMIC_ACQUIRE, "agent");
            asm volatile("s_waitcnt vmcnt(0)" ::: "memory");
        }
    }
    __syncthreads();
}

#define XL_SUB(j) (3584 + 64 * (j))
#define XL_GEN(j) (4608 + 64 * (j))
__device__ __forceinline__ void xcc_local_barrier(unsigned* bar, unsigned x, unsigned nloc, int wave, unsigned& gen) {
    if (wave == 0) asm volatile("buffer_inv sc1" ::: "memory");
    asm volatile("s_waitcnt vmcnt(0)" ::: "memory");
    __syncthreads();
    if (xb_leader(wave)) {
        __builtin_amdgcn_s_waitcnt(0);
        const unsigned old = xb_add(&bar[XL_SUB(x)], 1u);
        if (old + 1u == (gen + 1u) * nloc) xb_add(&bar[XL_GEN(x)], 1u);
        else XB_SPIN(xb_ld(&bar[XL_GEN(x)]) == gen, bar);
        asm volatile("s_waitcnt vmcnt(0)" ::: "memory");
    }
    ++gen;
    __syncthreads();
}

struct Frame {
    LAS unsigned char* lds;
    int vcu, G, wave;
    float* out; unsigned char* ws;
};
__device__ __forceinline__ int phase_tid(int wave) { return wave * 64 + (int)lane_id_now(); }
#define PHASE_IDS() const int tid_ = phase_tid(F.wave); const int tid = tid_, lane = tid & 63, wave = __builtin_amdgcn_readfirstlane(tid >> 6); (void)tid; (void)lane; (void)wave
__device__ __forceinline__ const float* arg_in(int k) { asm volatile("" : "+s"(k)); return ((const float* const __attribute__((address_space(4)))*)__builtin_amdgcn_kernarg_segment_ptr())[k]; }

__device__ __forceinline__ float wave_sum(float v) { return sum_xor32(sum_half32(v)); }
__device__ __forceinline__ void p0_transpose_item(const float* W, int N, bf16_t* WT, int ldk, int koff, LAS float* scr, int item, int lane, const float* gk = nullptr, bool gate_remap = false) {
    const int nblk = N / 32, kb = item / nblk, nb = item % nblk, k0 = 64 * kb, n0 = 32 * nb;
    int nd = n0;
    if (gate_remap && n0 >= NQKV) { const int gcol = n0 - NQKV, isd = gcol >= D, c = isd ? gcol - D : gcol; nd = NQKV + (c >> 7) * 256 + isd * 128 + (c & 127); }
    const float* src = W + (size_t)(k0 + (lane >> 3)) * N + n0 + (lane & 7) * 4;
    f32x4 v[8];
#pragma unroll
    for (int i = 0; i < 8; ++i) v[i] = *(const f32x4*)(src + (size_t)(8 * i) * N);
    if (gk) {
#pragma unroll
        for (int i = 0; i < 8; ++i) v[i] = v[i] * gk[k0 + 8 * i + (lane >> 3)]; }
#pragma unroll
    for (int i = 0; i < 8; ++i) { LAS float* d = scr + (8 * i + (lane >> 3)) * 33 + (lane & 7) * 4; d[0] = v[i][0]; d[1] = v[i][1]; d[2] = v[i][2]; d[3] = v[i][3]; }
    LDS_WAIT(); asm volatile("" ::: "memory");
    const int c = lane & 7;
#pragma unroll
    for (int j = 0; j < 4; ++j) { const int n = (lane >> 3) + 8 * j; const LAS float* s = scr + (8 * c) * 33 + n;
        u32x4 o; o.x = cvtpk(s[0 * 33], s[1 * 33]); o.y = cvtpk(s[2 * 33], s[3 * 33]); o.z = cvtpk(s[4 * 33], s[5 * 33]); o.w = cvtpk(s[6 * 33], s[7 * 33]);
        *(u32x4*)(WT + (size_t)(nd + n) * ldk + koff + k0 + 8 * c) = o; }
    LDS_WAIT(); asm volatile("" ::: "memory");
}
__device__ __forceinline__ void p0_prologue(Frame& F) {
    PHASE_IDS();
    LAS float* scr = (LAS float*)(F.lds + RING_OFF + wave * 16384);
    const int gw = F.vcu * NWAVES + wave, NGW = F.G * NWAVES;
    constexpr int I_IN = (D / 64) * (NIN / 32), I_B = (512 / 64) * (D / 32), I_O = (D / 64) * (D / 32), I_1 = (D / 64) * (FF / 32), I_2 = (FF / 64) * (D / 32);
    constexpr int NL = I_IN + 2 * I_B + I_O + I_1 + I_2, NITEMS = DEPTH * NL;
    for (int it = gw; it < NITEMS; it += NGW) {
        const int L = it / NL; int r = it % NL;
        unsigned char* wb = F.ws + WS_W + (size_t)L * W_LAYER;
        if (r < I_IN) { p0_transpose_item(arg_in(4) + (size_t)L * D * NIN, NIN, (bf16_t*)(wb + WO_IN), D, 0, scr, r, lane, arg_in(3) + L * D, true); continue; } r -= I_IN;
        if (r < I_B) { p0_transpose_item(arg_in(8) + (size_t)L * 512 * D, D, (bf16_t*)(wb + WO_M), D, 0, scr, r, lane); continue; } r -= I_B;
        if (r < I_B) { p0_transpose_item(arg_in(9) + (size_t)L * 512 * D, D, (bf16_t*)(wb + WO_M), D, 512, scr, r, lane); continue; } r -= I_B;
        if (r < I_O) { p0_transpose_item(arg_in(10) + (size_t)L * D * D, D, (bf16_t*)(wb + WO_OUT), D, 0, scr, r, lane); continue; } r -= I_O;
        if (r < I_1) { p0_transpose_item(arg_in(12) + (size_t)L * D * FF, FF, (bf16_t*)(wb + WO_FF1), D, 0, scr, r, lane, arg_in(11) + L * D); continue; } r -= I_1;
        p0_transpose_item(arg_in(13) + (size_t)L * FF * D, D, (bf16_t*)(wb + WO_FF2), FF, 0, scr, r, lane);
    }
    const float* x = arg_in(0); bf16_t* XN = (bf16_t*)(F.ws + WS_XNY); float* SS = (float*)(F.ws + WS_SS);
    for (int m0 = 2 * gw; m0 < M; m0 += 2 * NGW) {
        f32x4 v[2][4];
#pragma unroll
        for (int q = 0; q < 2; ++q)
#pragma unroll
            for (int j = 0; j < 4; ++j) v[q][j] = ((const f32x4*)(x + (size_t)(m0 + q) * D) + lane)[64 * j];
#pragma unroll
        for (int q = 0; q < 2; ++q) { const int m = m0 + q; u32x2* o8 = (u32x2*)(XN + (size_t)m * D) + lane; float s = 0.f;
#pragma unroll
            for (int j = 0; j < 4; ++j) { const f32x4 vv = v[q][j]; s += (vv[0] * vv[0] + vv[1] * vv[1]) + (vv[2] * vv[2] + vv[3] * vv[3]);
                u32x2 w; w.x = cvtpk(vv[0], vv[1]); w.y = cvtpk(vv[2], vv[3]); o8[64 * j] = w; }
            s = wave_sum(s);
            if (lane < 4) SS[(size_t)m * 4 + lane] = (lane == 0) ? s : 0.f; }
    }
}
namespace att {
typedef LAS const char* lcp;
__device__ __forceinline__ int crow(int r, int hi) { return (r & 3) + 8 * (r >> 2) + 4 * hi; }
typedef short v4i16_t __attribute__((ext_vector_type(4)));
__device__ __forceinline__ s16x4 vtr(lcp p) { return __builtin_bit_cast(s16x4, __builtin_amdgcn_ds_read_tr16_b64_v4i16((LAS v4i16_t*)p)); }
#define MFMA32(a, b, c) __builtin_amdgcn_mfma_f32_32x32x16_bf16(a, b, c, 0, 0, 0)
#define ATT_WAIT_BAR(N) asm volatile("s_waitcnt vmcnt(" #N ") lgkmcnt(0)\n\ts_barrier" ::: "memory")
#define ATT_LDS_BAR() asm volatile("s_waitcnt lgkmcnt(0)\n\ts_barrier" ::: "memory")
__device__ __forceinline__ void glds16(const void* gsrc, unsigned lds_dst) { unsigned keep;
    asm volatile("s_mov_b32 %0, m0\n\ts_mov_b32 m0, %2\n\ts_nop 0\n\tglobal_load_lds_dwordx4 %1, off\n\ts_mov_b32 m0, %0" : "=&s"(keep) : "v"(gsrc), "s"(lds_dst) : "memory"); }
#define GLDS16(gsrc, ldsdst) glds16((const void*)(gsrc), (unsigned)__builtin_amdgcn_readfirstlane((int)(unsigned)(uintptr_t)(ldsdst)))
__device__ __forceinline__ void glds16s(unsigned voff, const void* sbase, unsigned lds_dst) { unsigned keep;
    asm volatile("s_mov_b32 %0, m0\n\ts_mov_b32 m0, %2\n\ts_nop 2\n\tglobal_load_lds_dwordx4 %1, %3\n\ts_mov_b32 m0, %0" : "=&s"(keep) : "v"(voff), "s"(lds_dst), "s"(sbase) : "memory"); }
#define GLDS16S(voff, sbase, ldsdst) glds16s((voff), (const void*)(sbase), (unsigned)__builtin_amdgcn_readfirstlane((int)(unsigned)(uintptr_t)(ldsdst)))
#define ATT_BAR_IF(cond, N) do { if (cond) ATT_WAIT_BAR(N); } while (0)
#define MX3(a, b, c) __builtin_fmaxf(__builtin_fmaxf((a), (b)), (c))

__device__ __forceinline__ void kload(bf16x8 (&kf)[8], lcp kslot, const int (&koff)[4]) {
#pragma unroll
    for (int d0 = 0; d0 < 4; ++d0) { kf[2 * d0] = *(const LAS bf16x8*)(kslot + koff[d0]); kf[2 * d0 + 1] = *(const LAS bf16x8*)(kslot + koff[d0] + 4096); }
}
__device__ __forceinline__ void qk_mfma(f32x16& p0, f32x16& p1, const bf16x8 (&kf)[8], const bf16x8* qr, const f32x16& cinit) {
    p0 = MFMA32(kf[0], qr[0], cinit); p1 = MFMA32(kf[1], qr[0], cinit);
#pragma unroll
    for (int d0 = 1; d0 < 4; ++d0) { p0 = MFMA32(kf[2 * d0], qr[d0], p0); p1 = MFMA32(kf[2 * d0 + 1], qr[d0], p1); }
}
__device__ __forceinline__ float rowmax32(const f32x16& p0, const f32x16& p1) {
    float a = MX3(p0[0], p0[1], p1[0]), b = MX3(p0[2], p0[3], p1[1]); a = MX3(a, p1[2], p1[3]);
#pragma unroll
    for (int r = 4; r < 16; r += 4) { a = MX3(a, p0[r], p0[r + 1]); b = MX3(b, p0[r + 2], p0[r + 3]); a = MX3(a, p1[r], p1[r + 1]); b = MX3(b, p1[r + 2], p1[r + 3]); }
    a = __builtin_fmaxf(a, b);
    auto rr = __builtin_amdgcn_permlane32_swap(__float_as_uint(a), __float_as_uint(a), false, false);
    return __builtin_fmaxf(__uint_as_float(rr[0]), __uint_as_float(rr[1]));
}
template <int NB, int THR>
__device__ __forceinline__ bool softmax_part(f32x16& p0, f32x16& p1, f32x16 (&o)[NB], float& mhat, float& l, bool first, LAS float* wsf, int r32, int hi, u32x4 (&pw)[4]) {
    const float rm = rowmax32(p0, p1);
    bool resc = false, moved = false;
    if (first) {
        mhat += rm; moved = true;
#pragma unroll
        for (int r = 0; r < 16; ++r) { p0[r] -= rm; p1[r] -= rm; }
    } else if (__any(rm > (float)THR)) {
        const float dl = fmaxf(rm, 0.f); mhat += dl; moved = true; resc = true;
#pragma unroll
        for (int r = 0; r < 16; ++r) { p0[r] -= dl; p1[r] -= dl; }
        const float f = __builtin_amdgcn_exp2f(-dl); l *= f; if (hi == 0) wsf[r32] = f;
    }
    float s = 0.f;
#pragma unroll
    for (int r = 0; r < 16; ++r) { p0[r] = __builtin_amdgcn_exp2f(p0[r]); p1[r] = __builtin_amdgcn_exp2f(p1[r]); s += p0[r] + p1[r]; }
    l += s;
    pw[0] = (u32x4){cvtpk(p0[0], p0[1]), cvtpk(p0[2], p0[3]), cvtpk(p0[4], p0[5]), cvtpk(p0[6], p0[7])};
    pw[1] = (u32x4){cvtpk(p0[8], p0[9]), cvtpk(p0[10], p0[11]), cvtpk(p0[12], p0[13]), cvtpk(p0[14], p0[15])};
    pw[2] = (u32x4){cvtpk(p1[0], p1[1]), cvtpk(p1[2], p1[3]), cvtpk(p1[4], p1[5]), cvtpk(p1[6], p1[7])};
    pw[3] = (u32x4){cvtpk(p1[8], p1[9]), cvtpk(p1[10], p1[11]), cvtpk(p1[12], p1[13]), cvtpk(p1[14], p1[15])};
    if (resc) {
        float fr[16];
#pragma unroll
        for (int r = 0; r < 16; ++r) fr[r] = wsf[crow(r, hi)];
#pragma unroll
        for (int d = 0; d < NB; ++d)
#pragma unroll
            for (int r = 0; r < 16; ++r) o[d][r] *= fr[r];
    }
    return moved;
}
__device__ __forceinline__ void vload0(s16x4 (&lo)[4], s16x4 (&hh)[4], lcp vb) {
#pragma unroll
    for (int ks = 0; ks < 4; ++ks) { lo[ks] = vtr(vb + ks * 1024); hh[ks] = vtr(vb + ks * 1024 + 512); }
}
template <int NB>
__device__ __forceinline__ void pv_part(f32x16 (&o)[NB], lcp vb, const u32x4 (&pw)[4], const s16x4 (&lo0)[4], const s16x4 (&hh0)[4]) {
    s16x4 lo[2][4], hh[2][4];
#pragma unroll
    for (int ks = 0; ks < 4; ++ks) { lo[0][ks] = lo0[ks]; hh[0][ks] = hh0[ks]; }
#pragma unroll
    for (int d0 = 0; d0 < NB; ++d0) {
        if (d0 + 1 < NB) {
#pragma unroll
            for (int ks = 0; ks < 4; ++ks) { lo[(d0 + 1) & 1][ks] = vtr(vb + (d0 + 1) * 4096 + ks * 1024); hh[(d0 + 1) & 1][ks] = vtr(vb + (d0 + 1) * 4096 + ks * 1024 + 512); }
        }
        __builtin_amdgcn_sched_barrier(0);
#define ATT_PK(k) (bf16x8){lo[d0 & 1][k][0], lo[d0 & 1][k][1], lo[d0 & 1][k][2], lo[d0 & 1][k][3], hh[d0 & 1][k][0], hh[d0 & 1][k][1], hh[d0 & 1][k][2], hh[d0 & 1][k][3]}
        o[d0] = MFMA32(__builtin_bit_cast(bf16x8, pw[0]), ATT_PK(0), o[d0]);
        o[d0] = MFMA32(__builtin_bit_cast(bf16x8, pw[1]), ATT_PK(1), o[d0]);
        o[d0] = MFMA32(__builtin_bit_cast(bf16x8, pw[2]), ATT_PK(2), o[d0]);
        o[d0] = MFMA32(__builtin_bit_cast(bf16x8, pw[3]), ATT_PK(3), o[d0]);
#undef ATT_PK
        __builtin_amdgcn_sched_barrier(0);
    }
}
__device__ __forceinline__ void row_inv_l(float l, float (&rli)[16], LAS float* wsf, int r32, int hi) {
    auto rr = __builtin_amdgcn_permlane32_swap(__float_as_uint(l), __float_as_uint(l), false, false);
    const float lt = __uint_as_float(rr[0]) + __uint_as_float(rr[1]);
    if (hi == 0) wsf[32 + r32] = lt;
#pragma unroll
    for (int r = 0; r < 16; ++r) rli[r] = __builtin_amdgcn_rcpf(wsf[32 + crow(r, hi)]);
}
__device__ __forceinline__ int t5_bucket(int rel) {
    const int n = rel < 0 ? -rel : rel;
    const int large = 8 + (n >= 12) + (n >= 16) + (n >= 23) + (n >= 32) + (n >= 46) + (n >= 64) + (n >= 91);
    return (rel > 0 ? 16 : 0) + (n < 8 ? n : large);
}


template <int THR>
__device__ __forceinline__ void diff_unit(Frame& F, int layer, const bf16_t* qkv, bf16_t* Y, int h, int qb) {
    const int tid = phase_tid(F.wave), wid = F.wave;
    const int mp = wid >> 2, wq = wid & 3;
    const size_t tokb = 0;
    LAS unsigned char* lds = F.lds;
    LAS float* wsf = (LAS float*)(lds + ATT_WSF) + wid * 128;
    LAS float* TBL = (LAS float*)(lds + ATT_TBL);
    constexpr int NT = SEQ / 64;
    f32x16 o[4]; float l = 0.f;
    float lpv[4], sgv[4];
    {
    const int lane = tid & 63, r32 = lane & 31, hi = lane >> 5;
    const bf16_t* kbase = qkv + tokb * NQKV + COL_KD + h * 128; const bf16_t* vbase_g = qkv + tokb * NQKV + COL_VD + h * 128;
#define DIFF_KVO(L_) ((unsigned)((8 * wid + ((L_) >> 3)) * NQKV + (((L_) & 7) ^ ((L_) >> 3)) * 8) * 2u)
#define DIFF_VVO(L_) ((unsigned)((16 * (wid & 3) + ((L_) >> 2)) * NQKV + (wid >> 2) * 32 + ((L_) & 3) * 8) * 2u)
#define DIFF_DMA_K(t) do { if ((t) < NT) { const size_t go_ = (size_t)(t) * 64 * NQKV; LAS unsigned char* rb_ = lds + ((t) & 3) * 16384 + wid * 1024; \
        int ld_ = lane; asm volatile("" : "+v"(ld_)); const unsigned kvo_ = DIFF_KVO(ld_); GLDS16S(kvo_, kbase + go_, rb_); GLDS16S(kvo_, kbase + go_ + 64, rb_ + 8192); } } while (0)
#define DIFF_DMA_V(t) do { if ((t) < NT) { const size_t go_ = (size_t)(t) * 64 * NQKV; LAS unsigned char* rb_ = lds + 65536 + ((t) & 3) * 16384 + wid * 1024; \
        int ld_ = lane; asm volatile("" : "+v"(ld_)); const unsigned vvo_ = DIFF_VVO(ld_); GLDS16S(vvo_, vbase_g + go_, rb_); GLDS16S(vvo_, vbase_g + go_ + 64, rb_ + 8192); } } while (0)
#define DIFF_WAIT_BAR(t) asm volatile("s_waitcnt vmcnt(8)\n\ts_cmp_lt_i32 %0, %1\n\ts_cbranch_scc1 .Ldw%=\n\ts_waitcnt vmcnt(6)\n\ts_cmp_lt_i32 %0, %2\n\ts_cbranch_scc1 .Ldw%=\n\ts_waitcnt vmcnt(2)\n\ts_cmp_lt_i32 %0, %3\n\ts_cbranch_scc1 .Ldw%=\n\ts_waitcnt vmcnt(0)\n.Ldw%=:\n\ts_waitcnt lgkmcnt(0)\n\ts_barrier" \
        :: "s"((int)(t)), "n"(NT - 3), "n"(NT - 2), "n"(NT - 1) : "scc", "memory")
    DIFF_DMA_K(0); DIFF_DMA_K(1); DIFF_DMA_V(0); DIFF_DMA_K(2); DIFF_DMA_V(1);
    float tv = arg_in(1)[t5_bucket((tid < 257 ? tid : 256) - 128) * 4 + h];
    bf16x8 qr[4];
    { const bf16_t* Qw = qkv + (tokb + qb * 128 + wq * 32 + r32) * NQKV + COL_QD + h * 128 + mp * 64 + hi * 8;
#pragma unroll
      for (int d0 = 0; d0 < 4; ++d0) qr[d0] = *(const bf16x8*)(Qw + d0 * 16); }
    asm volatile("" : "+v"(tv), "+v"(qr[0]), "+v"(qr[1]), "+v"(qr[2]), "+v"(qr[3]));
    if (tid < 257) TBL[tid] = tv * LOG2E;
    const int voff = ((lane >> 4) & 1) * 32 + (lane & 3) * 8 + (4 * hi + ((lane & 15) >> 2)) * 64;
    o[0] = f32x16{}; o[1] = f32x16{}; o[2] = f32x16{}; o[3] = f32x16{};
    float mhat = 0.f;
    const int qw0 = qb * 128 + wq * 32;
    ATT_WAIT_BAR(8);
    const float tL = __uint_as_float((unsigned)__builtin_amdgcn_readfirstlane((int)__float_as_uint(TBL[0]))), tR = __uint_as_float((unsigned)__builtin_amdgcn_readfirstlane((int)__float_as_uint(TBL[256])));
    bf16x8 kf[8]; f32x16 p0, p1, cinit; u32x4 pwA[4], pwB[4]; s16x4 vlo[2][4], vhh[2][4]; bool moved = false; int zc_id;
    { const int dk0 = 0 - qw0; zc_id = (dk0 >= 122) ? 1 : 2; const float c0 = (zc_id == 1 ? tR : tL);
#pragma unroll
      for (int r = 0; r < 16; ++r) cinit[r] = c0; }
#define SBAR() __builtin_amdgcn_sched_barrier(0)
#define PIN(x) asm volatile("" : "+v"(x))
#define DIFF_SCORES(t, FIRST) do { \
        { int rk_ = r32; asm volatile("" : "+v"(rk_)); int koff[4];                       \
          _Pragma("unroll") for (int d0 = 0; d0 < 4; ++d0) koff[d0] = rk_ * 128 + (((2 * d0 + hi) ^ (rk_ & 7)) << 4); \
          kload(kf, (lcp)(lds + ((t) & 3) * 16384 + mp * 8192), koff); } \
        SBAR();                                                                     \
        qk_mfma(p0, p1, kf, qr, cinit); \
        SBAR(); \
        DIFF_DMA_K((t) + 3); DIFF_DMA_V((t) + 2); \
        const int dk_ = (t) * 64 - qw0; const int zone_ = (dk_ >= 122) ? 1 : ((dk_ <= -154) ? 2 : 0); \
        if (zone_ == 0) { int rq_ = r32; asm volatile("" : "+v"(rq_)); const int base_ = dk_ - rq_ + 128; const float zc_ = (zc_id == 1) ? tR : tL; \
            _Pragma("unroll") for (int r = 0; r < 16; ++r) { int i0 = base_ + crow(r, hi), i1 = i0 + 32; \
                i0 = i0 < 0 ? 0 : (i0 > 256 ? 256 : i0); i1 = i1 < 0 ? 0 : (i1 > 256 ? 256 : i1); \
                p0[r] += TBL[i0] - zc_; p1[r] += TBL[i1] - zc_; if ((r & 3) == 3) SBAR(); } } \
        const float rm_ = rowmax32(p0, p1); \
        bool shift_ = FIRST; float dl_ = rm_; moved = false; \
        if (!(FIRST)) { moved = __any(rm_ > (float)THR); shift_ = moved; dl_ = fmaxf(rm_, 0.f); } \
        if (shift_) { mhat += dl_; \
            _Pragma("unroll") for (int r = 0; r < 16; ++r) { float a_ = p0[r], b_ = p1[r]; asm volatile("v_sub_f32_e32 %0, %0, %2\n\tv_sub_f32_e32 %1, %1, %2" : "+v"(a_), "+v"(b_) : "v"(dl_)); p0[r] = a_; p1[r] = b_; } \
            if (!(FIRST)) { const float f_ = __builtin_amdgcn_exp2f(-dl_); l *= f_; if (hi == 0) wsf[r32] = f_; } } \
        { const int dn_ = dk_ + 64; const int zn_ = (dn_ >= 122) ? 1 : ((dn_ <= -154) ? 2 : 0); \
          if (shift_ || (zn_ != 0 && zn_ != zc_id)) { if (zn_ != 0) zc_id = zn_; const float cb_ = ((zc_id == 1) ? tR : tL) - mhat; \
              _Pragma("unroll") for (int r = 0; r < 16; ++r) cinit[r] = cb_; } } \
        SBAR(); } while (0)
#define DIFF_EXP2(g, PWN, SACC) do { \
        float x0_ = ((g) < 8 ? p0[2 * ((g) & 7)] : p1[2 * ((g) & 7)]), x1_ = ((g) < 8 ? p0[2 * ((g) & 7) + 1] : p1[2 * ((g) & 7) + 1]); \
        x0_ = __builtin_amdgcn_exp2f(x0_); x1_ = __builtin_amdgcn_exp2f(x1_); SACC += x0_; SACC += x1_; PWN[(g) >> 2][(g) & 3] = cvtpk(x0_, x1_); } while (0)
#define VFRAG(B, i) (bf16x8){vlo[B][i][0], vlo[B][i][1], vlo[B][i][2], vlo[B][i][3], vhh[B][i][0], vhh[B][i][1], vhh[B][i][2], vhh[B][i][3]}
#define DIFF_GAP(g, PWC, PWN, VB) do { \
        o[(g) >> 2] = MFMA32(__builtin_bit_cast(bf16x8, PWC[(g) & 3]), VFRAG(((g) >> 2) & 1, (g) & 3), o[(g) >> 2]); \
        if ((g) < 12) { vlo[(((g) >> 2) + 1) & 1][(g) & 3] = vtr(VB + (((g) >> 2) + 1) * 4096 + ((g) & 3) * 1024); vhh[(((g) >> 2) + 1) & 1][(g) & 3] = vtr(VB + (((g) >> 2) + 1) * 4096 + ((g) & 3) * 1024 + 512); } \
        DIFF_EXP2(g, PWN, sacc_); PIN(sacc_); PIN(PWN[(g) >> 2]); SBAR(); } while (0)
#define DIFF_STEP(t, PWC, PWN) do { \
        lcp vb_ = (lcp)(lds + 65536 + (((t) - 1) & 3) * 16384 + voff); \
        _Pragma("unroll") for (int i = 0; i < 4; ++i) { vlo[0][i] = vtr(vb_ + i * 1024); vhh[0][i] = vtr(vb_ + i * 1024 + 512); } \
        DIFF_SCORES(t, false); \
        float sacc_ = 0.f; \
        DIFF_GAP(0, PWC, PWN, vb_); DIFF_GAP(1, PWC, PWN, vb_); DIFF_GAP(2, PWC, PWN, vb_); DIFF_GAP(3, PWC, PWN, vb_); \
        DIFF_GAP(4, PWC, PWN, vb_); DIFF_GAP(5, PWC, PWN, vb_); DIFF_GAP(6, PWC, PWN, vb_); DIFF_GAP(7, PWC, PWN, vb_); \
        DIFF_GAP(8, PWC, PWN, vb_); DIFF_GAP(9, PWC, PWN, vb_); DIFF_GAP(10, PWC, PWN, vb_); DIFF_GAP(11, PWC, PWN, vb_); \
        DIFF_GAP(12, PWC, PWN, vb_); DIFF_GAP(13, PWC, PWN, vb_); DIFF_GAP(14, PWC, PWN, vb_); DIFF_GAP(15, PWC, PWN, vb_); \
        l += sacc_; \
        DIFF_WAIT_BAR(t); \
        if (moved) { float fr_[16]; \
            _Pragma("unroll") for (int r = 0; r < 16; ++r) fr_[r] = wsf[crow(r, hi)]; \
            _Pragma("unroll") for (int d = 0; d < 4; ++d) _Pragma("unroll") for (int r = 0; r < 16; ++r) o[d][r] *= fr_[r]; \
} \
    } while (0)
    if (wid >= 4) __builtin_amdgcn_s_setprio(1);
    DIFF_SCORES(0, true);
    { float sacc_ = 0.f;
#pragma unroll
      for (int g = 0; g < 16; ++g) DIFF_EXP2(g, pwA, sacc_);
      l += sacc_; }
    ATT_WAIT_BAR(8);
#pragma unroll 1
    for (int t = 1; t + 1 < NT; t += 2) { DIFF_STEP(t, pwA, pwB); DIFF_STEP(t + 1, pwB, pwA); }
    DIFF_STEP(NT - 1, pwA, pwB);
    { const float* lp = arg_in(6) + layer * 256; const float* sg = arg_in(7) + layer * 128;
#pragma unroll
      for (int j = 0; j < 4; ++j) { lpv[j] = lp[64 * j + lane]; sgv[j] = sg[j * 32 + r32]; } }
    { lcp vb_ = (lcp)(lds + 65536 + ((NT - 1) & 3) * 16384 + voff); s16x4 l0[4], h0[4]; vload0(l0, h0, vb_); pv_part<4>(o, vb_, pwB, l0, h0); }
    __builtin_amdgcn_s_setprio(0);
    ATT_LDS_BAR();
#undef DIFF_WAIT_BAR
#undef DIFF_DMA_K
#undef DIFF_DMA_V
#undef DIFF_KVO
#undef DIFF_VVO
#undef DIFF_SCORES
#undef DIFF_EXP2
#undef DIFF_GAP
#undef DIFF_STEP
#undef VFRAG
#undef SBAR
#undef PIN
    }
    const int tid2_ = phase_tid(F.wave);
    const int lane = tid2_ & 63, r32 = lane & 31, hi = lane >> 5;
    float rli[16]; row_inv_l(l, rli, wsf, r32, hi);
#pragma unroll
    for (int d = 0; d < 4; ++d)
#pragma unroll
        for (int r = 0; r < 16; ++r) o[d][r] *= rli[r];
    LAS float* xch = (LAS float*)(lds) + wq * 4096;
    if (mp == 1) {
#pragma unroll
        for (int d = 0; d < 4; ++d)
#pragma unroll
            for (int r4 = 0; r4 < 4; ++r4) *(LAS f32x4*)(xch + ((d * 4 + r4) * 64 + lane) * 4) = (f32x4){o[d][4 * r4], o[d][4 * r4 + 1], o[d][4 * r4 + 2], o[d][4 * r4 + 3]};
    }
    ATT_LDS_BAR();
    if (mp == 0) {
        const float lpa = lpv[0] * lpv[1], lpb = lpv[2] * lpv[3];
        const float s1 = wave_sum(lpa), s2 = wave_sum(lpb);
        unsigned lbits_ = (layer == 0) ? 0x3E4CCCCDu : 0x3EB60549u; asm volatile("" : "+s"(lbits_));
        const float lam_init = __uint_as_float(lbits_);
        const float lam = expf(s1) - expf(s2) + lam_init;
        float ssq[16];
#pragma unroll
        for (int r = 0; r < 16; ++r) ssq[r] = 0.f;
#pragma unroll
        for (int d = 0; d < 4; ++d) { f32x4 x2[4];
#pragma unroll
            for (int r4 = 0; r4 < 4; ++r4) x2[r4] = *(const LAS f32x4*)(xch + ((d * 4 + r4) * 64 + lane) * 4);
            __builtin_amdgcn_sched_barrier(0);
#pragma unroll
            for (int r4 = 0; r4 < 4; ++r4)
#pragma unroll
                for (int e = 0; e < 4; ++e) { const int r = 4 * r4 + e; const float v = o[d][r] - lam * x2[r4][e]; o[d][r] = v; ssq[r] += v * v; } }
#pragma unroll
        for (int r = 0; r < 16; ++r) {
            float v = ssq[r];
            v = sum_half32(v);
            ssq[r] = (1.0f - lam_init) * __builtin_amdgcn_rsqf(v * (1.0f / 128.0f) + RMS_EPS);
        }
        LAS bf16_t* stg = (LAS bf16_t*)(lds + 65536) + wq * 4096;
#pragma unroll
        for (int d = 0; d < 4; ++d) { const float gg = sgv[d];
#pragma unroll
            for (int r = 0; r < 16; ++r) { const float v = o[d][r] * ssq[r] * gg; stg[crow(r, hi) * 128 + d * 32 + r32] = (bf16_t)(cvtpk(v, v) & 0xffffu); } }
        bf16_t* yb = Y + (tokb + qb * 128 + wq * 32 + (lane >> 4)) * D + 512 + h * 128 + (lane & 15) * 8;
        u32x4 sv[8];
#pragma unroll
        for (int i = 0; i < 8; ++i) sv[i] = *(const LAS u32x4*)(stg + (i * 4 + (lane >> 4)) * 128 + (lane & 15) * 8);
#pragma unroll
        for (int i = 0; i < 8; ++i) store16_wt(yb + (size_t)i * 4 * D, sv[i]);
    }
    ATT_WAIT_BAR(0);
}

__device__ __forceinline__ void naq_mfma(f32x16& p0, f32x16& p1, const bf16x8 (&kf)[8], const bf16x8* qr, const f32x16& cM, float mhat) {
    { const f32x16 z = f32x16{}; p0 = MFMA32(kf[0], qr[0], cM); p1 = MFMA32(kf[1], qr[0], z); }
#pragma unroll
    for (int d0 = 1; d0 < 4; ++d0) { p0 = MFMA32(kf[2 * d0], qr[d0], p0); p1 = MFMA32(kf[2 * d0 + 1], qr[d0], p1); }
}
__device__ __forceinline__ void naq_vload(s16x4 (&lo)[2][3], s16x4 (&hh)[2][3], lcp vbF, lcp vbP) {
#pragma unroll
    for (int d0 = 0; d0 < 2; ++d0) {
#pragma unroll
        for (int k = 0; k < 2; ++k) { lo[d0][k] = vtr(vbF + d0 * 4096 + k * 1024); hh[d0][k] = vtr(vbF + d0 * 4096 + k * 1024 + 512); }
        lo[d0][2] = vtr(vbP + d0 * 4096); hh[d0][2] = vtr(vbP + d0 * 4096 + 512); }
}
template <int THR>
__device__ __forceinline__ void naq_softmax(f32x16& p0, f32x16& p1, f32x16 (&o)[2], float& mhat, float& l, bool first, float mh, const LAS float* rp, int vbase, int fo, int pk0,
                                            LAS float* wsf, int r32, int hi, u32x4 (&pw)[3]) {
    const LAS float* rpF = rp + fo; const LAS float* rpP = rp + pk0;
    float pbv[4];
#pragma unroll
    for (int r = 0; r < 4; ++r) pbv[r] = rpP[r];
#pragma unroll
    for (int r = 0; r < 16; ++r) { const int e = (r & 3) + 8 * (r >> 2); p0[r] += rpF[e] - mh; }
#pragma unroll
    for (int r = 0; r < 4; ++r) p1[r] = ((unsigned)(vbase + pk0 + r) < 16u) ? p1[r] + (pbv[r] - mh) : -INFINITY;
    float a = MX3(p0[0], p0[1], p0[2]), c = MX3(p0[3], p0[4], p0[5]);
    a = MX3(a, p0[6], p0[7]); c = MX3(c, p0[8], p0[9]); a = MX3(a, p0[10], p0[11]); c = MX3(c, p0[12], p0[13]); a = MX3(a, p0[14], p0[15]); c = MX3(c, p1[0], p1[1]); a = MX3(a, p1[2], p1[3]);
    a = __builtin_fmaxf(a, c);
    { auto rr = __builtin_amdgcn_permlane32_swap(__float_as_uint(a), __float_as_uint(a), false, false); a = __builtin_fmaxf(__uint_as_float(rr[0]), __uint_as_float(rr[1])); }
    const float rm = a; bool resc = false, shift = first; float dl = rm;
    if (!first) { shift = __any(rm > (float)THR); resc = shift; dl = fmaxf(rm, 0.f); }
    if (shift) { mhat += dl;
#pragma unroll
        for (int r = 0; r < 16; ++r) p0[r] -= dl;
#pragma unroll
        for (int r = 0; r < 4; ++r) p1[r] -= dl;
        if (resc) { const float f = __builtin_amdgcn_exp2f(-dl); l *= f; if (hi == 0) wsf[r32] = f; } }
    float sa = 0.f;
#pragma unroll
    for (int r = 0; r < 16; ++r) { p0[r] = __builtin_amdgcn_exp2f(p0[r]); sa += p0[r]; }
#pragma unroll
    for (int r = 0; r < 4; ++r) { p1[r] = __builtin_amdgcn_exp2f(p1[r]); sa += p1[r]; }
    l += sa;
    pw[0] = (u32x4){cvtpk(p0[0], p0[1]), cvtpk(p0[2], p0[3]), cvtpk(p0[4], p0[5]), cvtpk(p0[6], p0[7])};
    pw[1] = (u32x4){cvtpk(p0[8], p0[9]), cvtpk(p0[10], p0[11]), cvtpk(p0[12], p0[13]), cvtpk(p0[14], p0[15])};
    pw[2] = (u32x4){cvtpk(p1[0], p1[1]), cvtpk(p1[2], p1[3]), 0u, 0u};
    if (resc) {
        float fr[16];
#pragma unroll
        for (int r = 0; r < 16; ++r) fr[r] = wsf[crow(r, hi)];
#pragma unroll
        for (int d = 0; d < 2; ++d)
#pragma unroll
            for (int r = 0; r < 16; ++r) o[d][r] *= fr[r];
    }
}
__device__ __forceinline__ void naq_pv(f32x16 (&o)[2], const u32x4 (&pw)[3], const s16x4 (&lo)[2][3], const s16x4 (&hh)[2][3]) {
#pragma unroll
    for (int d0 = 0; d0 < 2; ++d0)
#pragma unroll
        for (int k = 0; k < 3; ++k)
            o[d0] = MFMA32(__builtin_bit_cast(bf16x8, pw[k]), ((bf16x8){lo[d0][k][0], lo[d0][k][1], lo[d0][k][2], lo[d0][k][3], hh[d0][k][0], hh[d0][k][1], hh[d0][k][2], hh[d0][k][3]}), o[d0]);
}
template <int THR>
__device__ __forceinline__ void na_quad_unit(Frame& F, int layer, const bf16_t* qkv, bf16_t* Y, int idx) {
    const int tid = phase_tid(F.wave), lane = tid & 63, wid = F.wave, r32 = lane & 31, hi = lane >> 5;
    const int hp = (idx >> 3) & 3, rq = idx & 7, grp = wid >> 2;
    const int h = 2 * hp + (wid >> 2), half = wid & 1, c = 32 * half + r32;
    const int rowA = 4 * rq + ((wid >> 1) & 1), rowB = rowA + 2;
    LAS unsigned char* lds = F.lds;
    LAS float* wsf = (LAS float*)(lds + ATT_WSF) + wid * 128;
    LAS float* RPB = (LAS float*)(lds + ATT_TBL);
    const int rF = 4 * rq, rL = 4 * rq + 3;
    const int lo = (rF - 4) < 0 ? 0 : ((rF - 4) > 24 ? 24 : (rF - 4));
    const int hr = ((rL - 4) < 0 ? 0 : ((rL - 4) > 24 ? 24 : (rL - 4))) + 7;
    const int ntile = hr - lo + 1;
    const int r0A = (rowA - 4) < 0 ? 0 : ((rowA - 4) > 24 ? 24 : (rowA - 4)), r0B = (rowB - 4) < 0 ? 0 : ((rowB - 4) > 24 ? 24 : (rowB - 4));
    const bf16_t* kbase = qkv + COL_KA + (2 * hp) * 64; const bf16_t* vbase_g = qkv + COL_VA + (2 * hp) * 64;
    const unsigned kvo = (unsigned)((8 * wid + (lane >> 3)) * NQKV + ((lane & 7) ^ (lane >> 3)) * 8) * 2u;
    const unsigned vvo = (unsigned)((16 * (wid & 3) + (lane >> 2)) * NQKV + (wid >> 2) * 32 + (lane & 3) * 8) * 2u;
#define NA_DMA(tt) do { if ((tt) < ntile) { const size_t go_ = (size_t)(lo + (tt)) * 64 * NQKV; LAS unsigned char* rb_ = lds + ((tt) & 3) * 32768 + wid * 1024; \
        GLDS16S(kvo, kbase + go_, rb_); GLDS16S(kvo, kbase + go_ + 64, rb_ + 8192); GLDS16S(vvo, vbase_g + go_, rb_ + 16384); GLDS16S(vvo, vbase_g + go_ + 64, rb_ + 24576); } } while (0)
#define NA_WAIT_BAR(t) asm volatile("s_waitcnt vmcnt(4)\n\ts_cmp_lt_i32 %0, %1\n\ts_cbranch_scc1 .Lnq%=\n\ts_waitcnt vmcnt(0)\n.Lnq%=:\n\ts_waitcnt lgkmcnt(0)\n\ts_barrier" :: "s"((t) + 2), "s"(ntile) : "scc", "memory")
    NA_DMA(0); NA_DMA(1); NA_DMA(2);
    const int tdr = (tid >> 5) < 15 ? (tid >> 5) : 14, ti = (tid & 31) < 31 ? (tid & 31) : 30;
    const float* rpbg = arg_in(5) + ((size_t)(layer * 8 + 2 * hp) * 15 + tdr) * 31 + ti;
    float tv0 = rpbg[0], tv1 = rpbg[15 * 31];
    bf16x8 qA[4], qB[4];
    { const bf16_t* Qw = qkv + (size_t)(rowA * 64 + c) * NQKV + COL_QA + h * 64 + hi * 8;
#pragma unroll
      for (int d0 = 0; d0 < 4; ++d0) { qA[d0] = *(const bf16x8*)(Qw + d0 * 16); qB[d0] = *(const bf16x8*)(Qw + (size_t)128 * NQKV + d0 * 16); } }
    asm volatile("" : "+v"(tv0), "+v"(tv1), "+v"(qA[0]), "+v"(qA[1]), "+v"(qA[2]), "+v"(qA[3]), "+v"(qB[0]), "+v"(qB[1]), "+v"(qB[2]), "+v"(qB[3]));
    if (tid < 480) { const bool in = (tid & 31) < 31; RPB[tid] = in ? tv0 * LOG2E : 0.f; RPB[480 + tid] = in ? tv1 * LOG2E : 0.f; }
    const int voff = ((lane >> 4) & 1) * 32 + (lane & 3) * 8 + (4 * hi + ((lane & 15) >> 2)) * 64 + grp * 8192;
    int koff[4];
#pragma unroll
    for (int d0 = 0; d0 < 4; ++d0) koff[d0] = r32 * 128 + (((2 * d0 + hi) ^ (r32 & 7)) << 4) + grp * 8192;
    const int dF = half * 4096, dP = half ? ((((r32 + 24) & 31) - r32) * 128) : 4096;
    const int fo = 32 * half, pk0 = half ? 24 : 32;
#define NA_KLOAD(slot_) do { lcp ks_ = (lcp)(lds + (slot_) * 32768); \
        _Pragma("unroll") for (int d0 = 0; d0 < 4; ++d0) { kf[2 * d0] = *(const LAS bf16x8*)(ks_ + koff[d0] + dF); kf[2 * d0 + 1] = *(const LAS bf16x8*)(ks_ + koff[d0] + dP); } } while (0)
    f32x16 oA[2], oB[2]; oA[0] = f32x16{}; oA[1] = f32x16{}; oB[0] = f32x16{}; oB[1] = f32x16{};
    float mhatA = 0.f, lA = 0.f, mhatB = 0.f, lB = 0.f;
    ATT_WAIT_BAR(8);
    bf16x8 kf[8];
    NA_KLOAD(0);
    const int c0 = (c - 8) < 0 ? 0 : ((c - 8) > 48 ? 48 : (c - 8));
    const int vbase = 4 * hi - c0;
    const int rpoff = grp * 480 + (4 * hi - c + 15);
    f32x16 cM;
#pragma unroll
    for (int r = 0; r < 16; ++r) { const int e = (r & 3) + 8 * (r >> 2) + fo; cM[r] = ((unsigned)(vbase + e) < 16u) ? 0.f : -INFINITY; }
#pragma unroll 1
    for (int t = 0; t < ntile; ++t) {
        const int kr = lo + t; const bool actA = (kr >= r0A && kr < r0A + 8), actB = (kr >= r0B && kr < r0B + 8);
        lcp vb = (lcp)(lds + (t & 3) * 32768 + 16384 + voff);
        lcp vbF = vb + half * 2048, vbP = vb + (half ? 1536 : 2048);
        s16x4 vlo[2][3], vhh[2][3]; f32x16 pA0, pA1, pB0, pB1; u32x4 pwA[3], pwB[3];
        const float mhA = actA ? mhatA : INFINITY, mhB = actB ? mhatB : INFINITY;
        const int drA = (kr - rowA + 7) < 0 ? 0 : ((kr - rowA + 7) > 14 ? 14 : (kr - rowA + 7)), drB = (kr - rowB + 7) < 0 ? 0 : ((kr - rowB + 7) > 14 ? 14 : (kr - rowB + 7));
        int ro = rpoff; asm volatile("" : "+v"(ro));
        naq_mfma(pA0, pA1, kf, qA, cM, mhA);
        naq_mfma(pB0, pB1, kf, qB, cM, mhB);
        __builtin_amdgcn_sched_barrier(0);
        if (actA) naq_softmax<THR>(pA0, pA1, oA, mhatA, lA, kr == r0A, mhA, RPB + drA * 32 + ro, vbase, fo, pk0, wsf, r32, hi, pwA);
        if (actB) naq_softmax<THR>(pB0, pB1, oB, mhatB, lB, kr == r0B, mhB, RPB + drB * 32 + ro, vbase, fo, pk0, wsf, r32, hi, pwB);
        __builtin_amdgcn_sched_barrier(0);
        naq_vload(vlo, vhh, vbF, vbP);
        if (grp == 1) { NA_WAIT_BAR(t); NA_DMA(t + 3); if (t + 1 < ntile) NA_KLOAD((t + 1) & 3); }
        __builtin_amdgcn_sched_barrier(0);
        if (actA) naq_pv(oA, pwA, vlo, vhh);
        if (actB) naq_pv(oB, pwB, vlo, vhh);
        if (grp == 0) { NA_WAIT_BAR(t); NA_DMA(t + 3); if (t + 1 < ntile) NA_KLOAD((t + 1) & 3); }
    }
    ATT_WAIT_BAR(0);
#undef NA_DMA
#undef NA_WAIT_BAR
#undef NA_KLOAD
    const int hie = (int)(lane_id_now() >> 5);
    LAS bf16_t* stg = (LAS bf16_t*)(lds + 65536) + wid * 4096;
    { float rli[16]; row_inv_l(lA, rli, wsf, r32, hie);
#pragma unroll
      for (int d = 0; d < 2; ++d)
#pragma unroll
        for (int r = 0; r < 16; ++r) { const float v = oA[d][r] * rli[r]; stg[crow(r, hie) * 64 + d * 32 + r32] = (bf16_t)(cvtpk(v, v) & 0xffffu); } }
    { float rli[16]; row_inv_l(lB, rli, wsf, r32, hie);
#pragma unroll
      for (int d = 0; d < 2; ++d)
#pragma unroll
        for (int r = 0; r < 16; ++r) { const float v = oB[d][r] * rli[r]; stg[2048 + crow(r, hie) * 64 + d * 32 + r32] = (bf16_t)(cvtpk(v, v) & 0xffffu); } }
    bf16_t* yb = Y + (size_t)(rowA * 64 + 32 * half + (lane >> 3)) * D + h * 64 + (lane & 7) * 8;
    u32x4 sv[8];
#pragma unroll
    for (int i = 0; i < 8; ++i) sv[i] = *(const LAS u32x4*)(stg + (i >> 2) * 2048 + ((i & 3) * 8 + (lane >> 3)) * 64 + (lane & 7) * 8);
#pragma unroll
    for (int i = 0; i < 8; ++i) store16_wt(yb + (size_t)((i >> 2) * 128 + (i & 3) * 8) * D, sv[i]);
    ATT_WAIT_BAR(0);
}
}

struct Args { const float* in[14]; float* out; unsigned char* ws; };
__global__ void __launch_bounds__(NWAVES * 64, 2) enc_fwd(Args args) {
    extern __shared__ __attribute__((aligned(16))) unsigned char lds[];
    Frame F;
    F.lds = (LAS unsigned char*)lds;
    F.wave = __builtin_amdgcn_readfirstlane((int)threadIdx.x >> 6); F.G = gridDim.x; { const int bx = blockIdx.x; F.vcu = (F.G % 8 == 0) ? (bx % 8) * (F.G / 8) + bx / 8 : bx; }
    F.out = args.out; F.ws = args.ws;
    unsigned char* ws = args.ws;
    volatile LAS unsigned* MISC = (volatile LAS unsigned*)(F.lds + MISC_OFF);
    for (int u = threadIdx.x; u < (LDS_BYTES - LDSCTL_OFF) / 4; u += NWAVES * 64) ((LAS unsigned*)(F.lds + LDSCTL_OFF))[u] = 0u;
    __syncthreads();
    XcdBarrier bar; bar.bar = (unsigned*)(ws + WS_CTL) + CW_BAR; bar.x = 0; bar.st = nullptr; bar.wave = F.wave;
    bar = xcd_barrier_post((unsigned*)(ws + WS_CTL) + CW_BAR, MISC + 8, F.wave);
    p0_prologue(F);
    xcd_barrier(bar);
    const unsigned xcc = bar.x;
    const int nloc = __builtin_amdgcn_readfirstlane((int)MISC[8]), nx = __builtin_amdgcn_readfirstlane((int)MISC[9]);
    const int rank = __builtin_amdgcn_readfirstlane((int)MISC[10]), xi = __builtin_amdgcn_readfirstlane((int)MISC[11]);
    unsigned* lbar = (unsigned*)(ws + WS_CTL) + CW_BAR;
    unsigned lgen = 0;
#define LSEAM() xcc_local_barrier(lbar, xcc, (unsigned)nloc, F.wave, lgen)
#pragma unroll 1
    for (int bb = xi; bb < BATCH; bb += nx) {
        unsigned char* breg = ws + WS_QKV + (size_t)bb * BREG;
        bf16_t* QKVb = (bf16_t*)breg; bf16_t* GATESb = (bf16_t*)(breg + BREG_GATES); bf16_t* MERGEDb = (bf16_t*)breg; bf16_t* HBb = (bf16_t*)breg;
        bf16_t* XBb = (bf16_t*)(ws + WS_XNY) + (size_t)bb * MB * D; float* SSb = (float*)(ws + WS_SS) + (size_t)bb * MB * 4;
        bf16_t* Yb = (bf16_t*)((unsigned char*)F.out + (size_t)bb * MB * D * 4);
        float* OUTb = F.out + (size_t)bb * MB * D;
#pragma unroll 1
        for (int L = 0; L < DEPTH; ++L) {
            unsigned char* wb = ws + WS_W + (size_t)L * W_LAYER;
            {
                pg8::Gemm g{XBb, (const bf16_t*)(wb + WO_IN), MB, NIN, D}; pg8::BatchOrder S{NIN / 256, nloc, rank, 12};
                pg8::EpiProj E{QKVb, GATESb, SSb, ((nloc & 7) == 0) ? (LAS float*)(F.lds + ATT_WSF) : (LAS float*)nullptr};
                pg8::gemm_phase<pg8::EpiProj, pg8::BatchOrder, true, true>(F.lds + RING_OFF, g, S, E, F.wave);
            }
            LSEAM();
            {
#pragma unroll 1
                for (int u = 2 * rank; u < 64; u += 2 * nloc) { att::diff_unit<8>(F, L, QKVb, Yb, u >> 4, u & 15); att::diff_unit<8>(F, L, QKVb, Yb, (u + 1) >> 4, (u + 1) & 15); }
#pragma unroll 1
                for (int u = rank; u < 32; u += nloc) att::na_quad_unit<8>(F, L, QKVb, Yb, u);
            }
            LSEAM();
            {
                pg8::Gemm g{Yb, (const bf16_t*)(wb + WO_M), MB, D, D}; pg8::BatchOrder S{D / 256, nloc, rank, 0};
                pg8::EpiMerge E{MERGEDb, GATESb};
                pg8::gemm_phase<pg8::EpiMerge, pg8::BatchOrder, true, true>(F.lds + RING_OFF, g, S, E, F.wave);
            }
            LSEAM();
            {
                pg8::Gemm g{MERGEDb, (const bf16_t*)(wb + WO_OUT), MB, D, D}; pg8::BatchOrder S{D / 256, nloc, rank, 0};
                pg8::EpiResid E{XBb, SSb, {}};
                pg8::gemm_phase<pg8::EpiResid, pg8::BatchOrder, true, true>(F.lds + RING_OFF, g, S, E, F.wave);
            }
            LSEAM();
            {
                pg8::Gemm g{XBb, (const bf16_t*)(wb + WO_FF1), MB, FF, D}; pg8::BatchOrder S{FF / 256, nloc, rank, 0};
                pg8::EpiFF1 E{HBb, SSb, ((nloc & 7) == 0) ? (LAS float*)(F.lds + ATT_WSF) : (LAS float*)nullptr};
                pg8::gemm_phase<pg8::EpiFF1, pg8::BatchOrder, true, true>(F.lds + RING_OFF, g, S, E, F.wave);
            }
            LSEAM();
            {
                pg8::Gemm g{HBb, (const bf16_t*)(wb + WO_FF2), MB, D, FF}; pg8::BatchOrder S{D / 256, nloc, rank, 0};
                if (L + 1 < DEPTH) { pg8::EpiResid E{XBb, SSb, {}};
                    pg8::gemm_phase<pg8::EpiResid, pg8::BatchOrder, true, true>(F.lds + RING_OFF, g, S, E, F.wave); }
                else { pg8::EpiFinal E{XBb, SSb, arg_in(2), OUTb, (unsigned*)(ws + WS_CTL) + CW_PANEL + bb * 8 * 64, {}};
                    pg8::gemm_phase<pg8::EpiFinal, pg8::BatchOrder, true, true>(F.lds + RING_OFF, g, S, E, F.wave); }
            }
            if (L + 1 < DEPTH) LSEAM();
        }
        if (bb + nx < BATCH) LSEAM();
    }
#undef LSEAM
}

extern "C" void kernel_launch(void* const* d_in, const int* in_sizes, int n_in, void* d_out, int out_size, void* d_ws, size_t ws_size, hipStream_t stream) {
    static int grid = 0;
    if (grid == 0) {
        if (n_in != 14 || in_sizes[0] != M * D || out_size != M * D || ws_size < WS_END) { fprintf(stderr, "kernel_launch: unexpected shapes (n_in %d, in0 %d, out %d, ws %zu); nothing launched\n", n_in, n_in > 0 ? in_sizes[0] : -1, out_size, ws_size); grid = -1; return; }
        int dev = 0, cus = 0;
        if (hipGetDevice(&dev) != hipSuccess || hipDeviceGetAttribute(&cus, hipDeviceAttributeMultiprocessorCount, dev) != hipSuccess) { grid = -1; return; }
        if (hipFuncSetAttribute((const void*)enc_fwd, hipFuncAttributeMaxDynamicSharedMemorySize, LDS_BYTES) != hipSuccess) { fprintf(stderr, "kernel_launch: hipFuncSetAttribute failed\n"); grid = -1; return; }
        int per_cu = 0;
        if (hipOccupancyMaxActiveBlocksPerMultiprocessor(&per_cu, (const void*)enc_fwd, NWAVES * 64, LDS_BYTES) != hipSuccess || per_cu < 1) fprintf(stderr, "kernel_launch: occupancy query reports %d per CU\n", per_cu);
        (void)hipGetLastError();
        grid = cus;
    }
    if (grid < 0) return;
    Args a{};
    for (int i = 0; i < 14; ++i) a.in[i] = (const float*)d_in[i];
    a.out = (float*)d_out; a.ws = (unsigned char*)d_ws;
    if (hipMemsetAsync((char*)d_ws + WS_CTL, 0, CTL_ZERO_BYTES, stream) != hipSuccess) { fprintf(stderr, "kernel_launch: memset failed\n"); return; }
    hipLaunchKernelGGL(enc_fwd, dim3(grid), dim3(NWAVES * 64), LDS_BYTES, stream, a);
}
```

```cpp
#include <hip/hip_runtime.h>
#include <cstdio>
#include <cstdint>

#define LAS __attribute__((address_space(3)))
#define GAS __attribute__((address_space(1)))
typedef unsigned short bf16_t;
typedef short bf16x8 __attribute__((ext_vector_type(8)));
typedef short s16x4 __attribute__((ext_vector_type(4)));
typedef float f32x4 __attribute__((ext_vector_type(4)));
typedef float f32x2 __attribute__((ext_vector_type(2)));
typedef float f32x16 __attribute__((ext_vector_type(16)));
typedef unsigned u32x4 __attribute__((ext_vector_type(4)));
typedef unsigned u32x2 __attribute__((ext_vector_type(2)));
typedef __bf16 bf16x2_t __attribute__((ext_vector_type(2)));

constexpr int BATCH = 8, SEQ = 2048, D = 1024, M = BATCH * SEQ, DEPTH = 2, FF = 4096;
constexpr int NQKV = 3072, NGATE = 2048, NIN = 5120;
constexpr int MB = SEQ;
constexpr float RMS_EPS = 1e-6f;
constexpr float LOG2E = 1.4426950408889634f;
constexpr float C2 = 0.125f * LOG2E;
constexpr int COL_QA = 0, COL_KA = 512, COL_VA = 1024, COL_QD = 1536, COL_KD = 2048, COL_VD = 2560;

__device__ __forceinline__ unsigned cvtpk(float lo, float hi) { f32x2 v = {lo, hi}; bf16x2_t b = __builtin_convertvector(v, bf16x2_t); return __builtin_bit_cast(unsigned, b); }
__device__ __forceinline__ float bf2f(unsigned short u) { return __uint_as_float((unsigned)u << 16); }
__device__ __forceinline__ float bflo(unsigned w) { return __uint_as_float(w << 16); }
__device__ __forceinline__ float bfhi(unsigned w) { return __uint_as_float(w & 0xffff0000u); }

__device__ __forceinline__ unsigned lane_id_now() { unsigned l; asm volatile("v_mbcnt_lo_u32_b32 %0, -1, 0\n\tv_mbcnt_hi_u32_b32 %0, -1, %0" : "=v"(l)); return l; }
__device__ __forceinline__ void store16_wt(void* p, u32x4 v) { asm volatile("global_store_dwordx4 %0, %1, off sc1\n\ts_nop 1" :: "v"(p), "v"(v) : "memory"); }
#define DPP_ADD(v, ctrl) ((v) + __uint_as_float((unsigned)__builtin_amdgcn_update_dpp(0, (int)__float_as_uint(v), (ctrl), 0xF, 0xF, true)))
__device__ __forceinline__ float sum_row16(float v) {
    v = DPP_ADD(v, 0xB1); v = DPP_ADD(v, 0x4E); v = DPP_ADD(v, 0x141); v = DPP_ADD(v, 0x140); return v; }
__device__ __forceinline__ float sum_xor16(float v) { auto rr = __builtin_amdgcn_permlane16_swap(__float_as_uint(v), __float_as_uint(v), false, false); return __uint_as_float(rr[0]) + __uint_as_float(rr[1]); }
__device__ __forceinline__ float sum_xor32(float v) { auto rr = __builtin_amdgcn_permlane32_swap(__float_as_uint(v), __float_as_uint(v), false, false); return __uint_as_float(rr[0]) + __uint_as_float(rr[1]); }
__device__ __forceinline__ float sum_half32(float v) { return sum_xor16(sum_row16(v)); }
namespace pg8 {
constexpr int BM = 256, BK = 64, HALF = 128, HTB = HALF * BK * 2, STAGE_BYTES = 8 * HTB, NXCD = 8, WGM = 8;
__host__ __device__ __forceinline__ int lds_byte(int r, int c) { const int st = (r >> 4) * 2 + (c >> 5), rr = r & 15, cc = c & 31, ob = rr * 64 + cc * 2; return st * 1024 + (ob ^ (((ob >> 9) & 1) << 5)); }
__host__ __device__ __forceinline__ void stage_rc(int b, int& R, int& C) { const int st = b / 1024, sb = b % 1024, swz = sb ^ (((sb >> 9) & 1) << 5); R = (st >> 1) * 16 + swz / 64; C = (st & 1) * 32 + (swz % 64) / 2; }
__host__ __device__ __forceinline__ int perm32(int rho) { const int n = rho >> 4, i = rho & 15; return 8 * (i >> 2) + 4 * n + (i & 3); }

struct Unit { int pm, pn; };
struct Gemm { const bf16_t* A; const bf16_t* Bt; int M, N, K; int kt0; };

struct BatchOrder {
    int nN, nloc, rank, rot;
    __device__ bool next(int i, Unit& u) const { const int L = i * nloc + rank; if (L >= 8 * nN) return false; u.pm = L & 7; int pn = (L >> 3) + rot; u.pn = pn >= nN ? pn - nN : pn; return true; }
};

__device__ __forceinline__ float row_rstd(const float* ss, int row) {
    const f32x4 a = *(const f32x4*)(ss + (size_t)row * 4);
    const float s = (a[0] + a[1]) + (a[2] + a[3]);
    return 1.0f / sqrtf(s * (1.0f / (float)D) + RMS_EPS);
}

struct EpiProj {
    static constexpr bool HAS_POST = false, HAS_RTAB = true;
    static constexpr bool PERM = true, HAS_MID = false;
    bf16_t* qkv; bf16_t* gates; const float* ss; LAS float* rtab;
    __device__ __forceinline__ void mid(f32x4 (&acc)[2][2][4][2], const Unit& u, int wr, int wc, int fr, int fq) const {}
    __device__ __forceinline__ void operator()(f32x4 (&acc)[2][2][4][2], const Unit& u, int wr, int wc, int fr, int fq) const {
        const int row0 = u.pm * BM + wr * 64 + fr;
        float rs[2][4];
        if (rtab) {
#pragma unroll
            for (int ai = 0; ai < 2; ++ai)
#pragma unroll
                for (int m = 0; m < 4; ++m) rs[ai][m] = rtab[wr * 64 + fr + ai * HALF + m * 16];
        } else {
#pragma unroll
            for (int ai = 0; ai < 2; ++ai)
#pragma unroll
                for (int m = 0; m < 4; ++m) rs[ai][m] = row_rstd(ss, row0 + ai * HALF + m * 16);
        }
        if (u.pn < 12) {
            const float sc = (u.pn < 2 || u.pn == 6 || u.pn == 7) ? C2 : 1.0f;
            const int col0 = u.pn * BM + wc * 32 + 8 * fq;
#pragma unroll
            for (int ai = 0; ai < 2; ++ai)
#pragma unroll
                for (int m = 0; m < 4; ++m) { const int row = row0 + ai * HALF + m * 16; const float r = rs[ai][m] * sc; bf16_t* rowp = qkv + (size_t)row * NQKV + col0;
#pragma unroll
                    for (int bj = 0; bj < 2; ++bj) { const f32x4 v0 = acc[ai][bj][m][0] * r, v1 = acc[ai][bj][m][1] * r;
                        u32x4 w; w.x = cvtpk(v0[0], v0[1]); w.y = cvtpk(v0[2], v0[3]); w.z = cvtpk(v1[0], v1[1]); w.w = cvtpk(v1[2], v1[3]);
                        store16_wt(rowp + bj * HALF, w); } }
        } else {
            const int col0 = (u.pn - 12) * HALF + wc * 32 + 8 * fq;
#pragma unroll
            for (int ai = 0; ai < 2; ++ai)
#pragma unroll
                for (int m = 0; m < 4; ++m) { const int row = row0 + ai * HALF + m * 16; const float r = rs[ai][m]; float rho[8], sg[8];
#pragma unroll
                    for (int n = 0; n < 2; ++n)
#pragma unroll
                        for (int e = 0; e < 4; ++e) { const float ga = acc[ai][0][m][n][e] * r, gd = fmaxf(acc[ai][1][m][n][e] * r, -80.f);
                            const float ed = 1.f + __expf(-gd), ea = 1.f + __expf(-ga); rho[4 * n + e] = ed * __builtin_amdgcn_rcpf(ea); sg[4 * n + e] = __builtin_amdgcn_rcpf(ed); }
                    u32x4 w; w.x = cvtpk(rho[0], rho[1]); w.y = cvtpk(rho[2], rho[3]); w.z = cvtpk(rho[4], rho[5]); w.w = cvtpk(rho[6], rho[7]);
                    store16_wt(gates + (size_t)row * D + col0, w);
                    w.x = cvtpk(sg[0], sg[1]); w.y = cvtpk(sg[2], sg[3]); w.z = cvtpk(sg[4], sg[5]); w.w = cvtpk(sg[6], sg[7]);
                    store16_wt(gates + (size_t)MB * D + (size_t)row * D + col0, w); }
        }
    }
};
struct EpiFF1 {
    static constexpr bool HAS_POST = false, HAS_RTAB = true;
    static constexpr bool PERM = true, HAS_MID = false;
    bf16_t* H; const float* ss; LAS float* rtab;
    __device__ __forceinline__ void mid(f32x4 (&acc)[2][2][4][2], const Unit& u, int wr, int wc, int fr, int fq) const {}
    __device__ __forceinline__ void operator()(f32x4 (&acc)[2][2][4][2], const Unit& u, int wr, int wc, int fr, int fq) const {
        const int row0 = u.pm * BM + wr * 64 + fr, col0 = u.pn * BM + wc * 32 + 8 * fq;
        float rs[2][4];
        if (rtab) {
#pragma unroll
            for (int ai = 0; ai < 2; ++ai)
#pragma unroll
                for (int m = 0; m < 4; ++m) rs[ai][m] = rtab[wr * 64 + fr + ai * HALF + m * 16];
        } else {
#pragma unroll
            for (int ai = 0; ai < 2; ++ai)
#pragma unroll
                for (int m = 0; m < 4; ++m) rs[ai][m] = row_rstd(ss, row0 + ai * HALF + m * 16);
        }
#pragma unroll
        for (int ai = 0; ai < 2; ++ai)
#pragma unroll
            for (int m = 0; m < 4; ++m) { const int row = row0 + ai * HALF + m * 16; const float r = rs[ai][m]; bf16_t* rowp = H + (size_t)row * FF + col0;
#pragma unroll
                for (int bj = 0; bj < 2; ++bj) { f32x4 v0 = acc[ai][bj][m][0] * r, v1 = acc[ai][bj][m][1] * r;
#pragma unroll
                    for (int e = 0; e < 4; ++e) { const float a = fmaxf(v0[e], 0.f), b = fmaxf(v1[e], 0.f); v0[e] = a * a; v1[e] = b * b; }
                    u32x4 w; w.x = cvtpk(v0[0], v0[1]); w.y = cvtpk(v0[2], v0[3]); w.z = cvtpk(v1[0], v1[1]); w.w = cvtpk(v1[2], v1[3]);
                    store16_wt(rowp + bj * HALF, w); } }
    }
};
struct EpiMerge {
    static constexpr bool HAS_POST = false, HAS_RTAB = false;
    static constexpr bool PERM = true, HAS_MID = true;
    bf16_t* O; const bf16_t* gates;
    __device__ __forceinline__ void mid(f32x4 (&acc)[2][2][4][2], const Unit& u, int wr, int wc, int fr, int fq) const {
        const int row0 = u.pm * BM + wr * 64 + fr, col0 = u.pn * BM + wc * 32 + 8 * fq;
        const bf16_t* gp = gates + (size_t)row0 * D + col0;
        asm volatile("" : "+v"(gp) :: "memory");
        u32x4 g[2][4][2];
#pragma unroll
        for (int ai = 0; ai < 2; ++ai)
#pragma unroll
            for (int q = 0; q < 4; ++q)
#pragma unroll
                for (int bj = 0; bj < 2; ++bj) g[ai][q][bj] = *(const GAS u32x4*)(gp + (ai * HALF + q * 16) * D + bj * HALF);
        __builtin_amdgcn_sched_barrier(0);
#pragma unroll
        for (int ai = 0; ai < 2; ++ai)
#pragma unroll
            for (int q = 0; q < 4; ++q)
#pragma unroll
                for (int bj = 0; bj < 2; ++bj)
#pragma unroll
                    for (int w = 0; w < 4; ++w) { acc[ai][bj][q][w >> 1][(w & 1) * 2] *= bflo(g[ai][q][bj][w]); acc[ai][bj][q][w >> 1][(w & 1) * 2 + 1] *= bfhi(g[ai][q][bj][w]); }
    }
    __device__ __forceinline__ void operator()(f32x4 (&acc)[2][2][4][2], const Unit& u, int wr, int wc, int fr, int fq) const {
        const int row0 = u.pm * BM + wr * 64 + fr, col0 = u.pn * BM + wc * 32 + 8 * fq;
        const bf16_t* gp = gates + (size_t)MB * D + (size_t)row0 * D + col0; bf16_t* rowp = O + (size_t)row0 * D + col0;
        asm volatile("" : "+v"(gp), "+v"(rowp) :: "memory");
        u32x4 g[2][4][2];
#pragma unroll
        for (int ai = 0; ai < 2; ++ai)
#pragma unroll
            for (int q = 0; q < 4; ++q)
#pragma unroll
                for (int bj = 0; bj < 2; ++bj) g[ai][q][bj] = *(const GAS u32x4*)(gp + (ai * HALF + q * 16) * D + bj * HALF);
        __builtin_amdgcn_sched_barrier(0);
#pragma unroll
        for (int ai = 0; ai < 2; ++ai)
#pragma unroll
            for (int q = 0; q < 4; ++q)
#pragma unroll
                for (int bj = 0; bj < 2; ++bj) { float o[8];
#pragma unroll
                    for (int w = 0; w < 4; ++w) { o[2 * w] = acc[ai][bj][q][w >> 1][(w & 1) * 2] * bflo(g[ai][q][bj][w]); o[2 * w + 1] = acc[ai][bj][q][w >> 1][(w & 1) * 2 + 1] * bfhi(g[ai][q][bj][w]); }
                    u32x4 w4; w4.x = cvtpk(o[0], o[1]); w4.y = cvtpk(o[2], o[3]); w4.z = cvtpk(o[4], o[5]); w4.w = cvtpk(o[6], o[7]);
                    store16_wt((void*)(rowp + (ai * HALF + q * 16) * D + bj * HALF), w4); }
    }
};
struct EpiResid {
    static constexpr bool HAS_POST = true, HAS_RTAB = false;
    static constexpr bool PERM = true, HAS_MID = false;
    bf16_t* xb; float* ss; float qs[2][4];
    __device__ __forceinline__ void mid(f32x4 (&acc)[2][2][4][2], const Unit& u, int wr, int wc, int fr, int fq) const {}
    __device__ __forceinline__ void operator()(f32x4 (&acc)[2][2][4][2], const Unit& u, int wr, int wc, int fr, int fq) {
        const int row0 = u.pm * BM + wr * 64 + fr, col0 = u.pn * BM + wc * 32 + 8 * fq;
        u32x4 xv[2][4][2];
#pragma unroll
        for (int ai = 0; ai < 2; ++ai)
#pragma unroll
            for (int m = 0; m < 4; ++m)
#pragma unroll
                for (int bj = 0; bj < 2; ++bj) xv[ai][m][bj] = *(const GAS u32x4*)(xb + (size_t)(row0 + ai * HALF + m * 16) * D + col0 + bj * HALF);
        __builtin_amdgcn_sched_barrier(0);
#pragma unroll
        for (int ai = 0; ai < 2; ++ai) {
#pragma unroll
            for (int m = 0; m < 4; ++m) { const int row = row0 + ai * HALF + m * 16; bf16_t* rowp = xb + (size_t)row * D + col0; float q = 0.f;
#pragma unroll
                for (int bj = 0; bj < 2; ++bj) { const u32x4 x4 = xv[ai][m][bj];
                    const f32x4 y0 = (f32x4){bflo(x4.x), bfhi(x4.x), bflo(x4.y), bfhi(x4.y)} + acc[ai][bj][m][0], y1 = (f32x4){bflo(x4.z), bfhi(x4.z), bflo(x4.w), bfhi(x4.w)} + acc[ai][bj][m][1];
                    q += (y0[0] * y0[0] + y0[1] * y0[1]) + (y0[2] * y0[2] + y0[3] * y0[3]) + (y1[0] * y1[0] + y1[1] * y1[1]) + (y1[2] * y1[2] + y1[3] * y1[3]);
                    u32x4 w; w.x = cvtpk(y0[0], y0[1]); w.y = cvtpk(y0[2], y0[3]); w.z = cvtpk(y1[0], y1[1]); w.w = cvtpk(y1[2], y1[3]);
                    *(GAS u32x4*)(rowp + bj * HALF) = w; }
                q = sum_xor32(sum_xor16(q));
                qs[ai][m] = q; }
            __builtin_amdgcn_sched_barrier(0);
        }
    }
    __device__ __forceinline__ void post(LAS unsigned char* lds, f32x4 (&acc)[2][2][4][2], const Unit& u, int wr, int wc, int fr, int fq, int tid) {
        LAS float* P = (LAS float*)lds;
        if (fq == 0) {
#pragma unroll
            for (int ai = 0; ai < 2; ++ai)
#pragma unroll
                for (int m = 0; m < 4; ++m) P[(ai * HALF + wr * 64 + m * 16 + fr) * 4 + wc] = qs[ai][m];
        }
        asm volatile("s_waitcnt lgkmcnt(0)" ::: "memory"); __builtin_amdgcn_s_barrier(); asm volatile("" ::: "memory");
        if (tid < 256) { const f32x4 v = *(const LAS f32x4*)(P + tid * 4); ss[(size_t)(u.pm * BM + tid) * 4 + u.pn] = (v[0] + v[1]) + (v[2] + v[3]); }
    }
};

struct EpiFinal {
    static constexpr bool HAS_POST = true, HAS_RTAB = false;
    static constexpr bool PERM = true, HAS_MID = false;
    const bf16_t* xb; float* ss; const float* g; float* out; unsigned* cnt; float qs[2][4];
    __device__ __forceinline__ void mid(f32x4 (&acc)[2][2][4][2], const Unit& u, int wr, int wc, int fr, int fq) const {}
    __device__ __forceinline__ void operator()(f32x4 (&acc)[2][2][4][2], const Unit& u, int wr, int wc, int fr, int fq) {
        const int row0 = u.pm * BM + wr * 64 + fr, col0 = u.pn * BM + wc * 32 + 8 * fq;
        u32x4 xq[2][4][2];
#pragma unroll
        for (int ai = 0; ai < 2; ++ai)
#pragma unroll
            for (int m = 0; m < 4; ++m)
#pragma unroll
                for (int bj = 0; bj < 2; ++bj) xq[ai][m][bj] = *(const GAS u32x4*)(xb + (size_t)(row0 + ai * HALF + m * 16) * D + col0 + bj * HALF);
        __builtin_amdgcn_sched_barrier(0);
#pragma unroll
        for (int ai = 0; ai < 2; ++ai)
#pragma unroll
            for (int m = 0; m < 4; ++m) { float q = 0.f;
#pragma unroll
                for (int bj = 0; bj < 2; ++bj) { const u32x4 xv = xq[ai][m][bj];
                    const f32x4 y0 = (f32x4){bflo(xv.x), bfhi(xv.x), bflo(xv.y), bfhi(xv.y)} + acc[ai][bj][m][0], y1 = (f32x4){bflo(xv.z), bfhi(xv.z), bflo(xv.w), bfhi(xv.w)} + acc[ai][bj][m][1];
                    q += (y0[0] * y0[0] + y0[1] * y0[1]) + (y0[2] * y0[2] + y0[3] * y0[3]) + (y1[0] * y1[0] + y1[1] * y1[1]) + (y1[2] * y1[2] + y1[3] * y1[3]);
                    acc[ai][bj][m][0] = y0; acc[ai][bj][m][1] = y1; }
                q = sum_xor32(sum_xor16(q));
                qs[ai][m] = q; }
    }
    __device__ __forceinline__ void post(LAS unsigned char* lds, f32x4 (&acc)[2][2][4][2], const Unit& u, int wr, int wc, int fr, int fq, int tid) {
        LAS float* P = (LAS float*)lds;
        LAS float* S = (LAS float*)(lds + 4096);
        LAS unsigned* flag = (LAS unsigned*)(lds + 4096 + 1024);
        if (fq == 0) {
#pragma unroll
            for (int ai = 0; ai < 2; ++ai)
#pragma unroll
                for (int m = 0; m < 4; ++m) P[(ai * HALF + wr * 64 + m * 16 + fr) * 4 + wc] = qs[ai][m];
        }
        asm volatile("s_waitcnt lgkmcnt(0)" ::: "memory"); __builtin_amdgcn_s_barrier(); asm volatile("" ::: "memory");
        unsigned* pc = cnt + 64 * u.pm;
        if (tid < 256) {
            const f32x4 v = *(const LAS f32x4*)(P + tid * 4);
            __hip_atomic_store(ss + (size_t)(u.pm * BM + tid) * 4 + u.pn, (v[0] + v[1]) + (v[2] + v[3]), __ATOMIC_RELAXED, __HIP_MEMORY_SCOPE_AGENT);
            asm volatile("s_waitcnt vmcnt(0)" ::: "memory");
            if ((tid & 63) == 0) __hip_atomic_fetch_add(pc, 1u, __ATOMIC_RELAXED, __HIP_MEMORY_SCOPE_AGENT);
        }
        if (tid < 64) {
            unsigned sp = 0;
            while ((unsigned)__builtin_amdgcn_readfirstlane(__hip_atomic_load(pc, __ATOMIC_RELAXED, __HIP_MEMORY_SCOPE_AGENT)) < 16u) { __builtin_amdgcn_s_sleep(2); if (++sp > (1u << 20)) break; }
            asm volatile("s_waitcnt vmcnt(0)" ::: "memory");
            if (tid == 0) flag[0] = 1u;
        }
        asm volatile("s_waitcnt lgkmcnt(0)" ::: "memory"); __builtin_amdgcn_s_barrier(); asm volatile("" ::: "memory");
        if (tid < 256) {
            const float* sp4 = ss + (size_t)(u.pm * BM + tid) * 4; float t = 0.f;
#pragma unroll
            for (int j = 0; j < 4; ++j) t += __hip_atomic_load(sp4 + j, __ATOMIC_RELAXED, __HIP_MEMORY_SCOPE_AGENT);
            S[tid] = 1.0f / sqrtf(t * (1.0f / (float)D) + RMS_EPS);
        }
        asm volatile("s_waitcnt vmcnt(0) lgkmcnt(0)" ::: "memory"); __builtin_amdgcn_s_barrier(); asm volatile("" ::: "memory");
        const int row0 = u.pm * BM + wr * 64 + fr, col0 = u.pn * BM + wc * 32 + 8 * fq;
        f32x4 gv[2][2];
#pragma unroll
        for (int bj = 0; bj < 2; ++bj)
#pragma unroll
            for (int n = 0; n < 2; ++n) gv[bj][n] = *(const f32x4*)(g + col0 + bj * HALF + 4 * n);
#pragma unroll
        for (int ai = 0; ai < 2; ++ai)
#pragma unroll
            for (int m = 0; m < 4; ++m) { const int rl = ai * HALF + wr * 64 + m * 16 + fr; const float r = S[rl]; float* rowp = out + (size_t)(u.pm * BM + rl) * D + col0;
#pragma unroll
                for (int bj = 0; bj < 2; ++bj) { *(f32x4*)(rowp + bj * HALF) = acc[ai][bj][m][0] * r * gv[bj][0]; *(f32x4*)(rowp + bj * HALF + 4) = acc[ai][bj][m][1] * r * gv[bj][1]; } }
    }
};

__device__ __forceinline__ void dma2(unsigned v0, unsigned v1, unsigned long long sbase, unsigned ldsdst) { unsigned keep;
    asm volatile("s_mov_b32 %0, m0\n\ts_mov_b32 m0, %3\n\ts_nop 0\n\tglobal_load_lds_dwordx4 %1, %4\n\ts_add_u32 m0, m0, 0x2000\n\ts_nop 0\n\tglobal_load_lds_dwordx4 %2, %4\n\ts_mov_b32 m0, %0"
                 : "=&s"(keep) : "v"(v0), "v"(v1), "s"(ldsdst), "s"(sbase) : "memory", "scc"); }
template <class Epi, class Sched, bool ALIGN_EPI, bool SP2>
__device__ __forceinline__ void gemm_phase(LAS unsigned char* lds, const Gemm g, const Sched& S, Epi& E, int wave_) {
    const int tid_ = wave_ * 64 + (int)lane_id_now();
    const int tid = tid_, wid = __builtin_amdgcn_readfirstlane(tid >> 6), lane = tid & 63, wr = wid >> 2, wc = wid & 3, fr = lane & 15, fq = lane >> 4;
    const int K = g.K, nt = K / BK;
    unsigned voffA[2], voffB[2];
#pragma unroll
    for (int i = 0; i < 2; ++i) { int R, C; stage_rc(tid * 16 + i * 8192, R, C); const int Rb = Epi::PERM ? ((R & ~31) + perm32(R & 31)) : R;
        voffA[i] = (unsigned)(R * K + C) * 2u; voffB[i] = (unsigned)(Rb * K + C) * 2u; }
    const size_t kstep = (size_t)(BK * 2);
    const size_t hstep = (size_t)HALF * K * 2;
    const size_t tstep = 2 * hstep;
    const unsigned ldsw = (unsigned)wid * 1024u, ldsb = (unsigned)(uintptr_t)lds;
    const int aoff = lds_byte(wr * 64 + fr, fq * 8), boff = lds_byte(wc * 32 + fr, fq * 8);
#define PG8_SA(b, h) (((b) * 2 + (h)) * HTB)
#define PG8_SB(b, h) ((4 + (b) * 2 + (h)) * HTB)
#define PG8_STAGE(bufoff, gbase, voff) do { const uintptr_t gb_ = (uintptr_t)(gbase); \
        const unsigned long long sb_ = ((unsigned long long)(unsigned)__builtin_amdgcn_readfirstlane((int)(unsigned)(gb_ >> 32)) << 32) | (unsigned)__builtin_amdgcn_readfirstlane((int)(unsigned)gb_); \
        dma2((voff)[0], (voff)[1], sb_, (unsigned)__builtin_amdgcn_readfirstlane((int)(ldsb + (unsigned)(bufoff) + ldsw))); } while (0)
#define PG8_LDA(dst, b, h) do { _Pragma("unroll") for (int m = 0; m < 4; ++m) _Pragma("unroll") for (int k = 0; k < 2; ++k) dst[m][k] = *(const LAS bf16x8*)(lds + PG8_SA(b, h) + aoff + m * 2048 + k * 1024); } while (0)
#define PG8_LDB(dst, b, h) do { _Pragma("unroll") for (int n = 0; n < 2; ++n) _Pragma("unroll") for (int k = 0; k < 2; ++k) dst[n][k] = *(const LAS bf16x8*)(lds + PG8_SB(b, h) + boff + n * 2048 + k * 1024); } while (0)
#define PG8_MMA(ai, bj, At, Bt) do { __builtin_amdgcn_s_setprio(1); _Pragma("unroll") for (int m = 0; m < 4; ++m) _Pragma("unroll") for (int n = 0; n < 2; ++n) _Pragma("unroll") for (int k = 0; k < 2; ++k) \
        acc[ai][bj][m][n] = __builtin_amdgcn_mfma_f32_16x16x32_bf16(Bt[n][k], At[m][k], acc[ai][bj][m][n], 0, 0, 0); __builtin_amdgcn_s_setprio(0); } while (0)
#define PG8_WAIT_V(n) asm volatile("s_waitcnt vmcnt(" #n ")" ::: "memory")
#define PG8_WAIT_L(n) asm volatile("s_waitcnt lgkmcnt(" #n ")" ::: "memory")
#define PG8_BAR __builtin_amdgcn_s_barrier()
#define PG8_SCHED __builtin_amdgcn_sched_barrier(0)
    Unit cur, nxt; int ui = 0;
    if (!S.next(0, cur)) return;
    f32x4 acc[2][2][4][2];
#pragma unroll
    for (int a = 0; a < 2; ++a)
#pragma unroll
        for (int b = 0; b < 2; ++b)
#pragma unroll
            for (int m = 0; m < 4; ++m)
#pragma unroll
                for (int n = 0; n < 2; ++n) acc[a][b][m][n] = (f32x4){0.f, 0.f, 0.f, 0.f};
    bf16x8 At[4][2], B0[2][2], B1[2][2];
    const char* cA = (const char*)g.A + (size_t)cur.pm * tstep; const char* cB = (const char*)g.Bt + (size_t)cur.pn * tstep;
    const int kmask = nt - 1; const size_t off0 = (size_t)(g.kt0 & kmask) * kstep;
    if constexpr (SP2) {
        PG8_STAGE(PG8_SB(0, 0), cB + off0, voffB); PG8_STAGE(PG8_SB(0, 1), cB + off0 + hstep, voffB); PG8_STAGE(PG8_SA(0, 0), cA + off0, voffA); PG8_STAGE(PG8_SA(0, 1), cA + off0 + hstep, voffA);
        if constexpr (Epi::HAS_RTAB) { if (E.rtab && tid < 256) E.rtab[tid] = row_rstd(E.ss, cur.pm * BM + tid); }
        if (wr == 1) PG8_BAR;
        PG8_WAIT_V(2); PG8_BAR;
        PG8_STAGE(PG8_SB(1, 0), cB + off0 + kstep, voffB); PG8_STAGE(PG8_SA(1, 0), cA + off0 + kstep, voffA); PG8_STAGE(PG8_SB(1, 1), cB + off0 + hstep + kstep, voffB);
        PG8_WAIT_V(6); PG8_BAR;
    } else {
        PG8_STAGE(PG8_SB(0, 0), cB + off0, voffB); PG8_STAGE(PG8_SA(0, 0), cA + off0, voffA); PG8_STAGE(PG8_SB(0, 1), cB + off0 + hstep, voffB); PG8_STAGE(PG8_SA(0, 1), cA + off0 + hstep, voffA);
        if (wr == 1) PG8_BAR;
        PG8_WAIT_V(4); PG8_BAR;
        PG8_STAGE(PG8_SB(1, 0), cB + off0 + kstep, voffB); PG8_STAGE(PG8_SA(1, 0), cA + off0 + kstep, voffA); PG8_STAGE(PG8_SB(1, 1), cB + off0 + hstep + kstep, voffB);
        PG8_WAIT_V(6); PG8_BAR;
    }
    for (;;) {
        const bool has_next = S.next(ui + 1, nxt);
        const char* nA = has_next ? (const char*)g.A + (size_t)nxt.pm * tstep : cA; const char* nB = has_next ? (const char*)g.Bt + (size_t)nxt.pn * tstep : cB;
        for (int t = 0; t < nt; t += 2) {
            if constexpr (Epi::HAS_MID) { if (t == nt / 2) E.mid(acc, cur, wr, wc, fr, fq); }
            const bool last = (t == nt - 2);
            const char* a1 = cA + (size_t)(((t + g.kt0) & kmask) + 1) * kstep;
            const size_t o2 = (size_t)((t + 2 + g.kt0) & kmask) * kstep;
            const char* a2 = last ? nA + off0 : cA + o2; const char* b2 = last ? nB + off0 : cB + o2;
            const char* a3 = a2 + kstep; const char* b3 = b2 + kstep;
            if constexpr (SP2) {
            PG8_LDB(B0, 0, 0); PG8_LDB(B1, 0, 1); PG8_SCHED; PG8_LDA(At, 0, 0); PG8_STAGE(PG8_SA(1, 1), a1 + hstep, voffA);
            PG8_WAIT_V(8); PG8_WAIT_L(0); PG8_BAR; PG8_MMA(0, 0, At, B0); PG8_MMA(0, 1, At, B1); PG8_BAR; PG8_SCHED;
            PG8_LDA(At, 0, 1); PG8_STAGE(PG8_SB(0, 0), b2, voffB); PG8_STAGE(PG8_SB(0, 1), b2 + hstep, voffB); PG8_STAGE(PG8_SA(0, 0), a2, voffA);
            PG8_WAIT_V(8); PG8_WAIT_L(0); PG8_BAR; PG8_MMA(1, 0, At, B0); PG8_MMA(1, 1, At, B1); PG8_BAR; PG8_SCHED;
            PG8_LDB(B0, 1, 0); PG8_LDB(B1, 1, 1); PG8_SCHED; PG8_LDA(At, 1, 0); PG8_STAGE(PG8_SA(0, 1), a2 + hstep, voffA);
            PG8_WAIT_V(8); PG8_WAIT_L(0); PG8_BAR; PG8_MMA(0, 0, At, B0); PG8_MMA(0, 1, At, B1); PG8_BAR; PG8_SCHED;
            PG8_LDA(At, 1, 1); PG8_STAGE(PG8_SB(1, 0), b3, voffB); PG8_STAGE(PG8_SB(1, 1), b3 + hstep, voffB); PG8_STAGE(PG8_SA(1, 0), a3, voffA);
            PG8_WAIT_V(8); PG8_WAIT_L(0); PG8_BAR; PG8_MMA(1, 0, At, B0); PG8_MMA(1, 1, At, B1); PG8_BAR; PG8_SCHED;
            } else {
            PG8_LDB(B0, 0, 0); PG8_SCHED; PG8_LDA(At, 0, 0); PG8_STAGE(PG8_SA(1, 1), a1 + hstep, voffA);
            PG8_WAIT_L(8); PG8_BAR; PG8_WAIT_L(0); PG8_MMA(0, 0, At, B0); PG8_BAR; PG8_SCHED;
            PG8_LDB(B1, 0, 1); PG8_STAGE(PG8_SB(0, 0), b2, voffB);
            PG8_BAR; PG8_WAIT_L(0); PG8_MMA(0, 1, At, B1); PG8_BAR;
            PG8_LDA(At, 0, 1); PG8_STAGE(PG8_SA(0, 0), a2, voffA);
            PG8_BAR; PG8_WAIT_L(0); PG8_MMA(1, 0, At, B0); PG8_BAR; PG8_SCHED;
            PG8_STAGE(PG8_SB(0, 1), b2 + hstep, voffB);
            PG8_WAIT_V(6); PG8_BAR; PG8_MMA(1, 1, At, B1); PG8_BAR;
            PG8_LDB(B0, 1, 0); PG8_SCHED; PG8_LDA(At, 1, 0); PG8_STAGE(PG8_SA(0, 1), a2 + hstep, voffA);
            PG8_WAIT_L(8); PG8_BAR; PG8_WAIT_L(0); PG8_MMA(0, 0, At, B0); PG8_BAR; PG8_SCHED;
            PG8_LDB(B1, 1, 1); PG8_STAGE(PG8_SB(1, 0), b3, voffB);
            PG8_BAR; PG8_WAIT_L(0); PG8_MMA(0, 1, At, B1); PG8_BAR;
            PG8_LDA(At, 1, 1); PG8_STAGE(PG8_SA(1, 0), a3, voffA);
            PG8_BAR; PG8_WAIT_L(0); PG8_MMA(1, 0, At, B0); PG8_BAR; PG8_SCHED;
            PG8_STAGE(PG8_SB(1, 1), b3 + hstep, voffB);
            PG8_WAIT_V(6); PG8_BAR; PG8_MMA(1, 1, At, B1); PG8_BAR;
            }
        }
        if constexpr (ALIGN_EPI) { if (wr == 0) PG8_BAR; }
        E(acc, cur, wr, wc, fr, fq);
        if (!has_next) break;
#pragma unroll
        for (int a = 0; a < 2; ++a)
#pragma unroll
            for (int b = 0; b < 2; ++b)
#pragma unroll
                for (int m = 0; m < 4; ++m)
#pragma unroll
                    for (int n = 0; n < 2; ++n) acc[a][b][m][n] = (f32x4){0.f, 0.f, 0.f, 0.f};
        cur = nxt; cA = nA; cB = nB; ++ui;
        if constexpr (ALIGN_EPI) { if (wr == 1) PG8_BAR; }
    }
    PG8_WAIT_V(0);
    if constexpr (!ALIGN_EPI) { if (wr == 0) PG8_BAR; }
    PG8_BAR;
    if constexpr (Epi::HAS_POST) E.post(lds, acc, cur, wr, wc, fr, fq, tid);
#undef PG8_SA
#undef PG8_SB
#undef PG8_STAGE
#undef PG8_LDA
#undef PG8_LDB
#undef PG8_MMA
#undef PG8_WAIT_V
#undef PG8_WAIT_L
#undef PG8_BAR
#undef PG8_SCHED
}
}

constexpr size_t MiB = 1u << 20;
constexpr size_t WS_CTL = 0, CTL_ZERO_BYTES = 64 * 1024;
constexpr size_t WS_SS = 1 * MiB;
constexpr size_t WS_W = 2 * MiB, W_LAYER = 30 * MiB;
constexpr size_t WO_IN = 0, WO_M = 10 * MiB, WO_OUT = 12 * MiB, WO_FF1 = 14 * MiB, WO_FF2 = 22 * MiB;
constexpr size_t WS_XNY = 62 * MiB;
constexpr size_t WS_QKV = 94 * MiB;
constexpr size_t BREG = 20 * MiB, BREG_GATES = 12 * MiB;
constexpr size_t WS_GATES = 190 * MiB;
constexpr size_t WS_MERGED = WS_QKV;
constexpr size_t WS_H = WS_QKV;
constexpr size_t WS_END = 254 * MiB;
constexpr int CW_BAR = 1024;
constexpr int CW_PANEL = 8192;

constexpr int RING_OFF = 0, RING_BYTES = 131072;
constexpr int ATT_WSF = 131072;
constexpr int ATT_TBL = ATT_WSF + 4096;
constexpr int LDSCTL_OFF = ATT_TBL + 4096, MISC_OFF = LDSCTL_OFF + 320;
constexpr int LDS_BYTES = 147456;
static_assert(MISC_OFF + 128 <= LDS_BYTES, "LDS map");
constexpr int NWAVES = 8;

#define RLX_AGENT __ATOMIC_RELAXED, __HIP_MEMORY_SCOPE_AGENT
#define LDS_WAIT() asm volatile("s_waitcnt lgkmcnt(0)" ::: "memory")
#define VM_WAIT() asm volatile("s_waitcnt vmcnt(0)" ::: "memory")

#define XB_TMO      128
#define XB_XCNT(j)  (256  + 64 * (j))
#define XB_XSUB(j)  (1280 + 64 * (j))
#define XB_XGEN(j)  (2304 + 64 * (j))
#define XB_TOP      3328
#define XB_TOPGEN   3392
#define XCD_BAR_WORDS 3456
#define XB_SPIN_CAP (1u << 18)
__device__ __forceinline__ unsigned xb_ld(unsigned* p)              { return __hip_atomic_load(p, __ATOMIC_RELAXED, __HIP_MEMORY_SCOPE_AGENT); }
__device__ __forceinline__ unsigned xb_add(unsigned* p, unsigned v) { return __hip_atomic_fetch_add(p, v, __ATOMIC_RELAXED, __HIP_MEMORY_SCOPE_AGENT); }
__device__ __forceinline__ unsigned xb_xcc_id() { return (unsigned)__builtin_amdgcn_s_getreg((3 << 11) | 20) & 0xFu; }
#define XB_SPIN(cond, bar) do { unsigned _sp = 0; while (cond) { __builtin_amdgcn_s_sleep(1); \
    if ((++_sp & 255u) == 0u) { if (xb_ld(&(bar)[XB_TMO])) break; if (_sp > XB_SPIN_CAP) { atomicAdd(&(bar)[XB_TMO], 1u); break; } } } } while (0)
struct XcdBarrier { unsigned* bar; unsigned x; volatile LAS unsigned* st; int wave; };
__device__ __forceinline__ bool xb_leader(int wave) { return wave == 0 && lane_id_now() == 0u; }
__device__ __forceinline__ XcdBarrier xcd_barrier_post(unsigned* bar, volatile LAS unsigned* st, int wave) {
    XcdBarrier b; b.bar = bar; b.x = xb_xcc_id(); b.st = st; b.wave = wave;
    if (xb_leader(wave)) st[2] = xb_add(&bar[XB_XCNT(b.x)], 1u);
    return b;
}
__device__ __forceinline__ void xcd_barrier_complete(unsigned* bar, unsigned x, unsigned& nloc, unsigned& nx, unsigned& xi) {
    const unsigned G = gridDim.x * gridDim.y * gridDim.z;
    unsigned sum, cnt, mine, below, sp = 0u;
    for (;;) {
        sum = 0u; cnt = 0u; mine = 0u; below = 0u;
#pragma unroll
        for (unsigned j = 0; j < 16; ++j) { const unsigned c = xb_ld(&bar[XB_XCNT(j)]); sum += c; cnt += (c > 0u) ? 1u : 0u; mine = (j == x) ? c : mine; below += (c > 0u && j < x) ? 1u : 0u; }
        if (sum == G) break;
        __builtin_amdgcn_s_sleep(1);
        if ((++sp & 255u) == 0u) { if (xb_ld(&bar[XB_TMO])) break; if (sp > XB_SPIN_CAP) { atomicAdd(&bar[XB_TMO], 1u); break; } }
    }
    nloc = mine > 0u ? mine : 1u; nx = cnt > 0u ? cnt : 1u; xi = below;
}
__device__ __forceinline__ void xcd_barrier(const XcdBarrier& b) {
    asm volatile("s_waitcnt vmcnt(0)" ::: "memory");
    __syncthreads();
    if (xb_leader(b.wave)) {
        unsigned* bar = b.bar;
        __builtin_amdgcn_s_waitcnt(0);
        unsigned nloc = b.st[0], nx = b.st[1];
        if (nloc == 0u) { unsigned xi; xcd_barrier_complete(bar, b.x, nloc, nx, xi); b.st[0] = nloc; b.st[1] = nx; b.st[3] = xi; }
        const unsigned old = xb_add(&bar[XB_XSUB(b.x)], 1u);
        const unsigned gen = old / nloc;
        if (old + 1u == (gen + 1u) * nloc) {
            __builtin_amdgcn_fence(__ATOMIC_RELEASE, "agent");
            asm volatile("s_waitcnt vmcnt(0)" ::: "memory");
            const unsigned og = xb_add(&bar[XB_TOP], 1u);
            const unsigned tg = og / nx;
            if (og + 1u == (tg + 1u) * nx) xb_add(&bar[XB_TOPGEN], 1u);
            else XB_SPIN(xb_ld(&bar[XB_TOPGEN]) == tg, bar);
            __builtin_amdgcn_fence(__ATOMIC_ACQUIRE, "agent");
            xb_add(&bar[XB_XGEN(b.x)], 1u);
            asm volatile("s_waitcnt vmcnt(0)" ::: "memory");
        } else {
            XB_SPIN(xb_ld(&bar[XB_XGEN(b.x)]) == gen, bar);
            __builtin_amdgcn_fence(__ATOMIC_ACQUIRE, "agent");
            asm volatile("s_waitcnt vmcnt(0)" ::: "memory");
        }
    }
    __syncthreads();
}

#define XL_SUB(j) (3584 + 64 * (j))
#define XL_GEN(j) (4608 + 64 * (j))
__device__ __forceinline__ void xcc_local_barrier(unsigned* bar, unsigned x, unsigned nloc, int wave, unsigned& gen) {
    if (wave == 0) asm volatile("buffer_inv sc1" ::: "memory");
    asm volatile("s_waitcnt vmcnt(0)" ::: "memory");
    __syncthreads();
    if (xb_leader(wave)) {
        __builtin_amdgcn_s_waitcnt(0);
        const unsigned old = xb_add(&bar[XL_SUB(x)], 1u);
        if (old + 1u == (gen + 1u) * nloc) xb_add(&bar[XL_GEN(x)], 1u);
        else XB_SPIN(xb_ld(&bar[XL_GEN(x)]) == gen, bar);
        asm volatile("s_waitcnt vmcnt(0)" ::: "memory");
    }
    ++gen;
    __syncthreads();
}

struct Frame {
    LAS unsigned char* lds;
    int vcu, G, wave;
    float* out; unsigned char* ws;
};
__device__ __forceinline__ int phase_tid(int wave) { return wave * 64 + (int)lane_id_now(); }
#define PHASE_IDS() const int tid_ = phase_tid(F.wave); const int tid = tid_, lane = tid & 63, wave = __builtin_amdgcn_readfirstlane(tid >> 6); (void)tid; (void)lane; (void)wave
__device__ __forceinline__ const float* arg_in(int k) { asm volatile("" : "+s"(k)); return ((const float* const __attribute__((address_space(4)))*)__builtin_amdgcn_kernarg_segment_ptr())[k]; }

__device__ __forceinline__ float wave_sum(float v) { return sum_xor32(sum_half32(v)); }
__device__ __forceinline__ void p0_transpose_item(const float* W, int N, bf16_t* WT, int ldk, int koff, LAS float* scr, int kb, int nb, int lane, const float* gk, bool gate_remap) {
    const int k0 = 64 * kb, n0 = 32 * nb;
    int nd = n0;
    if (gate_remap && n0 >= NQKV) { const int gcol = n0 - NQKV, isd = gcol >= D, c = isd ? gcol - D : gcol; nd = NQKV + (c >> 7) * 256 + isd * 128 + (c & 127); }
    const float* src = W + (size_t)(k0 + (lane >> 3)) * N + n0 + (lane & 7) * 4;
    f32x4 v[8];
#pragma unroll
    for (int i = 0; i < 8; ++i) v[i] = *(const f32x4*)(src + (size_t)(8 * i) * N);
    if (gk) {
#pragma unroll
        for (int i = 0; i < 8; ++i) v[i] = v[i] * gk[k0 + 8 * i + (lane >> 3)]; }
#pragma unroll
    for (int i = 0; i < 8; ++i) { LAS float* d = scr + (8 * i + (lane >> 3)) * 33 + (lane & 7) * 4; d[0] = v[i][0]; d[1] = v[i][1]; d[2] = v[i][2]; d[3] = v[i][3]; }
    LDS_WAIT(); asm volatile("" ::: "memory");
    const int c = lane & 7;
#pragma unroll
    for (int j = 0; j < 4; ++j) { const int n = (lane >> 3) + 8 * j; const LAS float* s = scr + (8 * c) * 33 + n;
        u32x4 o; o.x = cvtpk(s[0 * 33], s[1 * 33]); o.y = cvtpk(s[2 * 33], s[3 * 33]); o.z = cvtpk(s[4 * 33], s[5 * 33]); o.w = cvtpk(s[6 * 33], s[7 * 33]);
        *(u32x4*)(WT + (size_t)(nd + n) * ldk + koff + k0 + 8 * c) = o; }
    LDS_WAIT(); asm volatile("" ::: "memory");
}
constexpr int P0_I_IN = (D / 64) * (NIN / 32), P0_I_B = (512 / 64) * (D / 32), P0_I_O = (D / 64) * (D / 32), P0_I_1 = (D / 64) * (FF / 32), P0_I_2 = (FF / 64) * (D / 32);
constexpr int P0_NL = P0_I_IN + 2 * P0_I_B + P0_I_O + P0_I_1 + P0_I_2, P0_NITEMS = DEPTH * P0_NL;
__device__ __forceinline__ void p0_items(Frame& F, int it0, int it1, int gwx, int NGWx) {
    PHASE_IDS();
    LAS float* scr = (LAS float*)(F.lds + RING_OFF + wave * 16384);
    constexpr int I_IN = P0_I_IN, I_B = P0_I_B, I_O = P0_I_O, I_1 = P0_I_1, NL = P0_NL;
    for (int it = it0 + gwx; it < it1; it += NGWx) {
        const int L = it / NL; int r = it % NL;
        unsigned char* wb = F.ws + WS_W + (size_t)L * W_LAYER;
        const float* W; const float* gk = nullptr; bf16_t* WT; int N, ldk = D, koff = 0, kb, nb; bool remap = false;
        if (r < I_IN) { W = arg_in(4) + (size_t)L * D * NIN; N = NIN; WT = (bf16_t*)(wb + WO_IN); gk = arg_in(3) + L * D; remap = true; kb = r / (NIN / 32); nb = r % (NIN / 32); }
        else if ((r -= I_IN) < I_B) { W = arg_in(8) + (size_t)L * 512 * D; N = D; WT = (bf16_t*)(wb + WO_M); kb = r / (D / 32); nb = r % (D / 32); }
        else if ((r -= I_B) < I_B) { W = arg_in(9) + (size_t)L * 512 * D; N = D; WT = (bf16_t*)(wb + WO_M); koff = 512; kb = r / (D / 32); nb = r % (D / 32); }
        else if ((r -= I_B) < I_O) { W = arg_in(10) + (size_t)L * D * D; N = D; WT = (bf16_t*)(wb + WO_OUT); kb = r / (D / 32); nb = r % (D / 32); }
        else if ((r -= I_O) < I_1) { W = arg_in(12) + (size_t)L * D * FF; N = FF; WT = (bf16_t*)(wb + WO_FF1); gk = arg_in(11) + L * D; kb = r / (FF / 32); nb = r % (FF / 32); }
        else { r -= I_1; W = arg_in(13) + (size_t)L * FF * D; N = D; WT = (bf16_t*)(wb + WO_FF2); ldk = FF; kb = r / (D / 32); nb = r % (D / 32); }
        p0_transpose_item(W, N, WT, ldk, koff, scr, kb, nb, lane, gk, remap);
    }
}
__device__ __forceinline__ void p0_prologue(Frame& F) {
    PHASE_IDS();
    const int gw = F.vcu * NWAVES + wave, NGW = F.G * NWAVES;
    p0_items(F, 0, P0_I_IN, gw, NGW);
    const float* x = arg_in(0); bf16_t* XN = (bf16_t*)(F.ws + WS_XNY); float* SS = (float*)(F.ws + WS_SS);
    for (int m0 = 2 * gw; m0 < M; m0 += 2 * NGW) {
        f32x4 v[2][4];
#pragma unroll
        for (int q = 0; q < 2; ++q)
#pragma unroll
            for (int j = 0; j < 4; ++j) v[q][j] = ((const f32x4*)(x + (size_t)(m0 + q) * D) + lane)[64 * j];
#pragma unroll
        for (int q = 0; q < 2; ++q) { const int m = m0 + q; u32x2* o8 = (u32x2*)(XN + (size_t)m * D) + lane; float s = 0.f;
#pragma unroll
            for (int j = 0; j < 4; ++j) { const f32x4 vv = v[q][j]; s += (vv[0] * vv[0] + vv[1] * vv[1]) + (vv[2] * vv[2] + vv[3] * vv[3]);
                u32x2 w; w.x = cvtpk(vv[0], vv[1]); w.y = cvtpk(vv[2], vv[3]); o8[64 * j] = w; }
            s = wave_sum(s);
            if (lane < 4) SS[(size_t)m * 4 + lane] = (lane == 0) ? s : 0.f; }
    }
}
namespace att {
typedef LAS const char* lcp;
__device__ __forceinline__ int crow(int r, int hi) { return (r & 3) + 8 * (r >> 2) + 4 * hi; }
typedef short v4i16_t __attribute__((ext_vector_type(4)));
__device__ __forceinline__ s16x4 vtr(lcp p) { return __builtin_bit_cast(s16x4, __builtin_amdgcn_ds_read_tr16_b64_v4i16((LAS v4i16_t*)p)); }
#define MFMA32(a, b, c) __builtin_amdgcn_mfma_f32_32x32x16_bf16(a, b, c, 0, 0, 0)
#define ATT_WAIT_BAR(N) asm volatile("s_waitcnt vmcnt(" #N ") lgkmcnt(0)\n\ts_barrier" ::: "memory")
#define ATT_LDS_BAR() asm volatile("s_waitcnt lgkmcnt(0)\n\ts_barrier" ::: "memory")
__device__ __forceinline__ void glds16(const void* gsrc, unsigned lds_dst) { unsigned keep;
    asm volatile("s_mov_b32 %0, m0\n\ts_mov_b32 m0, %2\n\ts_nop 0\n\tglobal_load_lds_dwordx4 %1, off\n\ts_mov_b32 m0, %0" : "=&s"(keep) : "v"(gsrc), "s"(lds_dst) : "memory"); }
#define GLDS16(gsrc, ldsdst) glds16((const void*)(gsrc), (unsigned)__builtin_amdgcn_readfirstlane((int)(unsigned)(uintptr_t)(ldsdst)))
__device__ __forceinline__ void glds16s(unsigned voff, const void* sbase, unsigned lds_dst) { unsigned keep;
    asm volatile("s_mov_b32 %0, m0\n\ts_mov_b32 m0, %2\n\ts_nop 2\n\tglobal_load_lds_dwordx4 %1, %3\n\ts_mov_b32 m0, %0" : "=&s"(keep) : "v"(voff), "s"(lds_dst), "s"(sbase) : "memory"); }
#define GLDS16S(voff, sbase, ldsdst) glds16s((voff), (const void*)(sbase), (unsigned)__builtin_amdgcn_readfirstlane((int)(unsigned)(uintptr_t)(ldsdst)))
#define ATT_BAR_IF(cond, N) do { if (cond) ATT_WAIT_BAR(N); } while (0)
#define MX3(a, b, c) __builtin_fmaxf(__builtin_fmaxf((a), (b)), (c))

__device__ __forceinline__ void kload(bf16x8 (&kf)[8], lcp kslot, const int (&koff)[4]) {
#pragma unroll
    for (int d0 = 0; d0 < 4; ++d0) { kf[2 * d0] = *(const LAS bf16x8*)(kslot + koff[d0]); kf[2 * d0 + 1] = *(const LAS bf16x8*)(kslot + koff[d0] + 4096); }
}
__device__ __forceinline__ void qk_mfma(f32x16& p0, f32x16& p1, const bf16x8 (&kf)[8], const bf16x8* qr, const f32x16& cinit) {
    p0 = MFMA32(kf[0], qr[0], cinit); p1 = MFMA32(kf[1], qr[0], cinit);
#pragma unroll
    for (int d0 = 1; d0 < 4; ++d0) { p0 = MFMA32(kf[2 * d0], qr[d0], p0); p1 = MFMA32(kf[2 * d0 + 1], qr[d0], p1); }
}
__device__ __forceinline__ float rowmax32(const f32x16& p0, const f32x16& p1) {
    float a = MX3(p0[0], p0[1], p1[0]), b = MX3(p0[2], p0[3], p1[1]); a = MX3(a, p1[2], p1[3]);
#pragma unroll
    for (int r = 4; r < 16; r += 4) { a = MX3(a, p0[r], p0[r + 1]); b = MX3(b, p0[r + 2], p0[r + 3]); a = MX3(a, p1[r], p1[r + 1]); b = MX3(b, p1[r + 2], p1[r + 3]); }
    a = __builtin_fmaxf(a, b);
    auto rr = __builtin_amdgcn_permlane32_swap(__float_as_uint(a), __float_as_uint(a), false, false);
    return __builtin_fmaxf(__uint_as_float(rr[0]), __uint_as_float(rr[1]));
}
template <int NB, int THR>
__device__ __forceinline__ bool softmax_part(f32x16& p0, f32x16& p1, f32x16 (&o)[NB], float& mhat, float& l, bool first, LAS float* wsf, int r32, int hi, u32x4 (&pw)[4]) {
    const float rm = rowmax32(p0, p1);
    bool resc = false, moved = false;
    if (first) {
        mhat += rm; moved = true;
#pragma unroll
        for (int r = 0; r < 16; ++r) { p0[r] -= rm; p1[r] -= rm; }
    } else if (__any(rm > (float)THR)) {
        const float dl = fmaxf(rm, 0.f); mhat += dl; moved = true; resc = true;
#pragma unroll
        for (int r = 0; r < 16; ++r) { p0[r] -= dl; p1[r] -= dl; }
        const float f = __builtin_amdgcn_exp2f(-dl); l *= f; if (hi == 0) wsf[r32] = f;
    }
    float s = 0.f;
#pragma unroll
    for (int r = 0; r < 16; ++r) { p0[r] = __builtin_amdgcn_exp2f(p0[r]); p1[r] = __builtin_amdgcn_exp2f(p1[r]); s += p0[r] + p1[r]; }
    l += s;
    pw[0] = (u32x4){cvtpk(p0[0], p0[1]), cvtpk(p0[2], p0[3]), cvtpk(p0[4], p0[5]), cvtpk(p0[6], p0[7])};
    pw[1] = (u32x4){cvtpk(p0[8], p0[9]), cvtpk(p0[10], p0[11]), cvtpk(p0[12], p0[13]), cvtpk(p0[14], p0[15])};
    pw[2] = (u32x4){cvtpk(p1[0], p1[1]), cvtpk(p1[2], p1[3]), cvtpk(p1[4], p1[5]), cvtpk(p1[6], p1[7])};
    pw[3] = (u32x4){cvtpk(p1[8], p1[9]), cvtpk(p1[10], p1[11]), cvtpk(p1[12], p1[13]), cvtpk(p1[14], p1[15])};
    if (resc) {
        float fr[16];
#pragma unroll
        for (int r = 0; r < 16; ++r) fr[r] = wsf[crow(r, hi)];
#pragma unroll
        for (int d = 0; d < NB; ++d)
#pragma unroll
            for (int r = 0; r < 16; ++r) o[d][r] *= fr[r];
    }
    return moved;
}
__device__ __forceinline__ void vload0(s16x4 (&lo)[4], s16x4 (&hh)[4], lcp vb) {
#pragma unroll
    for (int ks = 0; ks < 4; ++ks) { lo[ks] = vtr(vb + ks * 1024); hh[ks] = vtr(vb + ks * 1024 + 512); }
}
template <int NB>
__device__ __forceinline__ void pv_part(f32x16 (&o)[NB], lcp vb, const u32x4 (&pw)[4], const s16x4 (&lo0)[4], const s16x4 (&hh0)[4]) {
    s16x4 lo[2][4], hh[2][4];
#pragma unroll
    for (int ks = 0; ks < 4; ++ks) { lo[0][ks] = lo0[ks]; hh[0][ks] = hh0[ks]; }
#pragma unroll
    for (int d0 = 0; d0 < NB; ++d0) {
        if (d0 + 1 < NB) {
#pragma unroll
            for (int ks = 0; ks < 4; ++ks) { lo[(d0 + 1) & 1][ks] = vtr(vb + (d0 + 1) * 4096 + ks * 1024); hh[(d0 + 1) & 1][ks] = vtr(vb + (d0 + 1) * 4096 + ks * 1024 + 512); }
        }
        __builtin_amdgcn_sched_barrier(0);
#define ATT_PK(k) (bf16x8){lo[d0 & 1][k][0], lo[d0 & 1][k][1], lo[d0 & 1][k][2], lo[d0 & 1][k][3], hh[d0 & 1][k][0], hh[d0 & 1][k][1], hh[d0 & 1][k][2], hh[d0 & 1][k][3]}
        o[d0] = MFMA32(__builtin_bit_cast(bf16x8, pw[0]), ATT_PK(0), o[d0]);
        o[d0] = MFMA32(__builtin_bit_cast(bf16x8, pw[1]), ATT_PK(1), o[d0]);
        o[d0] = MFMA32(__builtin_bit_cast(bf16x8, pw[2]), ATT_PK(2), o[d0]);
        o[d0] = MFMA32(__builtin_bit_cast(bf16x8, pw[3]), ATT_PK(3), o[d0]);
#undef ATT_PK
        __builtin_amdgcn_sched_barrier(0);
    }
}
__device__ __forceinline__ void row_inv_l(float l, float (&rli)[16], LAS float* wsf, int r32, int hi) {
    auto rr = __builtin_amdgcn_permlane32_swap(__float_as_uint(l), __float_as_uint(l), false, false);
    const float lt = __uint_as_float(rr[0]) + __uint_as_float(rr[1]);
    if (hi == 0) wsf[32 + r32] = lt;
#pragma unroll
    for (int r = 0; r < 16; ++r) rli[r] = __builtin_amdgcn_rcpf(wsf[32 + crow(r, hi)]);
}
__device__ __forceinline__ int t5_bucket(int rel) {
    const int n = rel < 0 ? -rel : rel;
    const int large = 8 + (n >= 12) + (n >= 16) + (n >= 23) + (n >= 32) + (n >= 46) + (n >= 64) + (n >= 91);
    return (rel > 0 ? 16 : 0) + (n < 8 ? n : large);
}


template <int THR>
__device__ __forceinline__ void diff_unit(Frame& F, int layer, const bf16_t* qkv, bf16_t* Y, int h, int qb) {
    const int tid = phase_tid(F.wave), wid = F.wave;
    const int mp = wid >> 2, wq = wid & 3;
    const size_t tokb = 0;
    LAS unsigned char* lds = F.lds;
    LAS float* wsf = (LAS float*)(lds + ATT_WSF) + wid * 128;
    LAS float* TBL = (LAS float*)(lds + ATT_TBL);
    constexpr int NT = SEQ / 64;
    f32x16 o[4]; float l = 0.f;
    float lpv[4], sgv[4];
    {
    const int lane = tid & 63, r32 = lane & 31, hi = lane >> 5;
    const bf16_t* kbase = qkv + tokb * NQKV + COL_KD + h * 128; const bf16_t* vbase_g = qkv + tokb * NQKV + COL_VD + h * 128;
#define DIFF_KVO(L_) ((unsigned)((8 * wid + ((L_) >> 3)) * NQKV + (((L_) & 7) ^ ((L_) >> 3)) * 8) * 2u)
#define DIFF_VVO(L_) ((unsigned)((16 * (wid & 3) + ((L_) >> 2)) * NQKV + (wid >> 2) * 32 + ((L_) & 3) * 8) * 2u)
#define DIFF_DMA_K(t) do { if ((t) < NT) { const size_t go_ = (size_t)(t) * 64 * NQKV; LAS unsigned char* rb_ = lds + ((t) & 3) * 16384 + wid * 1024; \
        int ld_ = lane; asm volatile("" : "+v"(ld_)); const unsigned kvo_ = DIFF_KVO(ld_); GLDS16S(kvo_, kbase + go_, rb_); GLDS16S(kvo_, kbase + go_ + 64, rb_ + 8192); } } while (0)
#define DIFF_DMA_V(t) do { if ((t) < NT) { const size_t go_ = (size_t)(t) * 64 * NQKV; LAS unsigned char* rb_ = lds + 65536 + ((t) & 3) * 16384 + wid * 1024; \
        int ld_ = lane; asm volatile("" : "+v"(ld_)); const unsigned vvo_ = DIFF_VVO(ld_); GLDS16S(vvo_, vbase_g + go_, rb_); GLDS16S(vvo_, vbase_g + go_ + 64, rb_ + 8192); } } while (0)
#define DIFF_WAIT_BAR(t) asm volatile("s_waitcnt vmcnt(8)\n\ts_cmp_lt_i32 %0, %1\n\ts_cbranch_scc1 .Ldw%=\n\ts_waitcnt vmcnt(6)\n\ts_cmp_lt_i32 %0, %2\n\ts_cbranch_scc1 .Ldw%=\n\ts_waitcnt vmcnt(2)\n\ts_cmp_lt_i32 %0, %3\n\ts_cbranch_scc1 .Ldw%=\n\ts_waitcnt vmcnt(0)\n.Ldw%=:\n\ts_waitcnt lgkmcnt(0)\n\ts_barrier" \
        :: "s"((int)(t)), "n"(NT - 3), "n"(NT - 2), "n"(NT - 1) : "scc", "memory")
    DIFF_DMA_K(0); DIFF_DMA_K(1); DIFF_DMA_V(0); DIFF_DMA_K(2); DIFF_DMA_V(1);
    float tv = arg_in(1)[t5_bucket((tid < 257 ? tid : 256) - 128) * 4 + h];
    bf16x8 qr[4];
    { const bf16_t* Qw = qkv + (tokb + qb * 128 + wq * 32 + r32) * NQKV + COL_QD + h * 128 + mp * 64 + hi * 8;
#pragma unroll
      for (int d0 = 0; d0 < 4; ++d0) qr[d0] = *(const bf16x8*)(Qw + d0 * 16); }
    asm volatile("" : "+v"(tv), "+v"(qr[0]), "+v"(qr[1]), "+v"(qr[2]), "+v"(qr[3]));
    if (tid < 257) TBL[tid] = tv * LOG2E;
    const int voff = ((lane >> 4) & 1) * 32 + (lane & 3) * 8 + (4 * hi + ((lane & 15) >> 2)) * 64;
    o[0] = f32x16{}; o[1] = f32x16{}; o[2] = f32x16{}; o[3] = f32x16{};
    float mhat = 0.f;
    const int qw0 = qb * 128 + wq * 32;
    ATT_WAIT_BAR(8);
    const float tL = __uint_as_float((unsigned)__builtin_amdgcn_readfirstlane((int)__float_as_uint(TBL[0]))), tR = __uint_as_float((unsigned)__builtin_amdgcn_readfirstlane((int)__float_as_uint(TBL[256])));
    bf16x8 kf[8]; f32x16 p0, p1, cinit; u32x4 pwA[4], pwB[4]; s16x4 vlo[2][4], vhh[2][4]; bool moved = false; int zc_id;
    { const int dk0 = 0 - qw0; zc_id = (dk0 >= 122) ? 1 : 2; const float c0 = (zc_id == 1 ? tR : tL);
#pragma unroll
      for (int r = 0; r < 16; ++r) cinit[r] = c0; }
#define SBAR() __builtin_amdgcn_sched_barrier(0)
#define PIN(x) asm volatile("" : "+v"(x))
#define DIFF_SCORES(t, FIRST) do { \
        { int rk_ = r32; asm volatile("" : "+v"(rk_)); int koff[4];                       \
          _Pragma("unroll") for (int d0 = 0; d0 < 4; ++d0) koff[d0] = rk_ * 128 + (((2 * d0 + hi) ^ (rk_ & 7)) << 4); \
          kload(kf, (lcp)(lds + ((t) & 3) * 16384 + mp * 8192), koff); } \
        SBAR();                                                                     \
        qk_mfma(p0, p1, kf, qr, cinit); \
        SBAR(); \
        DIFF_DMA_K((t) + 3); DIFF_DMA_V((t) + 2); \
        const int dk_ = (t) * 64 - qw0; const int zone_ = (dk_ >= 122) ? 1 : ((dk_ <= -154) ? 2 : 0); \
        if (zone_ == 0) { int rq_ = r32; asm volatile("" : "+v"(rq_)); const int base_ = dk_ - rq_ + 128; const float zc_ = (zc_id == 1) ? tR : tL; \
            _Pragma("unroll") for (int r = 0; r < 16; ++r) { int i0 = base_ + crow(r, hi), i1 = i0 + 32; \
                i0 = i0 < 0 ? 0 : (i0 > 256 ? 256 : i0); i1 = i1 < 0 ? 0 : (i1 > 256 ? 256 : i1); \
                p0[r] += TBL[i0] - zc_; p1[r] += TBL[i1] - zc_; if ((r & 3) == 3) SBAR(); } } \
        const float rm_ = rowmax32(p0, p1); \
        bool shift_ = FIRST; float dl_ = rm_; moved = false; \
        if (!(FIRST)) { moved = __any(rm_ > (float)THR); shift_ = moved; dl_ = fmaxf(rm_, 0.f); } \
        if (shift_) { mhat += dl_; \
            _Pragma("unroll") for (int r = 0; r < 16; ++r) { float a_ = p0[r], b_ = p1[r]; asm volatile("v_sub_f32_e32 %0, %0, %2\n\tv_sub_f32_e32 %1, %1, %2" : "+v"(a_), "+v"(b_) : "v"(dl_)); p0[r] = a_; p1[r] = b_; } \
            if (!(FIRST)) { const float f_ = __builtin_amdgcn_exp2f(-dl_); l *= f_; if (hi == 0) wsf[r32] = f_; } } \
        { const int dn_ = dk_ + 64; const int zn_ = (dn_ >= 122) ? 1 : ((dn_ <= -154) ? 2 : 0); \
          if (shift_ || (zn_ != 0 && zn_ != zc_id)) { if (zn_ != 0) zc_id = zn_; const float cb_ = ((zc_id == 1) ? tR : tL) - mhat; \
              _Pragma("unroll") for (int r = 0; r < 16; ++r) cinit[r] = cb_; } } \
        SBAR(); } while (0)
#define DIFF_EXP2(g, PWN, SACC) do { \
        float x0_ = ((g) < 8 ? p0[2 * ((g) & 7)] : p1[2 * ((g) & 7)]), x1_ = ((g) < 8 ? p0[2 * ((g) & 7) + 1] : p1[2 * ((g) & 7) + 1]); \
        x0_ = __builtin_amdgcn_exp2f(x0_); x1_ = __builtin_amdgcn_exp2f(x1_); SACC += x0_; SACC += x1_; PWN[(g) >> 2][(g) & 3] = cvtpk(x0_, x1_); } while (0)
#define VFRAG(B, i) (bf16x8){vlo[B][i][0], vlo[B][i][1], vlo[B][i][2], vlo[B][i][3], vhh[B][i][0], vhh[B][i][1], vhh[B][i][2], vhh[B][i][3]}
#define DIFF_GAP(g, PWC, PWN, VB) do { \
        o[(g) >> 2] = MFMA32(__builtin_bit_cast(bf16x8, PWC[(g) & 3]), VFRAG(((g) >> 2) & 1, (g) & 3), o[(g) >> 2]); \
        if ((g) < 12) { vlo[(((g) >> 2) + 1) & 1][(g) & 3] = vtr(VB + (((g) >> 2) + 1) * 4096 + ((g) & 3) * 1024); vhh[(((g) >> 2) + 1) & 1][(g) & 3] = vtr(VB + (((g) >> 2) + 1) * 4096 + ((g) & 3) * 1024 + 512); } \
        DIFF_EXP2(g, PWN, sacc_); PIN(sacc_); PIN(PWN[(g) >> 2]); SBAR(); } while (0)
#define DIFF_STEP(t, PWC, PWN) do { \
        lcp vb_ = (lcp)(lds + 65536 + (((t) - 1) & 3) * 16384 + voff); \
        _Pragma("unroll") for (int i = 0; i < 4; ++i) { vlo[0][i] = vtr(vb_ + i * 1024); vhh[0][i] = vtr(vb_ + i * 1024 + 512); } \
        DIFF_SCORES(t, false); \
        float sacc_ = 0.f; \
        DIFF_GAP(0, PWC, PWN, vb_); DIFF_GAP(1, PWC, PWN, vb_); DIFF_GAP(2, PWC, PWN, vb_); DIFF_GAP(3, PWC, PWN, vb_); \
        DIFF_GAP(4, PWC, PWN, vb_); DIFF_GAP(5, PWC, PWN, vb_); DIFF_GAP(6, PWC, PWN, vb_); DIFF_GAP(7, PWC, PWN, vb_); \
        DIFF_GAP(8, PWC, PWN, vb_); DIFF_GAP(9, PWC, PWN, vb_); DIFF_GAP(10, PWC, PWN, vb_); DIFF_GAP(11, PWC, PWN, vb_); \
        DIFF_GAP(12, PWC, PWN, vb_); DIFF_GAP(13, PWC, PWN, vb_); DIFF_GAP(14, PWC, PWN, vb_); DIFF_GAP(15, PWC, PWN, vb_); \
        l += sacc_; \
        DIFF_WAIT_BAR(t); \
        if (moved) { float fr_[16]; \
            _Pragma("unroll") for (int r = 0; r < 16; ++r) fr_[r] = wsf[crow(r, hi)]; \
            _Pragma("unroll") for (int d = 0; d < 4; ++d) _Pragma("unroll") for (int r = 0; r < 16; ++r) o[d][r] *= fr_[r]; \
} \
    } while (0)
    if (wid >= 4) __builtin_amdgcn_s_setprio(1);
    DIFF_SCORES(0, true);
    { float sacc_ = 0.f;
#pragma unroll
      for (int g = 0; g < 16; ++g) DIFF_EXP2(g, pwA, sacc_);
      l += sacc_; }
    ATT_WAIT_BAR(8);
#pragma unroll 1
    for (int t = 1; t + 1 < NT; t += 2) { DIFF_STEP(t, pwA, pwB); DIFF_STEP(t + 1, pwB, pwA); }
    DIFF_STEP(NT - 1, pwA, pwB);
    { const float* lp = arg_in(6) + layer * 256; const float* sg = arg_in(7) + layer * 128;
#pragma unroll
      for (int j = 0; j < 4; ++j) { lpv[j] = lp[64 * j + lane]; sgv[j] = sg[j * 32 + r32]; } }
    { lcp vb_ = (lcp)(lds + 65536 + ((NT - 1) & 3) * 16384 + voff); s16x4 l0[4], h0[4]; vload0(l0, h0, vb_); pv_part<4>(o, vb_, pwB, l0, h0); }
    __builtin_amdgcn_s_setprio(0);
    ATT_LDS_BAR();
#undef DIFF_WAIT_BAR
#undef DIFF_DMA_K
#undef DIFF_DMA_V
#undef DIFF_KVO
#undef DIFF_VVO
#undef DIFF_SCORES
#undef DIFF_EXP2
#undef DIFF_GAP
#undef DIFF_STEP
#undef VFRAG
#undef SBAR
#undef PIN
    }
    const int tid2_ = phase_tid(F.wave);
    const int lane = tid2_ & 63, r32 = lane & 31, hi = lane >> 5;
    float rli[16]; row_inv_l(l, rli, wsf, r32, hi);
#pragma unroll
    for (int d = 0; d < 4; ++d)
#pragma unroll
        for (int r = 0; r < 16; ++r) o[d][r] *= rli[r];
    LAS float* xch = (LAS float*)(lds) + wq * 4096;
    if (mp == 1) {
#pragma unroll
        for (int d = 0; d < 4; ++d)
#pragma unroll
            for (int r4 = 0; r4 < 4; ++r4) *(LAS f32x4*)(xch + ((d * 4 + r4) * 64 + lane) * 4) = (f32x4){o[d][4 * r4], o[d][4 * r4 + 1], o[d][4 * r4 + 2], o[d][4 * r4 + 3]};
    }
    ATT_LDS_BAR();
    if (mp == 0) {
        const float lpa = lpv[0] * lpv[1], lpb = lpv[2] * lpv[3];
        const float s1 = wave_sum(lpa), s2 = wave_sum(lpb);
        unsigned lbits_ = (layer == 0) ? 0x3E4CCCCDu : 0x3EB60549u; asm volatile("" : "+s"(lbits_));
        const float lam_init = __uint_as_float(lbits_);
        const float lam = expf(s1) - expf(s2) + lam_init;
        float ssq[16];
#pragma unroll
        for (int r = 0; r < 16; ++r) ssq[r] = 0.f;
#pragma unroll
        for (int d = 0; d < 4; ++d) { f32x4 x2[4];
#pragma unroll
            for (int r4 = 0; r4 < 4; ++r4) x2[r4] = *(const LAS f32x4*)(xch + ((d * 4 + r4) * 64 + lane) * 4);
            __builtin_amdgcn_sched_barrier(0);
#pragma unroll
            for (int r4 = 0; r4 < 4; ++r4)
#pragma unroll
                for (int e = 0; e < 4; ++e) { const int r = 4 * r4 + e; const float v = o[d][r] - lam * x2[r4][e]; o[d][r] = v; ssq[r] += v * v; } }
#pragma unroll
        for (int r = 0; r < 16; ++r) {
            float v = ssq[r];
            v = sum_half32(v);
            ssq[r] = (1.0f - lam_init) * __builtin_amdgcn_rsqf(v * (1.0f / 128.0f) + RMS_EPS);
        }
        LAS bf16_t* stg = (LAS bf16_t*)(lds + 65536) + wq * 4096;
#pragma unroll
        for (int d = 0; d < 4; ++d) { const float gg = sgv[d];
#pragma unroll
            for (int r = 0; r < 16; ++r) { const float v = o[d][r] * ssq[r] * gg; stg[crow(r, hi) * 128 + d * 32 + r32] = (bf16_t)(cvtpk(v, v) & 0xffffu); } }
        bf16_t* yb = Y + (tokb + qb * 128 + wq * 32 + (lane >> 4)) * D + 512 + h * 128 + (lane & 15) * 8;
        u32x4 sv[8];
#pragma unroll
        for (int i = 0; i < 8; ++i) sv[i] = *(const LAS u32x4*)(stg + (i * 4 + (lane >> 4)) * 128 + (lane & 15) * 8);
#pragma unroll
        for (int i = 0; i < 8; ++i) store16_wt(yb + (size_t)i * 4 * D, sv[i]);
    }
    ATT_WAIT_BAR(0);
}

__device__ __forceinline__ void naq_mfma(f32x16& p0, f32x16& p1, const bf16x8 (&kf)[8], const bf16x8* qr, int vbase, int fo, float mhat) {
    { int vb_ = vbase; asm volatile("" : "+v"(vb_));
#pragma unroll
      for (int r = 0; r < 16; ++r) p0[r] = ((unsigned)(vb_ + (r & 3) + 8 * (r >> 2) + fo) < 16u) ? 0.f : -INFINITY; }
    { const f32x16 z = f32x16{}; p0 = MFMA32(kf[0], qr[0], p0); p1 = MFMA32(kf[1], qr[0], z); }
#pragma unroll
    for (int d0 = 1; d0 < 4; ++d0) { p0 = MFMA32(kf[2 * d0], qr[d0], p0); p1 = MFMA32(kf[2 * d0 + 1], qr[d0], p1); }
}
__device__ __forceinline__ void naq_vload(s16x4 (&lo)[2][3], s16x4 (&hh)[2][3], lcp vbF, lcp vbP) {
#pragma unroll
    for (int d0 = 0; d0 < 2; ++d0) {
#pragma unroll
        for (int k = 0; k < 2; ++k) { lo[d0][k] = vtr(vbF + d0 * 4096 + k * 1024); hh[d0][k] = vtr(vbF + d0 * 4096 + k * 1024 + 512); }
        lo[d0][2] = vtr(vbP + d0 * 4096); hh[d0][2] = vtr(vbP + d0 * 4096 + 512); }
}
template <int THR>
__device__ __forceinline__ void naq_softmax(f32x16& p0, f32x16& p1, f32x16 (&o)[2], float& mhat, float& l, bool first, float mh, const LAS float* rp, int vbase, int fo, int pk0,
                                            LAS float* wsf, int r32, int hi, u32x4 (&pw)[3]) {
    const LAS float* rpF = rp + fo; const LAS float* rpP = rp + pk0;
    float pbv[4];
#pragma unroll
    for (int r = 0; r < 4; ++r) pbv[r] = rpP[r];
#pragma unroll
    for (int r = 0; r < 16; ++r) { const int e = (r & 3) + 8 * (r >> 2); p0[r] += rpF[e] - mh; }
#pragma unroll
    for (int r = 0; r < 4; ++r) p1[r] = ((unsigned)(vbase + pk0 + r) < 16u) ? p1[r] + (pbv[r] - mh) : -INFINITY;
    float a = MX3(p0[0], p0[1], p0[2]), c = MX3(p0[3], p0[4], p0[5]);
    a = MX3(a, p0[6], p0[7]); c = MX3(c, p0[8], p0[9]); a = MX3(a, p0[10], p0[11]); c = MX3(c, p0[12], p0[13]); a = MX3(a, p0[14], p0[15]); c = MX3(c, p1[0], p1[1]); a = MX3(a, p1[2], p1[3]);
    a = __builtin_fmaxf(a, c);
    { auto rr = __builtin_amdgcn_permlane32_swap(__float_as_uint(a), __float_as_uint(a), false, false); a = __builtin_fmaxf(__uint_as_float(rr[0]), __uint_as_float(rr[1])); }
    const float rm = a; bool resc = false, shift = first; float dl = rm;
    if (!first) { shift = __any(rm > (float)THR); resc = shift; dl = fmaxf(rm, 0.f); }
    if (shift) { mhat += dl;
#pragma unroll
        for (int r = 0; r < 16; ++r) p0[r] -= dl;
#pragma unroll
        for (int r = 0; r < 4; ++r) p1[r] -= dl;
        if (resc) { const float f = __builtin_amdgcn_exp2f(-dl); l *= f; if (hi == 0) wsf[r32] = f; } }
    float sa = 0.f;
#pragma unroll
    for (int r = 0; r < 16; ++r) { p0[r] = __builtin_amdgcn_exp2f(p0[r]); sa += p0[r]; }
#pragma unroll
    for (int r = 0; r < 4; ++r) { p1[r] = __builtin_amdgcn_exp2f(p1[r]); sa += p1[r]; }
    l += sa;
    pw[0] = (u32x4){cvtpk(p0[0], p0[1]), cvtpk(p0[2], p0[3]), cvtpk(p0[4], p0[5]), cvtpk(p0[6], p0[7])};
    pw[1] = (u32x4){cvtpk(p0[8], p0[9]), cvtpk(p0[10], p0[11]), cvtpk(p0[12], p0[13]), cvtpk(p0[14], p0[15])};
    pw[2] = (u32x4){cvtpk(p1[0], p1[1]), cvtpk(p1[2], p1[3]), 0u, 0u};
    if (resc) {
        float fr[16];
#pragma unroll
        for (int r = 0; r < 16; ++r) fr[r] = wsf[crow(r, hi)];
#pragma unroll
        for (int d = 0; d < 2; ++d)
#pragma unroll
            for (int r = 0; r < 16; ++r) o[d][r] *= fr[r];
    }
}
__device__ __forceinline__ void naq_pv(f32x16 (&o)[2], const u32x4 (&pw)[3], const s16x4 (&lo)[2][3], const s16x4 (&hh)[2][3]) {
#pragma unroll
    for (int d0 = 0; d0 < 2; ++d0)
#pragma unroll
        for (int k = 0; k < 3; ++k)
            o[d0] = MFMA32(__builtin_bit_cast(bf16x8, pw[k]), ((bf16x8){lo[d0][k][0], lo[d0][k][1], lo[d0][k][2], lo[d0][k][3], hh[d0][k][0], hh[d0][k][1], hh[d0][k][2], hh[d0][k][3]}), o[d0]);
}
template <int THR>
__device__ __forceinline__ void na_quad_unit(Frame& F, int layer, const bf16_t* qkv, bf16_t* Y, int idx) {
    const int tid = phase_tid(F.wave), lane = tid & 63, wid = F.wave, r32 = lane & 31, hi = lane >> 5;
    const int hp = (idx >> 3) & 3, rq = idx & 7, grp = wid >> 2;
    const int h = 2 * hp + (wid >> 2), half = wid & 1, c = 32 * half + r32;
    const int rowA = 4 * rq + ((wid >> 1) & 1), rowB = rowA + 2;
    LAS unsigned char* lds = F.lds;
    LAS float* wsf = (LAS float*)(lds + ATT_WSF) + wid * 128;
    LAS float* RPB = (LAS float*)(lds + ATT_TBL);
    const int rF = 4 * rq, rL = 4 * rq + 3;
    const int lo = (rF - 4) < 0 ? 0 : ((rF - 4) > 24 ? 24 : (rF - 4));
    const int hr = ((rL - 4) < 0 ? 0 : ((rL - 4) > 24 ? 24 : (rL - 4))) + 7;
    const int ntile = hr - lo + 1;
    const int r0A = (rowA - 4) < 0 ? 0 : ((rowA - 4) > 24 ? 24 : (rowA - 4)), r0B = (rowB - 4) < 0 ? 0 : ((rowB - 4) > 24 ? 24 : (rowB - 4));
    const bf16_t* kbase = qkv + COL_KA + (2 * hp) * 64; const bf16_t* vbase_g = qkv + COL_VA + (2 * hp) * 64;
    const unsigned kvo = (unsigned)((8 * wid + (lane >> 3)) * NQKV + ((lane & 7) ^ (lane >> 3)) * 8) * 2u;
    const unsigned vvo = (unsigned)((16 * (wid & 3) + (lane >> 2)) * NQKV + (wid >> 2) * 32 + (lane & 3) * 8) * 2u;
#define NA_DMA(tt) do { if ((tt) < ntile) { const size_t go_ = (size_t)(lo + (tt)) * 64 * NQKV; LAS unsigned char* rb_ = lds + ((tt) & 3) * 32768 + wid * 1024; \
        GLDS16S(kvo, kbase + go_, rb_); GLDS16S(kvo, kbase + go_ + 64, rb_ + 8192); GLDS16S(vvo, vbase_g + go_, rb_ + 16384); GLDS16S(vvo, vbase_g + go_ + 64, rb_ + 24576); } } while (0)
#define NA_WAIT_BAR(t) asm volatile("s_waitcnt vmcnt(4)\n\ts_cmp_lt_i32 %0, %1\n\ts_cbranch_scc1 .Lnq%=\n\ts_waitcnt vmcnt(0)\n.Lnq%=:\n\ts_waitcnt lgkmcnt(0)\n\ts_barrier" :: "s"((t) + 2), "s"(ntile) : "scc", "memory")
    NA_DMA(0); NA_DMA(1); NA_DMA(2);
    const int tdr = (tid >> 5) < 15 ? (tid >> 5) : 14, ti = (tid & 31) < 31 ? (tid & 31) : 30;
    const float* rpbg = arg_in(5) + ((size_t)(layer * 8 + 2 * hp) * 15 + tdr) * 31 + ti;
    float tv0 = rpbg[0], tv1 = rpbg[15 * 31];
    bf16x8 qA[4], qB[4];
    { const bf16_t* Qw = qkv + (size_t)(rowA * 64 + c) * NQKV + COL_QA + h * 64 + hi * 8;
#pragma unroll
      for (int d0 = 0; d0 < 4; ++d0) { qA[d0] = *(const bf16x8*)(Qw + d0 * 16); qB[d0] = *(const bf16x8*)(Qw + (size_t)128 * NQKV + d0 * 16); } }
    asm volatile("" : "+v"(tv0), "+v"(tv1), "+v"(qA[0]), "+v"(qA[1]), "+v"(qA[2]), "+v"(qA[3]), "+v"(qB[0]), "+v"(qB[1]), "+v"(qB[2]), "+v"(qB[3]));
    if (tid < 480) { const bool in = (tid & 31) < 31; RPB[tid] = in ? tv0 * LOG2E : 0.f; RPB[480 + tid] = in ? tv1 * LOG2E : 0.f; }
    const int voff = ((lane >> 4) & 1) * 32 + (lane & 3) * 8 + (4 * hi + ((lane & 15) >> 2)) * 64 + grp * 8192;
    int koff[4];
#pragma unroll
    for (int d0 = 0; d0 < 4; ++d0) koff[d0] = r32 * 128 + (((2 * d0 + hi) ^ (r32 & 7)) << 4) + grp * 8192;
    const int dF = half * 4096, dP = half ? ((((r32 + 24) & 31) - r32) * 128) : 4096;
    const int fo = 32 * half, pk0 = half ? 24 : 32;
#define NA_KLOAD(slot_) do { lcp ks_ = (lcp)(lds + (slot_) * 32768); \
        _Pragma("unroll") for (int d0 = 0; d0 < 4; ++d0) { kf[2 * d0] = *(const LAS bf16x8*)(ks_ + koff[d0] + dF); kf[2 * d0 + 1] = *(const LAS bf16x8*)(ks_ + koff[d0] + dP); } } while (0)
    f32x16 oA[2], oB[2]; oA[0] = f32x16{}; oA[1] = f32x16{}; oB[0] = f32x16{}; oB[1] = f32x16{};
    float mhatA = 0.f, lA = 0.f, mhatB = 0.f, lB = 0.f;
    ATT_WAIT_BAR(8);
    bf16x8 kf[8];
    NA_KLOAD(0);
    const int c0 = (c - 8) < 0 ? 0 : ((c - 8) > 48 ? 48 : (c - 8));
    const int vbase = 4 * hi - c0;
    const int rpoff = grp * 480 + (4 * hi - c + 15);
#pragma unroll 1
    for (int t = 0; t < ntile; ++t) {
        const int kr = lo + t; const bool actA = (kr >= r0A && kr < r0A + 8), actB = (kr >= r0B && kr < r0B + 8);
        lcp vb = (lcp)(lds + (t & 3) * 32768 + 16384 + voff);
        lcp vbF = vb + half * 2048, vbP = vb + (half ? 1536 : 2048);
        s16x4 vlo[2][3], vhh[2][3]; f32x16 pA0, pA1, pB0, pB1; u32x4 pwA[3], pwB[3];
        const float mhA = actA ? mhatA : INFINITY, mhB = actB ? mhatB : INFINITY;
        const int drA = (kr - rowA + 7) < 0 ? 0 : ((kr - rowA + 7) > 14 ? 14 : (kr - rowA + 7)), drB = (kr - rowB + 7) < 0 ? 0 : ((kr - rowB + 7) > 14 ? 14 : (kr - rowB + 7));
        int ro = rpoff; asm volatile("" : "+v"(ro));
        naq_mfma(pA0, pA1, kf, qA, vbase, fo, mhA);
        naq_mfma(pB0, pB1, kf, qB, vbase, fo, mhB);
        __builtin_amdgcn_sched_barrier(0);
        if (actA) naq_softmax<THR>(pA0, pA1, oA, mhatA, lA, kr == r0A, mhA, RPB + drA * 32 + ro, vbase, fo, pk0, wsf, r32, hi, pwA);
        if (actB) naq_softmax<THR>(pB0, pB1, oB, mhatB, lB, kr == r0B, mhB, RPB + drB * 32 + ro, vbase, fo, pk0, wsf, r32, hi, pwB);
        __builtin_amdgcn_sched_barrier(0);
        naq_vload(vlo, vhh, vbF, vbP);
        if (grp == 1) { NA_WAIT_BAR(t); NA_DMA(t + 3); if (t + 1 < ntile) NA_KLOAD((t + 1) & 3); }
        __builtin_amdgcn_sched_barrier(0);
        if (actA) naq_pv(oA, pwA, vlo, vhh);
        if (actB) naq_pv(oB, pwB, vlo, vhh);
        if (grp == 0) { NA_WAIT_BAR(t); NA_DMA(t + 3); if (t + 1 < ntile) NA_KLOAD((t + 1) & 3); }
    }
    ATT_WAIT_BAR(0);
#undef NA_DMA
#undef NA_WAIT_BAR
#undef NA_KLOAD
    const int hie = (int)(lane_id_now() >> 5);
    LAS bf16_t* stg = (LAS bf16_t*)(lds + 65536) + wid * 4096;
    { float rli[16]; row_inv_l(lA, rli, wsf, r32, hie);
#pragma unroll
      for (int d = 0; d < 2; ++d)
#pragma unroll
        for (int r = 0; r < 16; ++r) { const float v = oA[d][r] * rli[r]; stg[crow(r, hie) * 64 + d * 32 + r32] = (bf16_t)(cvtpk(v, v) & 0xffffu); } }
    { float rli[16]; row_inv_l(lB, rli, wsf, r32, hie);
#pragma unroll
      for (int d = 0; d < 2; ++d)
#pragma unroll
        for (int r = 0; r < 16; ++r) { const float v = oB[d][r] * rli[r]; stg[2048 + crow(r, hie) * 64 + d * 32 + r32] = (bf16_t)(cvtpk(v, v) & 0xffffu); } }
    bf16_t* yb = Y + (size_t)(rowA * 64 + 32 * half + (lane >> 3)) * D + h * 64 + (lane & 7) * 8;
    u32x4 sv[8];
#pragma unroll
    for (int i = 0; i < 8; ++i) sv[i] = *(const LAS u32x4*)(stg + (i >> 2) * 2048 + ((i & 3) * 8 + (lane >> 3)) * 64 + (lane & 7) * 8);
#pragma unroll
    for (int i = 0; i < 8; ++i) store16_wt(yb + (size_t)((i >> 2) * 128 + (i & 3) * 8) * D, sv[i]);
    ATT_WAIT_BAR(0);
}
}

struct Args { const float* in[14]; float* out; unsigned char* ws; };
__global__ void __launch_bounds__(NWAVES * 64, 2) enc_fwd(Args args) {
    extern __shared__ __attribute__((aligned(16))) unsigned char lds[];
    Frame F;
    F.lds = (LAS unsigned char*)lds;
    F.wave = __builtin_amdgcn_readfirstlane((int)threadIdx.x >> 6); F.G = gridDim.x; { const int bx = blockIdx.x; F.vcu = (F.G % 8 == 0) ? (bx % 8) * (F.G / 8) + bx / 8 : bx; }
    F.out = args.out; F.ws = args.ws;
    unsigned char* ws = args.ws;
    volatile LAS unsigned* MISC = (volatile LAS unsigned*)(F.lds + MISC_OFF);
    for (int u = threadIdx.x; u < (LDS_BYTES - LDSCTL_OFF) / 4; u += NWAVES * 64) ((LAS unsigned*)(F.lds + LDSCTL_OFF))[u] = 0u;
    __syncthreads();
    XcdBarrier bar; bar.bar = (unsigned*)(ws + WS_CTL) + CW_BAR; bar.x = 0; bar.st = nullptr; bar.wave = F.wave;
    bar = xcd_barrier_post((unsigned*)(ws + WS_CTL) + CW_BAR, MISC + 8, F.wave);
    p0_prologue(F);
    xcd_barrier(bar);
    const unsigned xcc = bar.x;
    const int nloc = __builtin_amdgcn_readfirstlane((int)MISC[8]), nx = __builtin_amdgcn_readfirstlane((int)MISC[9]);
    const int rank = __builtin_amdgcn_readfirstlane((int)MISC[10]), xi = __builtin_amdgcn_readfirstlane((int)MISC[11]);
    unsigned* lbar = (unsigned*)(ws + WS_CTL) + CW_BAR;
    unsigned lgen = 0;
#define LSEAM() xcc_local_barrier(lbar, xcc, (unsigned)nloc, F.wave, lgen)
    const bool wsplit = (nloc * nx == F.G) && (nx == BATCH);
    if (xi < BATCH) {
            const bool uniform = (nloc * nx == F.G) && (nx == BATCH);
            const int gsz = uniform ? (nx >> 1) : 0;
            const bool grpA = (gsz == 0) || (xi < gsz);
            const int gx = grpA ? xi : xi - gsz, gcount = gsz == 0 ? 1 : (grpA ? gsz : nx - gsz);
            const int gwx = uniform ? (gx * nloc + rank) * NWAVES + F.wave : F.vcu * NWAVES + F.wave, NGWx = uniform ? gcount * nloc * NWAVES : F.G * NWAVES;
            const int itMid = gsz == 0 ? P0_NITEMS : P0_I_IN + (P0_NITEMS - P0_I_IN) / 2;
            const int cit0 = grpA ? P0_I_IN : itMid, cit1 = grpA ? itMid : P0_NITEMS;
#pragma unroll 1
            for (int step = 0; step < 2; ++step) {
                if ((step == 0) == grpA) { p0_items(F, cit0, cit1, gwx, NGWx); __syncthreads();
                    if (gsz == 0) xcd_barrier(bar); }
                else {
                    unsigned char* wb = ws + WS_W; unsigned char* breg = ws + WS_QKV + (size_t)xi * BREG;
                    bf16_t* QKVb = (bf16_t*)breg; bf16_t* GATESb = (bf16_t*)(breg + BREG_GATES); bf16_t* XBb = (bf16_t*)(ws + WS_XNY) + (size_t)xi * MB * D; float* SSb = (float*)(ws + WS_SS) + (size_t)xi * MB * 4;
                    pg8::Gemm g{XBb, (const bf16_t*)(wb + WO_IN), MB, NIN, D, 0}; pg8::BatchOrder S{NIN / 256, nloc, rank, (12 + 4 * xi) % 20};
                    pg8::EpiProj E{QKVb, GATESb, SSb, ((nloc & 7) == 0) ? (LAS float*)(F.lds + ATT_WSF) : (LAS float*)nullptr};
                    pg8::gemm_phase<pg8::EpiProj, pg8::BatchOrder, true, true>(F.lds + RING_OFF, g, S, E, F.wave);
                    LSEAM();
                }
            }
        }
#pragma unroll 1
    for (int bb = xi; bb < BATCH; bb += nx) {
        unsigned char* breg = ws + WS_QKV + (size_t)bb * BREG;
        bf16_t* QKVb = (bf16_t*)breg; bf16_t* GATESb = (bf16_t*)(breg + BREG_GATES); bf16_t* MERGEDb = (bf16_t*)breg; bf16_t* HBb = (bf16_t*)breg;
        bf16_t* XBb = (bf16_t*)(ws + WS_XNY) + (size_t)bb * MB * D; float* SSb = (float*)(ws + WS_SS) + (size_t)bb * MB * 4;
        bf16_t* Yb = (bf16_t*)((unsigned char*)F.out + (size_t)bb * MB * D * 4);
        float* OUTb = F.out + (size_t)bb * MB * D;
#pragma unroll 1
        for (int L = 0; L < DEPTH; ++L) {
            unsigned char* wb = ws + WS_W + (size_t)L * W_LAYER;
            if (L > 0 || bb != xi) {
                pg8::Gemm g{XBb, (const bf16_t*)(wb + WO_IN), MB, NIN, D, 0}; pg8::BatchOrder S{NIN / 256, nloc, rank, (12 + 4 * xi) % 20};
                pg8::EpiProj E{QKVb, GATESb, SSb, ((nloc & 7) == 0) ? (LAS float*)(F.lds + ATT_WSF) : (LAS float*)nullptr};
                pg8::gemm_phase<pg8::EpiProj, pg8::BatchOrder, true, true>(F.lds + RING_OFF, g, S, E, F.wave);
                LSEAM();
            }
            {
#pragma unroll 1
                for (int u = 2 * rank; u < 64; u += 2 * nloc) { att::diff_unit<8>(F, L, QKVb, Yb, u >> 4, u & 15); att::diff_unit<8>(F, L, QKVb, Yb, (u + 1) >> 4, (u + 1) & 15); }
#pragma unroll 1
                for (int u = rank; u < 32; u += nloc) att::na_quad_unit<8>(F, L, QKVb, Yb, u);
            }
            if (L == 0 && bb == xi && wsplit) xcd_barrier(bar); else LSEAM();
            {
                pg8::Gemm g{Yb, (const bf16_t*)(wb + WO_M), MB, D, D, 0}; pg8::BatchOrder S{D / 256, nloc, rank, 0};
                pg8::EpiMerge E{MERGEDb, GATESb};
                pg8::gemm_phase<pg8::EpiMerge, pg8::BatchOrder, true, true>(F.lds + RING_OFF, g, S, E, F.wave);
            }
            LSEAM();
            {
                pg8::Gemm g{MERGEDb, (const bf16_t*)(wb + WO_OUT), MB, D, D, 2 * xi};     pg8::BatchOrder S{D / 256, nloc, rank, 0};
                pg8::EpiResid E{XBb, SSb, {}};
                pg8::gemm_phase<pg8::EpiResid, pg8::BatchOrder, true, true>(F.lds + RING_OFF, g, S, E, F.wave);
            }
            LSEAM();
            {
                pg8::Gemm g{XBb, (const bf16_t*)(wb + WO_FF1), MB, FF, D, 0}; pg8::BatchOrder S{FF / 256, nloc, rank, (4 * xi) % 16};
                pg8::EpiFF1 E{HBb, SSb, ((nloc & 7) == 0) ? (LAS float*)(F.lds + ATT_WSF) : (LAS float*)nullptr};
                pg8::gemm_phase<pg8::EpiFF1, pg8::BatchOrder, true, true>(F.lds + RING_OFF, g, S, E, F.wave);
            }
            LSEAM();
            {
                pg8::Gemm g{HBb, (const bf16_t*)(wb + WO_FF2), MB, D, FF, 8 * xi}; pg8::BatchOrder S{D / 256, nloc, rank, 0};
                if (L + 1 < DEPTH) { pg8::EpiResid E{XBb, SSb, {}};
                    pg8::gemm_phase<pg8::EpiResid, pg8::BatchOrder, true, true>(F.lds + RING_OFF, g, S, E, F.wave); }
                else { pg8::EpiFinal E{XBb, SSb, arg_in(2), OUTb, (unsigned*)(ws + WS_CTL) + CW_PANEL + bb * 8 * 64, {}};
                    pg8::gemm_phase<pg8::EpiFinal, pg8::BatchOrder, true, true>(F.lds + RING_OFF, g, S, E, F.wave); }
            }
            if (L + 1 < DEPTH) LSEAM();
        }
        if (bb + nx < BATCH) LSEAM();
    }
#undef LSEAM
}

extern "C" void kernel_launch(void* const* d_in, const int* in_sizes, int n_in, void* d_out, int out_size, void* d_ws, size_t ws_size, hipStream_t stream) {
    static int grid = 0;
    if (grid == 0) {
        if (n_in != 14 || in_sizes[0] != M * D || out_size != M * D || ws_size < WS_END) { fprintf(stderr, "kernel_launch: unexpected shapes (n_in %d, in0 %d, out %d, ws %zu); nothing launched\n", n_in, n_in > 0 ? in_sizes[0] : -1, out_size, ws_size); grid = -1; return; }
        int dev = 0, cus = 0;
        if (hipGetDevice(&dev) != hipSuccess || hipDeviceGetAttribute(&cus, hipDeviceAttributeMultiprocessorCount, dev) != hipSuccess) { grid = -1; return; }
        if (hipFuncSetAttribute((const void*)enc_fwd, hipFuncAttributeMaxDynamicSharedMemorySize, LDS_BYTES) != hipSuccess) { fprintf(stderr, "kernel_launch: hipFuncSetAttribute failed\n"); grid = -1; return; }
        int per_cu = 0;
        if (hipOccupancyMaxActiveBlocksPerMultiprocessor(&per_cu, (const void*)enc_fwd, NWAVES * 64, LDS_BYTES) != hipSuccess || per_cu < 1) fprintf(stderr, "kernel_launch: occupancy query reports %d per CU\n", per_cu);
        (void)hipGetLastError();
        grid = cus;
    }
    if (grid < 0) return;
    Args a{};
    for (int i = 0; i < 14; ++i) a.in[i] = (const float*)d_in[i];
    a.out = (float*)d_out; a.ws = (unsigned char*)d_ws;
    if (hipMemsetAsync((char*)d_ws + WS_CTL, 0, CTL_ZERO_BYTES, stream) != hipSuccess) { fprintf(stderr, "kernel_launch: memset failed\n"); return; }
    hipLaunchKernelGGL(enc_fwd, dim3(grid), dim3(NWAVES * 64), LDS_BYTES, stream, a);
}
```
